# Optimizing an MI355X kernel written in HIP

```python
import jax
import jax.numpy as jnp
from jax import lax
import numpy as np


D_MODEL = 1024
BATCH = 8
SEQ = 2048
DEPTH = 4

HEAD_DIM = 64
N_HEADS_A = D_MODEL // HEAD_DIM // 2
N_GROUPS_B = D_MODEL // HEAD_DIM // 2
WIDTH_A = N_HEADS_A * HEAD_DIM
WIDTH_B = N_GROUPS_B * HEAD_DIM
MIX_WIDTH = WIDTH_A + WIDTH_B
MIX_IN_WIDTH = 3 * WIDTH_A + 2 * WIDTH_B
DILATED_PATTERNS = ((128, 1), (512, 4), (2048, 16))
SGU_CHUNK = 128
RWKV_HEADS = D_MODEL // HEAD_DIM
D_DECAY_LORA = 64
D_AAA_LORA = 64
D_MV_LORA = 32
D_GATE_LORA = 160
RWKV_GN_EPS = 64e-5
N_EXPERTS = 16
N_EXPERT_GROUPS = 4
EXPERTS_PER_GROUP = N_EXPERTS // N_EXPERT_GROUPS
TOP_K = 2
D_EXPERT = 256
N_EVEN = (DEPTH + 1) // 2
N_ODD = DEPTH // 2
RMS_EPS = 1e-6

kernel_name = 'hybrid_dilated_sgu_rwkv7_grouped_moe'


def _rmsnorm(x):
    xf = x.astype(jnp.float32)
    return (xf * lax.rsqrt(jnp.mean(xf * xf, axis=-1, keepdims=True) + RMS_EPS)).astype(x.dtype)


def _ada(c_act, w, b):
    shift, scale, gate = jnp.split(c_act @ w + b, 3, axis=-1)
    return shift[:, None], scale[:, None], gate[:, None]


def _from_sub(t, S, L):
    B, R = t.shape[0], t.shape[1]
    rest = t.shape[4:]
    t = t.reshape((B, R, -1) + rest)[:, :, :L]
    return jnp.swapaxes(t, 1, 2).reshape((B, L * R) + rest)[:, :S]


def _dilated_branch(q, k, v, dilation, span):
    B, S, H, Dh = q.shape
    L = -(-S // dilation)
    n_blk = -(-L // span)
    Lp = n_blk * span

    def to_sub(t):
        t = jnp.pad(t, ((0, 0), (0, L * dilation - S), (0, 0), (0, 0)))
        t = jnp.swapaxes(t.reshape(B, L, dilation, H, Dh), 1, 2)
        t = jnp.pad(t, ((0, 0), (0, 0), (0, Lp - L), (0, 0), (0, 0)))
        return t.reshape(B, dilation, n_blk, span, H, Dh)

    def with_prev(t):
        prev = jnp.pad(t, ((0, 0), (0, 0), (1, 0), (0, 0), (0, 0), (0, 0)))[:, :, :-1]
        return jnp.concatenate([prev, t], axis=3)

    qb = to_sub(q)
    kw = with_prev(to_sub(k))
    vw = with_prev(to_sub(v))
    s = jnp.einsum('brnqhd,brnkhd->brnhqk', qb, kw).astype(jnp.float32) * (Dh ** -0.5)
    q_pos = jnp.arange(span)[:, None] + span
    k_pos = jnp.arange(2 * span)[None, :]
    dist = q_pos - k_pos
    band = (dist >= 0) & (dist <= span)
    no_prev = (jnp.arange(n_blk)[:, None, None] == 0) & (k_pos[None] < span)
    valid = band[None] & ~no_prev
    s = jnp.where(valid[:, None], s, -jnp.inf)
    m = jnp.max(s, axis=-1, keepdims=True)
    p = jnp.exp(s - m)
    den = jnp.sum(p, axis=-1, keepdims=True)
    o = jnp.einsum('brnhqk,brnkhd->brnhqd', p, vw.astype(jnp.float32)) / den
    lse = (m + jnp.log(den))[..., 0]
    o = jnp.swapaxes(o, 3, 4)
    lse = jnp.swapaxes(lse, 3, 4)
    return _from_sub(o, S, L), _from_sub(lse, S, L)


def _dilated_attention(q, k, v):
    outs, lses = [], []
    for window, dilation in DILATED_PATTERNS:
        o, lse = _dilated_branch(q, k, v, dilation, window // dilation)
        outs.append(o)
        lses.append(lse)
    wts = jax.nn.softmax(jnp.stack(lses), axis=0)
    o = jnp.sum(wts[..., None] * jnp.stack(outs), axis=0)
    return o.astype(q.dtype)


def _spatial_gating(u, z, norm_g, w_s, b_s):
    B, S, _ = u.shape
    u = jax.nn.gelu(u, approximate=False)
    z = _rmsnorm(jax.nn.gelu(z, approximate=False)) * norm_g
    zc = z.reshape(B, S // SGU_CHUNK, SGU_CHUNK, N_GROUPS_B, HEAD_DIM)
    causal = jnp.tril(jnp.ones((SGU_CHUNK, SGU_CHUNK), dtype=bool))
    w = jnp.where(causal, w_s, 0)
    mixed = jnp.einsum('gij,bcjgd->bcigd', w, zc) + b_s.T[:, :, None]
    return u * mixed.reshape(B, S, WIDTH_B)


def _even_mixer(h, w_in, w_out, sgu_norm_g, sgu_w, sgu_b):
    B, S, _ = h.shape
    proj = h @ w_in
    q, k, v, u, z = jnp.split(proj, [WIDTH_A, 2 * WIDTH_A, 3 * WIDTH_A, 3 * WIDTH_A + WIDTH_B], axis=-1)
    heads = lambda t: t.reshape(B, S, N_HEADS_A, HEAD_DIM)
    o_a = _dilated_attention(heads(q), heads(k), heads(v)).reshape(B, S, WIDTH_A)
    o_b = _spatial_gating(u, z, sgu_norm_g, sgu_w, sgu_b)
    return jnp.concatenate([o_a, o_b], axis=-1) @ w_out


def _wkv7(r, w_log, k, v, a, b):
    B, T, H, N = r.shape
    f32 = jnp.float32
    decay = jnp.exp(-jnp.exp(w_log.astype(f32)))
    seq = tuple(jnp.moveaxis(t.astype(f32), 1, 0) for t in (r, decay, k, v, a, b))

    def step(state, inp):
        r_t, w_t, k_t, v_t, a_t, b_t = inp
        sa = jnp.einsum('bhvk,bhk->bhv', state, a_t)
        state = (state * w_t[:, :, None, :] + sa[..., None] * b_t[:, :, None, :]
                 + v_t[..., None] * k_t[:, :, None, :])
        return state, jnp.einsum('bhvk,bhk->bhv', state, r_t)

    _, y = lax.scan(step, jnp.zeros((B, H, N, N), f32), seq)
    return jnp.moveaxis(y, 0, 1)


def _rwkv7_time_mix(h, v_first, vres, mu, w_rkv, w_o, w0, w1, w2, a0, a1, a2,
                    g1, g2, k_k, k_a, r_k, ln_w, ln_b):
    B, T, C = h.shape
    H, N = RWKV_HEADS, HEAD_DIM
    xx = jnp.pad(h, ((0, 0), (1, 0), (0, 0)))[:, :-1] - h
    xr, xw, xk, xv, xa, xg = [h + xx * mu[i] for i in range(6)]
    r = xr @ w_rkv[0]
    k = xk @ w_rkv[1]
    v = xv @ w_rkv[2]
    w = -jax.nn.softplus(-(w0 + jnp.tanh(xw @ w1) @ w2)) - 0.5
    if vres is None:
        v_first = v
    else:
        v0, v1, v2 = vres
        v = v + (v_first - v) * jax.nn.sigmoid(v0 + (xv @ v1) @ v2)
    a = jax.nn.sigmoid(a0 + (xa @ a1) @ a2)
    g = jax.nn.sigmoid(xg @ g1) @ g2
    heads = lambda t: t.reshape(B, T, H, N)
    kk = heads(k * k_k).astype(jnp.float32)
    kk = kk / jnp.maximum(jnp.linalg.norm(kk, axis=-1, keepdims=True), 1e-12)
    k = k * (1 + (a - 1) * k_a)
    rh, kh, vh, ah = heads(r), heads(k), heads(v), heads(a).astype(jnp.float32)
    y = _wkv7(rh, heads(w), kh, vh, -kk, kk * ah)
    mean = jnp.mean(y, axis=-1, keepdims=True)
    var = jnp.mean(jnp.square(y - mean), axis=-1, keepdims=True)
    y = ((y - mean) * lax.rsqrt(var + RWKV_GN_EPS)).reshape(B, T, C).astype(h.dtype)
    y = y * ln_w + ln_b
    y = y + (jnp.sum(rh * kh * r_k, axis=-1, keepdims=True) * vh).reshape(B, T, C)
    return (y * g) @ w_o, v_first


def _moe(h, router_w, router_b, w1, w3, w2):
    B, S, D = h.shape
    t = h.reshape(-1, D)
    n_tok = t.shape[0]
    s = jax.nn.sigmoid(t.astype(jnp.float32) @ router_w.astype(jnp.float32))
    sel = (s + router_b.astype(jnp.float32)).reshape(n_tok, N_EXPERT_GROUPS, EXPERTS_PER_GROUP)
    group_score = jnp.sum(lax.top_k(sel, TOP_K)[0], axis=-1)
    g_idx = jnp.argmax(group_score, axis=-1)
    in_group = sel[jnp.arange(n_tok), g_idx]
    _, local = lax.top_k(in_group, TOP_K)
    e_idx = g_idx[:, None] * EXPERTS_PER_GROUP + local
    wts = jnp.take_along_axis(s, e_idx, axis=1)
    wts = wts / jnp.sum(wts, axis=-1, keepdims=True)
    gates = jnp.sum(jax.nn.one_hot(e_idx, N_EXPERTS, dtype=jnp.float32) * wts[..., None], axis=1)
    gates = gates.astype(t.dtype)
    y = jnp.zeros_like(t)
    for e in range(N_EXPERTS):
        hid = jax.nn.silu(t @ w1[e]) * (t @ w3[e])
        y = y + gates[:, e:e + 1] * (hid @ w2[e])
    return y.reshape(B, S, D)


def setup_inputs(seed: int = 0) -> dict:
    key = jax.random.key(seed)
    ks = iter(jax.random.split(key, 48))
    nrm = lambda shape, scale: jax.random.normal(next(ks), shape, jnp.float32) * scale
    D = D_MODEL
    inp = {}
    inp['x'] = nrm((BATCH, SEQ, D), 1.0)
    inp['c'] = nrm((BATCH, D), 1.0)
    inp['ada_w'] = nrm((DEPTH, 2, D, 3 * D), 0.5 * D ** -0.5)
    inp['ada_b'] = nrm((DEPTH, 2, 3 * D), 0.02)
    inp['mix_w_in'] = nrm((N_EVEN, D, MIX_IN_WIDTH), D ** -0.5)
    inp['mix_w_out'] = nrm((N_EVEN, MIX_WIDTH, D), MIX_WIDTH ** -0.5)
    inp['sgu_norm_g'] = 1.0 + nrm((N_EVEN, WIDTH_B), 0.05)
    inp['sgu_w'] = nrm((N_EVEN, N_GROUPS_B, SGU_CHUNK, SGU_CHUNK), SGU_CHUNK ** -0.5)
    inp['sgu_b'] = 1.0 + nrm((N_EVEN, N_GROUPS_B, SGU_CHUNK), 0.1)
    inp['rwkv_mu'] = jax.random.uniform(next(ks), (N_ODD, 6, D), jnp.float32)
    inp['rwkv_w_rkv'] = nrm((N_ODD, 3, D, D), D ** -0.5)
    inp['rwkv_w_o'] = nrm((N_ODD, D, D), D ** -0.5)
    inp['rwkv_w0'] = jax.random.uniform(next(ks), (N_ODD, D), jnp.float32, -6.5, -1.5)
    inp['rwkv_w1'] = nrm((N_ODD, D, D_DECAY_LORA), D ** -0.5)
    inp['rwkv_w2'] = nrm((N_ODD, D_DECAY_LORA, D), 0.1 * D_DECAY_LORA ** -0.5)
    inp['rwkv_a0'] = nrm((N_ODD, D), 0.1)
    inp['rwkv_a1'] = nrm((N_ODD, D, D_AAA_LORA), D ** -0.5)
    inp['rwkv_a2'] = nrm((N_ODD, D_AAA_LORA, D), D_AAA_LORA ** -0.5)
    inp['rwkv_v0'] = 1.0 + nrm((N_ODD - 1, D), 0.1)
    inp['rwkv_v1'] = nrm((N_ODD - 1, D, D_MV_LORA), D ** -0.5)
    inp['rwkv_v2'] = nrm((N_ODD - 1, D_MV_LORA, D), D_MV_LORA ** -0.5)
    inp['rwkv_g1'] = nrm((N_ODD, D, D_GATE_LORA), D ** -0.5)
    inp['rwkv_g2'] = nrm((N_ODD, D_GATE_LORA, D), D_GATE_LORA ** -0.5)
    inp['rwkv_k_k'] = 0.85 + nrm((N_ODD, D), 0.05)
    inp['rwkv_k_a'] = 1.0 + nrm((N_ODD, D), 0.05)
    inp['rwkv_r_k'] = nrm((N_ODD, RWKV_HEADS, HEAD_DIM), 0.1)
    inp['rwkv_ln_w'] = 1.0 + nrm((N_ODD, D), 0.05)
    inp['rwkv_ln_b'] = nrm((N_ODD, D), 0.02)
    inp['router_w'] = nrm((D, N_EXPERTS), D ** -0.5)
    inp['router_b'] = nrm((N_EXPERTS,), 0.01)
    inp['moe_w1'] = nrm((DEPTH, N_EXPERTS, D, D_EXPERT), D ** -0.5)
    inp['moe_w3'] = nrm((DEPTH, N_EXPERTS, D, D_EXPERT), D ** -0.5)
    inp['moe_w2'] = nrm((DEPTH, N_EXPERTS, D_EXPERT, D), D_EXPERT ** -0.5)
    inp['final_norm_g'] = 1.0 + nrm((D,), 0.05)
    return inp


def reference(x, c, ada_w, ada_b, mix_w_in, mix_w_out, sgu_norm_g, sgu_w, sgu_b,
              rwkv_mu, rwkv_w_rkv, rwkv_w_o, rwkv_w0, rwkv_w1, rwkv_w2,
              rwkv_a0, rwkv_a1, rwkv_a2, rwkv_v0, rwkv_v1, rwkv_v2,
              rwkv_g1, rwkv_g2, rwkv_k_k, rwkv_k_a, rwkv_r_k, rwkv_ln_w, rwkv_ln_b,
              router_w, router_b, moe_w1, moe_w3, moe_w2, final_norm_g):
    c_act = jax.nn.silu(c)
    v_first = None
    for layer in range(DEPTH):
        i = layer // 2
        shift, scale, gate = _ada(c_act, ada_w[layer, 0], ada_b[layer, 0])
        h = _rmsnorm(x) * (1 + scale) + shift
        if layer % 2 == 0:
            y = _even_mixer(h, mix_w_in[i], mix_w_out[i], sgu_norm_g[i], sgu_w[i], sgu_b[i])
        else:
            vres = None if i == 0 else (rwkv_v0[i - 1], rwkv_v1[i - 1], rwkv_v2[i - 1])
            y, v_first = _rwkv7_time_mix(
                h, v_first, vres, rwkv_mu[i], rwkv_w_rkv[i], rwkv_w_o[i],
                rwkv_w0[i], rwkv_w1[i], rwkv_w2[i], rwkv_a0[i], rwkv_a1[i], rwkv_a2[i],
                rwkv_g1[i], rwkv_g2[i], rwkv_k_k[i], rwkv_k_a[i], rwkv_r_k[i],
                rwkv_ln_w[i], rwkv_ln_b[i])
        x = x + gate * y
        shift, scale, gate = _ada(c_act, ada_w[layer, 1], ada_b[layer, 1])
        h = _rmsnorm(x) * (1 + scale) + shift
        x = x + gate * _moe(h, router_w, router_b, moe_w1[layer], moe_w3[layer], moe_w2[layer])
    return _rmsnorm(x) * final_norm_g
```

```cpp
#include <hip/hip_runtime.h>
#include <stdint.h>
#include <stddef.h>
#ifndef NV_B
#define NV_B 8
#endif
#ifndef NV_S
#define NV_S 2048
#endif
#ifndef NV_BC
#define NV_BC 4
#endif
namespace nv {
constexpr int Bn = NV_B, S = NV_S, D = 1024, BC = NV_BC, TC = BC * S;
constexpr int HD = 64, NH = 8, WA = 512, WB = 512, MIXIN = 2560, CH = 128;
constexpr int RH = 16, LW = 64, LA = 64, LV = 32, LG = 160, NE = 16, DE = 256;

#ifdef CPU_EMU
#define NV_DEV static inline
#define NV_LAUNCH(body, n, ...) do { long long n__ = (long long)(n); _Pragma("omp parallel for schedule(dynamic, 256)") for (long long i__ = 0; i__ < n__; ++i__) body(i__, __VA_ARGS__); } while (0)
#else
#define NV_DEV __device__ __forceinline__
#define NV_LAUNCH(body, n, ...) do { long long n__ = (long long)(n); int nb__ = (int)((n__ + 255) / 256); hipLaunchKernelGGL(body##_k, dim3(nb__), dim3(256), 0, stream, n__, __VA_ARGS__); } while (0)
#endif

NV_DEV float sigm(float x) { return 1.f / (1.f + expf(-x)); }
NV_DEV float siluf(float x) { return x * sigm(x); }
NV_DEV float geluf(float x) { return 0.5f * x * (1.f + erff(x * 0.70710678118654752f)); }
NV_DEV float softplusf(float x) { return x > 20.f ? x : log1pf(expf(x)); }

#ifdef CPU_EMU
#define NV_KERNEL(name, ...) static inline void name(long long idx, __VA_ARGS__)
#define NV_KERNEL_END(name, ...)
#else
#define NV_KERNEL(name, ...) __device__ __forceinline__ void name(long long idx, __VA_ARGS__)
#endif

NV_KERNEL(ada_body, const float* c, const float* w, const float* bia, float* mod) {
    int n = (int)(idx % 3072); int b = (int)((idx / 3072) % Bn); int ls = (int)(idx / (3072 * Bn));
    const float* W = w + (size_t)ls * D * 3072; float acc = 0.f;
    for (int k = 0; k < D; ++k) acc += siluf(c[b * D + k]) * W[(size_t)k * 3072 + n];
    mod[idx] = acc + bia[ls * 3072 + n];
}
NV_KERNEL(rms_body, const float* x, int ld, int n, float* rinv) {
    const float* r = x + (size_t)idx * ld; float s = 0.f;
    for (int k = 0; k < n; ++k) s += r[k] * r[k];
    rinv[idx] = 1.f / sqrtf(s / (float)n + 1e-6f);
}
NV_KERNEL(modnorm_body, const float* x, const float* rinv, const float* mod, int b0, float* h) {
    int c = (int)(idx % D); long long t = idx / D; int b = b0 + (int)(t / S);
    const float* m = mod + (size_t)b * 3072;
    h[idx] = x[idx] * rinv[t] * (1.f + m[1024 + c]) + m[c];
}
NV_KERNEL(gemm_body, const float* A, int lda, const float* Bm, int ldb, float* C, int ldc, int N, int K, int act) {
    int n = (int)(idx % N); long long m = idx / N;
    const float* a = A + (size_t)m * lda; float acc = 0.f;
    for (int k = 0; k < K; ++k) acc += a[k] * Bm[(size_t)k * ldb + n];
    if (act == 1) acc = tanhf(acc); else if (act == 2) acc = sigm(acc);
    C[(size_t)m * ldc + n] = acc;
}
NV_KERNEL(gemm_res_body, const float* A, int lda, const float* Bm, int K, const float* mod, int b0, float* x) {
    int n = (int)(idx % D); long long m = idx / D; int b = b0 + (int)(m / S);
    const float* a = A + (size_t)m * lda; float acc = 0.f;
    for (int k = 0; k < K; ++k) acc += a[k] * Bm[(size_t)k * D + n];
    x[idx] += mod[(size_t)b * 3072 + 2048 + n] * acc;
}
NV_KERNEL(attn_body, const float* proj, float* o  ) {
    int dq = (int)(idx % 4); int hh = (int)((idx / 4) % NH); long long t = idx / (4 * NH);
    int tl = (int)(t % S); long long tb = t - tl;
    const float* q = proj + (size_t)t * MIXIN + hh * HD;
    float m = -INFINITY, l = 0.f; float acc[16];
#pragma unroll
    for (int d = 0; d < 16; ++d) acc[d] = 0.f;
    for (int br = 0; br < 3; ++br) {
        int dil = br == 0 ? 1 : (br == 1 ? 4 : 16);
        for (int j = 0; j <= 128; ++j) {
            int tk = tl - j * dil; if (tk < 0) break;
            const float* kp = proj + (size_t)(tb + tk) * MIXIN + WA + hh * HD;
            const float* vp = proj + (size_t)(tb + tk) * MIXIN + 2 * WA + hh * HD + dq * 16;
            float s = 0.f;
            for (int d = 0; d < HD; ++d) s += q[d] * kp[d];
            s *= 0.125f;
            float mn = fmaxf(m, s), sc = expf(m - mn), p = expf(s - mn);
            l = l * sc + p;
#pragma unroll
            for (int d = 0; d < 16; ++d) acc[d] = acc[d] * sc + p * vp[d];
            m = mn;
        }
    }
    float* op = o + (size_t)t * D + hh * HD + dq * 16;
#pragma unroll
    for (int d = 0; d < 16; ++d) op[d] = acc[d] / l;
}
NV_KERNEL(sgu_gelu_body, float* proj) {
    int c = (int)(idx % 1024); long long t = idx / 1024;
    float* p = proj + (size_t)t * MIXIN + 3 * WA + c; *p = geluf(*p);
}
NV_KERNEL(sgu_zn_body, float* proj, const float* rinvz, const float* ng) {
    int c = (int)(idx % WB); long long t = idx / WB;
    float* p = proj + (size_t)t * MIXIN + 3 * WA + WB + c; *p = *p * rinvz[t] * ng[c];
}
NV_KERNEL(sgu_mix_body, const float* proj, const float* w, const float* bs, float* o) {
    int c = (int)(idx % WB); long long t = idx / WB; int g = c / HD; int i = (int)(t % CH); long long t0 = t - i;
    const float* wr = w + ((size_t)g * CH + i) * CH; float acc = 0.f;
    for (int j = 0; j <= i; ++j) acc += wr[j] * proj[(size_t)(t0 + j) * MIXIN + 3 * WA + WB + c];
    acc += bs[g * CH + i];
    o[(size_t)t * D + WA + c] = proj[(size_t)t * MIXIN + 3 * WA + c] * acc;
}
NV_KERNEL(router_body, const float* h, const float* rw, const float* rb, int* eidx, float* ewt) {
    const float* r = h + (size_t)idx * D;
    float s[16];
#pragma unroll
    for (int e = 0; e < 16; ++e) s[e] = 0.f;
    for (int k = 0; k < D; ++k) { float hv = r[k];
#pragma unroll
        for (int e = 0; e < 16; ++e) s[e] += hv * rw[k * 16 + e]; }
    float sel[16];
#pragma unroll
    for (int e = 0; e < 16; ++e) { s[e] = sigm(s[e]); sel[e] = s[e] + rb[e]; }
    int bg = 0; float bgs = -INFINITY;
#pragma unroll
    for (int g = 0; g < 4; ++g) {
        float a0 = sel[4 * g], a1 = sel[4 * g + 1], a2 = sel[4 * g + 2], a3 = sel[4 * g + 3];
        float m1 = fmaxf(fmaxf(a0, a1), fmaxf(a2, a3));
        float tot = a0 + a1 + a2 + a3, mn = fminf(fminf(a0, a1), fminf(a2, a3));
        float lo01 = fminf(a0, a1), hi01 = fmaxf(a0, a1), lo23 = fminf(a2, a3), hi23 = fmaxf(a2, a3);
        float m2 = fmaxf(fminf(hi01, hi23), fmaxf(lo01, lo23));
        (void)tot; (void)mn;
        float gs = m1 + m2;
        if (gs > bgs) { bgs = gs; bg = g; }
    }
    int i0 = 0; float v0 = -INFINITY;
#pragma unroll
    for (int j = 0; j < 4; ++j) { float v = bg == 0 ? sel[j] : bg == 1 ? sel[4 + j] : bg == 2 ? sel[8 + j] : sel[12 + j]; if (v > v0) { v0 = v; i0 = j; } }
    int i1 = 0; float v1 = -INFINITY;
#pragma unroll
    for (int j = 0; j < 4; ++j) { float v = bg == 0 ? sel[j] : bg == 1 ? sel[4 + j] : bg == 2 ? sel[8 + j] : sel[12 + j]; if (j != i0 && v > v1) { v1 = v; i1 = j; } }
    int e0 = bg * 4 + i0, e1 = bg * 4 + i1; float w0 = 0.f, w1 = 0.f;
#pragma unroll
    for (int e = 0; e < 16; ++e) { if (e == e0) w0 = s[e]; if (e == e1) w1 = s[e]; }
    float inv = 1.f / (w0 + w1);
    eidx[idx * 2] = e0; eidx[idx * 2 + 1] = e1; ewt[idx * 2] = w0 * inv; ewt[idx * 2 + 1] = w1 * inv;
}
NV_KERNEL(moe_hid_body, const float* h, const int* eidx, const float* w1, const float* w3, float* hid) {
    int j = (int)(idx % DE); long long ts = idx / DE; long long t = ts >> 1; int e = eidx[ts];
    const float* r = h + (size_t)t * D; const float* W1 = w1 + (size_t)e * D * DE; const float* W3 = w3 + (size_t)e * D * DE;
    float a = 0.f, b = 0.f;
    for (int k = 0; k < D; ++k) { float hv = r[k]; a += hv * W1[(size_t)k * DE + j]; b += hv * W3[(size_t)k * DE + j]; }
    hid[idx] = siluf(a) * b;
}
NV_KERNEL(moe_out_body, const float* hid, const int* eidx, const float* ewt, const float* w2, const float* mod, int b0, float* x) {
    int n = (int)(idx % D); long long t = idx / D; int b = b0 + (int)(t / S); float y = 0.f;
    for (int sl = 0; sl < 2; ++sl) { int e = eidx[t * 2 + sl]; const float* W2 = w2 + (size_t)e * DE * D; const float* hr = hid + ((size_t)t * 2 + sl) * DE; float acc = 0.f;
        for (int j = 0; j < DE; ++j) acc += hr[j] * W2[(size_t)j * D + n];
        y += ewt[t * 2 + sl] * acc; }
    x[idx] += mod[(size_t)b * 3072 + 2048 + n] * y;
}
NV_KERNEL(rk_mix_body, const float* h, const float* mu, float* xm) {
    int c = (int)(idx % D); long long t = idx / D; int tl = (int)(t % S);
    float hv = h[idx], hp = tl == 0 ? 0.f : h[idx - D];
    xm[idx] = hv + (hp - hv) * mu[c];
}
NV_KERNEL(rk_prep_body, const float* wl, const float* w2, const float* w0, const float* al, const float* a2, const float* a0,
          const float* vl, const float* v2, const float* v0, const float* vfirst, float* v, float* wd, float* av) {
    int c = (int)(idx % D); long long t = idx / D;
    float acc = 0.f; for (int j = 0; j < LW; ++j) acc += wl[t * LW + j] * w2[(size_t)j * D + c];
    float w = -softplusf(-(w0[c] + acc)) - 0.5f; wd[idx] = expf(-expf(w));
    acc = 0.f; for (int j = 0; j < LA; ++j) acc += al[t * LA + j] * a2[(size_t)j * D + c];
    av[idx] = sigm(a0[c] + acc);
    if (vl) { acc = 0.f; for (int j = 0; j < LV; ++j) acc += vl[t * LV + j] * v2[(size_t)j * D + c];
        float vv = v[idx]; v[idx] = vv + (vfirst[idx] - vv) * sigm(v0[c] + acc); }
}
NV_KERNEL(wkv_body, const float* r, const float* wd, const float* k, const float* v, const float* av, const float* k_k, const float* k_a, float* y) {
    int vr = (int)(idx % HD); int hh = (int)((idx / HD) % RH); long long bl = idx / (HD * RH);
    float st[HD];
#pragma unroll
    for (int i = 0; i < HD; ++i) st[i] = 0.f;
    const float* kkw = k_k + hh * HD; const float* kaw = k_a + hh * HD;
    for (int t = 0; t < S; ++t) {
        size_t base = ((size_t)bl * S + t) * D + hh * HD;
        float nrm = 0.f;
#pragma unroll
        for (int i = 0; i < HD; ++i) { float kv = k[base + i] * kkw[i]; nrm += kv * kv; }
        float inv = 1.f / fmaxf(sqrtf(nrm), 1e-12f);
        float sa = 0.f;
#pragma unroll
        for (int i = 0; i < HD; ++i) { float kkv = k[base + i] * kkw[i] * inv; sa += st[i] * (-kkv); }
        float vv = v[base + vr], yv = 0.f;
#pragma unroll
        for (int i = 0; i < HD; ++i) {
            float ko = k[base + i], a = av[base + i]; float kkv = ko * kkw[i] * inv; float kn = ko * (1.f + (a - 1.f) * kaw[i]);
            st[i] = st[i] * wd[base + i] + sa * (kkv * a) + vv * kn;
            yv += st[i] * r[base + i];
        }
        y[base + vr] = yv;
    }
}
NV_KERNEL(rk_post_body, const float* y, const float* r, const float* k, const float* v, const float* av, const float* k_a, const float* r_k,
          const float* lnw, const float* lnb, const float* gl, const float* g2, float* outA) {
    int hh = (int)(idx % RH); long long t = idx / RH; size_t base = (size_t)t * D + hh * HD;
    float mean = 0.f; for (int i = 0; i < HD; ++i) mean += y[base + i]; mean *= (1.f / HD);
    float var = 0.f; for (int i = 0; i < HD; ++i) { float d = y[base + i] - mean; var += d * d; } var *= (1.f / HD);
    float rstd = 1.f / sqrtf(var + 64e-5f);
    float rk = 0.f; for (int i = 0; i < HD; ++i) { int c = hh * HD + i; float kn = k[base + i] * (1.f + (av[base + i] - 1.f) * k_a[c]); rk += r[base + i] * kn * r_k[c]; }
    for (int i = 0; i < HD; ++i) { int c = hh * HD + i;
        float g = 0.f; for (int j = 0; j < LG; ++j) g += gl[t * LG + j] * g2[(size_t)j * D + c];
        float yy = (y[base + i] - mean) * rstd * lnw[c] + lnb[c] + rk * v[base + i];
        outA[base + i] = yy * g; }
}
NV_KERNEL(copy_body, const float* src, float* dst) { dst[idx] = src[idx]; }
NV_KERNEL(final_body, const float* x, const float* rinv, const float* g, float* out) { int c = (int)(idx % D); long long t = idx / D; out[idx] = x[idx] * rinv[t] * g[c]; }

#ifndef CPU_EMU
#define NV_WRAP(body, ...)
template <class F> __global__ void __launch_bounds__(256) generic_k(long long n, F f) { long long i = (long long)blockIdx.x * 256 + threadIdx.x; if (i < n) f(i); }
__global__ void __launch_bounds__(256) ada_body_k(long long n, const float* c, const float* w, const float* bia, float* mod) { long long i = (long long)blockIdx.x * 256 + threadIdx.x; if (i < n) ada_body(i, c, w, bia, mod); }
__global__ void __launch_bounds__(256) rms_body_k(long long n, const float* x, int ld, int nn, float* rinv) { long long i = (long long)blockIdx.x * 256 + threadIdx.x; if (i < n) rms_body(i, x, ld, nn, rinv); }
__global__ void __launch_bounds__(256) modnorm_body_k(long long n, const float* x, const float* rinv, const float* mod, int b0, float* h) { long long i = (long long)blockIdx.x * 256 + threadIdx.x; if (i < n) modnorm_body(i, x, rinv, mod, b0, h); }
__global__ void __launch_bounds__(256) gemm_body_k(long long n, const float* A, int lda, const float* Bm, int ldb, float* C, int ldc, int N, int K, int act) { long long i = (long long)blockIdx.x * 256 + threadIdx.x; if (i < n) gemm_body(i, A, lda, Bm, ldb, C, ldc, N, K, act); }
__global__ void __launch_bounds__(256) gemm_res_body_k(long long n, const float* A, int lda, const float* Bm, int K, const float* mod, int b0, float* x) { long long i = (long long)blockIdx.x * 256 + threadIdx.x; if (i < n) gemm_res_body(i, A, lda, Bm, K, mod, b0, x); }
__global__ void __launch_bounds__(256) attn_body_k(long long n, const float* proj, float* o) { long long i = (long long)blockIdx.x * 256 + threadIdx.x; if (i < n) attn_body(i, proj, o); }
__global__ void __launch_bounds__(256) sgu_gelu_body_k(long long n, float* proj) { long long i = (long long)blockIdx.x * 256 + threadIdx.x; if (i < n) sgu_gelu_body(i, proj); }
__global__ void __launch_bounds__(256) sgu_zn_body_k(long long n, float* proj, const float* rinvz, const float* ng) { long long i = (long long)blockIdx.x * 256 + threadIdx.x; if (i < n) sgu_zn_body(i, proj, rinvz, ng); }
__global__ void __launch_bounds__(256) sgu_mix_body_k(long long n, const float* proj, const float* w, const float* bs, float* o) { long long i = (long long)blockIdx.x * 256 + threadIdx.x; if (i < n) sgu_mix_body(i, proj, w, bs, o); }
__global__ void __launch_bounds__(256) router_body_k(long long n, const float* h, const float* rw, const float* rb, int* eidx, float* ewt) { long long i = (long long)blockIdx.x * 256 + threadIdx.x; if (i < n) router_body(i, h, rw, rb, eidx, ewt); }
__global__ void __launch_bounds__(256) moe_hid_body_k(long long n, const float* h, const int* eidx, const float* w1, const float* w3, float* hid) { long long i = (long long)blockIdx.x * 256 + threadIdx.x; if (i < n) moe_hid_body(i, h, eidx, w1, w3, hid); }
__global__ void __launch_bounds__(256) moe_out_body_k(long long n, const float* hid, const int* eidx, const float* ewt, const float* w2, const float* mod, int b0, float* x) { long long i = (long long)blockIdx.x * 256 + threadIdx.x; if (i < n) moe_out_body(i, hid, eidx, ewt, w2, mod, b0, x); }
__global__ void __launch_bounds__(256) rk_mix_body_k(long long n, const float* h, const float* mu, float* xm) { long long i = (long long)blockIdx.x * 256 + threadIdx.x; if (i < n) rk_mix_body(i, h, mu, xm); }
__global__ void __launch_bounds__(256) rk_prep_body_k(long long n, const float* wl, const float* w2, const float* w0, const float* al, const float* a2, const float* a0, const float* vl, const float* v2, const float* v0, const float* vfirst, float* v, float* wd, float* av) { long long i = (long long)blockIdx.x * 256 + threadIdx.x; if (i < n) rk_prep_body(i, wl, w2, w0, al, a2, a0, vl, v2, v0, vfirst, v, wd, av); }
__global__ void __launch_bounds__(256) wkv_body_k(long long n, const float* r, const float* wd, const float* k, const float* v, const float* av, const float* k_k, const float* k_a, float* y) { long long i = (long long)blockIdx.x * 256 + threadIdx.x; if (i < n) wkv_body(i, r, wd, k, v, av, k_k, k_a, y); }
__global__ void __launch_bounds__(256) rk_post_body_k(long long n, const float* y, const float* r, const float* k, const float* v, const float* av, const float* k_a, const float* r_k, const float* lnw, const float* lnb, const float* gl, const float* g2, float* outA) { long long i = (long long)blockIdx.x * 256 + threadIdx.x; if (i < n) rk_post_body(i, y, r, k, v, av, k_a, r_k, lnw, lnb, gl, g2, outA); }
__global__ void __launch_bounds__(256) copy_body_k(long long n, const float* src, float* dst) { long long i = (long long)blockIdx.x * 256 + threadIdx.x; if (i < n) copy_body(i, src, dst); }
__global__ void __launch_bounds__(256) final_body_k(long long n, const float* x, const float* rinv, const float* g, float* out) { long long i = (long long)blockIdx.x * 256 + threadIdx.x; if (i < n) final_body(i, x, rinv, g, out); }
#endif

#ifdef CPU_EMU
#define NV_STREAM_ARG
#define NV_STREAM_PARAM
#else
#define NV_STREAM_ARG , stream
#define NV_STREAM_PARAM , hipStream_t stream
#endif
static size_t naive_ws_floats() { return (size_t)8 * Bn * 3072 + (size_t)TC * 6 + (size_t)TC * 320 + (size_t)Bn * S * D + (size_t)6 * TC * D; }

static void naive_forward(void* const* d_in, float* xw, float* ws NV_STREAM_PARAM) {
    const float* in[34]; for (int i = 0; i < 34; ++i) in[i] = (const float*)d_in[i];
    const float *x_in = in[0], *c = in[1], *ada_w = in[2], *ada_b = in[3], *mix_w_in = in[4], *mix_w_out = in[5], *sgu_ng = in[6], *sgu_w = in[7], *sgu_b = in[8];
    const float *mu = in[9], *w_rkv = in[10], *w_o = in[11], *w0 = in[12], *w1 = in[13], *w2 = in[14], *a0 = in[15], *a1 = in[16], *a2 = in[17], *v0 = in[18], *v1 = in[19], *v2 = in[20];
    const float *g1 = in[21], *g2 = in[22], *k_k = in[23], *k_a = in[24], *r_k = in[25], *ln_w = in[26], *ln_b = in[27], *router_w = in[28], *router_b = in[29];
    const float *moe_w1 = in[30], *moe_w3 = in[31], *moe_w2 = in[32], *fng = in[33];
    float* p = ws;
    float* mod = p; p += (size_t)8 * Bn * 3072;
    float* rinv = p; p += TC; float* rinvz = p; p += TC;
    int* eidx = (int*)p; p += 2 * TC; float* ewt = p; p += 2 * TC;
    float* lwl = p; p += (size_t)TC * LW; float* lal = p; p += (size_t)TC * LA; float* lvl = p; p += (size_t)TC * LV; float* lgl = p; p += (size_t)TC * LG;
    float* vfirst = p; p += (size_t)Bn * S * D;
    float* big = p; const size_t BUF = (size_t)TC * D;
    float* h = big;
    float* proj = big + BUF;
    float* obuf = big + 4 * BUF;
    float* hid = big + BUF;
    float* R = big + BUF, *Kb = big + 2 * BUF, *Vb = big + 3 * BUF, *XM = big + 4 * BUF, *Wd = big + 4 * BUF  , *Av = big + 5 * BUF, *Y = big;

    NV_LAUNCH(copy_body, (size_t)Bn * S * D, x_in, xw);
    NV_LAUNCH(ada_body, (size_t)8 * Bn * 3072, c, ada_w, ada_b, mod);
    for (int layer = 0; layer < 4; ++layer) {
        const int li = layer / 2;
        for (int b0 = 0; b0 < Bn; b0 += BC) {
            float* x = xw + (size_t)b0 * S * D;
            const float* m0 = mod + (size_t)(layer * 2 + 0) * Bn * 3072; const float* m1 = mod + (size_t)(layer * 2 + 1) * Bn * 3072;
            NV_LAUNCH(rms_body, TC, x, D, D, rinv);
            NV_LAUNCH(modnorm_body, BUF, x, rinv, m0, b0, h);
            if (layer % 2 == 0) {
                NV_LAUNCH(gemm_body, (size_t)TC * MIXIN, h, D, mix_w_in + (size_t)li * D * MIXIN, MIXIN, proj, MIXIN, MIXIN, D, 0);
                NV_LAUNCH(attn_body, (size_t)TC * NH * 4, proj, obuf);
                NV_LAUNCH(sgu_gelu_body, (size_t)TC * 1024, proj);
                NV_LAUNCH(rms_body, TC, proj + 3 * WA + WB, MIXIN, WB, rinvz);
                NV_LAUNCH(sgu_zn_body, (size_t)TC * WB, proj, rinvz, sgu_ng + li * WB);
                NV_LAUNCH(sgu_mix_body, (size_t)TC * WB, proj, sgu_w + (size_t)li * 8 * CH * CH, sgu_b + li * 8 * CH, obuf);
                NV_LAUNCH(gemm_res_body, BUF, obuf, D, mix_w_out + (size_t)li * D * D, D, m0, b0, x);
            } else {
                const float* muL = mu + (size_t)li * 6 * D;
                float* vf = vfirst + (size_t)b0 * S * D;
                NV_LAUNCH(rk_mix_body, BUF, h, muL + 0 * D, XM); NV_LAUNCH(gemm_body, BUF, XM, D, w_rkv + ((size_t)li * 3 + 0) * D * D, D, R, D, D, D, 0);
                NV_LAUNCH(rk_mix_body, BUF, h, muL + 1 * D, XM); NV_LAUNCH(gemm_body, (size_t)TC * LW, XM, D, w1 + (size_t)li * D * LW, LW, lwl, LW, LW, D, 1);
                NV_LAUNCH(rk_mix_body, BUF, h, muL + 2 * D, XM); NV_LAUNCH(gemm_body, BUF, XM, D, w_rkv + ((size_t)li * 3 + 1) * D * D, D, Kb, D, D, D, 0);
                NV_LAUNCH(rk_mix_body, BUF, h, muL + 3 * D, XM); NV_LAUNCH(gemm_body, BUF, XM, D, w_rkv + ((size_t)li * 3 + 2) * D * D, D, Vb, D, D, D, 0);
                if (li > 0) NV_LAUNCH(gemm_body, (size_t)TC * LV, XM, D, v1 + (size_t)(li - 1) * D * LV, LV, lvl, LV, LV, D, 0);
                NV_LAUNCH(rk_mix_body, BUF, h, muL + 4 * D, XM); NV_LAUNCH(gemm_body, (size_t)TC * LA, XM, D, a1 + (size_t)li * D * LA, LA, lal, LA, LA, D, 0);
                NV_LAUNCH(rk_mix_body, BUF, h, muL + 5 * D, XM); NV_LAUNCH(gemm_body, (size_t)TC * LG, XM, D, g1 + (size_t)li * D * LG, LG, lgl, LG, LG, D, 2);
                if (li == 0) {
                    NV_LAUNCH(rk_prep_body, BUF, lwl, w2 + (size_t)li * LW * D, w0 + li * D, lal, a2 + (size_t)li * LA * D, a0 + li * D,
                              (const float*)nullptr, (const float*)nullptr, (const float*)nullptr, (const float*)nullptr, Vb, Wd, Av);
                    NV_LAUNCH(copy_body, BUF, Vb, vf);
                } else {
                    NV_LAUNCH(rk_prep_body, BUF, lwl, w2 + (size_t)li * LW * D, w0 + li * D, lal, a2 + (size_t)li * LA * D, a0 + li * D,
                              lvl, v2 + (size_t)(li - 1) * LV * D, v0 + (li - 1) * D, vf, Vb, Wd, Av);
                }
                NV_LAUNCH(wkv_body, (size_t)BC * RH * HD, R, Wd, Kb, Vb, Av, k_k + li * D, k_a + li * D, Y);
                NV_LAUNCH(rk_post_body, (size_t)TC * RH, Y, R, Kb, Vb, Av, k_a + li * D, r_k + li * D, ln_w + li * D, ln_b + li * D, lgl, g2 + (size_t)li * LG * D, Wd);
                NV_LAUNCH(gemm_res_body, BUF, Wd, D, w_o + (size_t)li * D * D, D, m0, b0, x);
            }
            NV_LAUNCH(rms_body, TC, x, D, D, rinv);
            NV_LAUNCH(modnorm_body, BUF, x, rinv, m1, b0, h);
            NV_LAUNCH(router_body, TC, h, router_w, router_b, eidx, ewt);
            NV_LAUNCH(moe_hid_body, (size_t)TC * 2 * DE, h, eidx, moe_w1 + (size_t)layer * NE * D * DE, moe_w3 + (size_t)layer * NE * D * DE, hid);
            NV_LAUNCH(moe_out_body, BUF, hid, eidx, ewt, moe_w2 + (size_t)layer * NE * DE * D, m1, b0, x);
        }
    }
    for (int b0 = 0; b0 < Bn; b0 += BC) {
        float* x = xw + (size_t)b0 * S * D;
        NV_LAUNCH(rms_body, TC, x, D, D, rinv);
        NV_LAUNCH(final_body, (size_t)TC * D, x, rinv, fng, x);
    }
}
}

extern "C" void kernel_launch(void* const* d_in, const int* in_sizes, int n_in, void* d_out, int out_size, void* d_ws, size_t ws_size, hipStream_t stream) {
    (void)in_sizes; (void)n_in; (void)out_size;
    if (ws_size < nv::naive_ws_floats() * sizeof(float)) return;
    nv::naive_forward(d_in, (float*)d_out, (float*)d_ws, stream);
}
```

```cpp
#include <hip/hip_runtime.h>
#include <stdint.h>
#include <stddef.h>
#include <math.h>
#include <stdio.h>
#define NV_PERSIST 1
#define GAS __attribute__((address_space(1)))
#define LAS __attribute__((address_space(3)))
#define XB_TMO      128
#define XB_XCNT(j)  (256  + 64 * (j))
#define XB_XSUB(j)  (1280 + 64 * (j))
#define XB_XGEN(j)  (2304 + 64 * (j))
#define XB_TOP      3328
#define XB_TOPGEN   3392
#define XCD_BAR_WORDS 3456
#define XB_SPIN_CAP (1u << 22)
__device__ __forceinline__ unsigned xb_ld(unsigned* p)              { return __hip_atomic_load(p, __ATOMIC_RELAXED, __HIP_MEMORY_SCOPE_AGENT); }
__device__ __forceinline__ unsigned xb_add(unsigned* p, unsigned v) { return __hip_atomic_fetch_add(p, v, __ATOMIC_RELAXED, __HIP_MEMORY_SCOPE_AGENT); }
__device__ __forceinline__ unsigned xb_xcc_id() { return (unsigned)__builtin_amdgcn_s_getreg((3 << 11) | 20) & 0xFu; }
#define XB_SPIN(cond, bar) do { unsigned _sp = 0; while (cond) { __builtin_amdgcn_s_sleep(1); \
    if ((++_sp & 255u) == 0u) { if (xb_ld(&(bar)[XB_TMO])) break; if (_sp > XB_SPIN_CAP) { atomicAdd(&(bar)[XB_TMO], 1u); break; } } } } while (0)
struct XcdBarrier { unsigned* bar; unsigned x; volatile LAS unsigned* st; };
__device__ __forceinline__ XcdBarrier xcd_barrier_post(unsigned* bar, volatile LAS unsigned* st) {
    XcdBarrier b; b.bar = bar; b.x = xb_xcc_id(); b.st = st;
    if (threadIdx.x == 0) (void)xb_add(&bar[XB_XCNT(b.x)], 1u);
    return b;
}
__device__ __forceinline__ void xcd_barrier_complete(unsigned* bar, unsigned x, unsigned& nloc, unsigned& nx) {
    const unsigned G = gridDim.x * gridDim.y * gridDim.z;
    unsigned sum, cnt, mine, sp = 0u;
    for (;;) {
        sum = 0u; cnt = 0u; mine = 0u;
#pragma unroll
        for (unsigned j = 0; j < 16; ++j) { const unsigned c = xb_ld(&bar[XB_XCNT(j)]); sum += c; cnt += (c > 0u) ? 1u : 0u; mine = (j == x) ? c : mine; }
        if (sum == G) break;
        __builtin_amdgcn_s_sleep(1);
        if ((++sp & 255u) == 0u) { if (xb_ld(&bar[XB_TMO])) break; if (sp > XB_SPIN_CAP) { atomicAdd(&bar[XB_TMO], 1u); break; } }
    }
    nloc = mine > 0u ? mine : 1u; nx = cnt > 0u ? cnt : 1u;
}
__device__ __forceinline__ void xcd_barrier(const XcdBarrier& b) {
    asm volatile("s_waitcnt vmcnt(0)" ::: "memory");
    __syncthreads();
    if (threadIdx.x == 0) {
        unsigned* bar = b.bar;
        __builtin_amdgcn_s_waitcnt(0);
        unsigned nloc = b.st[0], nx = b.st[1];
        if (nloc == 0u) { xcd_barrier_complete(bar, b.x, nloc, nx); b.st[0] = nloc; b.st[1] = nx; }
        const unsigned old = xb_add(&bar[XB_XSUB(b.x)], 1u);
        const unsigned gen = old / nloc;
        if (old + 1u == (gen + 1u) * nloc) {
            __builtin_amdgcn_fence(__ATOMIC_RELEASE, "agent");
            asm volatile("s_waitcnt vmcnt(0)" ::: "memory");
            const unsigned og = xb_add(&bar[XB_TOP], 1u);
            const unsigned tg = og / nx;
            if (og + 1u == (tg + 1u) * nx) xb_add(&bar[XB_TOPGEN], 1u);
            else XB_SPIN(xb_ld(&bar[XB_TOPGEN]) == tg, bar);
            __builtin_amdgcn_fence(__ATOMIC_ACQUIRE, "agent");
            xb_add(&bar[XB_XGEN(b.x)], 1u);
            asm volatile("s_waitcnt vmcnt(0)" ::: "memory");
        } else {
            XB_SPIN(xb_ld(&bar[XB_XGEN(b.x)]) == gen, bar);
            __builtin_amdgcn_fence(__ATOMIC_ACQUIRE, "agent");
            asm volatile("s_waitcnt vmcnt(0)" ::: "memory");
        }
    }
    __syncthreads();
}
constexpr int RING_BYTES = 131072;
constexpr int LDSCTL_OFF = RING_BYTES;
constexpr int MISC_OFF = LDSCTL_OFF + 320;
constexpr int LDS_BYTES = 147456;
constexpr int NTHREADS = 512;
#ifndef NV_B
#define NV_B 8
#endif
#ifndef NV_S
#define NV_S 2048
#endif
#ifndef NV_BC
#define NV_BC 4
#endif
namespace nv {
constexpr int Bn = NV_B, S = NV_S, D = 1024, BC = NV_BC, TC = BC * S;
constexpr int HD = 64, NH = 8, WA = 512, WB = 512, MIXIN = 2560, CH = 128;
constexpr int RH = 16, LW = 64, LA = 64, LV = 32, LG = 160, NE = 16, DE = 256;

#ifdef CPU_EMU
#define NV_DEV static inline
#define NV_LAUNCH(body, n, ...) do { long long n__ = (long long)(n); _Pragma("omp parallel for schedule(dynamic, 256)") for (long long i__ = 0; i__ < n__; ++i__) body(i__, __VA_ARGS__); } while (0)
#elif defined(NV_PERSIST)
#define NV_DEV __device__ __forceinline__
#define NV_LAUNCH(body, n, ...) do { long long n__ = (long long)(n); for (long long i__ = nv_gtid; i__ < n__; i__ += nv_nthr) body(i__, __VA_ARGS__); NV_GRID_BARRIER(); } while (0)
#else
#define NV_DEV __device__ __forceinline__
#define NV_LAUNCH(body, n, ...) do { long long n__ = (long long)(n); int nb__ = (int)((n__ + 255) / 256); hipLaunchKernelGGL(body##_k, dim3(nb__), dim3(256), 0, stream, n__, __VA_ARGS__); } while (0)
#endif

NV_DEV float sigm(float x) { return 1.f / (1.f + expf(-x)); }
NV_DEV float siluf(float x) { return x * sigm(x); }
NV_DEV float geluf(float x) { return 0.5f * x * (1.f + erff(x * 0.70710678118654752f)); }
NV_DEV float softplusf(float x) { return x > 20.f ? x : log1pf(expf(x)); }

#ifdef CPU_EMU
#define NV_KERNEL(name, ...) static inline void name(long long idx, __VA_ARGS__)
#define NV_KERNEL_END(name, ...)
#else
#define NV_KERNEL(name, ...) __device__ __forceinline__ void name(long long idx, __VA_ARGS__)
#endif

NV_KERNEL(ada_body, const float* c, const float* w, const float* bia, float* mod) {
    int n = (int)(idx % 3072); int b = (int)((idx / 3072) % Bn); int ls = (int)(idx / (3072 * Bn));
    const float* W = w + (size_t)ls * D * 3072; float acc = 0.f;
    for (int k = 0; k < D; ++k) acc += siluf(c[b * D + k]) * W[(size_t)k * 3072 + n];
    mod[idx] = acc + bia[ls * 3072 + n];
}
NV_KERNEL(rms_body, const float* x, int ld, int n, float* rinv) {
    const float* r = x + (size_t)idx * ld; float s = 0.f;
    for (int k = 0; k < n; ++k) s += r[k] * r[k];
    rinv[idx] = 1.f / sqrtf(s / (float)n + 1e-6f);
}
NV_KERNEL(modnorm_body, const float* x, const float* rinv, const float* mod, int b0, float* h) {
    int c = (int)(idx % D); long long t = idx / D; int b = b0 + (int)(t / S);
    const float* m = mod + (size_t)b * 3072;
    h[idx] = x[idx] * rinv[t] * (1.f + m[1024 + c]) + m[c];
}
NV_KERNEL(gemm_body, const float* A, int lda, const float* Bm, int ldb, float* C, int ldc, int N, int K, int act) {
    int n = (int)(idx % N); long long m = idx / N;
    const float* a = A + (size_t)m * lda; float acc = 0.f;
    for (int k = 0; k < K; ++k) acc += a[k] * Bm[(size_t)k * ldb + n];
    if (act == 1) acc = tanhf(acc); else if (act == 2) acc = sigm(acc);
    C[(size_t)m * ldc + n] = acc;
}
NV_KERNEL(gemm_res_body, const float* A, int lda, const float* Bm, int K, const float* mod, int b0, float* x) {
    int n = (int)(idx % D); long long m = idx / D; int b = b0 + (int)(m / S);
    const float* a = A + (size_t)m * lda; float acc = 0.f;
    for (int k = 0; k < K; ++k) acc += a[k] * Bm[(size_t)k * D + n];
    x[idx] += mod[(size_t)b * 3072 + 2048 + n] * acc;
}
NV_KERNEL(attn_body, const float* proj, float* o  ) {
    int dq = (int)(idx % 4); int hh = (int)((idx / 4) % NH); long long t = idx / (4 * NH);
    int tl = (int)(t % S); long long tb = t - tl;
    const float* q = proj + (size_t)t * MIXIN + hh * HD;
    float m = -INFINITY, l = 0.f; float acc[16];
#pragma unroll
    for (int d = 0; d < 16; ++d) acc[d] = 0.f;
    for (int br = 0; br < 3; ++br) {
        int dil = br == 0 ? 1 : (br == 1 ? 4 : 16);
        for (int j = 0; j <= 128; ++j) {
            int tk = tl - j * dil; if (tk < 0) break;
            const float* kp = proj + (size_t)(tb + tk) * MIXIN + WA + hh * HD;
            const float* vp = proj + (size_t)(tb + tk) * MIXIN + 2 * WA + hh * HD + dq * 16;
            float s = 0.f;
            for (int d = 0; d < HD; ++d) s += q[d] * kp[d];
            s *= 0.125f;
            float mn = fmaxf(m, s), sc = expf(m - mn), p = expf(s - mn);
            l = l * sc + p;
#pragma unroll
            for (int d = 0; d < 16; ++d) acc[d] = acc[d] * sc + p * vp[d];
            m = mn;
        }
    }
    float* op = o + (size_t)t * D + hh * HD + dq * 16;
#pragma unroll
    for (int d = 0; d < 16; ++d) op[d] = acc[d] / l;
}
NV_KERNEL(sgu_gelu_body, float* proj) {
    int c = (int)(idx % 1024); long long t = idx / 1024;
    float* p = proj + (size_t)t * MIXIN + 3 * WA + c; *p = geluf(*p);
}
NV_KERNEL(sgu_zn_body, float* proj, const float* rinvz, const float* ng) {
    int c = (int)(idx % WB); long long t = idx / WB;
    float* p = proj + (size_t)t * MIXIN + 3 * WA + WB + c; *p = *p * rinvz[t] * ng[c];
}
NV_KERNEL(sgu_mix_body, const float* proj, const float* w, const float* bs, float* o) {
    int c = (int)(idx % WB); long long t = idx / WB; int g = c / HD; int i = (int)(t % CH); long long t0 = t - i;
    const float* wr = w + ((size_t)g * CH + i) * CH; float acc = 0.f;
    for (int j = 0; j <= i; ++j) acc += wr[j] * proj[(size_t)(t0 + j) * MIXIN + 3 * WA + WB + c];
    acc += bs[g * CH + i];
    o[(size_t)t * D + WA + c] = proj[(size_t)t * MIXIN + 3 * WA + c] * acc;
}
NV_KERNEL(router_body, const float* h, const float* rw, const float* rb, int* eidx, float* ewt) {
    const float* r = h + (size_t)idx * D;
    float s[16];
#pragma unroll
    for (int e = 0; e < 16; ++e) s[e] = 0.f;
    for (int k = 0; k < D; ++k) { float hv = r[k];
#pragma unroll
        for (int e = 0; e < 16; ++e) s[e] += hv * rw[k * 16 + e]; }
    float sel[16];
#pragma unroll
    for (int e = 0; e < 16; ++e) { s[e] = sigm(s[e]); sel[e] = s[e] + rb[e]; }
    int bg = 0; float bgs = -INFINITY;
#pragma unroll
    for (int g = 0; g < 4; ++g) {
        float a0 = sel[4 * g], a1 = sel[4 * g + 1], a2 = sel[4 * g + 2], a3 = sel[4 * g + 3];
        float m1 = fmaxf(fmaxf(a0, a1), fmaxf(a2, a3));
        float tot = a0 + a1 + a2 + a3, mn = fminf(fminf(a0, a1), fminf(a2, a3));
        float lo01 = fminf(a0, a1), hi01 = fmaxf(a0, a1), lo23 = fminf(a2, a3), hi23 = fmaxf(a2, a3);
        float m2 = fmaxf(fminf(hi01, hi23), fmaxf(lo01, lo23));
        (void)tot; (void)mn;
        float gs = m1 + m2;
        if (gs > bgs) { bgs = gs; bg = g; }
    }
    int i0 = 0; float v0 = -INFINITY;
#pragma unroll
    for (int j = 0; j < 4; ++j) { float v = bg == 0 ? sel[j] : bg == 1 ? sel[4 + j] : bg == 2 ? sel[8 + j] : sel[12 + j]; if (v > v0) { v0 = v; i0 = j; } }
    int i1 = 0; float v1 = -INFINITY;
#pragma unroll
    for (int j = 0; j < 4; ++j) { float v = bg == 0 ? sel[j] : bg == 1 ? sel[4 + j] : bg == 2 ? sel[8 + j] : sel[12 + j]; if (j != i0 && v > v1) { v1 = v; i1 = j; } }
    int e0 = bg * 4 + i0, e1 = bg * 4 + i1; float w0 = 0.f, w1 = 0.f;
#pragma unroll
    for (int e = 0; e < 16; ++e) { if (e == e0) w0 = s[e]; if (e == e1) w1 = s[e]; }
    float inv = 1.f / (w0 + w1);
    eidx[idx * 2] = e0; eidx[idx * 2 + 1] = e1; ewt[idx * 2] = w0 * inv; ewt[idx * 2 + 1] = w1 * inv;
}
NV_KERNEL(moe_hid_body, const float* h, const int* eidx, const float* w1, const float* w3, float* hid) {
    int j = (int)(idx % DE); long long ts = idx / DE; long long t = ts >> 1; int e = eidx[ts];
    const float* r = h + (size_t)t * D; const float* W1 = w1 + (size_t)e * D * DE; const float* W3 = w3 + (size_t)e * D * DE;
    float a = 0.f, b = 0.f;
    for (int k = 0; k < D; ++k) { float hv = r[k]; a += hv * W1[(size_t)k * DE + j]; b += hv * W3[(size_t)k * DE + j]; }
    hid[idx] = siluf(a) * b;
}
NV_KERNEL(moe_out_body, const float* hid, const int* eidx, const float* ewt, const float* w2, const float* mod, int b0, float* x) {
    int n = (int)(idx % D); long long t = idx / D; int b = b0 + (int)(t / S); float y = 0.f;
    for (int sl = 0; sl < 2; ++sl) { int e = eidx[t * 2 + sl]; const float* W2 = w2 + (size_t)e * DE * D; const float* hr = hid + ((size_t)t * 2 + sl) * DE; float acc = 0.f;
        for (int j = 0; j < DE; ++j) acc += hr[j] * W2[(size_t)j * D + n];
        y += ewt[t * 2 + sl] * acc; }
    x[idx] += mod[(size_t)b * 3072 + 2048 + n] * y;
}
NV_KERNEL(rk_mix_body, const float* h, const float* mu, float* xm) {
    int c = (int)(idx % D); long long t = idx / D; int tl = (int)(t % S);
    float hv = h[idx], hp = tl == 0 ? 0.f : h[idx - D];
    xm[idx] = hv + (hp - hv) * mu[c];
}
NV_KERNEL(rk_prep_body, const float* wl, const float* w2, const float* w0, const float* al, const float* a2, const float* a0,
          const float* vl, const float* v2, const float* v0, const float* vfirst, float* v, float* wd, float* av) {
    int c = (int)(idx % D); long long t = idx / D;
    float acc = 0.f; for (int j = 0; j < LW; ++j) acc += wl[t * LW + j] * w2[(size_t)j * D + c];
    float w = -softplusf(-(w0[c] + acc)) - 0.5f; wd[idx] = expf(-expf(w));
    acc = 0.f; for (int j = 0; j < LA; ++j) acc += al[t * LA + j] * a2[(size_t)j * D + c];
    av[idx] = sigm(a0[c] + acc);
    if (vl) { acc = 0.f; for (int j = 0; j < LV; ++j) acc += vl[t * LV + j] * v2[(size_t)j * D + c];
        float vv = v[idx]; v[idx] = vv + (vfirst[idx] - vv) * sigm(v0[c] + acc); }
}
#ifdef NV_PERSIST
#define NV_WKV_UNROLL _Pragma("unroll 4")
#else
#define NV_WKV_UNROLL _Pragma("unroll")
#endif
NV_KERNEL(wkv_body, const float* r, const float* wd, const float* k, const float* v, const float* av, const float* k_k, const float* k_a, float* y) {
    int vr = (int)(idx % HD); int hh = (int)((idx / HD) % RH); long long bl = idx / (HD * RH);
#ifdef NV_PERSIST
    extern __shared__ __attribute__((aligned(16))) unsigned char lds[];
    float* nv_lds = (float*)lds;
#define st(i) nv_lds[(i) * 512 + threadIdx.x]
#else
    float st_[HD];
#define st(i) st_[i]
#endif
NV_WKV_UNROLL
    for (int i = 0; i < HD; ++i) st(i) = 0.f;
    const float* kkw = k_k + hh * HD; const float* kaw = k_a + hh * HD;
    for (int t = 0; t < S; ++t) {
        size_t base = ((size_t)bl * S + t) * D + hh * HD;
        float nrm = 0.f;
NV_WKV_UNROLL
        for (int i = 0; i < HD; ++i) { float kv = k[base + i] * kkw[i]; nrm += kv * kv; }
        float inv = 1.f / fmaxf(sqrtf(nrm), 1e-12f);
        float sa = 0.f;
NV_WKV_UNROLL
        for (int i = 0; i < HD; ++i) { float kkv = k[base + i] * kkw[i] * inv; sa += st(i) * (-kkv); }
        float vv = v[base + vr], yv = 0.f;
NV_WKV_UNROLL
        for (int i = 0; i < HD; ++i) {
            float ko = k[base + i], a = av[base + i]; float kkv = ko * kkw[i] * inv; float kn = ko * (1.f + (a - 1.f) * kaw[i]);
            float sn = st(i) * wd[base + i] + sa * (kkv * a) + vv * kn; st(i) = sn;
            yv += sn * r[base + i];
        }
        y[base + vr] = yv;
    }
#undef st
}
NV_KERNEL(rk_post_body, const float* y, const float* r, const float* k, const float* v, const float* av, const float* k_a, const float* r_k,
          const float* lnw, const float* lnb, const float* gl, const float* g2, float* outA) {
    int hh = (int)(idx % RH); long long t = idx / RH; size_t base = (size_t)t * D + hh * HD;
    float mean = 0.f; for (int i = 0; i < HD; ++i) mean += y[base + i]; mean *= (1.f / HD);
    float var = 0.f; for (int i = 0; i < HD; ++i) { float d = y[base + i] - mean; var += d * d; } var *= (1.f / HD);
    float rstd = 1.f / sqrtf(var + 64e-5f);
    float rk = 0.f; for (int i = 0; i < HD; ++i) { int c = hh * HD + i; float kn = k[base + i] * (1.f + (av[base + i] - 1.f) * k_a[c]); rk += r[base + i] * kn * r_k[c]; }
    for (int i = 0; i < HD; ++i) { int c = hh * HD + i;
        float g = 0.f; for (int j = 0; j < LG; ++j) g += gl[t * LG + j] * g2[(size_t)j * D + c];
        float yy = (y[base + i] - mean) * rstd * lnw[c] + lnb[c] + rk * v[base + i];
        outA[base + i] = yy * g; }
}
NV_KERNEL(copy_body, const float* src, float* dst) { dst[idx] = src[idx]; }
NV_KERNEL(final_body, const float* x, const float* rinv, const float* g, float* out) { int c = (int)(idx % D); long long t = idx / D; out[idx] = x[idx] * rinv[t] * g[c]; }

#if !defined(CPU_EMU) && !defined(NV_PERSIST)
#define NV_WRAP(body, ...)
template <class F> __global__ void __launch_bounds__(256) generic_k(long long n, F f) { long long i = (long long)blockIdx.x * 256 + threadIdx.x; if (i < n) f(i); }
__global__ void __launch_bounds__(256) ada_body_k(long long n, const float* c, const float* w, const float* bia, float* mod) { long long i = (long long)blockIdx.x * 256 + threadIdx.x; if (i < n) ada_body(i, c, w, bia, mod); }
__global__ void __launch_bounds__(256) rms_body_k(long long n, const float* x, int ld, int nn, float* rinv) { long long i = (long long)blockIdx.x * 256 + threadIdx.x; if (i < n) rms_body(i, x, ld, nn, rinv); }
__global__ void __launch_bounds__(256) modnorm_body_k(long long n, const float* x, const float* rinv, const float* mod, int b0, float* h) { long long i = (long long)blockIdx.x * 256 + threadIdx.x; if (i < n) modnorm_body(i, x, rinv, mod, b0, h); }
__global__ void __launch_bounds__(256) gemm_body_k(long long n, const float* A, int lda, const float* Bm, int ldb, float* C, int ldc, int N, int K, int act) { long long i = (long long)blockIdx.x * 256 + threadIdx.x; if (i < n) gemm_body(i, A, lda, Bm, ldb, C, ldc, N, K, act); }
__global__ void __launch_bounds__(256) gemm_res_body_k(long long n, const float* A, int lda, const float* Bm, int K, const float* mod, int b0, float* x) { long long i = (long long)blockIdx.x * 256 + threadIdx.x; if (i < n) gemm_res_body(i, A, lda, Bm, K, mod, b0, x); }
__global__ void __launch_bounds__(256) attn_body_k(long long n, const float* proj, float* o) { long long i = (long long)blockIdx.x * 256 + threadIdx.x; if (i < n) attn_body(i, proj, o); }
__global__ void __launch_bounds__(256) sgu_gelu_body_k(long long n, float* proj) { long long i = (long long)blockIdx.x * 256 + threadIdx.x; if (i < n) sgu_gelu_body(i, proj); }
__global__ void __launch_bounds__(256) sgu_zn_body_k(long long n, float* proj, const float* rinvz, const float* ng) { long long i = (long long)blockIdx.x * 256 + threadIdx.x; if (i < n) sgu_zn_body(i, proj, rinvz, ng); }
__global__ void __launch_bounds__(256) sgu_mix_body_k(long long n, const float* proj, const float* w, const float* bs, float* o) { long long i = (long long)blockIdx.x * 256 + threadIdx.x; if (i < n) sgu_mix_body(i, proj, w, bs, o); }
__global__ void __launch_bounds__(256) router_body_k(long long n, const float* h, const float* rw, const float* rb, int* eidx, float* ewt) { long long i = (long long)blockIdx.x * 256 + threadIdx.x; if (i < n) router_body(i, h, rw, rb, eidx, ewt); }
__global__ void __launch_bounds__(256) moe_hid_body_k(long long n, const float* h, const int* eidx, const float* w1, const float* w3, float* hid) { long long i = (long long)blockIdx.x * 256 + threadIdx.x; if (i < n) moe_hid_body(i, h, eidx, w1, w3, hid); }
__global__ void __launch_bounds__(256) moe_out_body_k(long long n, const float* hid, const int* eidx, const float* ewt, const float* w2, const float* mod, int b0, float* x) { long long i = (long long)blockIdx.x * 256 + threadIdx.x; if (i < n) moe_out_body(i, hid, eidx, ewt, w2, mod, b0, x); }
__global__ void __launch_bounds__(256) rk_mix_body_k(long long n, const float* h, const float* mu, float* xm) { long long i = (long long)blockIdx.x * 256 + threadIdx.x; if (i < n) rk_mix_body(i, h, mu, xm); }
__global__ void __launch_bounds__(256) rk_prep_body_k(long long n, const float* wl, const float* w2, const float* w0, const float* al, const float* a2, const float* a0, const float* vl, const float* v2, const float* v0, const float* vfirst, float* v, float* wd, float* av) { long long i = (long long)blockIdx.x * 256 + threadIdx.x; if (i < n) rk_prep_body(i, wl, w2, w0, al, a2, a0, vl, v2, v0, vfirst, v, wd, av); }
__global__ void __launch_bounds__(256) wkv_body_k(long long n, const float* r, const float* wd, const float* k, const float* v, const float* av, const float* k_k, const float* k_a, float* y) { long long i = (long long)blockIdx.x * 256 + threadIdx.x; if (i < n) wkv_body(i, r, wd, k, v, av, k_k, k_a, y); }
__global__ void __launch_bounds__(256) rk_post_body_k(long long n, const float* y, const float* r, const float* k, const float* v, const float* av, const float* k_a, const float* r_k, const float* lnw, const float* lnb, const float* gl, const float* g2, float* outA) { long long i = (long long)blockIdx.x * 256 + threadIdx.x; if (i < n) rk_post_body(i, y, r, k, v, av, k_a, r_k, lnw, lnb, gl, g2, outA); }
__global__ void __launch_bounds__(256) copy_body_k(long long n, const float* src, float* dst) { long long i = (long long)blockIdx.x * 256 + threadIdx.x; if (i < n) copy_body(i, src, dst); }
__global__ void __launch_bounds__(256) final_body_k(long long n, const float* x, const float* rinv, const float* g, float* out) { long long i = (long long)blockIdx.x * 256 + threadIdx.x; if (i < n) final_body(i, x, rinv, g, out); }
#endif

#if defined(CPU_EMU)
#define NV_STREAM_ARG
#define NV_STREAM_PARAM
#define NV_FWD_QUAL static
#elif defined(NV_PERSIST)
#define NV_STREAM_ARG
#define NV_STREAM_PARAM , const XcdBarrier& nv_bar, long long nv_gtid, long long nv_nthr
#define NV_GRID_BARRIER() xcd_barrier(nv_bar)
#define NV_FWD_QUAL __device__ __forceinline__
#else
#define NV_FWD_QUAL static
#define NV_STREAM_ARG , stream
#define NV_STREAM_PARAM , hipStream_t stream
#endif
__host__ __device__ static inline size_t naive_ws_floats() { return (size_t)8 * Bn * 3072 + (size_t)TC * 6 + (size_t)TC * 320 + (size_t)Bn * S * D + (size_t)6 * TC * D; }

struct InPtrs { const float* p[34]; };
NV_FWD_QUAL void naive_forward(const InPtrs& ip, float* xw, float* ws NV_STREAM_PARAM) {
#define in ip.p
    const float *x_in = in[0], *c = in[1], *ada_w = in[2], *ada_b = in[3], *mix_w_in = in[4], *mix_w_out = in[5], *sgu_ng = in[6], *sgu_w = in[7], *sgu_b = in[8];
    const float *mu = in[9], *w_rkv = in[10], *w_o = in[11], *w0 = in[12], *w1 = in[13], *w2 = in[14], *a0 = in[15], *a1 = in[16], *a2 = in[17], *v0 = in[18], *v1 = in[19], *v2 = in[20];
    const float *g1 = in[21], *g2 = in[22], *k_k = in[23], *k_a = in[24], *r_k = in[25], *ln_w = in[26], *ln_b = in[27], *router_w = in[28], *router_b = in[29];
    const float *moe_w1 = in[30], *moe_w3 = in[31], *moe_w2 = in[32], *fng = in[33];
    float* p = ws;
    float* mod = p; p += (size_t)8 * Bn * 3072;
    float* rinv = p; p += TC; float* rinvz = p; p += TC;
    int* eidx = (int*)p; p += 2 * TC; float* ewt = p; p += 2 * TC;
    float* lwl = p; p += (size_t)TC * LW; float* lal = p; p += (size_t)TC * LA; float* lvl = p; p += (size_t)TC * LV; float* lgl = p; p += (size_t)TC * LG;
    float* vfirst = p; p += (size_t)Bn * S * D;
    float* big = p; const size_t BUF = (size_t)TC * D;
    float* h = big;
    float* proj = big + BUF;
    float* obuf = big + 4 * BUF;
    float* hid = big + BUF;
    float* R = big + BUF, *Kb = big + 2 * BUF, *Vb = big + 3 * BUF, *XM = big + 4 * BUF, *Wd = big + 4 * BUF  , *Av = big + 5 * BUF, *Y = big;

    NV_LAUNCH(copy_body, (size_t)Bn * S * D, x_in, xw);
    NV_LAUNCH(ada_body, (size_t)8 * Bn * 3072, c, ada_w, ada_b, mod);
    for (int layer = 0; layer < 4; ++layer) {
        const int li = layer / 2;
        for (int b0 = 0; b0 < Bn; b0 += BC) {
            float* x = xw + (size_t)b0 * S * D;
            const float* m0 = mod + (size_t)(layer * 2 + 0) * Bn * 3072; const float* m1 = mod + (size_t)(layer * 2 + 1) * Bn * 3072;
            NV_LAUNCH(rms_body, TC, x, D, D, rinv);
            NV_LAUNCH(modnorm_body, BUF, x, rinv, m0, b0, h);
            if (layer % 2 == 0) {
                NV_LAUNCH(gemm_body, (size_t)TC * MIXIN, h, D, mix_w_in + (size_t)li * D * MIXIN, MIXIN, proj, MIXIN, MIXIN, D, 0);
                NV_LAUNCH(attn_body, (size_t)TC * NH * 4, proj, obuf);
                NV_LAUNCH(sgu_gelu_body, (size_t)TC * 1024, proj);
                NV_LAUNCH(rms_body, TC, proj + 3 * WA + WB, MIXIN, WB, rinvz);
                NV_LAUNCH(sgu_zn_body, (size_t)TC * WB, proj, rinvz, sgu_ng + li * WB);
                NV_LAUNCH(sgu_mix_body, (size_t)TC * WB, proj, sgu_w + (size_t)li * 8 * CH * CH, sgu_b + li * 8 * CH, obuf);
                NV_LAUNCH(gemm_res_body, BUF, obuf, D, mix_w_out + (size_t)li * D * D, D, m0, b0, x);
            } else {
                const float* muL = mu + (size_t)li * 6 * D;
                float* vf = vfirst + (size_t)b0 * S * D;
                NV_LAUNCH(rk_mix_body, BUF, h, muL + 0 * D, XM); NV_LAUNCH(gemm_body, BUF, XM, D, w_rkv + ((size_t)li * 3 + 0) * D * D, D, R, D, D, D, 0);
                NV_LAUNCH(rk_mix_body, BUF, h, muL + 1 * D, XM); NV_LAUNCH(gemm_body, (size_t)TC * LW, XM, D, w1 + (size_t)li * D * LW, LW, lwl, LW, LW, D, 1);
                NV_LAUNCH(rk_mix_body, BUF, h, muL + 2 * D, XM); NV_LAUNCH(gemm_body, BUF, XM, D, w_rkv + ((size_t)li * 3 + 1) * D * D, D, Kb, D, D, D, 0);
                NV_LAUNCH(rk_mix_body, BUF, h, muL + 3 * D, XM); NV_LAUNCH(gemm_body, BUF, XM, D, w_rkv + ((size_t)li * 3 + 2) * D * D, D, Vb, D, D, D, 0);
                if (li > 0) NV_LAUNCH(gemm_body, (size_t)TC * LV, XM, D, v1 + (size_t)(li - 1) * D * LV, LV, lvl, LV, LV, D, 0);
                NV_LAUNCH(rk_mix_body, BUF, h, muL + 4 * D, XM); NV_LAUNCH(gemm_body, (size_t)TC * LA, XM, D, a1 + (size_t)li * D * LA, LA, lal, LA, LA, D, 0);
                NV_LAUNCH(rk_mix_body, BUF, h, muL + 5 * D, XM); NV_LAUNCH(gemm_body, (size_t)TC * LG, XM, D, g1 + (size_t)li * D * LG, LG, lgl, LG, LG, D, 2);
                if (li == 0) {
                    NV_LAUNCH(rk_prep_body, BUF, lwl, w2 + (size_t)li * LW * D, w0 + li * D, lal, a2 + (size_t)li * LA * D, a0 + li * D,
                              (const float*)nullptr, (const float*)nullptr, (const float*)nullptr, (const float*)nullptr, Vb, Wd, Av);
                    NV_LAUNCH(copy_body, BUF, Vb, vf);
                } else {
                    NV_LAUNCH(rk_prep_body, BUF, lwl, w2 + (size_t)li * LW * D, w0 + li * D, lal, a2 + (size_t)li * LA * D, a0 + li * D,
                              lvl, v2 + (size_t)(li - 1) * LV * D, v0 + (li - 1) * D, vf, Vb, Wd, Av);
                }
                NV_LAUNCH(wkv_body, (size_t)BC * RH * HD, R, Wd, Kb, Vb, Av, k_k + li * D, k_a + li * D, Y);
                NV_LAUNCH(rk_post_body, (size_t)TC * RH, Y, R, Kb, Vb, Av, k_a + li * D, r_k + li * D, ln_w + li * D, ln_b + li * D, lgl, g2 + (size_t)li * LG * D, Wd);
                NV_LAUNCH(gemm_res_body, BUF, Wd, D, w_o + (size_t)li * D * D, D, m0, b0, x);
            }
            NV_LAUNCH(rms_body, TC, x, D, D, rinv);
            NV_LAUNCH(modnorm_body, BUF, x, rinv, m1, b0, h);
            NV_LAUNCH(router_body, TC, h, router_w, router_b, eidx, ewt);
            NV_LAUNCH(moe_hid_body, (size_t)TC * 2 * DE, h, eidx, moe_w1 + (size_t)layer * NE * D * DE, moe_w3 + (size_t)layer * NE * D * DE, hid);
            NV_LAUNCH(moe_out_body, BUF, hid, eidx, ewt, moe_w2 + (size_t)layer * NE * DE * D, m1, b0, x);
        }
    }
    for (int b0 = 0; b0 < Bn; b0 += BC) {
        float* x = xw + (size_t)b0 * S * D;
        NV_LAUNCH(rms_body, TC, x, D, D, rinv);
        NV_LAUNCH(final_body, (size_t)TC * D, x, rinv, fng, x);
    }
#undef in
}
}
constexpr size_t MiB = 1u << 20;
constexpr size_t WS_CTL = 0, CTL_ZERO_BYTES = 64 * 1024;
constexpr size_t WS_NAIVE = 4 * MiB;
struct Args { nv::InPtrs in; float* out; unsigned char* ws; };
__global__ void __launch_bounds__(NTHREADS, 2) mega_fwd(Args args) {
    extern __shared__ __attribute__((aligned(16))) unsigned char lds[];
    LAS unsigned char* L = (LAS unsigned char*)lds;
    for (int u = threadIdx.x; u < (LDS_BYTES - LDSCTL_OFF) / 4; u += NTHREADS) ((LAS unsigned*)(L + LDSCTL_OFF))[u] = 0u;
    __syncthreads();
    volatile LAS unsigned* MISC = (volatile LAS unsigned*)(L + MISC_OFF);
    XcdBarrier bar = xcd_barrier_post((unsigned*)(args.ws + WS_CTL), MISC + 8);
    nv::naive_forward(args.in, args.out, (float*)(args.ws + WS_NAIVE), bar, (long long)blockIdx.x * NTHREADS + threadIdx.x, (long long)gridDim.x * NTHREADS);
}
extern "C" void kernel_launch(void* const* d_in, const int* in_sizes, int n_in, void* d_out, int out_size, void* d_ws, size_t ws_size, hipStream_t stream) {
    (void)in_sizes; (void)out_size;
    static int grid = 0;
    if (grid == 0) {
        int dev = 0, cus = 0, per_cu = 0;
        hipGetDevice(&dev); hipDeviceGetAttribute(&cus, hipDeviceAttributeMultiprocessorCount, dev);
        hipFuncSetAttribute((const void*)mega_fwd, hipFuncAttributeMaxDynamicSharedMemorySize, LDS_BYTES);
        hipOccupancyMaxActiveBlocksPerMultiprocessor(&per_cu, (const void*)mega_fwd, NTHREADS, LDS_BYTES);
        (void)hipGetLastError();
        grid = cus;
        if (per_cu < 1) fprintf(stderr, "kernel_launch: occupancy query says %d blocks/CU\n", per_cu);
        if (n_in != 34 || ws_size < WS_NAIVE + nv::naive_ws_floats() * 4) { fprintf(stderr, "kernel_launch: unexpected n_in %d / ws %zu\n", n_in, ws_size); grid = -1; }
    }
    if (grid < 0) return;
    hipMemsetAsync((char*)d_ws + WS_CTL, 0, CTL_ZERO_BYTES, stream);
    Args a{};
    for (int i = 0; i < 34; ++i) a.in.p[i] = (const float*)d_in[i];
    a.out = (float*)d_out; a.ws = (unsigned char*)d_ws;
    void* kargs[] = {&a};
    hipError_t e = hipLaunchCooperativeKernel((const void*)mega_fwd, dim3(grid), dim3(NTHREADS), kargs, LDS_BYTES, stream);
    if (e != hipSuccess) fprintf(stderr, "cooperative launch failed: %s (grid %d)\n", hipGetErrorString(e), grid);
}
```

```cpp
#include <hip/hip_runtime.h>
#include <stdint.h>
#include <stddef.h>
#include <math.h>
#include <stdio.h>
#define NV_PERSIST 1
#define GAS __attribute__((address_space(1)))
#define LAS __attribute__((address_space(3)))
#define XB_TMO      128
#define XB_XCNT(j)  (256  + 64 * (j))
#define XB_XSUB(j)  (1280 + 64 * (j))
#define XB_XGEN(j)  (2304 + 64 * (j))
#define XB_TOP      3328
#define XB_TOPGEN   3392
#define XCD_BAR_WORDS 3456
#define XB_SPIN_CAP (1u << 22)
__device__ __forceinline__ unsigned xb_ld(unsigned* p)              { return __hip_atomic_load(p, __ATOMIC_RELAXED, __HIP_MEMORY_SCOPE_AGENT); }
__device__ __forceinline__ unsigned xb_add(unsigned* p, unsigned v) { return __hip_atomic_fetch_add(p, v, __ATOMIC_RELAXED, __HIP_MEMORY_SCOPE_AGENT); }
__device__ __forceinline__ unsigned xb_xcc_id() { return (unsigned)__builtin_amdgcn_s_getreg((3 << 11) | 20) & 0xFu; }
#define XB_SPIN(cond, bar) do { unsigned _sp = 0; while (cond) { __builtin_amdgcn_s_sleep(1); \
    if ((++_sp & 255u) == 0u) { if (xb_ld(&(bar)[XB_TMO])) break; if (_sp > XB_SPIN_CAP) { atomicAdd(&(bar)[XB_TMO], 1u); break; } } } } while (0)
struct XcdBarrier { unsigned* bar; unsigned x; volatile LAS unsigned* st; };
__device__ __forceinline__ XcdBarrier xcd_barrier_post(unsigned* bar, volatile LAS unsigned* st) {
    XcdBarrier b; b.bar = bar; b.x = xb_xcc_id(); b.st = st;
    if (threadIdx.x == 0) (void)xb_add(&bar[XB_XCNT(b.x)], 1u);
    return b;
}
__device__ __forceinline__ void xcd_barrier_complete(unsigned* bar, unsigned x, unsigned& nloc, unsigned& nx) {
    const unsigned G = gridDim.x * gridDim.y * gridDim.z;
    unsigned sum, cnt, mine, sp = 0u;
    for (;;) {
        sum = 0u; cnt = 0u; mine = 0u;
#pragma unroll
        for (unsigned j = 0; j < 16; ++j) { const unsigned c = xb_ld(&bar[XB_XCNT(j)]); sum += c; cnt += (c > 0u) ? 1u : 0u; mine = (j == x) ? c : mine; }
        if (sum == G) break;
        __builtin_amdgcn_s_sleep(1);
        if ((++sp & 255u) == 0u) { if (xb_ld(&bar[XB_TMO])) break; if (sp > XB_SPIN_CAP) { atomicAdd(&bar[XB_TMO], 1u); break; } }
    }
    nloc = mine > 0u ? mine : 1u; nx = cnt > 0u ? cnt : 1u;
}
__device__ __forceinline__ void xcd_barrier(const XcdBarrier& b) {
    asm volatile("s_waitcnt vmcnt(0)" ::: "memory");
    __syncthreads();
    if (threadIdx.x == 0) {
        unsigned* bar = b.bar;
        __builtin_amdgcn_s_waitcnt(0);
        unsigned nloc = b.st[0], nx = b.st[1];
        if (nloc == 0u) { xcd_barrier_complete(bar, b.x, nloc, nx); b.st[0] = nloc; b.st[1] = nx; }
        const unsigned old = xb_add(&bar[XB_XSUB(b.x)], 1u);
        const unsigned gen = old / nloc;
        if (old + 1u == (gen + 1u) * nloc) {
            __builtin_amdgcn_fence(__ATOMIC_RELEASE, "agent");
            asm volatile("s_waitcnt vmcnt(0)" ::: "memory");
            const unsigned og = xb_add(&bar[XB_TOP], 1u);
            const unsigned tg = og / nx;
            if (og + 1u == (tg + 1u) * nx) xb_add(&bar[XB_TOPGEN], 1u);
            else XB_SPIN(xb_ld(&bar[XB_TOPGEN]) == tg, bar);
            __builtin_amdgcn_fence(__ATOMIC_ACQUIRE, "agent");
            xb_add(&bar[XB_XGEN(b.x)], 1u);
            asm volatile("s_waitcnt vmcnt(0)" ::: "memory");
        } else {
            XB_SPIN(xb_ld(&bar[XB_XGEN(b.x)]) == gen, bar);
            __builtin_amdgcn_fence(__ATOMIC_ACQUIRE, "agent");
            asm volatile("s_waitcnt vmcnt(0)" ::: "memory");
        }
    }
    __syncthreads();
}
constexpr int RING_BYTES = 131072;
constexpr int LDSCTL_OFF = RING_BYTES;
constexpr int MISC_OFF = LDSCTL_OFF + 320;
constexpr int LDS_BYTES = 147456;
constexpr int NTHREADS = 512;

__device__ __forceinline__ const void* karg(int i) {
    const unsigned long long volatile* tbl = (const unsigned long long volatile*)__builtin_amdgcn_kernarg_segment_ptr();
    const unsigned long long v = tbl[i];
    const unsigned lo = __builtin_amdgcn_readfirstlane((unsigned)v), hi = __builtin_amdgcn_readfirstlane((unsigned)(v >> 32));
    return (const void*)(((unsigned long long)hi << 32) | lo);
}
__device__ __forceinline__ const float* kin(int i) { return (const float*)karg(i); }
__device__ __forceinline__ float* kout() { return (float*)karg(34); }
__device__ __forceinline__ unsigned char* kws() { return (unsigned char*)karg(35); }
#ifndef NV_B
#define NV_B 8
#endif
#ifndef NV_S
#define NV_S 2048
#endif
#ifndef NV_BC
#define NV_BC 4
#endif
namespace nv {
constexpr int Bn = NV_B, S = NV_S, D = 1024, BC = NV_BC, TC = BC * S;
constexpr int HD = 64, NH = 8, WA = 512, WB = 512, MIXIN = 2560, CH = 128;
constexpr int RH = 16, LW = 64, LA = 64, LV = 32, LG = 160, NE = 16, DE = 256;

#ifdef CPU_EMU
#define NV_HD
#define NV_DEV static inline
#define NV_LAUNCH(body, n, ...) do { long long n__ = (long long)(n); _Pragma("omp parallel for schedule(dynamic, 256)") for (long long i__ = 0; i__ < n__; ++i__) body(i__, __VA_ARGS__); } while (0)
#elif defined(NV_PERSIST)
#define NV_HD __host__ __device__
#define NV_DEV __device__ __forceinline__
#define NV_LAUNCH(body, n, ...) do { long long n__ = (long long)(n); long long g__ = nv_gtid; asm volatile("" : "+v"(g__)); for (long long i__ = g__; i__ < n__; i__ += nv_nthr) body(i__, __VA_ARGS__); NV_GRID_BARRIER(); } while (0)
#else
#define NV_HD __host__ __device__
#define NV_DEV __device__ __forceinline__
#define NV_LAUNCH(body, n, ...) do { long long n__ = (long long)(n); int nb__ = (int)((n__ + 255) / 256); hipLaunchKernelGGL(body##_k, dim3(nb__), dim3(256), 0, stream, n__, __VA_ARGS__); } while (0)
#endif

NV_DEV float sigm(float x) { return 1.f / (1.f + expf(-x)); }
NV_DEV float siluf(float x) { return x * sigm(x); }
NV_DEV float geluf(float x) { return 0.5f * x * (1.f + erff(x * 0.70710678118654752f)); }
NV_DEV float softplusf(float x) { return x > 20.f ? x : log1pf(expf(x)); }

#ifdef CPU_EMU
#define NV_KERNEL(name, ...) static inline void name(long long idx, __VA_ARGS__)
#define NV_KERNEL_END(name, ...)
#else
#define NV_KERNEL(name, ...) __device__ __forceinline__ void name(long long idx, __VA_ARGS__)
#endif

NV_KERNEL(ada_body, const float* c, const float* w, const float* bia, float* mod) {
    int n = (int)(idx % 3072); int b = (int)((idx / 3072) % Bn); int ls = (int)(idx / (3072 * Bn));
    const float* W = w + (size_t)ls * D * 3072; float acc = 0.f;
    for (int k = 0; k < D; ++k) acc += siluf(c[b * D + k]) * W[(size_t)k * 3072 + n];
    mod[idx] = acc + bia[ls * 3072 + n];
}
NV_KERNEL(rms_body, const float* x, int ld, int n, float* rinv) {
    const float* r = x + (size_t)idx * ld; float s = 0.f;
    for (int k = 0; k < n; ++k) s += r[k] * r[k];
    rinv[idx] = 1.f / sqrtf(s / (float)n + 1e-6f);
}
NV_KERNEL(modnorm_body, const float* x, const float* rinv, const float* mod, int b0, float* h) {
    int c = (int)(idx % D); long long t = idx / D; int b = b0 + (int)(t / S);
    const float* m = mod + (size_t)b * 3072;
    h[idx] = x[idx] * rinv[t] * (1.f + m[1024 + c]) + m[c];
}
NV_KERNEL(gemm_body, const float* A, int lda, const float* Bm, int ldb, float* C, int ldc, int N, int K, int act) {
    int n = (int)(idx % N); long long m = idx / N;
    const float* a = A + (size_t)m * lda; float acc = 0.f;
    for (int k = 0; k < K; ++k) acc += a[k] * Bm[(size_t)k * ldb + n];
    if (act == 1) acc = tanhf(acc); else if (act == 2) acc = sigm(acc);
    C[(size_t)m * ldc + n] = acc;
}
NV_KERNEL(gemm_res_body, const float* A, int lda, const float* Bm, int K, const float* mod, int b0, float* x) {
    int n = (int)(idx % D); long long m = idx / D; int b = b0 + (int)(m / S);
    const float* a = A + (size_t)m * lda; float acc = 0.f;
    for (int k = 0; k < K; ++k) acc += a[k] * Bm[(size_t)k * D + n];
    x[idx] += mod[(size_t)b * 3072 + 2048 + n] * acc;
}
NV_KERNEL(attn_body, const float* proj, float* o  ) {
    int dq = (int)(idx % 4); int hh = (int)((idx / 4) % NH); long long t = idx / (4 * NH);
    int tl = (int)(t % S); long long tb = t - tl;
    const float* q = proj + (size_t)t * MIXIN + hh * HD;
    float m = -INFINITY, l = 0.f; float acc[16];
#pragma unroll
    for (int d = 0; d < 16; ++d) acc[d] = 0.f;
    for (int br = 0; br < 3; ++br) {
        int dil = br == 0 ? 1 : (br == 1 ? 4 : 16);
        for (int j = 0; j <= 128; ++j) {
            int tk = tl - j * dil; if (tk < 0) break;
            const float* kp = proj + (size_t)(tb + tk) * MIXIN + WA + hh * HD;
            const float* vp = proj + (size_t)(tb + tk) * MIXIN + 2 * WA + hh * HD + dq * 16;
            float s = 0.f;
            for (int d = 0; d < HD; ++d) s += q[d] * kp[d];
            s *= 0.125f;
            float mn = fmaxf(m, s), sc = expf(m - mn), p = expf(s - mn);
            l = l * sc + p;
#pragma unroll
            for (int d = 0; d < 16; ++d) acc[d] = acc[d] * sc + p * vp[d];
            m = mn;
        }
    }
    float* op = o + (size_t)t * D + hh * HD + dq * 16;
#pragma unroll
    for (int d = 0; d < 16; ++d) op[d] = acc[d] / l;
}
NV_KERNEL(sgu_gelu_body, float* proj) {
    int c = (int)(idx % 1024); long long t = idx / 1024;
    float* p = proj + (size_t)t * MIXIN + 3 * WA + c; *p = geluf(*p);
}
NV_KERNEL(sgu_zn_body, float* proj, const float* rinvz, const float* ng) {
    int c = (int)(idx % WB); long long t = idx / WB;
    float* p = proj + (size_t)t * MIXIN + 3 * WA + WB + c; *p = *p * rinvz[t] * ng[c];
}
NV_KERNEL(sgu_mix_body, const float* proj, const float* w, const float* bs, float* o) {
    int c = (int)(idx % WB); long long t = idx / WB; int g = c / HD; int i = (int)(t % CH); long long t0 = t - i;
    const float* wr = w + ((size_t)g * CH + i) * CH; float acc = 0.f;
    for (int j = 0; j <= i; ++j) acc += wr[j] * proj[(size_t)(t0 + j) * MIXIN + 3 * WA + WB + c];
    acc += bs[g * CH + i];
    o[(size_t)t * D + WA + c] = proj[(size_t)t * MIXIN + 3 * WA + c] * acc;
}
NV_KERNEL(router_body, const float* h, const float* rw, const float* rb, int* eidx, float* ewt) {
    const float* r = h + (size_t)idx * D;
    float s[16];
#pragma unroll
    for (int e = 0; e < 16; ++e) s[e] = 0.f;
    for (int k = 0; k < D; ++k) { float hv = r[k];
#pragma unroll
        for (int e = 0; e < 16; ++e) s[e] += hv * rw[k * 16 + e]; }
    float sel[16];
#pragma unroll
    for (int e = 0; e < 16; ++e) { s[e] = sigm(s[e]); sel[e] = s[e] + rb[e]; }
    int bg = 0; float bgs = -INFINITY;
#pragma unroll
    for (int g = 0; g < 4; ++g) {
        float a0 = sel[4 * g], a1 = sel[4 * g + 1], a2 = sel[4 * g + 2], a3 = sel[4 * g + 3];
        float m1 = fmaxf(fmaxf(a0, a1), fmaxf(a2, a3));
        float tot = a0 + a1 + a2 + a3, mn = fminf(fminf(a0, a1), fminf(a2, a3));
        float lo01 = fminf(a0, a1), hi01 = fmaxf(a0, a1), lo23 = fminf(a2, a3), hi23 = fmaxf(a2, a3);
        float m2 = fmaxf(fminf(hi01, hi23), fmaxf(lo01, lo23));
        (void)tot; (void)mn;
        float gs = m1 + m2;
        if (gs > bgs) { bgs = gs; bg = g; }
    }
    int i0 = 0; float v0 = -INFINITY;
#pragma unroll
    for (int j = 0; j < 4; ++j) { float v = bg == 0 ? sel[j] : bg == 1 ? sel[4 + j] : bg == 2 ? sel[8 + j] : sel[12 + j]; if (v > v0) { v0 = v; i0 = j; } }
    int i1 = 0; float v1 = -INFINITY;
#pragma unroll
    for (int j = 0; j < 4; ++j) { float v = bg == 0 ? sel[j] : bg == 1 ? sel[4 + j] : bg == 2 ? sel[8 + j] : sel[12 + j]; if (j != i0 && v > v1) { v1 = v; i1 = j; } }
    int e0 = bg * 4 + i0, e1 = bg * 4 + i1; float w0 = 0.f, w1 = 0.f;
#pragma unroll
    for (int e = 0; e < 16; ++e) { if (e == e0) w0 = s[e]; if (e == e1) w1 = s[e]; }
    float inv = 1.f / (w0 + w1);
    eidx[idx * 2] = e0; eidx[idx * 2 + 1] = e1; ewt[idx * 2] = w0 * inv; ewt[idx * 2 + 1] = w1 * inv;
}
NV_KERNEL(moe_hid_body, const float* h, const int* eidx, const float* w1, const float* w3, float* hid) {
    int j = (int)(idx % DE); long long ts = idx / DE; long long t = ts >> 1; int e = eidx[ts];
    const float* r = h + (size_t)t * D; const float* W1 = w1 + (size_t)e * D * DE; const float* W3 = w3 + (size_t)e * D * DE;
    float a = 0.f, b = 0.f;
    for (int k = 0; k < D; ++k) { float hv = r[k]; a += hv * W1[(size_t)k * DE + j]; b += hv * W3[(size_t)k * DE + j]; }
    hid[idx] = siluf(a) * b;
}
NV_KERNEL(moe_out_body, const float* hid, const int* eidx, const float* ewt, const float* w2, const float* mod, int b0, float* x) {
    int n = (int)(idx % D); long long t = idx / D; int b = b0 + (int)(t / S); float y = 0.f;
    for (int sl = 0; sl < 2; ++sl) { int e = eidx[t * 2 + sl]; const float* W2 = w2 + (size_t)e * DE * D; const float* hr = hid + ((size_t)t * 2 + sl) * DE; float acc = 0.f;
        for (int j = 0; j < DE; ++j) acc += hr[j] * W2[(size_t)j * D + n];
        y += ewt[t * 2 + sl] * acc; }
    x[idx] += mod[(size_t)b * 3072 + 2048 + n] * y;
}
NV_KERNEL(rk_mix_body, const float* h, const float* mu, float* xm) {
    int c = (int)(idx % D); long long t = idx / D; int tl = (int)(t % S);
    float hv = h[idx], hp = tl == 0 ? 0.f : h[idx - D];
    xm[idx] = hv + (hp - hv) * mu[c];
}
NV_KERNEL(rk_prep_body, const float* wl, const float* w2, const float* w0, const float* al, const float* a2, const float* a0,
          const float* vl, const float* v2, const float* v0, const float* vfirst, float* v, float* wd, float* av) {
    int c = (int)(idx % D); long long t = idx / D;
    float acc = 0.f; for (int j = 0; j < LW; ++j) acc += wl[t * LW + j] * w2[(size_t)j * D + c];
    float w = -softplusf(-(w0[c] + acc)) - 0.5f; wd[idx] = expf(-expf(w));
    acc = 0.f; for (int j = 0; j < LA; ++j) acc += al[t * LA + j] * a2[(size_t)j * D + c];
    av[idx] = sigm(a0[c] + acc);
    if (vl) { acc = 0.f; for (int j = 0; j < LV; ++j) acc += vl[t * LV + j] * v2[(size_t)j * D + c];
        float vv = v[idx]; v[idx] = vv + (vfirst[idx] - vv) * sigm(v0[c] + acc); }
}
#ifdef NV_PERSIST
#define NV_WKV_UNROLL _Pragma("unroll 4")
#else
#define NV_WKV_UNROLL _Pragma("unroll")
#endif
NV_KERNEL(wkv_body, const float* r, const float* wd, const float* k, const float* v, const float* av, const float* k_k, const float* k_a, float* y) {
    int vr = (int)(idx % HD); int hh = (int)((idx / HD) % RH); long long bl = idx / (HD * RH);
#ifdef NV_PERSIST
    extern __shared__ __attribute__((aligned(16))) unsigned char lds[];
    float* nv_lds = (float*)lds;
#define st(i) nv_lds[(i) * 512 + threadIdx.x]
#else
    float st_[HD];
#define st(i) st_[i]
#endif
NV_WKV_UNROLL
    for (int i = 0; i < HD; ++i) st(i) = 0.f;
    const float* kkw = k_k + hh * HD; const float* kaw = k_a + hh * HD;
    for (int t = 0; t < S; ++t) {
        size_t base = ((size_t)bl * S + t) * D + hh * HD;
        float nrm = 0.f;
NV_WKV_UNROLL
        for (int i = 0; i < HD; ++i) { float kv = k[base + i] * kkw[i]; nrm += kv * kv; }
        float inv = 1.f / fmaxf(sqrtf(nrm), 1e-12f);
        float sa = 0.f;
NV_WKV_UNROLL
        for (int i = 0; i < HD; ++i) { float kkv = k[base + i] * kkw[i] * inv; sa += st(i) * (-kkv); }
        float vv = v[base + vr], yv = 0.f;
NV_WKV_UNROLL
        for (int i = 0; i < HD; ++i) {
            float ko = k[base + i], a = av[base + i]; float kkv = ko * kkw[i] * inv; float kn = ko * (1.f + (a - 1.f) * kaw[i]);
            float sn = st(i) * wd[base + i] + sa * (kkv * a) + vv * kn; st(i) = sn;
            yv += sn * r[base + i];
        }
        y[base + vr] = yv;
    }
#undef st
}
NV_KERNEL(rk_post_body, const float* y, const float* r, const float* k, const float* v, const float* av, const float* k_a, const float* r_k,
          const float* lnw, const float* lnb, const float* gl, const float* g2, float* outA) {
    int hh = (int)(idx % RH); long long t = idx / RH; size_t base = (size_t)t * D + hh * HD;
    float mean = 0.f; for (int i = 0; i < HD; ++i) mean += y[base + i]; mean *= (1.f / HD);
    float var = 0.f; for (int i = 0; i < HD; ++i) { float d = y[base + i] - mean; var += d * d; } var *= (1.f / HD);
    float rstd = 1.f / sqrtf(var + 64e-5f);
    float rk = 0.f; for (int i = 0; i < HD; ++i) { int c = hh * HD + i; float kn = k[base + i] * (1.f + (av[base + i] - 1.f) * k_a[c]); rk += r[base + i] * kn * r_k[c]; }
    for (int i = 0; i < HD; ++i) { int c = hh * HD + i;
        float g = 0.f; for (int j = 0; j < LG; ++j) g += gl[t * LG + j] * g2[(size_t)j * D + c];
        float yy = (y[base + i] - mean) * rstd * lnw[c] + lnb[c] + rk * v[base + i];
        outA[base + i] = yy * g; }
}
NV_KERNEL(copy_body, const float* src, float* dst) { dst[idx] = src[idx]; }
NV_KERNEL(final_body, const float* x, const float* rinv, const float* g, float* out) { int c = (int)(idx % D); long long t = idx / D; out[idx] = x[idx] * rinv[t] * g[c]; }

#if !defined(CPU_EMU) && !defined(NV_PERSIST)
#define NV_WRAP(body, ...)
template <class F> __global__ void __launch_bounds__(256) generic_k(long long n, F f) { long long i = (long long)blockIdx.x * 256 + threadIdx.x; if (i < n) f(i); }
__global__ void __launch_bounds__(256) ada_body_k(long long n, const float* c, const float* w, const float* bia, float* mod) { long long i = (long long)blockIdx.x * 256 + threadIdx.x; if (i < n) ada_body(i, c, w, bia, mod); }
__global__ void __launch_bounds__(256) rms_body_k(long long n, const float* x, int ld, int nn, float* rinv) { long long i = (long long)blockIdx.x * 256 + threadIdx.x; if (i < n) rms_body(i, x, ld, nn, rinv); }
__global__ void __launch_bounds__(256) modnorm_body_k(long long n, const float* x, const float* rinv, const float* mod, int b0, float* h) { long long i = (long long)blockIdx.x * 256 + threadIdx.x; if (i < n) modnorm_body(i, x, rinv, mod, b0, h); }
__global__ void __launch_bounds__(256) gemm_body_k(long long n, const float* A, int lda, const float* Bm, int ldb, float* C, int ldc, int N, int K, int act) { long long i = (long long)blockIdx.x * 256 + threadIdx.x; if (i < n) gemm_body(i, A, lda, Bm, ldb, C, ldc, N, K, act); }
__global__ void __launch_bounds__(256) gemm_res_body_k(long long n, const float* A, int lda, const float* Bm, int K, const float* mod, int b0, float* x) { long long i = (long long)blockIdx.x * 256 + threadIdx.x; if (i < n) gemm_res_body(i, A, lda, Bm, K, mod, b0, x); }
__global__ void __launch_bounds__(256) attn_body_k(long long n, const float* proj, float* o) { long long i = (long long)blockIdx.x * 256 + threadIdx.x; if (i < n) attn_body(i, proj, o); }
__global__ void __launch_bounds__(256) sgu_gelu_body_k(long long n, float* proj) { long long i = (long long)blockIdx.x * 256 + threadIdx.x; if (i < n) sgu_gelu_body(i, proj); }
__global__ void __launch_bounds__(256) sgu_zn_body_k(long long n, float* proj, const float* rinvz, const float* ng) { long long i = (long long)blockIdx.x * 256 + threadIdx.x; if (i < n) sgu_zn_body(i, proj, rinvz, ng); }
__global__ void __launch_bounds__(256) sgu_mix_body_k(long long n, const float* proj, const float* w, const float* bs, float* o) { long long i = (long long)blockIdx.x * 256 + threadIdx.x; if (i < n) sgu_mix_body(i, proj, w, bs, o); }
__global__ void __launch_bounds__(256) router_body_k(long long n, const float* h, const float* rw, const float* rb, int* eidx, float* ewt) { long long i = (long long)blockIdx.x * 256 + threadIdx.x; if (i < n) router_body(i, h, rw, rb, eidx, ewt); }
__global__ void __launch_bounds__(256) moe_hid_body_k(long long n, const float* h, const int* eidx, const float* w1, const float* w3, float* hid) { long long i = (long long)blockIdx.x * 256 + threadIdx.x; if (i < n) moe_hid_body(i, h, eidx, w1, w3, hid); }
__global__ void __launch_bounds__(256) moe_out_body_k(long long n, const float* hid, const int* eidx, const float* ewt, const float* w2, const float* mod, int b0, float* x) { long long i = (long long)blockIdx.x * 256 + threadIdx.x; if (i < n) moe_out_body(i, hid, eidx, ewt, w2, mod, b0, x); }
__global__ void __launch_bounds__(256) rk_mix_body_k(long long n, const float* h, const float* mu, float* xm) { long long i = (long long)blockIdx.x * 256 + threadIdx.x; if (i < n) rk_mix_body(i, h, mu, xm); }
__global__ void __launch_bounds__(256) rk_prep_body_k(long long n, const float* wl, const float* w2, const float* w0, const float* al, const float* a2, const float* a0, const float* vl, const float* v2, const float* v0, const float* vfirst, float* v, float* wd, float* av) { long long i = (long long)blockIdx.x * 256 + threadIdx.x; if (i < n) rk_prep_body(i, wl, w2, w0, al, a2, a0, vl, v2, v0, vfirst, v, wd, av); }
__global__ void __launch_bounds__(256) wkv_body_k(long long n, const float* r, const float* wd, const float* k, const float* v, const float* av, const float* k_k, const float* k_a, float* y) { long long i = (long long)blockIdx.x * 256 + threadIdx.x; if (i < n) wkv_body(i, r, wd, k, v, av, k_k, k_a, y); }
__global__ void __launch_bounds__(256) rk_post_body_k(long long n, const float* y, const float* r, const float* k, const float* v, const float* av, const float* k_a, const float* r_k, const float* lnw, const float* lnb, const float* gl, const float* g2, float* outA) { long long i = (long long)blockIdx.x * 256 + threadIdx.x; if (i < n) rk_post_body(i, y, r, k, v, av, k_a, r_k, lnw, lnb, gl, g2, outA); }
__global__ void __launch_bounds__(256) copy_body_k(long long n, const float* src, float* dst) { long long i = (long long)blockIdx.x * 256 + threadIdx.x; if (i < n) copy_body(i, src, dst); }
__global__ void __launch_bounds__(256) final_body_k(long long n, const float* x, const float* rinv, const float* g, float* out) { long long i = (long long)blockIdx.x * 256 + threadIdx.x; if (i < n) final_body(i, x, rinv, g, out); }
#endif

#if defined(CPU_EMU)
#define NV_STREAM_ARG
#define NV_STREAM_PARAM
#define NV_FWD_QUAL static
#elif defined(NV_PERSIST)
#define NV_STREAM_ARG
#define NV_STREAM_PARAM , const XcdBarrier& nv_bar, long long nv_gtid, long long nv_nthr
#define NV_GRID_BARRIER() xcd_barrier(nv_bar)
#define NV_FWD_QUAL __device__ __forceinline__
#else
#define NV_FWD_QUAL static
#define NV_STREAM_ARG , stream
#define NV_STREAM_PARAM , hipStream_t stream
#endif
NV_HD static inline size_t naive_ws_floats() { return (size_t)8 * Bn * 3072 + (size_t)TC * 6 + (size_t)TC * 320 + (size_t)Bn * S * D + (size_t)6 * TC * D; }

struct InPtrs { const float* p[34]; };
struct NvCtx {
    float *mod, *rinv, *rinvz, *ewt, *lwl, *lal, *lvl, *lgl, *vfirst, *big; int* eidx;
};
NV_FWD_QUAL NvCtx nv_ctx(float* ws, float* big = nullptr) {
    NvCtx c; float* p = ws;
    c.mod = p; p += (size_t)8 * Bn * 3072;
    c.rinv = p; p += TC; c.rinvz = p; p += TC;
    c.eidx = (int*)p; p += 2 * TC; c.ewt = p; p += 2 * TC;
    c.lwl = p; p += (size_t)TC * LW; c.lal = p; p += (size_t)TC * LA; c.lvl = p; p += (size_t)TC * LV; c.lgl = p; p += (size_t)TC * LG;
    c.vfirst = p; p += (size_t)Bn * S * D;
    c.big = big ? big : p; return c;
}
#ifdef NV_PERSIST
#define in(k) kin(k)
#else
#define in(k) ip.p[k]
#endif
NV_FWD_QUAL void nv_prologue(const InPtrs& ip, float* xw, const NvCtx& C NV_STREAM_PARAM) {
    NV_LAUNCH(copy_body, (size_t)Bn * S * D, in(0), xw);
    NV_LAUNCH(ada_body, (size_t)8 * Bn * 3072, in(1), in(2), in(3), C.mod);
}
NV_FWD_QUAL void nv_even(const InPtrs& ip, float* xw, const NvCtx& C, int layer NV_STREAM_PARAM) {
    const float *mix_w_in = in(4), *mix_w_out = in(5), *sgu_ng = in(6), *sgu_w = in(7), *sgu_b = in(8);
    const size_t BUF = (size_t)TC * D; float* h = C.big; float* proj = C.big + BUF; float* obuf = C.big + 4 * BUF; float* rinv = C.rinv; float* rinvz = C.rinvz;
    const int li = layer / 2;
    for (int b0 = 0; b0 < Bn; b0 += BC) {
        float* x = xw + (size_t)b0 * S * D;
        const float* m0 = C.mod + (size_t)(layer * 2 + 0) * Bn * 3072;
        NV_LAUNCH(rms_body, TC, x, D, D, rinv);
        NV_LAUNCH(modnorm_body, BUF, x, rinv, m0, b0, h);
        NV_LAUNCH(gemm_body, (size_t)TC * MIXIN, h, D, mix_w_in + (size_t)li * D * MIXIN, MIXIN, proj, MIXIN, MIXIN, D, 0);
        NV_LAUNCH(attn_body, (size_t)TC * NH * 4, proj, obuf);
        NV_LAUNCH(sgu_gelu_body, (size_t)TC * 1024, proj);
        NV_LAUNCH(rms_body, TC, proj + 3 * WA + WB, MIXIN, WB, rinvz);
        NV_LAUNCH(sgu_zn_body, (size_t)TC * WB, proj, rinvz, sgu_ng + li * WB);
        NV_LAUNCH(sgu_mix_body, (size_t)TC * WB, proj, sgu_w + (size_t)li * 8 * CH * CH, sgu_b + li * 8 * CH, obuf);
        NV_LAUNCH(gemm_res_body, BUF, obuf, D, mix_w_out + (size_t)li * D * D, D, m0, b0, x);
    }
}
NV_FWD_QUAL void nv_odd(const InPtrs& ip, float* xw, const NvCtx& C, int layer NV_STREAM_PARAM) {
    const float *mu = in(9), *w_rkv = in(10), *w_o = in(11), *w0 = in(12), *w1 = in(13), *w2 = in(14), *a0 = in(15), *a1 = in(16), *a2 = in(17), *v0 = in(18), *v1 = in(19), *v2 = in(20);
    const float *g1 = in(21), *g2 = in(22), *k_k = in(23), *k_a = in(24), *r_k = in(25), *ln_w = in(26), *ln_b = in(27);
    const size_t BUF = (size_t)TC * D; float* big = C.big; float* h = big; float* rinv = C.rinv;
    float* R = big + BUF, *Kb = big + 2 * BUF, *Vb = big + 3 * BUF, *XM = big + 4 * BUF, *Wd = big + 4 * BUF, *Av = big + 5 * BUF, *Y = big;
    float *lwl = C.lwl, *lal = C.lal, *lvl = C.lvl, *lgl = C.lgl;
    const int li = layer / 2;
    for (int b0 = 0; b0 < Bn; b0 += BC) {
        float* x = xw + (size_t)b0 * S * D;
        const float* m0 = C.mod + (size_t)(layer * 2 + 0) * Bn * 3072;
        NV_LAUNCH(rms_body, TC, x, D, D, rinv);
        NV_LAUNCH(modnorm_body, BUF, x, rinv, m0, b0, h);
        const float* muL = mu + (size_t)li * 6 * D;
        float* vf = C.vfirst + (size_t)b0 * S * D;
        NV_LAUNCH(rk_mix_body, BUF, h, muL + 0 * D, XM); NV_LAUNCH(gemm_body, BUF, XM, D, w_rkv + ((size_t)li * 3 + 0) * D * D, D, R, D, D, D, 0);
        NV_LAUNCH(rk_mix_body, BUF, h, muL + 1 * D, XM); NV_LAUNCH(gemm_body, (size_t)TC * LW, XM, D, w1 + (size_t)li * D * LW, LW, lwl, LW, LW, D, 1);
        NV_LAUNCH(rk_mix_body, BUF, h, muL + 2 * D, XM); NV_LAUNCH(gemm_body, BUF, XM, D, w_rkv + ((size_t)li * 3 + 1) * D * D, D, Kb, D, D, D, 0);
        NV_LAUNCH(rk_mix_body, BUF, h, muL + 3 * D, XM); NV_LAUNCH(gemm_body, BUF, XM, D, w_rkv + ((size_t)li * 3 + 2) * D * D, D, Vb, D, D, D, 0);
        if (li > 0) NV_LAUNCH(gemm_body, (size_t)TC * LV, XM, D, v1 + (size_t)(li - 1) * D * LV, LV, lvl, LV, LV, D, 0);
        NV_LAUNCH(rk_mix_body, BUF, h, muL + 4 * D, XM); NV_LAUNCH(gemm_body, (size_t)TC * LA, XM, D, a1 + (size_t)li * D * LA, LA, lal, LA, LA, D, 0);
        NV_LAUNCH(rk_mix_body, BUF, h, muL + 5 * D, XM); NV_LAUNCH(gemm_body, (size_t)TC * LG, XM, D, g1 + (size_t)li * D * LG, LG, lgl, LG, LG, D, 2);
        if (li == 0) {
            NV_LAUNCH(rk_prep_body, BUF, lwl, w2 + (size_t)li * LW * D, w0 + li * D, lal, a2 + (size_t)li * LA * D, a0 + li * D,
                      (const float*)nullptr, (const float*)nullptr, (const float*)nullptr, (const float*)nullptr, Vb, Wd, Av);
            NV_LAUNCH(copy_body, BUF, Vb, vf);
        } else {
            NV_LAUNCH(rk_prep_body, BUF, lwl, w2 + (size_t)li * LW * D, w0 + li * D, lal, a2 + (size_t)li * LA * D, a0 + li * D,
                      lvl, v2 + (size_t)(li - 1) * LV * D, v0 + (li - 1) * D, vf, Vb, Wd, Av);
        }
        NV_LAUNCH(wkv_body, (size_t)BC * RH * HD, R, Wd, Kb, Vb, Av, k_k + li * D, k_a + li * D, Y);
        NV_LAUNCH(rk_post_body, (size_t)TC * RH, Y, R, Kb, Vb, Av, k_a + li * D, r_k + li * D, ln_w + li * D, ln_b + li * D, lgl, g2 + (size_t)li * LG * D, Wd);
        NV_LAUNCH(gemm_res_body, BUF, Wd, D, w_o + (size_t)li * D * D, D, m0, b0, x);
    }
}
NV_FWD_QUAL void nv_moe(const InPtrs& ip, float* xw, const NvCtx& C, int layer NV_STREAM_PARAM) {
    const float *router_w = in(28), *router_b = in(29), *moe_w1 = in(30), *moe_w3 = in(31), *moe_w2 = in(32);
    const size_t BUF = (size_t)TC * D; float* h = C.big; float* hid = C.big + BUF; float* rinv = C.rinv;
    for (int b0 = 0; b0 < Bn; b0 += BC) {
        float* x = xw + (size_t)b0 * S * D;
        const float* m1 = C.mod + (size_t)(layer * 2 + 1) * Bn * 3072;
        NV_LAUNCH(rms_body, TC, x, D, D, rinv);
        NV_LAUNCH(modnorm_body, BUF, x, rinv, m1, b0, h);
        NV_LAUNCH(router_body, TC, h, router_w, router_b, C.eidx, C.ewt);
        NV_LAUNCH(moe_hid_body, (size_t)TC * 2 * DE, h, C.eidx, moe_w1 + (size_t)layer * NE * D * DE, moe_w3 + (size_t)layer * NE * D * DE, hid);
        NV_LAUNCH(moe_out_body, BUF, hid, C.eidx, C.ewt, moe_w2 + (size_t)layer * NE * DE * D, m1, b0, x);
    }
}
NV_FWD_QUAL void nv_final(const InPtrs& ip, float* xw, const NvCtx& C NV_STREAM_PARAM) {
    for (int b0 = 0; b0 < Bn; b0 += BC) {
        float* x = xw + (size_t)b0 * S * D;
        NV_LAUNCH(rms_body, TC, x, D, D, C.rinv);
        NV_LAUNCH(final_body, (size_t)TC * D, x, C.rinv, in(33), x);
    }
}
#undef in
#if defined(NV_PERSIST)
#define NV_PASS , nv_bar, nv_gtid, nv_nthr
#elif defined(CPU_EMU)
#define NV_PASS
#else
#define NV_PASS , stream
#endif
NV_FWD_QUAL void naive_forward(const InPtrs& ip, float* xw, float* ws NV_STREAM_PARAM) {
    const NvCtx C = nv_ctx(ws);
    nv_prologue(ip, xw, C NV_PASS);
    for (int layer = 0; layer < 4; ++layer) {
        if (layer % 2 == 0) nv_even(ip, xw, C, layer NV_PASS); else nv_odd(ip, xw, C, layer NV_PASS);
        nv_moe(ip, xw, C, layer NV_PASS);
    }
    nv_final(ip, xw, C NV_PASS);
}
}
namespace pg8 {
#define PG8_LAS __attribute__((address_space(3)))
typedef unsigned short bf16_t;
typedef short bf16x8 __attribute__((ext_vector_type(8)));
typedef float f32x4 __attribute__((ext_vector_type(4)));
typedef unsigned u32x4 __attribute__((ext_vector_type(4)));
constexpr int BM = 256, BK = 64, HALF = 128, HTB = HALF * BK * 2  , STAGE_BYTES = 8 * HTB, NXCD = 8, WGM = 8;

__host__ __device__ __forceinline__ int lds_byte(int r, int c) { const int st = (r >> 4) * 2 + (c >> 5), rr = r & 15, cc = c & 31, ob = rr * 64 + cc * 2; return st * 1024 + (ob ^ (((ob >> 9) & 1) << 5)); }
__host__ __device__ __forceinline__ void stage_rc(int b, int& R, int& C) { const int st = b / 1024, sb = b % 1024, swz = sb ^ (((sb >> 9) & 1) << 5); R = (st >> 1) * 16 + swz / 64; C = (st & 1) * 32 + (swz % 64) / 2; }
__host__ __device__ __forceinline__ int perm32(int rho) { const int n = rho >> 4, i = rho & 15; return 8 * (i >> 2) + 4 * n + (i & 3); }

struct Unit { int pm, pn; };
struct Gemm { int K; };
__device__ __forceinline__ unsigned cvt_pk_bf16(float lo, float hi) { unsigned r; asm volatile("v_cvt_pk_bf16_f32 %0, %1, %2" : "=v"(r) : "v"(lo), "v"(hi)); return r; }
typedef float f32x2 __attribute__((ext_vector_type(2)));
__device__ __forceinline__ f32x2 gelu_pk(f32x2 v) {
    const f32x2 av = __builtin_elementwise_abs(v), d = av * 0.2316418882f + 1.0f;
    f32x2 t; t.x = __builtin_amdgcn_rcpf(d.x); t.y = __builtin_amdgcn_rcpf(d.y);
    f32x2 q = t * 0.5307027145f + (-0.7265760135f); q = q * t + 0.7107068705f; q = q * t + (-0.142248368f); q = q * t + 0.127414796f; q = q * t;
    const f32x2 s = (v * v) * (-0.72134752044f);
    f32x2 e; e.x = __builtin_amdgcn_exp2f(s.x); e.y = __builtin_amdgcn_exp2f(s.y);
    const f32x2 m = v * (q * e), r = v - m;
    f32x2 o; o.x = v.x < 0.f ? m.x : r.x; o.y = v.y < 0.f ? m.y : r.y; return o;
}
template <class Epi, class Sched, bool ALIGN_EPI = false, bool SP2 = false>
__device__ __forceinline__ void gemm_phase(PG8_LAS unsigned char* lds, const Gemm g, const Sched& S, const Epi& E) {
    int tid_ = threadIdx.x; asm volatile("" : "+v"(tid_));
    const int tid = tid_, wid = __builtin_amdgcn_readfirstlane(tid >> 6), lane = tid & 63, wr = wid >> 2, wc = wid & 3, fr = lane & 15, fq = lane >> 4;
    int Kop = g.K; asm volatile("" : "+s"(Kop));
    const int K = Kop, nt = K / BK;
    unsigned voffA[2], voffB[2];
#pragma unroll
    for (int i = 0; i < 2; ++i) { int R, C; stage_rc(tid * 16 + i * 8192, R, C); const int Rb = Epi::PERM ? ((R & ~31) + perm32(R & 31)) : R;
        voffA[i] = (unsigned)(R * K + C) * 2u; voffB[i] = (unsigned)(Rb * K + C) * 2u; }
    const size_t kstep = (size_t)(BK * 2);
    const size_t hstep = (size_t)HALF * K * 2;
        const unsigned ldsw = (unsigned)wid * 1024u;
    const int aoff = lds_byte(wr * 64 + fr, fq * 8), boff = lds_byte(wc * 32 + fr, fq * 8);
#define PG8_SA(b, h) (((b) * 2 + (h)) * HTB)
#define PG8_SB(b, h) ((4 + (b) * 2 + (h)) * HTB)
#define PG8_STAGE(bufoff, gbase, voff) do { _Pragma("unroll") for (int _i = 0; _i < 2; ++_i) \
        __builtin_amdgcn_global_load_lds((const unsigned*)((const char*)(gbase) + (voff)[_i]), (PG8_LAS unsigned*)(lds + (bufoff) + ldsw + _i * 8192), 16, 0, 0); } while (0)
#define PG8_LDA(dst, b, h) do { _Pragma("unroll") for (int m = 0; m < 4; ++m) _Pragma("unroll") for (int k = 0; k < 2; ++k) dst[m][k] = *(const PG8_LAS bf16x8*)(lds + PG8_SA(b, h) + aoff + m * 2048 + k * 1024); } while (0)
#define PG8_LDB(dst, b, h) do { _Pragma("unroll") for (int n = 0; n < 2; ++n) _Pragma("unroll") for (int k = 0; k < 2; ++k) dst[n][k] = *(const PG8_LAS bf16x8*)(lds + PG8_SB(b, h) + boff + n * 2048 + k * 1024); } while (0)
#define PG8_MMA(ai, bj, At, Bt) do { __builtin_amdgcn_s_setprio(1); _Pragma("unroll") for (int m = 0; m < 4; ++m) _Pragma("unroll") for (int n = 0; n < 2; ++n) _Pragma("unroll") for (int k = 0; k < 2; ++k) \
        acc[ai][bj][m][n] = __builtin_amdgcn_mfma_f32_16x16x32_bf16(Bt[n][k], At[m][k], acc[ai][bj][m][n], 0, 0, 0); __builtin_amdgcn_s_setprio(0); } while (0)
#define PG8_WAIT_V(n) asm volatile("s_waitcnt vmcnt(" #n ")" ::: "memory")
#define PG8_WAIT_L(n) asm volatile("s_waitcnt lgkmcnt(" #n ")" ::: "memory")
#define PG8_BAR __builtin_amdgcn_s_barrier()
#define PG8_SCHED __builtin_amdgcn_sched_barrier(0)
    Unit cur, nxt; int ui = 0;
    if (!S.next(0, cur)) return;
    f32x4 acc[2][2][4][2];
#pragma unroll
    for (int a = 0; a < 2; ++a)
#pragma unroll
        for (int b = 0; b < 2; ++b)
#pragma unroll
            for (int m = 0; m < 4; ++m)
#pragma unroll
                for (int n = 0; n < 2; ++n) acc[a][b][m][n] = (f32x4){0.f, 0.f, 0.f, 0.f};
    bf16x8 At[4][2], B0[2][2], B1[2][2];
    const char* cA = S.a_base(cur); const char* cB = S.b_base(cur);
    S.a_ready(cur);
    if constexpr (SP2) {
        PG8_STAGE(PG8_SB(0, 0), cB, voffB); PG8_STAGE(PG8_SB(0, 1), cB + hstep, voffB); PG8_STAGE(PG8_SA(0, 0), cA, voffA); PG8_STAGE(PG8_SA(0, 1), cA + hstep, voffA);
        if (wr == 1) PG8_BAR;
        PG8_WAIT_V(2); PG8_BAR;
        PG8_STAGE(PG8_SB(1, 0), cB + kstep, voffB); PG8_STAGE(PG8_SA(1, 0), cA + kstep, voffA); PG8_STAGE(PG8_SB(1, 1), cB + hstep + kstep, voffB);
        PG8_WAIT_V(6); PG8_BAR;
    } else {
        PG8_STAGE(PG8_SB(0, 0), cB, voffB); PG8_STAGE(PG8_SA(0, 0), cA, voffA); PG8_STAGE(PG8_SB(0, 1), cB + hstep, voffB); PG8_STAGE(PG8_SA(0, 1), cA + hstep, voffA);
        if (wr == 1) PG8_BAR;
        PG8_WAIT_V(4); PG8_BAR;
        PG8_STAGE(PG8_SB(1, 0), cB + kstep, voffB); PG8_STAGE(PG8_SA(1, 0), cA + kstep, voffA); PG8_STAGE(PG8_SB(1, 1), cB + hstep + kstep, voffB);
        PG8_WAIT_V(6); PG8_BAR;
    }
    for (;;) {
        const bool has_next = S.next(ui + 1, nxt);
        const char* nA = has_next ? S.a_base(nxt) : cA; const char* nB = has_next ? S.b_base(nxt) : cB;
        for (int t = 0; t < nt; t += 2) {
            const bool last = (t == nt - 2);
            const char* a1 = cA + (size_t)(t + 1) * kstep;
            const char* a2 = last ? nA : cA + (size_t)(t + 2) * kstep; const char* b2 = last ? nB : cB + (size_t)(t + 2) * kstep;
            const char* a3 = a2 + kstep; const char* b3 = b2 + kstep;
            if (last && has_next) S.a_ready(nxt);
            if constexpr (SP2) {
            PG8_LDB(B0, 0, 0); PG8_LDB(B1, 0, 1); PG8_SCHED; PG8_LDA(At, 0, 0); PG8_STAGE(PG8_SA(1, 1), a1 + hstep, voffA);
            PG8_WAIT_V(8); PG8_WAIT_L(0); PG8_BAR; PG8_MMA(0, 0, At, B0); PG8_MMA(0, 1, At, B1); PG8_BAR; PG8_SCHED;
            PG8_LDA(At, 0, 1); PG8_STAGE(PG8_SB(0, 0), b2, voffB); PG8_STAGE(PG8_SB(0, 1), b2 + hstep, voffB); PG8_STAGE(PG8_SA(0, 0), a2, voffA);
            PG8_WAIT_V(8); PG8_WAIT_L(0); PG8_BAR; PG8_MMA(1, 0, At, B0); PG8_MMA(1, 1, At, B1); PG8_BAR; PG8_SCHED;
            PG8_LDB(B0, 1, 0); PG8_LDB(B1, 1, 1); PG8_SCHED; PG8_LDA(At, 1, 0); PG8_STAGE(PG8_SA(0, 1), a2 + hstep, voffA);
            PG8_WAIT_V(8); PG8_WAIT_L(0); PG8_BAR; PG8_MMA(0, 0, At, B0); PG8_MMA(0, 1, At, B1); PG8_BAR; PG8_SCHED;
            PG8_LDA(At, 1, 1); PG8_STAGE(PG8_SB(1, 0), b3, voffB); PG8_STAGE(PG8_SB(1, 1), b3 + hstep, voffB); PG8_STAGE(PG8_SA(1, 0), a3, voffA);
            PG8_WAIT_V(8); PG8_WAIT_L(0); PG8_BAR; PG8_MMA(1, 0, At, B0); PG8_MMA(1, 1, At, B1); PG8_BAR; PG8_SCHED;
            } else {
            PG8_LDB(B0, 0, 0); PG8_SCHED; PG8_LDA(At, 0, 0); PG8_STAGE(PG8_SA(1, 1), a1 + hstep, voffA);
            PG8_WAIT_L(8); PG8_BAR; PG8_WAIT_L(0); PG8_MMA(0, 0, At, B0); PG8_BAR; PG8_SCHED;
            PG8_LDB(B1, 0, 1); PG8_STAGE(PG8_SB(0, 0), b2, voffB);
            PG8_BAR; PG8_WAIT_L(0); PG8_MMA(0, 1, At, B1); PG8_BAR;
            PG8_LDA(At, 0, 1); PG8_STAGE(PG8_SA(0, 0), a2, voffA);
            PG8_BAR; PG8_WAIT_L(0); PG8_MMA(1, 0, At, B0); PG8_BAR; PG8_SCHED;
            PG8_STAGE(PG8_SB(0, 1), b2 + hstep, voffB);
            PG8_WAIT_V(6); PG8_BAR; PG8_MMA(1, 1, At, B1); PG8_BAR;
            PG8_LDB(B0, 1, 0); PG8_SCHED; PG8_LDA(At, 1, 0); PG8_STAGE(PG8_SA(0, 1), a2 + hstep, voffA);
            PG8_WAIT_L(8); PG8_BAR; PG8_WAIT_L(0); PG8_MMA(0, 0, At, B0); PG8_BAR; PG8_SCHED;
            PG8_LDB(B1, 1, 1); PG8_STAGE(PG8_SB(1, 0), b3, voffB);
            PG8_BAR; PG8_WAIT_L(0); PG8_MMA(0, 1, At, B1); PG8_BAR;
            PG8_LDA(At, 1, 1); PG8_STAGE(PG8_SA(1, 0), a3, voffA);
            PG8_BAR; PG8_WAIT_L(0); PG8_MMA(1, 0, At, B0); PG8_BAR; PG8_SCHED;
            PG8_STAGE(PG8_SB(1, 1), b3 + hstep, voffB);
            PG8_WAIT_V(6); PG8_BAR; PG8_MMA(1, 1, At, B1); PG8_BAR;
            }
        }
        if constexpr (ALIGN_EPI) { if (wr == 0) PG8_BAR; }
        if constexpr (!Epi::AFTER_DRAIN) { E(acc, cur, wr, wc, fr, fq); S.done(cur); }
        if (!has_next) break;
#pragma unroll
        for (int a = 0; a < 2; ++a)
#pragma unroll
            for (int b = 0; b < 2; ++b)
#pragma unroll
                for (int m = 0; m < 4; ++m)
#pragma unroll
                    for (int n = 0; n < 2; ++n) acc[a][b][m][n] = (f32x4){0.f, 0.f, 0.f, 0.f};
        cur = nxt; cA = nA; cB = nB; ++ui;
        if constexpr (ALIGN_EPI) { if (wr == 1) PG8_BAR; }
    }
    PG8_WAIT_V(0);
    if constexpr (!ALIGN_EPI) { if (wr == 0) PG8_BAR; }
    PG8_BAR;
    if constexpr (Epi::AFTER_DRAIN) { E.fused(acc, cur, wr, wc, fr, fq, lds, wid, lane); S.done(cur); }
#undef PG8_SA
#undef PG8_SB
#undef PG8_STAGE
#undef PG8_LDA
#undef PG8_LDB
#undef PG8_MMA
#undef PG8_WAIT_V
#undef PG8_WAIT_L
#undef PG8_BAR
#undef PG8_SCHED
}
}
namespace fm {
using pg8::bf16_t; using pg8::f32x4; using pg8::u32x4; using pg8::Unit;
typedef unsigned v4u __attribute__((ext_vector_type(4)));
typedef unsigned v2u __attribute__((ext_vector_type(2)));
constexpr int T = 16384, D = 1024, S = 2048, NB = 8, NWAVES = 8;
constexpr size_t MiB = 1u << 20;
constexpr size_t WS_CTL = 0, CTL_ZERO_BYTES = 64 * 1024;
constexpr size_t WS_SMALL = 1 * MiB;
constexpr size_t WS_NAIVE = 4 * MiB;
constexpr size_t WS_NAIVE_BIG = 120 * MiB;
constexpr size_t WS_WMIX = 80 * MiB;
constexpr size_t WS_WMOE = 120 * MiB;
constexpr size_t WS_XN = 144 * MiB;
constexpr size_t WS_R1 = 176 * MiB;
constexpr size_t WS_YS = WS_R1;
constexpr size_t WS_AG = WS_R1 + 64 * MiB + 4096;
constexpr size_t WS_HID = WS_R1 + 137 * MiB;
constexpr size_t WS_END = 400 * MiB;
constexpr size_t SM_TOKE = 0;
constexpr size_t SM_TOKW = 128 * 1024;
constexpr size_t SM_CNTG = 256 * 1024;
constexpr size_t SM_ROWINFO = 384 * 1024;
constexpr size_t SM_ROWW = 640 * 1024;
constexpr int MOE_ROWS_MAX = 2 * T + 16 * 256;
constexpr int LX_SEG = 1024, LX_TILEE = 1152, LX_BASE = 1792, LX_DPOS = 2048, LX_TE = 2560, LX_TW = 3072, LX_PS = 4096, LX_PB = 6144;

struct Ctx {
    LAS unsigned char* lds; int tid, lane, wave, G, wg, vcu;
};
__device__ __forceinline__ float wave_sum(float v) {
#pragma unroll
    for (int o = 1; o < 64; o <<= 1) v += __shfl_xor(v, o);
    return v;
}
__device__ __forceinline__ unsigned f2bf(float f) { unsigned u = __builtin_bit_cast(unsigned, f); return (u + 0x7fffu + ((u >> 16) & 1u)) >> 16; }
__device__ __forceinline__ unsigned pk2(float lo, float hi) { return f2bf(lo) | (f2bf(hi) << 16); }
__device__ __forceinline__ float bf2f(unsigned short b) { return __builtin_bit_cast(float, (unsigned)b << 16); }
__device__ __forceinline__ float bflo(unsigned w) { return __builtin_bit_cast(float, w << 16); }
__device__ __forceinline__ float bfhi(unsigned w) { return __builtin_bit_cast(float, w & 0xffff0000u); }
#define LDS_WAIT() asm volatile("s_waitcnt lgkmcnt(0)" ::: "memory")
__device__ __forceinline__ void transpose_item(const float* W, int N, bf16_t* WT, int ldk, int k0, int n0, int drow0, LAS float* scr, int lane) {
#pragma unroll 8
    for (int i = 0; i < 32; ++i) { const int kk = 2 * i + (lane >> 5); scr[kk * 33 + (lane & 31)] = W[(size_t)(k0 + kk) * N + n0 + (lane & 31)]; }
    LDS_WAIT(); asm volatile("" ::: "memory");
    const int c = lane & 7;
#pragma unroll
    for (int j = 0; j < 4; ++j) { const int n = (lane >> 3) + 8 * j; const LAS float* s = scr + (8 * c) * 33 + n;
        v4u o; o.x = pk2(s[0 * 33], s[1 * 33]); o.y = pk2(s[2 * 33], s[3 * 33]); o.z = pk2(s[4 * 33], s[5 * 33]); o.w = pk2(s[6 * 33], s[7 * 33]);
        *(v4u*)(WT + (size_t)(drow0 + n) * ldk + k0 + 8 * c) = o; }
    LDS_WAIT(); asm volatile("" ::: "memory");
}
__device__ __forceinline__ void transpose_item_pad(const float* W, int N, int nvalid, int kvalid, bf16_t* WT, int ldk, int k0, int n0, int drow0, LAS float* scr, int lane) {
#pragma unroll 8
    for (int i = 0; i < 32; ++i) { const int kk = 2 * i + (lane >> 5); const int n = n0 + (lane & 31); float v = 0.f; if (n < nvalid && (k0 + kk) < kvalid) v = W[(size_t)(k0 + kk) * N + n]; scr[kk * 33 + (lane & 31)] = v; }
    LDS_WAIT(); asm volatile("" ::: "memory");
    const int c = lane & 7;
#pragma unroll
    for (int j = 0; j < 4; ++j) { const int n = (lane >> 3) + 8 * j; const LAS float* s = scr + (8 * c) * 33 + n;
        v4u o; o.x = pk2(s[0 * 33], s[1 * 33]); o.y = pk2(s[2 * 33], s[3 * 33]); o.z = pk2(s[4 * 33], s[5 * 33]); o.w = pk2(s[6 * 33], s[7 * 33]);
        *(v4u*)(WT + (size_t)(drow0 + n) * ldk + k0 + 8 * c) = o; }
    LDS_WAIT(); asm volatile("" ::: "memory");
}
__device__ __forceinline__ float fast_sigmoid(float v) { return __builtin_amdgcn_rcpf(1.f + __expf(-v)); }
}
namespace fm {
__device__ __forceinline__ void moe_convert_weights(const Ctx& F_, const float* w1, const float* w3, const float* w2, int layer) {
    Ctx F = F_; asm volatile("" : "+v"(F.tid), "+v"(F.lane));
    unsigned char* const ws_ = kws();
    LAS float* scr = (LAS float*)(F.lds + F.wave * 8448);
    bf16_t* W13T = (bf16_t*)(ws_ + WS_WMOE); bf16_t* W2T = W13T + (size_t)16 * 512 * 1024;
    const int gw = F.wg * NWAVES + F.wave, NGW = F.G * NWAVES;
    for (int it = gw; it < 16 * 384; it += NGW) {
        const int e = it / 384, r = it % 384;
        const size_t eoff = (size_t)(layer * 16 + e);
        if (r < 256) {
            const int q = r & 127, kb = q >> 3, nb = q & 7, n0 = nb * 32;
            const float* W = (r < 128 ? w1 : w3) + eoff * 1024 * 256;
            transpose_item(W, 256, W13T + (size_t)e * 512 * 1024, 1024, kb * 64, n0, (n0 >> 7) * 256 + (n0 & 127) + (r < 128 ? 0 : 128), scr, F.lane);
        } else {
            const int q = r - 256, kb = q >> 5, nb = q & 31;
            transpose_item(w2 + eoff * 256 * 1024, 1024, W2T + (size_t)e * 1024 * 256, 256, kb * 64, nb * 32, nb * 32, scr, F.lane);
        }
    }
}
__device__ __forceinline__ void moe_route_phase(const Ctx& F_, const float* router_w, const float* router_b, int layer) {
    Ctx F = F_; asm volatile("" : "+v"(F.tid), "+v"(F.lane));
    unsigned char* const ws_ = kws(); const float* const x_ = kout(); const float* const mod_ = (const float*)(ws_ + WS_NAIVE);
    LAS float* rwT = (LAS float*)F.lds;
    LAS int* cnt = (LAS int*)(F.lds + 65536);
    for (int i = F.tid; i < 16384; i += NTHREADS) { const int e = i >> 10, c = i & 1023; rwT[i] = router_w[c * 16 + e]; }
    if (F.tid < 16) cnt[F.tid] = 0;
    __syncthreads();
    int* tok_e = (int*)(ws_ + WS_SMALL + SM_TOKE); float* tok_w = (float*)(ws_ + WS_SMALL + SM_TOKW);
    bf16_t* XN = (bf16_t*)(ws_ + WS_XN);
    const int row0 = F.wg * 64 + F.wave * 8, b = row0 / S;
    const float* m = mod_ + ((size_t)(layer * 2 + 1) * NB + b) * 3072;
    float rb[16];
#pragma unroll
    for (int e = 0; e < 16; ++e) rb[e] = router_b[e];
#pragma unroll 1
    for (int r = 0; r < 8; ++r) {
        const int row = row0 + r;
        const f32x4* xr = (const f32x4*)(x_ + (size_t)row * D) + F.lane;
        f32x4 v[4]; float ss = 0.f;
#pragma unroll
        for (int j = 0; j < 4; ++j) { v[j] = xr[64 * j]; ss += (v[j].x * v[j].x + v[j].y * v[j].y) + (v[j].z * v[j].z + v[j].w * v[j].w); }
        const float rinv = 1.0f / sqrtf(wave_sum(ss) * (1.f / D) + 1e-6f);
        unsigned long long* o8 = (unsigned long long*)(XN + (size_t)row * D) + F.lane;
#pragma unroll
        for (int j = 0; j < 4; ++j) {
            const f32x4 sh = ((const f32x4*)m)[64 * j + F.lane], sc = ((const f32x4*)(m + 1024))[64 * j + F.lane];
            v[j] = v[j] * rinv * (sc + 1.0f) + sh;
            o8[64 * j] = (unsigned long long)pk2(v[j].x, v[j].y) | ((unsigned long long)pk2(v[j].z, v[j].w) << 32);
        }
        asm volatile("" ::: "memory");
        float acc[16];
#pragma unroll
        for (int e = 0; e < 16; ++e) {
            float a = 0.f;
#pragma unroll
            for (int j = 0; j < 4; ++j) { const f32x4 w = *(const LAS f32x4*)(rwT + e * 1024 + 256 * j + 4 * F.lane); a += (v[j].x * w.x + v[j].y * w.y) + (v[j].z * w.z + v[j].w * w.w); }
            acc[e] = a;
            if ((e & 1) == 1) asm volatile("" ::: "memory");
        }
        float s[16], sel[16];
#pragma unroll
        for (int e = 0; e < 16; ++e) { const float lg = wave_sum(acc[e]); s[e] = 1.f / (1.f + expf(-lg)); sel[e] = s[e] + rb[e]; }
        int bg = 0; float bgs = -INFINITY;
#pragma unroll
        for (int g = 0; g < 4; ++g) {
            const float a0 = sel[4 * g], a1 = sel[4 * g + 1], a2 = sel[4 * g + 2], a3 = sel[4 * g + 3];
            const float m1 = fmaxf(fmaxf(a0, a1), fmaxf(a2, a3));
            const float lo01 = fminf(a0, a1), hi01 = fmaxf(a0, a1), lo23 = fminf(a2, a3), hi23 = fmaxf(a2, a3);
            const float m2 = fmaxf(fminf(hi01, hi23), fmaxf(lo01, lo23));
            const float gs = m1 + m2;
            if (gs > bgs) { bgs = gs; bg = g; }
        }
        float g0 = sel[0], g1 = sel[1], g2 = sel[2], g3 = sel[3], t0 = s[0], t1 = s[1], t2 = s[2], t3 = s[3];
#pragma unroll
        for (int g = 1; g < 4; ++g) if (bg == g) { g0 = sel[4 * g]; g1 = sel[4 * g + 1]; g2 = sel[4 * g + 2]; g3 = sel[4 * g + 3]; t0 = s[4 * g]; t1 = s[4 * g + 1]; t2 = s[4 * g + 2]; t3 = s[4 * g + 3]; }
        int i0 = 0; float v0 = g0, w0 = t0;
        if (g1 > v0) { v0 = g1; i0 = 1; w0 = t1; } if (g2 > v0) { v0 = g2; i0 = 2; w0 = t2; } if (g3 > v0) { v0 = g3; i0 = 3; w0 = t3; }
        int i1 = -1; float v1 = -INFINITY, w1 = 0.f;
        if (i0 != 0 && g0 > v1) { v1 = g0; i1 = 0; w1 = t0; } if (i0 != 1 && g1 > v1) { v1 = g1; i1 = 1; w1 = t1; }
        if (i0 != 2 && g2 > v1) { v1 = g2; i1 = 2; w1 = t2; } if (i0 != 3 && g3 > v1) { v1 = g3; i1 = 3; w1 = t3; }
        const int e0 = bg * 4 + i0, e1 = bg * 4 + i1; const float inv = 1.f / (w0 + w1);
        if (F.lane == 0) { tok_e[row * 2] = e0; tok_e[row * 2 + 1] = e1; tok_w[row * 2] = w0 * inv; tok_w[row * 2 + 1] = w1 * inv;
            __hip_atomic_fetch_add(cnt + e0, 1, __ATOMIC_RELAXED, __HIP_MEMORY_SCOPE_WORKGROUP); __hip_atomic_fetch_add(cnt + e1, 1, __ATOMIC_RELAXED, __HIP_MEMORY_SCOPE_WORKGROUP); }
    }
    __syncthreads();
    if (F.tid < 16) ((int*)(ws_ + WS_SMALL + SM_CNTG))[F.wg * 16 + F.tid] = cnt[F.tid];
}
__device__ __forceinline__ void moe_sort_phase(const Ctx& F_) {
    Ctx F = F_; asm volatile("" : "+v"(F.tid), "+v"(F.lane));
    unsigned char* const ws_ = kws();
    LAS unsigned char* X = F.lds + LDSCTL_OFF;
    LAS int* seg = (LAS int*)(X + LX_SEG); LAS int* tile_e = (LAS int*)(X + LX_TILEE); LAS int* base = (LAS int*)(X + LX_BASE); LAS int* dpos = (LAS int*)(X + LX_DPOS);
    LAS int* te = (LAS int*)(X + LX_TE); LAS float* tw = (LAS float*)(X + LX_TW); LAS int* ps = (LAS int*)(X + LX_PS); LAS int* pb = (LAS int*)(X + LX_PB);
    const int* cntG = (const int*)(ws_ + WS_SMALL + SM_CNTG);
    const int* tok_e = (const int*)(ws_ + WS_SMALL + SM_TOKE); const float* tok_w = (const float*)(ws_ + WS_SMALL + SM_TOKW);
    int* rowinfo = (int*)(ws_ + WS_SMALL + SM_ROWINFO); float* roww = (float*)(ws_ + WS_SMALL + SM_ROWW);
    { const int e = F.tid & 15, part = F.tid >> 4; int tot = 0, bef = 0;
#pragma unroll
        for (int i = 0; i < 8; ++i) { const int w = part * 8 + i; const int c = cntG[w * 16 + e]; tot += c; bef += (w < F.wg) ? c : 0; }
        ps[part * 16 + e] = tot; pb[part * 16 + e] = bef; }
    if (F.tid < 128) { te[F.tid] = tok_e[F.wg * 128 + F.tid]; tw[F.tid] = tok_w[F.wg * 128 + F.tid]; }
    __syncthreads();
    if (F.tid == 0) {
        int run = 0;
        for (int e = 0; e < 16; ++e) { int tot = 0, bef = 0; for (int p = 0; p < 32; ++p) { tot += ps[p * 16 + e]; bef += pb[p * 16 + e]; }
            seg[e] = run; base[e] = run + bef; ps[e] = tot; run += (tot + 255) & ~255; }
        seg[16] = run;
        for (int i = 0; i < 128; ++i) { const int e = te[i]; const int pos = base[e]; base[e] = pos + 1; dpos[i] = pos; rowinfo[pos] = (i & 1) * T + F.wg * 64 + (i >> 1); roww[pos] = tw[i]; }
    }
    __syncthreads();
    const int ntile = seg[16] >> 8;
    for (int t = F.tid; t < ntile; t += NTHREADS) { int e = 0;
#pragma unroll
        for (int k = 1; k < 16; ++k) e += (t * 256 >= seg[k]) ? 1 : 0;
        tile_e[t] = e; }
    if (F.wg < 16) { const int e = F.wg; for (int p = seg[e] + ps[e] + F.tid; p < seg[e + 1]; p += NTHREADS) rowinfo[p] = 2 * T; }
    const bf16_t* XN = (const bf16_t*)(ws_ + WS_XN); bf16_t* AG = (bf16_t*)(ws_ + WS_AG);
    for (int r = 0; r < 8; ++r) {
        const int lr = F.wave * 8 + r, row = F.wg * 64 + lr;
        const v4u* src = (const v4u*)(XN + (size_t)row * D) + F.lane; const v4u a = src[0], b = src[64];
        const int p0 = dpos[lr * 2], p1 = dpos[lr * 2 + 1];
        v4u* d0 = (v4u*)(AG + (size_t)p0 * D) + F.lane; v4u* d1 = (v4u*)(AG + (size_t)p1 * D) + F.lane;
        d0[0] = a; d0[64] = b; d1[0] = a; d1[64] = b;
    }
}
struct SchedMoe {
    const char* A; const char* Bw; size_t a_tile, b_exp, b_tile; int n_units, G, c, sh; const LAS int* tile_e;
    __device__ __forceinline__ bool next(int i, Unit& u) const { const long L = (long)i * G + c; if (L >= n_units) return false; u.pm = (int)(L >> sh); u.pn = (int)(L & ((1 << sh) - 1)); return true; }
    __device__ __forceinline__ const char* a_base(const Unit& u) const { return A + (size_t)u.pm * a_tile; }
    __device__ __forceinline__ const char* b_base(const Unit& u) const { const int e = __builtin_amdgcn_readfirstlane(tile_e[u.pm]); return Bw + (size_t)e * b_exp + (size_t)u.pn * b_tile; }
    __device__ __forceinline__ void a_ready(const Unit&) const {}
    __device__ __forceinline__ void done(const Unit&) const {}
};
struct EpiSwiglu {
    static constexpr bool PERM = true, AFTER_DRAIN = false;
    bf16_t* HID;
    __device__ __forceinline__ void operator()(const f32x4 (&acc)[2][2][4][2], const Unit& u, int wr, int wc, int fr, int fq) const {
        const int row0 = u.pm * 256 + wr * 64 + fr, col0 = u.pn * 128 + wc * 32 + 8 * fq;
#pragma unroll
        for (int ai = 0; ai < 2; ++ai)
#pragma unroll
            for (int m = 0; m < 4; ++m) {
                float h[8];
#pragma unroll
                for (int n = 0; n < 2; ++n)
#pragma unroll
                    for (int q = 0; q < 4; ++q) { const float a = acc[ai][0][m][n][q], g = acc[ai][1][m][n][q]; h[4 * n + q] = a * fast_sigmoid(a) * g; }
                u32x4 w; w.x = pg8::cvt_pk_bf16(h[0], h[1]); w.y = pg8::cvt_pk_bf16(h[2], h[3]); w.z = pg8::cvt_pk_bf16(h[4], h[5]); w.w = pg8::cvt_pk_bf16(h[6], h[7]);
                *(u32x4*)(HID + (size_t)(row0 + ai * 128 + m * 16) * 256 + col0) = w;
                asm volatile("" ::: "memory");
            }
    }
};
struct EpiMoeOut {
    static constexpr bool PERM = true, AFTER_DRAIN = false;
    const int* rowinfo; const float* roww; bf16_t* YS;
    __device__ __forceinline__ void operator()(const f32x4 (&acc)[2][2][4][2], const Unit& u, int wr, int wc, int fr, int fq) const {
        const int row0 = u.pm * 256 + wr * 64 + fr; const unsigned col0 = u.pn * 256 + wc * 32 + 8 * fq;
#pragma unroll
        for (int ai = 0; ai < 2; ++ai)
#pragma unroll
            for (int m = 0; m < 4; ++m) {
                const int r = row0 + ai * 128 + m * 16; const unsigned drow = (unsigned)rowinfo[r]; const float w = roww[r];
                bf16_t* dst = YS + (drow * 1024u + col0);
#pragma unroll
                for (int bj = 0; bj < 2; ++bj) { const f32x4 v0 = acc[ai][bj][m][0] * w, v1 = acc[ai][bj][m][1] * w;
                    u32x4 o; o.x = pg8::cvt_pk_bf16(v0[0], v0[1]); o.y = pg8::cvt_pk_bf16(v0[2], v0[3]); o.z = pg8::cvt_pk_bf16(v1[0], v1[1]); o.w = pg8::cvt_pk_bf16(v1[2], v1[3]);
                    *(u32x4*)(dst + bj * 128) = o; }
                asm volatile("" ::: "memory");
            }
    }
};
__device__ __forceinline__ void moe_gemm1_phase(const Ctx& F_) {
    Ctx F = F_; asm volatile("" : "+v"(F.tid), "+v"(F.lane));
    unsigned char* const ws_ = kws();
    LAS unsigned char* X = F.lds + LDSCTL_OFF; const LAS int* seg = (const LAS int*)(X + LX_SEG);
    const int ntile = __builtin_amdgcn_readfirstlane(seg[16]) >> 8;
    SchedMoe Sc{(const char*)(ws_ + WS_AG), (const char*)(ws_ + WS_WMOE), (size_t)256 * 1024 * 2, (size_t)512 * 1024 * 2, (size_t)256 * 1024 * 2, ntile * 2, F.G, F.vcu, 1, (const LAS int*)(X + LX_TILEE)};
    EpiSwiglu E{(bf16_t*)(ws_ + WS_HID)};
    pg8::gemm_phase<EpiSwiglu, SchedMoe, true, true>(F.lds, pg8::Gemm{1024}, Sc, E);
}
__device__ __forceinline__ void moe_gemm2_phase(const Ctx& F_) {
    Ctx F = F_; asm volatile("" : "+v"(F.tid), "+v"(F.lane));
    unsigned char* const ws_ = kws();
    LAS unsigned char* X = F.lds + LDSCTL_OFF; const LAS int* seg = (const LAS int*)(X + LX_SEG);
    const int ntile = __builtin_amdgcn_readfirstlane(seg[16]) >> 8;
    SchedMoe Sc{(const char*)(ws_ + WS_HID), (const char*)(ws_ + WS_WMOE) + (size_t)16 * 512 * 1024 * 2, (size_t)256 * 256 * 2, (size_t)1024 * 256 * 2, (size_t)256 * 256 * 2, ntile * 4, F.G, F.vcu, 2, (const LAS int*)(X + LX_TILEE)};
    EpiMoeOut E{(const int*)(ws_ + WS_SMALL + SM_ROWINFO), (const float*)(ws_ + WS_SMALL + SM_ROWW), (bf16_t*)(ws_ + WS_YS)};
    pg8::gemm_phase<EpiMoeOut, SchedMoe, true, true>(F.lds, pg8::Gemm{256}, Sc, E);
}
__device__ __forceinline__ void moe_combine_phase(const Ctx& F_, int layer) {
    Ctx F = F_; asm volatile("" : "+v"(F.tid), "+v"(F.lane));
    unsigned char* const ws_ = kws(); float* const x_ = kout(); const float* const mod_ = (const float*)(ws_ + WS_NAIVE);
    const bf16_t* YS = (const bf16_t*)(ws_ + WS_YS);
    const int row0 = F.wg * 64 + F.wave * 8, b = row0 / S;
    const float* m = mod_ + ((size_t)(layer * 2 + 1) * NB + b) * 3072 + 2048;
    f32x4 gt[4];
#pragma unroll
    for (int j = 0; j < 4; ++j) gt[j] = ((const f32x4*)m)[64 * j + F.lane];
    for (int r = 0; r < 8; ++r) {
        const int row = row0 + r;
        f32x4* xr = (f32x4*)(x_ + (size_t)row * D) + F.lane;
        const v2u* y0 = (const v2u*)(YS + (size_t)row * D) + F.lane; const v2u* y1 = (const v2u*)(YS + ((size_t)T + row) * D) + F.lane;
#pragma unroll
        for (int j = 0; j < 4; ++j) { const v2u a = y0[64 * j], c = y1[64 * j]; f32x4 v = xr[64 * j];
            v.x += gt[j].x * (bflo(a.x) + bflo(c.x)); v.y += gt[j].y * (bfhi(a.x) + bfhi(c.x)); v.z += gt[j].z * (bflo(a.y) + bflo(c.y)); v.w += gt[j].w * (bfhi(a.y) + bfhi(c.y));
            xr[64 * j] = v; }
    }
}
}
namespace fm {
typedef short bf16x8 __attribute__((ext_vector_type(8)));
typedef short s16x4 __attribute__((ext_vector_type(4)));
typedef float f32x16 __attribute__((ext_vector_type(16)));
typedef float f32x2 __attribute__((ext_vector_type(2)));
constexpr int PROJ_LD = 2560;
constexpr float QSCALE = 0.125f * 1.4426950408889634f;
constexpr size_t WM_EVEN_STRIDE = 8 * MiB;
constexpr size_t WM_WIN = 0, WM_WOUT = 5 * MiB, WM_SGUW = 7 * MiB;
constexpr size_t WS_PROJ = WS_R1;
constexpr size_t WS_O = WS_R1 + 80 * MiB;
constexpr size_t SM_ZSS = 1024 * 1024;

struct SchedStd {
    const char* A; const char* Bt; size_t tile_bytes; int nM, nN, nwg, G, c;
    __device__ __forceinline__ void init(const void* A_, const void* Bt_, int M, int N, int K, int G_, int c_) { A = (const char*)A_; Bt = (const char*)Bt_; tile_bytes = (size_t)256 * K * 2; nM = M / 256; nN = N / 256; nwg = nM * nN; G = G_; c = c_; }
    __device__ __forceinline__ bool next(int i, Unit& u) const {
        const long L = (long)i * G + c; if (L >= nwg) return false;
        int wgid = (int)L; { const int q = nwg / 8, r = nwg % 8, xcd = wgid % 8, off = wgid / 8; wgid = (xcd < r ? xcd * (q + 1) : r * (q + 1) + (xcd - r) * q) + off; }
        const int nig = 8 * nN, gid = wgid / nig, fm_ = gid * 8, gsz = (nM - fm_) < 8 ? (nM - fm_) : 8;
        u.pm = fm_ + ((wgid % nig) % gsz); u.pn = (wgid % nig) / gsz; return true;
    }
    __device__ __forceinline__ const char* a_base(const Unit& u) const { return A + (size_t)u.pm * tile_bytes; }
    __device__ __forceinline__ const char* b_base(const Unit& u) const { return Bt + (size_t)u.pn * tile_bytes; }
    __device__ __forceinline__ void a_ready(const Unit&) const {}
    __device__ __forceinline__ void done(const Unit&) const {}
};
__device__ __forceinline__ void even_convert_weights(const Ctx& F_, int li) {
    Ctx F = F_; asm volatile("" : "+v"(F.tid), "+v"(F.lane));
    unsigned char* const ws_ = kws();
    LAS float* scr = (LAS float*)(F.lds + F.wave * 8448);
    bf16_t* base = (bf16_t*)(ws_ + WS_WMIX + (size_t)li * WM_EVEN_STRIDE);
    bf16_t* WinT = base + WM_WIN / 2; bf16_t* WoutT = base + WM_WOUT / 2; bf16_t* SW = base + WM_SGUW / 2;
    const float* w_in = kin(4) + (size_t)li * 1024 * 2560; const float* w_out = kin(5) + (size_t)li * 1024 * 1024; const float* sw = kin(7) + (size_t)li * 8 * 128 * 128;
    const int gw = F.wg * NWAVES + F.wave, NGW = F.G * NWAVES;
    constexpr int I_IN = 16 * 80, I_OUT = 16 * 32;
    for (int it = gw; it < I_IN + I_OUT; it += NGW) {
        if (it < I_IN) { const int kb = it / 80, nb = it % 80; transpose_item(w_in, 2560, WinT, 1024, kb * 64, nb * 32, nb * 32, scr, F.lane); }
        else { const int r = it - I_IN, kb = r / 32, nb = r % 32; transpose_item(w_out, 1024, WoutT, 1024, kb * 64, nb * 32, nb * 32, scr, F.lane); }
    }
    for (int i = gw * 64 + F.lane; i < 8 * 128 * 128 / 4; i += NGW * 64) { const f32x4 v = ((const f32x4*)sw)[i]; v2u o; o.x = pk2(v.x, v.y); o.y = pk2(v.z, v.w); ((v2u*)SW)[i] = o; }
}
__device__ __forceinline__ void norm_phase(const Ctx& F_, int ls) {
    Ctx F = F_; asm volatile("" : "+v"(F.tid), "+v"(F.lane));
    unsigned char* const ws_ = kws(); const float* const x_ = kout(); const float* const mod_ = (const float*)(ws_ + WS_NAIVE);
    bf16_t* XN = (bf16_t*)(ws_ + WS_XN);
    const int row0 = F.wg * 64 + F.wave * 8, b = row0 / S;
    const float* m = mod_ + ((size_t)ls * NB + b) * 3072;
#pragma unroll 1
    for (int r = 0; r < 8; ++r) {
        const int row = row0 + r;
        const f32x4* xr = (const f32x4*)(x_ + (size_t)row * D) + F.lane;
        f32x4 v[4]; float ss = 0.f;
#pragma unroll
        for (int j = 0; j < 4; ++j) { v[j] = xr[64 * j]; ss += (v[j].x * v[j].x + v[j].y * v[j].y) + (v[j].z * v[j].z + v[j].w * v[j].w); }
        const float rinv = 1.0f / sqrtf(wave_sum(ss) * (1.f / D) + 1e-6f);
        unsigned long long* o8 = (unsigned long long*)(XN + (size_t)row * D) + F.lane;
#pragma unroll
        for (int j = 0; j < 4; ++j) {
            const f32x4 sh = ((const f32x4*)m)[64 * j + F.lane], sc = ((const f32x4*)(m + 1024))[64 * j + F.lane];
            const f32x4 h = v[j] * rinv * (sc + 1.0f) + sh;
            o8[64 * j] = (unsigned long long)pk2(h.x, h.y) | ((unsigned long long)pk2(h.z, h.w) << 32);
        }
    }
}
struct EpiInProj {
    static constexpr bool PERM = true, AFTER_DRAIN = false;
    bf16_t* P; float* zss;
    __device__ __forceinline__ void operator()(const f32x4 (&acc)[2][2][4][2], const Unit& u, int wr, int wc, int fr, int fq) const {
        const int row0 = u.pm * 256 + wr * 64 + fr, col0 = u.pn * 256 + wc * 32 + 8 * fq;
        const int kind = u.pn < 2 ? 0 : (u.pn < 6 ? 1 : (u.pn < 8 ? 2 : 3));
#pragma unroll
        for (int ai = 0; ai < 2; ++ai)
#pragma unroll
            for (int m = 0; m < 4; ++m) {
                const int row = row0 + ai * 128 + m * 16; bf16_t* rowp = P + (size_t)row * PROJ_LD + col0; float ssq = 0.f;
#pragma unroll
                for (int bj = 0; bj < 2; ++bj) {
                    f32x4 v0 = acc[ai][bj][m][0], v1 = acc[ai][bj][m][1];
                    if (kind == 0) { v0 = v0 * QSCALE; v1 = v1 * QSCALE; }
                    else if (kind >= 2) {
                        const f32x2 a = pg8::gelu_pk((f32x2){v0[0], v0[1]}), b = pg8::gelu_pk((f32x2){v0[2], v0[3]}), c = pg8::gelu_pk((f32x2){v1[0], v1[1]}), d = pg8::gelu_pk((f32x2){v1[2], v1[3]});
                        v0 = (f32x4){a.x, a.y, b.x, b.y}; v1 = (f32x4){c.x, c.y, d.x, d.y};
                        ssq += (v0[0] * v0[0] + v0[1] * v0[1]) + (v0[2] * v0[2] + v0[3] * v0[3]) + (v1[0] * v1[0] + v1[1] * v1[1]) + (v1[2] * v1[2] + v1[3] * v1[3]);
                    }
                    u32x4 w; w.x = pg8::cvt_pk_bf16(v0[0], v0[1]); w.y = pg8::cvt_pk_bf16(v0[2], v0[3]); w.z = pg8::cvt_pk_bf16(v1[0], v1[1]); w.w = pg8::cvt_pk_bf16(v1[2], v1[3]);
                    *(u32x4*)(rowp + bj * 128) = w;
                }
                if (kind == 3) { ssq += __shfl_xor(ssq, 16); ssq += __shfl_xor(ssq, 32); if (fq == 0) zss[(size_t)row * 8 + (u.pn - 8) * 4 + wc] = ssq; }
                asm volatile("" ::: "memory");
            }
    }
};
struct EpiResid {
    static constexpr bool PERM = false, AFTER_DRAIN = false;
    const float* xin; float* xout; const float* mod;
    __device__ __forceinline__ void operator()(const f32x4 (&acc)[2][2][4][2], const Unit& u, int wr, int wc, int fr, int fq) const {
        const int row0 = u.pm * 256 + wr * 64 + fr, col0 = u.pn * 256 + wc * 32 + 4 * fq, b = (u.pm * 256) / S;
        const float* g = mod + (size_t)b * 3072 + 2048 + col0;
        f32x4 gv[2][2];
#pragma unroll
        for (int bj = 0; bj < 2; ++bj)
#pragma unroll
            for (int n = 0; n < 2; ++n) gv[bj][n] = *(const f32x4*)(g + bj * 128 + n * 16);
#pragma unroll
        for (int ai = 0; ai < 2; ++ai)
#pragma unroll
            for (int m = 0; m < 4; ++m) { const size_t off = (size_t)(row0 + ai * 128 + m * 16) * D + col0;
#pragma unroll
                for (int bj = 0; bj < 2; ++bj)
#pragma unroll
                    for (int n = 0; n < 2; ++n) { const f32x4 xv = *(const f32x4*)(xin + off + bj * 128 + n * 16); *(f32x4*)(xout + off + bj * 128 + n * 16) = xv + gv[bj][n] * acc[ai][bj][m][n]; }
                asm volatile("" ::: "memory"); }
    }
};
__device__ __forceinline__ void even_inproj_phase(const Ctx& F_, int li) {
    Ctx F = F_; asm volatile("" : "+v"(F.tid), "+v"(F.lane));
    unsigned char* const ws_ = kws();
    SchedStd Sc; Sc.init(ws_ + WS_XN, ws_ + WS_WMIX + (size_t)li * WM_EVEN_STRIDE + WM_WIN, T, 2560, 1024, F.G, F.wg);
    EpiInProj E{(bf16_t*)(ws_ + WS_PROJ), (float*)(ws_ + WS_SMALL + SM_ZSS)};
    pg8::gemm_phase<EpiInProj, SchedStd, true, true>(F.lds, pg8::Gemm{1024}, Sc, E);
}
__device__ __forceinline__ void even_outproj_phase(const Ctx& F_, int layer) {
    Ctx F = F_; asm volatile("" : "+v"(F.tid), "+v"(F.lane));
    unsigned char* const ws_ = kws(); float* const x_ = kout();
    SchedStd Sc; Sc.init(ws_ + WS_O, ws_ + WS_WMIX + (size_t)(layer / 2) * WM_EVEN_STRIDE + WM_WOUT, T, 1024, 1024, F.G, F.wg);
    EpiResid E{x_, x_, (const float*)(ws_ + WS_NAIVE) + (size_t)(layer * 2) * NB * 3072};
    pg8::gemm_phase<EpiResid, SchedStd, true, true>(F.lds, pg8::Gemm{1024}, Sc, E);
}
__device__ __forceinline__ s16x4 tr_read(const LAS unsigned char* p) { typedef short v4i16_t __attribute__((ext_vector_type(4))); return __builtin_bit_cast(s16x4, __builtin_amdgcn_ds_read_tr16_b64_v4i16((LAS v4i16_t*)p)); }
constexpr int VPITCH = 144;
__device__ __forceinline__ void attn_task(const bf16_t* __restrict__ P, bf16_t* __restrict__ O, LAS unsigned char* vl, int b, int hh, int jt, int rq, int lane) {
    const int r32 = lane & 31, h2 = lane >> 5;
    const bf16_t* Pb = P + (size_t)b * S * PROJ_LD + hh * 64;
    const bf16_t* qrow = Pb + (size_t)(16 * (32 * jt + r32) + rq) * PROJ_LD + 8 * h2;
    bf16x8 qf[4];
#pragma unroll
    for (int ks = 0; ks < 4; ++ks) qf[ks] = *(const bf16x8*)(qrow + 16 * ks);
    float mrun = -INFINITY, lrun = 0.f; f32x16 o0, o1;
#pragma unroll
    for (int r = 0; r < 16; ++r) { o0[r] = 0.f; o1[r] = 0.f; }
    const int vkey = lane >> 3, vch = lane & 7;
    const int g4 = lane >> 4, i16 = lane & 15;
    const LAS unsigned char* trb = vl + (4 * h2 + (i16 >> 2)) * VPITCH + (16 * (g4 & 1) + 4 * (i16 & 3)) * 2;
#pragma unroll 1
    for (int c = 0; c < 16; ++c) {
        const int off = rq - c; const int W = (off == 0) ? 2048 : (((off & 3) == 0) ? 512 : 128);
        const int kt0 = (off == 0) ? 0 : (jt > 0 ? jt - 1 : 0);
#pragma unroll 1
        for (int kt = kt0; kt <= jt; ++kt) {
            const bf16_t* krow = Pb + (size_t)(16 * (32 * kt + r32) + c) * PROJ_LD + 512 + 8 * h2;
            bf16x8 kf[4];
#pragma unroll
            for (int ks = 0; ks < 4; ++ks) kf[ks] = *(const bf16x8*)(krow + 16 * ks);
            v4u vv[4];
#pragma unroll
            for (int it = 0; it < 4; ++it) vv[it] = *(const v4u*)(Pb + (size_t)(16 * (32 * kt + vkey + 8 * it) + c) * PROJ_LD + 1024 + 8 * vch);
            f32x16 s;
#pragma unroll
            for (int r = 0; r < 16; ++r) s[r] = 0.f;
#pragma unroll
            for (int ks = 0; ks < 4; ++ks) s = __builtin_amdgcn_mfma_f32_32x32x16_bf16(kf[ks], qf[ks], s, 0, 0, 0);
#pragma unroll
            for (int it = 0; it < 4; ++it) *(LAS v4u*)(vl + (vkey + 8 * it) * VPITCH + vch * 16) = vv[it];
            const int dbase = 16 * (32 * (jt - kt) + r32 - 4 * h2) + off;
            float tmax = -INFINITY;
#pragma unroll
            for (int r = 0; r < 16; ++r) {
                const int dlt = dbase - 16 * ((r & 3) + 8 * (r >> 2));
                const int mult = ((dlt >= 0 && dlt <= 128) ? 1 : 0) + ((W >= 512 && dlt >= 0 && dlt <= 512) ? 1 : 0) + ((W == 2048 && dlt >= 0) ? 1 : 0);
                const float lg = mult == 0 ? -INFINITY : (mult == 1 ? 0.f : (mult == 2 ? 1.f : 1.5849625007f));
                s[r] += lg; tmax = fmaxf(tmax, s[r]);
            }
            tmax = fmaxf(tmax, __shfl_xor(tmax, 32));
            const float mnew = fmaxf(mrun, tmax), msafe = (mnew == -INFINITY) ? 0.f : mnew;
            const float alpha = __builtin_amdgcn_exp2f(mrun - msafe);
            float psum = 0.f;
#pragma unroll
            for (int r = 0; r < 16; ++r) { s[r] = __builtin_amdgcn_exp2f(s[r] - msafe); psum += s[r]; }
            lrun = lrun * alpha + psum; mrun = mnew;
#pragma unroll
            for (int r = 0; r < 16; ++r) { o0[r] *= alpha; o1[r] *= alpha; }
            bf16x8 pf[2];
#pragma unroll
            for (int st = 0; st < 2; ++st) { v4u w; w.x = pg8::cvt_pk_bf16(s[8 * st], s[8 * st + 1]); w.y = pg8::cvt_pk_bf16(s[8 * st + 2], s[8 * st + 3]); w.z = pg8::cvt_pk_bf16(s[8 * st + 4], s[8 * st + 5]); w.w = pg8::cvt_pk_bf16(s[8 * st + 6], s[8 * st + 7]); pf[st] = __builtin_bit_cast(bf16x8, w); }
            asm volatile("s_waitcnt lgkmcnt(0)" ::: "memory");
#pragma unroll
            for (int st = 0; st < 2; ++st) {
                const s16x4 a0 = tr_read(trb + (16 * st) * VPITCH), a1 = tr_read(trb + (16 * st + 8) * VPITCH);
                const s16x4 b0 = tr_read(trb + (16 * st) * VPITCH + 64), b1 = tr_read(trb + (16 * st + 8) * VPITCH + 64);
                const bf16x8 A0 = (bf16x8){a0[0], a0[1], a0[2], a0[3], a1[0], a1[1], a1[2], a1[3]}, A1 = (bf16x8){b0[0], b0[1], b0[2], b0[3], b1[0], b1[1], b1[2], b1[3]};
                o0 = __builtin_amdgcn_mfma_f32_32x32x16_bf16(A0, pf[st], o0, 0, 0, 0);
                o1 = __builtin_amdgcn_mfma_f32_32x32x16_bf16(A1, pf[st], o1, 0, 0, 0);
            }
            asm volatile("s_waitcnt lgkmcnt(0)" ::: "memory");
        }
    }
    const float ltot = lrun + __shfl_xor(lrun, 32), inv = 1.0f / ltot;
    bf16_t* orow = O + ((size_t)b * S + 16 * (32 * jt + r32) + rq) * D + hh * 64 + 4 * h2;
#pragma unroll
    for (int gq = 0; gq < 4; ++gq) {
        v2u w0, w1; w0.x = pg8::cvt_pk_bf16(o0[4 * gq] * inv, o0[4 * gq + 1] * inv); w0.y = pg8::cvt_pk_bf16(o0[4 * gq + 2] * inv, o0[4 * gq + 3] * inv);
        w1.x = pg8::cvt_pk_bf16(o1[4 * gq] * inv, o1[4 * gq + 1] * inv); w1.y = pg8::cvt_pk_bf16(o1[4 * gq + 2] * inv, o1[4 * gq + 3] * inv);
        *(v2u*)(orow + 8 * gq) = w0; *(v2u*)(orow + 32 + 8 * gq) = w1;
    }
}
__device__ __forceinline__ unsigned mask_pair(unsigned x, int e0, int lim) { if (e0 > lim) x &= 0xffff0000u; if (e0 + 1 > lim) x &= 0x0000ffffu; return x; }
constexpr int ZPITCH = 128;
__device__ __forceinline__ void sgu_task(const bf16_t* __restrict__ P, bf16_t* __restrict__ O, const bf16_t* __restrict__ SW, const float* __restrict__ zss, const float* __restrict__ ng, const float* __restrict__ bs,
                                         LAS unsigned char* zl, int b, int ch, int g, int lane) {
    const int r32 = lane & 31, h2 = lane >> 5;
    const size_t t0 = (size_t)b * S + ch * 128;
    { const int chn = lane & 7; f32x4 n0 = *(const f32x4*)(ng + g * 64 + 8 * chn), n1 = *(const f32x4*)(ng + g * 64 + 8 * chn + 4);
#pragma unroll 4
        for (int it = 0; it < 16; ++it) { const int row = (lane >> 3) + 8 * it;
            const float* zp = zss + (t0 + row) * 8; const f32x4 p0 = *(const f32x4*)zp, p1 = *(const f32x4*)(zp + 4);
            const float ri = 1.0f / sqrtf(((p0.x + p0.y) + (p0.z + p0.w) + (p1.x + p1.y) + (p1.z + p1.w)) * (1.f / 512.f) + 1e-6f);
            const v4u z = *(const v4u*)(P + (t0 + row) * PROJ_LD + 2048 + g * 64 + 8 * chn);
            v4u o; o.x = pk2(bflo(z.x) * ri * n0.x, bfhi(z.x) * ri * n0.y); o.y = pk2(bflo(z.y) * ri * n0.z, bfhi(z.y) * ri * n0.w);
            o.z = pk2(bflo(z.z) * ri * n1.x, bfhi(z.z) * ri * n1.y); o.w = pk2(bflo(z.w) * ri * n1.z, bfhi(z.w) * ri * n1.w);
            *(LAS v4u*)(zl + row * ZPITCH + chn * 16) = o; } }
    asm volatile("s_waitcnt lgkmcnt(0)" ::: "memory");
    const int g4 = lane >> 4, i16 = lane & 15;
    const LAS unsigned char* trb = zl + (8 * h2 + (i16 >> 2)) * ZPITCH + (16 * (g4 & 1) + 4 * (i16 & 3)) * 2;
    const bf16_t* Wg = SW + (size_t)g * 128 * 128;
#pragma unroll 1
    for (int mt = 0; mt < 4; ++mt) {
        f32x16 a0, a1;
#pragma unroll
        for (int r = 0; r < 16; ++r) { a0[r] = 0.f; a1[r] = 0.f; }
        const int irow = 32 * mt + r32;
#pragma unroll 1
        for (int kt = 0; kt <= mt; ++kt) {
#pragma unroll
            for (int ks = 0; ks < 2; ++ks) {
                const int j0 = 32 * kt + 16 * ks + 8 * h2;
                v4u wv = *(const v4u*)(Wg + (size_t)irow * 128 + j0);
                if (kt == mt) {
                    const int lim = irow - j0;
                    wv.x = mask_pair(wv.x, 0, lim); wv.y = mask_pair(wv.y, 2, lim); wv.z = mask_pair(wv.z, 4, lim); wv.w = mask_pair(wv.w, 6, lim);
                }
                const bf16x8 af = __builtin_bit_cast(bf16x8, wv);
                const LAS unsigned char* tb = trb + (32 * kt + 16 * ks) * ZPITCH;
                const s16x4 x0 = tr_read(tb), x1 = tr_read(tb + 4 * ZPITCH), y0 = tr_read(tb + 64), y1 = tr_read(tb + 4 * ZPITCH + 64);
                const bf16x8 B0 = (bf16x8){x0[0], x0[1], x0[2], x0[3], x1[0], x1[1], x1[2], x1[3]}, B1 = (bf16x8){y0[0], y0[1], y0[2], y0[3], y1[0], y1[1], y1[2], y1[3]};
                a0 = __builtin_amdgcn_mfma_f32_32x32x16_bf16(af, B0, a0, 0, 0, 0);
                a1 = __builtin_amdgcn_mfma_f32_32x32x16_bf16(af, B1, a1, 0, 0, 0);
            }
        }
#pragma unroll
        for (int r = 0; r < 16; ++r) {
            const int i = 32 * mt + (r & 3) + 8 * (r >> 2) + 4 * h2; const float bb = bs[g * 128 + i];
            const bf16_t* up = P + (t0 + i) * PROJ_LD + 1536 + g * 64; bf16_t* op = O + (t0 + i) * D + 512 + g * 64;
            op[r32] = (bf16_t)f2bf(bf2f(up[r32]) * (a0[r] + bb)); op[32 + r32] = (bf16_t)f2bf(bf2f(up[32 + r32]) * (a1[r] + bb));
        }
    }
}
__device__ __forceinline__ void even_mix_phase(const Ctx& F_, int li) {
    Ctx F = F_; asm volatile("" : "+v"(F.tid), "+v"(F.lane));
    unsigned char* const ws_ = kws();
    const bf16_t* P = (const bf16_t*)(ws_ + WS_PROJ); bf16_t* O = (bf16_t*)(ws_ + WS_O);
    LAS unsigned char* wl = F.lds + F.wave * 16384;
    { const int b = F.wg >> 5, hh = (F.wg >> 2) & 7, jt = F.wg & 3;
        attn_task(P, O, wl, b, hh, jt, F.wave, F.lane);
        attn_task(P, O, wl, b, hh, jt, F.wave + 8, F.lane); }
    if (F.wave < 4) { const int task = F.wg * 4 + F.wave, b = task >> 7, ch = (task >> 3) & 15, g = task & 7;
        sgu_task(P, O, (const bf16_t*)(ws_ + WS_WMIX + (size_t)li * WM_EVEN_STRIDE + WM_SGUW), (const float*)(ws_ + WS_SMALL + SM_ZSS), kin(6) + li * 512, kin(8) + li * 8 * 128, wl, b, ch, g, F.lane); }
}
}
namespace fm {
constexpr size_t WM_ODD_BASE = 16 * MiB, WM_ODD_STRIDE = 12 * MiB, WM_WRKV = 0, WM_WLD = 6 * MiB, WM_WLU = 8 * MiB, WM_WO = 10 * MiB;
constexpr size_t WS_VFIRST = 16 * MiB;
constexpr size_t WS_LORA = 48 * MiB;
constexpr size_t WS_MIX = WS_R1;
constexpr size_t WS_WDEC = WS_R1, WS_AV = WS_R1 + 64 * MiB, WS_G = WS_R1 + 96 * MiB;
constexpr size_t WS_R = WS_R1 + 128 * MiB, WS_K = WS_R1 + 160 * MiB, WS_V = WS_R1 + 192 * MiB;
constexpr size_t WS_Y = WS_XN;

__device__ __forceinline__ void odd_convert_weights(const Ctx& F_, int li) {
    Ctx F = F_; asm volatile("" : "+v"(F.tid), "+v"(F.lane));
    unsigned char* const ws_ = kws();
    LAS float* scr = (LAS float*)(F.lds + F.wave * 8448);
    unsigned char* base = ws_ + WS_WMIX + WM_ODD_BASE + (size_t)li * WM_ODD_STRIDE;
    bf16_t* WRKV = (bf16_t*)(base + WM_WRKV); bf16_t* WLD = (bf16_t*)(base + WM_WLD); bf16_t* WLU = (bf16_t*)(base + WM_WLU); bf16_t* WO = (bf16_t*)(base + WM_WO);
    const float* w_rkv = kin(10) + (size_t)li * 3 * 1024 * 1024; const float* w_o = kin(11) + (size_t)li * 1024 * 1024;
    const float* w1 = kin(13) + (size_t)li * 1024 * 64; const float* a1 = kin(16) + (size_t)li * 1024 * 64; const float* g1 = kin(21) + (size_t)li * 1024 * 160;
    const float* v1 = kin(19);
    const float* w2 = kin(14) + (size_t)li * 64 * 1024; const float* a2 = kin(17) + (size_t)li * 64 * 1024; const float* g2 = kin(22) + (size_t)li * 160 * 1024; const float* v2 = kin(20);
    const int gw = F.wg * NWAVES + F.wave, NGW = F.G * NWAVES;
    constexpr int I_SQ = 16 * 32;
    constexpr int I_LD = 16 * 8;
    constexpr int I_LU = 4 * 32;
    constexpr int NIT = 4 * I_SQ + 4 * I_LD + 4 * I_LU;
    for (int it = gw; it < NIT; it += NGW) {
        int r = it;
        if (r < 4 * I_SQ) { const int mtx = r / I_SQ, q = r % I_SQ, kb = q / 32, nb = q % 32;
            if (mtx < 3) transpose_item(w_rkv + (size_t)mtx * 1024 * 1024, 1024, WRKV + (size_t)mtx * 1024 * 1024, 1024, kb * 64, nb * 32, nb * 32, scr, F.lane);
            else transpose_item(w_o, 1024, WO, 1024, kb * 64, nb * 32, nb * 32, scr, F.lane);
            continue; }
        r -= 4 * I_SQ;
        if (r < 4 * I_LD) { const int tl = r / I_LD, q = r % I_LD, kb = q / 8, nb = q % 8;
            const float* W = tl == 0 ? w1 : (tl == 1 ? a1 : (tl == 2 ? g1 : v1)); const int nv = tl == 0 ? 64 : (tl == 1 ? 64 : (tl == 2 ? 160 : (li > 0 ? 32 : 0)));
            transpose_item_pad(W, tl == 2 ? 160 : (tl == 3 ? 32 : 64), nv, 1024, WLD + (size_t)tl * 256 * 1024, 1024, kb * 64, nb * 32, nb * 32, scr, F.lane);
            continue; }
        r -= 4 * I_LD;
        { const int tl = r / I_LU, q = r % I_LU, kb = q / 32, nb = q % 32;
            const float* W = tl == 0 ? w2 : (tl == 1 ? a2 : (tl == 2 ? g2 : v2)); const int kv = tl == 0 ? 64 : (tl == 1 ? 64 : (tl == 2 ? 160 : (li > 0 ? 32 : 0)));
            transpose_item_pad(W, 1024, 1024, kv, WLU + (size_t)tl * 1024 * 256, 256, kb * 64, nb * 32, nb * 32, scr, F.lane); }
    }
}
template <int NMIX> __device__ __forceinline__ void odd_mix_phase(const Ctx& F_, int li, int m0, int m1, int m2, int m3) {
    Ctx F = F_; asm volatile("" : "+v"(F.tid), "+v"(F.lane));
    unsigned char* const ws_ = kws();
    const bf16_t* XN = (const bf16_t*)(ws_ + WS_XN); bf16_t* MIX = (bf16_t*)(ws_ + WS_MIX);
    const float* mu = kin(9) + (size_t)li * 6 * 1024;
    const int ids[4] = {m0, m1, m2, m3};
    const int row0 = F.wg * 64 + F.wave * 8;
    f32x4 hp[4];
    { const bool first = (row0 % S) == 0; const v2u* pr = (const v2u*)(XN + (size_t)(row0 - (first ? 0 : 1)) * D) + F.lane;
#pragma unroll
        for (int j = 0; j < 4; ++j) { const v2u w = pr[64 * j]; hp[j] = first ? (f32x4){0.f, 0.f, 0.f, 0.f} : (f32x4){bflo(w.x), bfhi(w.x), bflo(w.y), bfhi(w.y)}; } }
#pragma unroll 1
    for (int r = 0; r < 8; ++r) {
        const int row = row0 + r; const v2u* pr = (const v2u*)(XN + (size_t)row * D) + F.lane;
        f32x4 h[4];
#pragma unroll
        for (int j = 0; j < 4; ++j) { const v2u w = pr[64 * j]; h[j] = (f32x4){bflo(w.x), bfhi(w.x), bflo(w.y), bfhi(w.y)}; }
#pragma unroll
        for (int s = 0; s < NMIX; ++s) {
            v2u* po = (v2u*)(MIX + ((size_t)s * T + row) * D) + F.lane;
#pragma unroll
            for (int j = 0; j < 4; ++j) { const f32x4 m = ((const f32x4*)(mu + ids[s] * 1024))[64 * j + F.lane]; const f32x4 x = h[j] + (hp[j] - h[j]) * m;
                v2u o; o.x = pk2(x.x, x.y); o.y = pk2(x.z, x.w); po[64 * j] = o; }
        }
#pragma unroll
        for (int j = 0; j < 4; ++j) hp[j] = h[j];
    }
}
struct SchedMulti {
    const char* A; const char* Bt; size_t a_tile, a_sel_stride, b_tile; int nN, nwg, G, c, a_shift;
    __device__ __forceinline__ bool next(int i, Unit& u) const { const long L = (long)i * G + c; if (L >= nwg) return false; u.pm = (int)(L / nN); u.pn = (int)(L % nN); return true; }
    __device__ __forceinline__ const char* a_base(const Unit& u) const { return A + (size_t)(u.pn >> a_shift) * a_sel_stride + (size_t)u.pm * a_tile; }
    __device__ __forceinline__ const char* b_base(const Unit& u) const { return Bt + (size_t)u.pn * b_tile; }
    __device__ __forceinline__ void a_ready(const Unit&) const {}
    __device__ __forceinline__ void done(const Unit&) const {}
};
struct EpiRKV {
    static constexpr bool PERM = true, AFTER_DRAIN = false;
    unsigned char* ws; size_t offV;
    __device__ __forceinline__ void operator()(const f32x4 (&acc)[2][2][4][2], const Unit& u, int wr, int wc, int fr, int fq) const {
        const int row0 = u.pm * 256 + wr * 64 + fr, col0 = (u.pn & 3) * 256 + wc * 32 + 8 * fq; const int sel = u.pn >> 2;
        size_t boff = WS_R + (size_t)sel * (WS_K - WS_R); if (sel == 2) boff = offV;
        bf16_t* base = (bf16_t*)(ws + boff);
#pragma unroll
        for (int ai = 0; ai < 2; ++ai)
#pragma unroll
            for (int m = 0; m < 4; ++m) { bf16_t* rowp = base + (size_t)(row0 + ai * 128 + m * 16) * D + col0;
#pragma unroll
                for (int bj = 0; bj < 2; ++bj) { const f32x4 v0 = acc[ai][bj][m][0], v1 = acc[ai][bj][m][1];
                    u32x4 w; w.x = pg8::cvt_pk_bf16(v0[0], v0[1]); w.y = pg8::cvt_pk_bf16(v0[2], v0[3]); w.z = pg8::cvt_pk_bf16(v1[0], v1[1]); w.w = pg8::cvt_pk_bf16(v1[2], v1[3]);
                    *(u32x4*)(rowp + bj * 128) = w; }
                asm volatile("" ::: "memory"); }
    }
};
struct EpiLoraDown {
    static constexpr bool PERM = true, AFTER_DRAIN = false;
    bf16_t* L;
    __device__ __forceinline__ void operator()(const f32x4 (&acc)[2][2][4][2], const Unit& u, int wr, int wc, int fr, int fq) const {
        const int row0 = u.pm * 256 + wr * 64 + fr, col0 = wc * 32 + 8 * fq; const int act = u.pn == 0 ? 1 : (u.pn == 2 ? 2 : 0);
        bf16_t* base = L + (size_t)u.pn * T * 256;
#pragma unroll
        for (int ai = 0; ai < 2; ++ai)
#pragma unroll
            for (int m = 0; m < 4; ++m) { bf16_t* rowp = base + (size_t)(row0 + ai * 128 + m * 16) * 256 + col0;
#pragma unroll
                for (int bj = 0; bj < 2; ++bj) { float h[8];
#pragma unroll
                    for (int n = 0; n < 2; ++n)
#pragma unroll
                        for (int q = 0; q < 4; ++q) { float v = acc[ai][bj][m][n][q];
                            if (act == 1) v = 1.f - 2.f * __builtin_amdgcn_rcpf(1.f + __expf(2.f * v)); else if (act == 2) v = fast_sigmoid(v);
                            h[4 * n + q] = v; }
                    u32x4 w; w.x = pg8::cvt_pk_bf16(h[0], h[1]); w.y = pg8::cvt_pk_bf16(h[2], h[3]); w.z = pg8::cvt_pk_bf16(h[4], h[5]); w.w = pg8::cvt_pk_bf16(h[6], h[7]);
                    *(u32x4*)(rowp + bj * 128) = w; }
                asm volatile("" ::: "memory"); }
    }
};
struct EpiLoraUp {
    static constexpr bool PERM = true, AFTER_DRAIN = false;
    unsigned char* ws; const float* vecs;
    const float *w0, *a0, *v0;
    __device__ __forceinline__ void operator()(const f32x4 (&acc)[2][2][4][2], const Unit& u, int wr, int wc, int fr, int fq) const {
        const int row0 = u.pm * 256 + wr * 64 + fr, col0 = (u.pn & 3) * 256 + wc * 32 + 8 * fq; const int sub = u.pn >> 2;
        f32x4 bv[2][2];
#pragma unroll
        for (int bj = 0; bj < 2; ++bj)
#pragma unroll
            for (int n = 0; n < 2; ++n) { const int cc = col0 + bj * 128 + 4 * n; f32x4 t = (f32x4){0.f, 0.f, 0.f, 0.f};
                if (sub == 0) t = *(const f32x4*)(w0 + cc); else if (sub == 1) t = *(const f32x4*)(a0 + cc); else if (sub == 3) t = *(const f32x4*)(v0 + cc);
                bv[bj][n] = t; }
#pragma unroll
        for (int ai = 0; ai < 2; ++ai)
#pragma unroll
            for (int m = 0; m < 4; ++m) { const size_t off = (size_t)(row0 + ai * 128 + m * 16) * D + col0;
#pragma unroll
                for (int bj = 0; bj < 2; ++bj) {
                    f32x4 v0_ = acc[ai][bj][m][0] + bv[bj][0], v1_ = acc[ai][bj][m][1] + bv[bj][1];
                    if (sub == 0) {
#pragma unroll
                        for (int q = 0; q < 4; ++q) { v0_[q] = __expf(-0.6065306597f * fast_sigmoid(v0_[q])); v1_[q] = __expf(-0.6065306597f * fast_sigmoid(v1_[q])); }
                        float* WDEC = (float*)(ws + WS_WDEC);
                        *(f32x4*)(WDEC + off + bj * 128) = v0_; *(f32x4*)(WDEC + off + bj * 128 + 4) = v1_;
                    } else {
                        size_t doff = WS_AV; if (sub == 2) doff = WS_G; if (sub == 3) doff = WS_V;
                        if (sub == 1) {
#pragma unroll
                            for (int q = 0; q < 4; ++q) { v0_[q] = fast_sigmoid(v0_[q]); v1_[q] = fast_sigmoid(v1_[q]); }
                        } else if (sub == 3) {
                            const u32x4 vo = *(const u32x4*)((const bf16_t*)(ws + WS_V) + off + bj * 128), vf = *(const u32x4*)((const bf16_t*)(ws + WS_VFIRST) + off + bj * 128);
                            const f32x4 olo = (f32x4){bflo(vo.x), bfhi(vo.x), bflo(vo.y), bfhi(vo.y)}, ohi = (f32x4){bflo(vo.z), bfhi(vo.z), bflo(vo.w), bfhi(vo.w)};
                            const f32x4 flo = (f32x4){bflo(vf.x), bfhi(vf.x), bflo(vf.y), bfhi(vf.y)}, fhi = (f32x4){bflo(vf.z), bfhi(vf.z), bflo(vf.w), bfhi(vf.w)};
#pragma unroll
                            for (int q = 0; q < 4; ++q) { v0_[q] = olo[q] + (flo[q] - olo[q]) * fast_sigmoid(v0_[q]); v1_[q] = ohi[q] + (fhi[q] - ohi[q]) * fast_sigmoid(v1_[q]); }
                        }
                        u32x4 w; w.x = pg8::cvt_pk_bf16(v0_[0], v0_[1]); w.y = pg8::cvt_pk_bf16(v0_[2], v0_[3]); w.z = pg8::cvt_pk_bf16(v1_[0], v1_[1]); w.w = pg8::cvt_pk_bf16(v1_[2], v1_[3]);
                        *(u32x4*)((bf16_t*)(ws + doff) + off + bj * 128) = w;
                    }
                }
                asm volatile("" ::: "memory"); }
    }
};
__device__ __forceinline__ bf16_t* odd_vbuf(unsigned char* ws_, int li) { return (bf16_t*)(ws_ + (li == 0 ? WS_VFIRST : WS_V)); }
__device__ __forceinline__ void odd_gemm_rkv_phase(const Ctx& F_, int li) {
    Ctx F = F_; asm volatile("" : "+v"(F.tid), "+v"(F.lane));
    unsigned char* const ws_ = kws();
    SchedMulti Sc{(const char*)(ws_ + WS_MIX), (const char*)(ws_ + WS_WMIX + WM_ODD_BASE + (size_t)li * WM_ODD_STRIDE + WM_WRKV), (size_t)256 * 1024 * 2, (size_t)T * D * 2, (size_t)256 * 1024 * 2, 12, 64 * 12, F.G, F.vcu, 2};
    EpiRKV E{ws_, li == 0 ? WS_VFIRST : WS_V};
    pg8::gemm_phase<EpiRKV, SchedMulti, true, true>(F.lds, pg8::Gemm{1024}, Sc, E);
}
__device__ __forceinline__ void odd_gemm_loradown_phase(const Ctx& F_, int li) {
    Ctx F = F_; asm volatile("" : "+v"(F.tid), "+v"(F.lane));
    unsigned char* const ws_ = kws(); const int nN = li == 0 ? 3 : 4;
    SchedMulti Sc{(const char*)(ws_ + WS_MIX), (const char*)(ws_ + WS_WMIX + WM_ODD_BASE + (size_t)li * WM_ODD_STRIDE + WM_WLD), (size_t)256 * 1024 * 2, (size_t)T * D * 2, (size_t)256 * 1024 * 2, nN, 64 * nN, F.G, F.vcu, 0};
    EpiLoraDown E{(bf16_t*)(ws_ + WS_LORA)};
    pg8::gemm_phase<EpiLoraDown, SchedMulti, true, true>(F.lds, pg8::Gemm{1024}, Sc, E);
}
__device__ __forceinline__ void odd_gemm_loraup_phase(const Ctx& F_, int li) {
    Ctx F = F_; asm volatile("" : "+v"(F.tid), "+v"(F.lane));
    unsigned char* const ws_ = kws(); const int nN = li == 0 ? 12 : 16;
    SchedMulti Sc{(const char*)(ws_ + WS_LORA), (const char*)(ws_ + WS_WMIX + WM_ODD_BASE + (size_t)li * WM_ODD_STRIDE + WM_WLU), (size_t)256 * 256 * 2, (size_t)T * 256 * 2, (size_t)256 * 256 * 2, nN, 64 * nN, F.G, F.vcu, 2};
    EpiLoraUp E{ws_, nullptr, kin(12) + li * 1024, kin(15) + li * 1024, kin(18)};
    pg8::gemm_phase<EpiLoraUp, SchedMulti, true, true>(F.lds, pg8::Gemm{256}, Sc, E);
}
__device__ __forceinline__ void odd_gemm_wo_phase(const Ctx& F_, int layer) {
    Ctx F = F_; asm volatile("" : "+v"(F.tid), "+v"(F.lane));
    unsigned char* const ws_ = kws(); float* const x_ = kout();
    SchedStd Sc; Sc.init(ws_ + WS_Y, ws_ + WS_WMIX + WM_ODD_BASE + (size_t)(layer / 2) * WM_ODD_STRIDE + WM_WO, T, 1024, 1024, F.G, F.wg);
    EpiResid E{x_, x_, (const float*)(ws_ + WS_NAIVE) + (size_t)(layer * 2) * NB * 3072};
    pg8::gemm_phase<EpiResid, SchedStd, true, true>(F.lds, pg8::Gemm{1024}, Sc, E);
}
__device__ __forceinline__ void odd_prep_phase(const Ctx& F_, int li) {
    Ctx F = F_; asm volatile("" : "+v"(F.tid), "+v"(F.lane));
    unsigned char* const ws_ = kws();
    bf16_t* K = (bf16_t*)(ws_ + WS_K); const bf16_t* AV = (const bf16_t*)(ws_ + WS_AV); bf16_t* KK = (bf16_t*)(ws_ + WS_LORA);
    const float* k_k = kin(23) + li * 1024; const float* k_a = kin(24) + li * 1024;
    const int row0 = F.wg * 64 + F.wave * 8;
#pragma unroll 1
    for (int r = 0; r < 8; ++r) {
        const size_t ro = (size_t)(row0 + r) * D;
#pragma unroll
        for (int j = 0; j < 4; ++j) {
            const int e4 = 64 * j + F.lane;
            const v2u kw = ((const v2u*)(K + ro))[e4], aw = ((const v2u*)(AV + ro))[e4];
            const f32x4 kv = (f32x4){bflo(kw.x), bfhi(kw.x), bflo(kw.y), bfhi(kw.y)}, av = (f32x4){bflo(aw.x), bfhi(aw.x), bflo(aw.y), bfhi(aw.y)};
            const f32x4 kkv = kv * ((const f32x4*)k_k)[e4]; const f32x4 ka = ((const f32x4*)k_a)[e4];
            float ss = (kkv.x * kkv.x + kkv.y * kkv.y) + (kkv.z * kkv.z + kkv.w * kkv.w);
            ss += __shfl_xor(ss, 1); ss += __shfl_xor(ss, 2); ss += __shfl_xor(ss, 4); ss += __shfl_xor(ss, 8);
            const float inv = 1.0f / fmaxf(sqrtf(ss), 1e-12f);
            const f32x4 kn = kv * ((av - 1.0f) * ka + 1.0f), kq = kkv * inv;
            v2u o; o.x = pk2(kq.x, kq.y); o.y = pk2(kq.z, kq.w); ((v2u*)(KK + ro))[e4] = o;
            o.x = pk2(kn.x, kn.y); o.y = pk2(kn.z, kn.w); ((v2u*)(K + ro))[e4] = o;
        }
    }
}
__device__ __forceinline__ void odd_wkv_simple_phase(const Ctx& F_, int li) {
    Ctx F = F_; asm volatile("" : "+v"(F.tid), "+v"(F.lane));
    unsigned char* const ws_ = kws();
    const bf16_t* R = (const bf16_t*)(ws_ + WS_R); const bf16_t* K = (const bf16_t*)(ws_ + WS_K); const bf16_t* V = odd_vbuf(ws_, li); const bf16_t* AV = (const bf16_t*)(ws_ + WS_AV);
    const bf16_t* KK = (const bf16_t*)(ws_ + WS_LORA); const float* WD = (const float*)(ws_ + WS_WDEC); bf16_t* Y = (bf16_t*)(ws_ + WS_Y);
    LAS float* st = (LAS float*)F.lds;
    const int gt = F.wg * NTHREADS + F.tid;
    if (gt < NB * 16 * 64) {
        const int vr = gt & 63, hh = (gt >> 6) & 15, b = gt >> 10;
#pragma unroll 4
        for (int i = 0; i < 64; ++i) st[i * NTHREADS + F.tid] = 0.f;
        for (int t = 0; t < S; ++t) {
            const size_t base = ((size_t)b * S + t) * D + hh * 64;
            float sa = 0.f;
#pragma unroll 4
            for (int i = 0; i < 64; ++i) sa -= st[i * NTHREADS + F.tid] * bf2f(KK[base + i]);
            const float vv = bf2f(V[base + vr]); float yv = 0.f;
#pragma unroll 4
            for (int i = 0; i < 64; ++i) { const float kk = bf2f(KK[base + i]); const float sn = st[i * NTHREADS + F.tid] * WD[base + i] + sa * (kk * bf2f(AV[base + i])) + vv * bf2f(K[base + i]); st[i * NTHREADS + F.tid] = sn; yv += sn * bf2f(R[base + i]); }
            Y[base + vr] = (bf16_t)f2bf(yv);
        }
    }
}
__device__ __forceinline__ void odd_post_phase(const Ctx& F_, int li) {
    Ctx F = F_; asm volatile("" : "+v"(F.tid), "+v"(F.lane));
    unsigned char* const ws_ = kws();
    const bf16_t* R = (const bf16_t*)(ws_ + WS_R); const bf16_t* K = (const bf16_t*)(ws_ + WS_K); const bf16_t* V = odd_vbuf(ws_, li); const bf16_t* G = (const bf16_t*)(ws_ + WS_G); bf16_t* Y = (bf16_t*)(ws_ + WS_Y);
    const float* r_k = kin(25) + li * 1024; const float* ln_w = kin(26) + li * 1024; const float* ln_b = kin(27) + li * 1024;
    const int row0 = F.wg * 64 + F.wave * 8;
#pragma unroll 1
    for (int r = 0; r < 8; ++r) {
        const size_t ro = (size_t)(row0 + r) * D;
#pragma unroll
        for (int j = 0; j < 4; ++j) {
            const int e4 = 64 * j + F.lane;
            const v2u yw = ((const v2u*)(Y + ro))[e4], rw = ((const v2u*)(R + ro))[e4], kw = ((const v2u*)(K + ro))[e4], vw = ((const v2u*)(V + ro))[e4], gw_ = ((const v2u*)(G + ro))[e4];
            const f32x4 y = (f32x4){bflo(yw.x), bfhi(yw.x), bflo(yw.y), bfhi(yw.y)}, rr = (f32x4){bflo(rw.x), bfhi(rw.x), bflo(rw.y), bfhi(rw.y)}, kk = (f32x4){bflo(kw.x), bfhi(kw.x), bflo(kw.y), bfhi(kw.y)};
            const f32x4 vv = (f32x4){bflo(vw.x), bfhi(vw.x), bflo(vw.y), bfhi(vw.y)}, gg = (f32x4){bflo(gw_.x), bfhi(gw_.x), bflo(gw_.y), bfhi(gw_.y)};
            float s1 = (y.x + y.y) + (y.z + y.w);
            s1 += __shfl_xor(s1, 1); s1 += __shfl_xor(s1, 2); s1 += __shfl_xor(s1, 4); s1 += __shfl_xor(s1, 8);
            const float mean = s1 * (1.f / 64.f); const f32x4 d = y - mean;
            float s2 = (d.x * d.x + d.y * d.y) + (d.z * d.z + d.w * d.w);
            s2 += __shfl_xor(s2, 1); s2 += __shfl_xor(s2, 2); s2 += __shfl_xor(s2, 4); s2 += __shfl_xor(s2, 8);
            const float rstd = 1.0f / sqrtf(s2 * (1.f / 64.f) + 64e-5f);
            const f32x4 rk4 = rr * kk * ((const f32x4*)r_k)[e4]; float s3 = (rk4.x + rk4.y) + (rk4.z + rk4.w);
            s3 += __shfl_xor(s3, 1); s3 += __shfl_xor(s3, 2); s3 += __shfl_xor(s3, 4); s3 += __shfl_xor(s3, 8);
            const f32x4 o = (d * rstd * ((const f32x4*)ln_w)[e4] + ((const f32x4*)ln_b)[e4] + vv * s3) * gg;
            v2u w; w.x = pk2(o.x, o.y); w.y = pk2(o.z, o.w); ((v2u*)(Y + ro))[e4] = w;
        }
    }
}
}
#ifndef FAST_MOE
#define FAST_MOE 1
#endif
#ifndef FAST_EVEN
#define FAST_EVEN 1
#endif
#ifndef FAST_ODD
#define FAST_ODD 1
#endif
struct Args { nv::InPtrs in; float* out; unsigned char* ws; };
__global__ void __launch_bounds__(NTHREADS, 2) mega_fwd(Args args) {
    extern __shared__ __attribute__((aligned(16))) unsigned char lds[];
    LAS unsigned char* L = (LAS unsigned char*)lds;
    for (int u = threadIdx.x; u < (LDS_BYTES - LDSCTL_OFF) / 4; u += NTHREADS) ((LAS unsigned*)(L + LDSCTL_OFF))[u] = 0u;
    __syncthreads();
    volatile LAS unsigned* MISC = (volatile LAS unsigned*)(L + MISC_OFF);
    const XcdBarrier bar = xcd_barrier_post((unsigned*)(kws() + fm::WS_CTL), MISC + 8);
    const long long nv_gtid = (long long)blockIdx.x * NTHREADS + threadIdx.x, nv_nthr = (long long)gridDim.x * NTHREADS;
    fm::Ctx F; F.lds = L; F.tid = threadIdx.x; F.lane = F.tid & 63; F.wave = __builtin_amdgcn_readfirstlane(F.tid >> 6);
    F.G = gridDim.x; F.wg = blockIdx.x; F.vcu = (F.G % 8 == 0) ? (F.wg % 8) * (F.G / 8) + F.wg / 8 : F.wg;
#define GRID_BAR() xcd_barrier(bar)
#define NVC nv::nv_ctx((float*)(kws() + fm::WS_NAIVE), (float*)(kws() + fm::WS_NAIVE_BIG))
    nv::nv_prologue(args.in, kout(), NVC, bar, nv_gtid, nv_nthr);
#if FAST_EVEN
    fm::even_convert_weights(F, 0); fm::even_convert_weights(F, 1);
#endif
#if FAST_ODD
    fm::odd_convert_weights(F, 0); fm::odd_convert_weights(F, 1);
#endif
    GRID_BAR();
    for (int layer = 0; layer < 4; ++layer) {
#if FAST_EVEN
        if (layer % 2 == 0) {
            fm::norm_phase(F, layer * 2); GRID_BAR();
            fm::even_inproj_phase(F, layer / 2); GRID_BAR();
            fm::even_mix_phase(F, layer / 2); GRID_BAR();
            fm::even_outproj_phase(F, layer); GRID_BAR();
        }
#else
        if (layer % 2 == 0) nv::nv_even(args.in, kout(), NVC, layer, bar, nv_gtid, nv_nthr);
#endif
#if FAST_ODD
        if (layer % 2 == 1) {
            const int li = layer / 2;
            fm::norm_phase(F, layer * 2); GRID_BAR();
            fm::odd_mix_phase<3>(F, li, 0, 2, 3, 0); GRID_BAR();
            fm::odd_gemm_rkv_phase(F, li); GRID_BAR();
            fm::odd_mix_phase<4>(F, li, 1, 4, 5, 3); GRID_BAR();
            fm::odd_gemm_loradown_phase(F, li); GRID_BAR();
            fm::odd_gemm_loraup_phase(F, li); GRID_BAR();
            fm::odd_prep_phase(F, li); GRID_BAR();
            fm::odd_wkv_simple_phase(F, li); GRID_BAR();
            fm::odd_post_phase(F, li); GRID_BAR();
            fm::odd_gemm_wo_phase(F, layer); GRID_BAR();
        }
#else
        if (layer % 2 == 1) nv::nv_odd(args.in, kout(), NVC, layer, bar, nv_gtid, nv_nthr);
#endif
#if FAST_MOE
        fm::moe_convert_weights(F, kin(30), kin(31), kin(32), layer);
        __syncthreads();
        fm::moe_route_phase(F, kin(28), kin(29), layer);
        GRID_BAR();
        fm::moe_sort_phase(F);
        GRID_BAR();
        fm::moe_gemm1_phase(F);
        GRID_BAR();
        fm::moe_gemm2_phase(F);
        GRID_BAR();
        fm::moe_combine_phase(F, layer);
        GRID_BAR();
#else
        nv::nv_moe(args.in, kout(), NVC, layer, bar, nv_gtid, nv_nthr);
#endif
    }
    nv::nv_final(args.in, kout(), NVC, bar, nv_gtid, nv_nthr);
}
extern "C" void kernel_launch(void* const* d_in, const int* in_sizes, int n_in, void* d_out, int out_size, void* d_ws, size_t ws_size, hipStream_t stream) {
    (void)in_sizes; (void)out_size;
    static int grid = 0;
    if (grid == 0) {
        int dev = 0, cus = 0, per_cu = 0;
        hipGetDevice(&dev); hipDeviceGetAttribute(&cus, hipDeviceAttributeMultiprocessorCount, dev);
        hipFuncSetAttribute((const void*)mega_fwd, hipFuncAttributeMaxDynamicSharedMemorySize, LDS_BYTES);
        hipOccupancyMaxActiveBlocksPerMultiprocessor(&per_cu, (const void*)mega_fwd, NTHREADS, LDS_BYTES);
        (void)hipGetLastError();
        grid = 256;
        if (per_cu < 1) fprintf(stderr, "kernel_launch: occupancy query says %d blocks/CU\n", per_cu);
        if (cus < 256 || n_in != 34 || ws_size < fm::WS_END) { fprintf(stderr, "kernel_launch: unexpected cus %d / n_in %d / ws %zu\n", cus, n_in, ws_size); grid = -1; }
    }
    if (grid < 0) return;
    hipMemsetAsync((char*)d_ws + fm::WS_CTL, 0, fm::CTL_ZERO_BYTES, stream);
    Args a{};
    for (int i = 0; i < 34; ++i) a.in.p[i] = (const float*)d_in[i];
    a.out = (float*)d_out; a.ws = (unsigned char*)d_ws;
    void* kargs[] = {&a};
    hipError_t e = hipLaunchCooperativeKernel((const void*)mega_fwd, dim3(grid), dim3(NTHREADS), kargs, LDS_BYTES, stream);
    if (e != hipSuccess) fprintf(stderr, "cooperative launch failed: %s (grid %d)\n", hipGetErrorString(e), grid);
}
```

```cpp
#include <hip/hip_runtime.h>
#include <stdint.h>
#include <stddef.h>
#include <math.h>
#include <stdio.h>
#define NV_PERSIST 1
#define GAS __attribute__((address_space(1)))
#define LAS __attribute__((address_space(3)))
#define XB_TMO      128
#define XB_XCNT(j)  (256  + 64 * (j))
#define XB_XSUB(j)  (1280 + 64 * (j))
#define XB_XGEN(j)  (2304 + 64 * (j))
#define XB_TOP      3328
#define XB_TOPGEN   3392
#define XCD_BAR_WORDS 3456
#define XB_SPIN_CAP (1u << 22)
__device__ __forceinline__ unsigned xb_ld(unsigned* p)              { return __hip_atomic_load(p, __ATOMIC_RELAXED, __HIP_MEMORY_SCOPE_AGENT); }
__device__ __forceinline__ unsigned xb_add(unsigned* p, unsigned v) { return __hip_atomic_fetch_add(p, v, __ATOMIC_RELAXED, __HIP_MEMORY_SCOPE_AGENT); }
__device__ __forceinline__ unsigned xb_xcc_id() { return (unsigned)__builtin_amdgcn_s_getreg((3 << 11) | 20) & 0xFu; }
#define XB_SPIN(cond, bar) do { unsigned _sp = 0; while (cond) { __builtin_amdgcn_s_sleep(1); \
    if ((++_sp & 255u) == 0u) { if (xb_ld(&(bar)[XB_TMO])) break; if (_sp > XB_SPIN_CAP) { atomicAdd(&(bar)[XB_TMO], 1u); break; } } } } while (0)
struct XcdBarrier { unsigned* bar; unsigned x; volatile LAS unsigned* st; };
__device__ __forceinline__ XcdBarrier xcd_barrier_post(unsigned* bar, volatile LAS unsigned* st) {
    XcdBarrier b; b.bar = bar; b.x = xb_xcc_id(); b.st = st;
    if (threadIdx.x == 0) (void)xb_add(&bar[XB_XCNT(b.x)], 1u);
    return b;
}
__device__ __forceinline__ void xcd_barrier_complete(unsigned* bar, unsigned x, unsigned& nloc, unsigned& nx) {
    const unsigned G = gridDim.x * gridDim.y * gridDim.z;
    unsigned sum, cnt, mine, sp = 0u;
    for (;;) {
        sum = 0u; cnt = 0u; mine = 0u;
#pragma unroll
        for (unsigned j = 0; j < 16; ++j) { const unsigned c = xb_ld(&bar[XB_XCNT(j)]); sum += c; cnt += (c > 0u) ? 1u : 0u; mine = (j == x) ? c : mine; }
        if (sum == G) break;
        __builtin_amdgcn_s_sleep(1);
        if ((++sp & 255u) == 0u) { if (xb_ld(&bar[XB_TMO])) break; if (sp > XB_SPIN_CAP) { atomicAdd(&bar[XB_TMO], 1u); break; } }
    }
    nloc = mine > 0u ? mine : 1u; nx = cnt > 0u ? cnt : 1u;
}
__device__ __forceinline__ void xcd_barrier(const XcdBarrier& b) {
    asm volatile("s_waitcnt vmcnt(0)" ::: "memory");
    __syncthreads();
    if (threadIdx.x == 0) {
        unsigned* bar = b.bar;
        __builtin_amdgcn_s_waitcnt(0);
        unsigned nloc = b.st[0], nx = b.st[1];
        if (nloc == 0u) { xcd_barrier_complete(bar, b.x, nloc, nx); b.st[0] = nloc; b.st[1] = nx; }
        const unsigned old = xb_add(&bar[XB_XSUB(b.x)], 1u);
        const unsigned gen = old / nloc;
        if (old + 1u == (gen + 1u) * nloc) {
            __builtin_amdgcn_fence(__ATOMIC_RELEASE, "agent");
            asm volatile("s_waitcnt vmcnt(0)" ::: "memory");
            const unsigned og = xb_add(&bar[XB_TOP], 1u);
            const unsigned tg = og / nx;
            if (og + 1u == (tg + 1u) * nx) xb_add(&bar[XB_TOPGEN], 1u);
            else XB_SPIN(xb_ld(&bar[XB_TOPGEN]) == tg, bar);
            __builtin_amdgcn_fence(__ATOMIC_ACQUIRE, "agent");
            xb_add(&bar[XB_XGEN(b.x)], 1u);
            asm volatile("s_waitcnt vmcnt(0)" ::: "memory");
        } else {
            XB_SPIN(xb_ld(&bar[XB_XGEN(b.x)]) == gen, bar);
            __builtin_amdgcn_fence(__ATOMIC_ACQUIRE, "agent");
            asm volatile("s_waitcnt vmcnt(0)" ::: "memory");
        }
    }
    __syncthreads();
}
constexpr int RING_BYTES = 131072;
constexpr int LDSCTL_OFF = RING_BYTES;
constexpr int MISC_OFF = LDSCTL_OFF + 320;
constexpr int LDS_BYTES = 147456;
constexpr int NTHREADS = 512;

__device__ __forceinline__ const void* karg(int i) {
    const unsigned long long volatile* tbl = (const unsigned long long volatile*)__builtin_amdgcn_kernarg_segment_ptr();
    const unsigned long long v = tbl[i];
    const unsigned lo = __builtin_amdgcn_readfirstlane((unsigned)v), hi = __builtin_amdgcn_readfirstlane((unsigned)(v >> 32));
    return (const void*)(((unsigned long long)hi << 32) | lo);
}
__device__ __forceinline__ const float* kin(int i) { return (const float*)karg(i); }
__device__ __forceinline__ float* kout() { return (float*)karg(34); }
__device__ __forceinline__ unsigned char* kws() { return (unsigned char*)karg(35); }
#ifndef NV_B
#define NV_B 8
#endif
#ifndef NV_S
#define NV_S 2048
#endif
#ifndef NV_BC
#define NV_BC 4
#endif
namespace nv {
constexpr int Bn = NV_B, S = NV_S, D = 1024, BC = NV_BC, TC = BC * S;
constexpr int HD = 64, NH = 8, WA = 512, WB = 512, MIXIN = 2560, CH = 128;
constexpr int RH = 16, LW = 64, LA = 64, LV = 32, LG = 160, NE = 16, DE = 256;

#ifdef CPU_EMU
#define NV_HD
#define NV_DEV static inline
#define NV_LAUNCH(body, n, ...) do { long long n__ = (long long)(n); _Pragma("omp parallel for schedule(dynamic, 256)") for (long long i__ = 0; i__ < n__; ++i__) body(i__, __VA_ARGS__); } while (0)
#elif defined(NV_PERSIST)
#define NV_HD __host__ __device__
#define NV_DEV __device__ __forceinline__
#define NV_LAUNCH(body, n, ...) do { long long n__ = (long long)(n); long long g__ = nv_gtid; asm volatile("" : "+v"(g__)); for (long long i__ = g__; i__ < n__; i__ += nv_nthr) body(i__, __VA_ARGS__); NV_GRID_BARRIER(); } while (0)
#else
#define NV_HD __host__ __device__
#define NV_DEV __device__ __forceinline__
#define NV_LAUNCH(body, n, ...) do { long long n__ = (long long)(n); int nb__ = (int)((n__ + 255) / 256); hipLaunchKernelGGL(body##_k, dim3(nb__), dim3(256), 0, stream, n__, __VA_ARGS__); } while (0)
#endif

NV_DEV float sigm(float x) { return 1.f / (1.f + expf(-x)); }
NV_DEV float siluf(float x) { return x * sigm(x); }
NV_DEV float geluf(float x) { return 0.5f * x * (1.f + erff(x * 0.70710678118654752f)); }
NV_DEV float softplusf(float x) { return x > 20.f ? x : log1pf(expf(x)); }

#ifdef CPU_EMU
#define NV_KERNEL(name, ...) static inline void name(long long idx, __VA_ARGS__)
#define NV_KERNEL_END(name, ...)
#else
#define NV_KERNEL(name, ...) __device__ __forceinline__ void name(long long idx, __VA_ARGS__)
#endif

NV_KERNEL(ada_body, const float* c, const float* w, const float* bia, float* mod) {
    int n = (int)(idx % 3072); int b = (int)((idx / 3072) % Bn); int ls = (int)(idx / (3072 * Bn));
    const float* W = w + (size_t)ls * D * 3072; float acc = 0.f;
    for (int k = 0; k < D; ++k) acc += siluf(c[b * D + k]) * W[(size_t)k * 3072 + n];
    mod[idx] = acc + bia[ls * 3072 + n];
}
NV_KERNEL(rms_body, const float* x, int ld, int n, float* rinv) {
    const float* r = x + (size_t)idx * ld; float s = 0.f;
    for (int k = 0; k < n; ++k) s += r[k] * r[k];
    rinv[idx] = 1.f / sqrtf(s / (float)n + 1e-6f);
}
NV_KERNEL(modnorm_body, const float* x, const float* rinv, const float* mod, int b0, float* h) {
    int c = (int)(idx % D); long long t = idx / D; int b = b0 + (int)(t / S);
    const float* m = mod + (size_t)b * 3072;
    h[idx] = x[idx] * rinv[t] * (1.f + m[1024 + c]) + m[c];
}
NV_KERNEL(gemm_body, const float* A, int lda, const float* Bm, int ldb, float* C, int ldc, int N, int K, int act) {
    int n = (int)(idx % N); long long m = idx / N;
    const float* a = A + (size_t)m * lda; float acc = 0.f;
    for (int k = 0; k < K; ++k) acc += a[k] * Bm[(size_t)k * ldb + n];
    if (act == 1) acc = tanhf(acc); else if (act == 2) acc = sigm(acc);
    C[(size_t)m * ldc + n] = acc;
}
NV_KERNEL(gemm_res_body, const float* A, int lda, const float* Bm, int K, const float* mod, int b0, float* x) {
    int n = (int)(idx % D); long long m = idx / D; int b = b0 + (int)(m / S);
    const float* a = A + (size_t)m * lda; float acc = 0.f;
    for (int k = 0; k < K; ++k) acc += a[k] * Bm[(size_t)k * D + n];
    x[idx] += mod[(size_t)b * 3072 + 2048 + n] * acc;
}
NV_KERNEL(attn_body, const float* proj, float* o  ) {
    int dq = (int)(idx % 4); int hh = (int)((idx / 4) % NH); long long t = idx / (4 * NH);
    int tl = (int)(t % S); long long tb = t - tl;
    const float* q = proj + (size_t)t * MIXIN + hh * HD;
    float m = -INFINITY, l = 0.f; float acc[16];
#pragma unroll
    for (int d = 0; d < 16; ++d) acc[d] = 0.f;
    for (int br = 0; br < 3; ++br) {
        int dil = br == 0 ? 1 : (br == 1 ? 4 : 16);
        for (int j = 0; j <= 128; ++j) {
            int tk = tl - j * dil; if (tk < 0) break;
            const float* kp = proj + (size_t)(tb + tk) * MIXIN + WA + hh * HD;
            const float* vp = proj + (size_t)(tb + tk) * MIXIN + 2 * WA + hh * HD + dq * 16;
            float s = 0.f;
            for (int d = 0; d < HD; ++d) s += q[d] * kp[d];
            s *= 0.125f;
            float mn = fmaxf(m, s), sc = expf(m - mn), p = expf(s - mn);
            l = l * sc + p;
#pragma unroll
            for (int d = 0; d < 16; ++d) acc[d] = acc[d] * sc + p * vp[d];
            m = mn;
        }
    }
    float* op = o + (size_t)t * D + hh * HD + dq * 16;
#pragma unroll
    for (int d = 0; d < 16; ++d) op[d] = acc[d] / l;
}
NV_KERNEL(sgu_gelu_body, float* proj) {
    int c = (int)(idx % 1024); long long t = idx / 1024;
    float* p = proj + (size_t)t * MIXIN + 3 * WA + c; *p = geluf(*p);
}
NV_KERNEL(sgu_zn_body, float* proj, const float* rinvz, const float* ng) {
    int c = (int)(idx % WB); long long t = idx / WB;
    float* p = proj + (size_t)t * MIXIN + 3 * WA + WB + c; *p = *p * rinvz[t] * ng[c];
}
NV_KERNEL(sgu_mix_body, const float* proj, const float* w, const float* bs, float* o) {
    int c = (int)(idx % WB); long long t = idx / WB; int g = c / HD; int i = (int)(t % CH); long long t0 = t - i;
    const float* wr = w + ((size_t)g * CH + i) * CH; float acc = 0.f;
    for (int j = 0; j <= i; ++j) acc += wr[j] * proj[(size_t)(t0 + j) * MIXIN + 3 * WA + WB + c];
    acc += bs[g * CH + i];
    o[(size_t)t * D + WA + c] = proj[(size_t)t * MIXIN + 3 * WA + c] * acc;
}
NV_KERNEL(router_body, const float* h, const float* rw, const float* rb, int* eidx, float* ewt) {
    const float* r = h + (size_t)idx * D;
    float s[16];
#pragma unroll
    for (int e = 0; e < 16; ++e) s[e] = 0.f;
    for (int k = 0; k < D; ++k) { float hv = r[k];
#pragma unroll
        for (int e = 0; e < 16; ++e) s[e] += hv * rw[k * 16 + e]; }
    float sel[16];
#pragma unroll
    for (int e = 0; e < 16; ++e) { s[e] = sigm(s[e]); sel[e] = s[e] + rb[e]; }
    int bg = 0; float bgs = -INFINITY;
#pragma unroll
    for (int g = 0; g < 4; ++g) {
        float a0 = sel[4 * g], a1 = sel[4 * g + 1], a2 = sel[4 * g + 2], a3 = sel[4 * g + 3];
        float m1 = fmaxf(fmaxf(a0, a1), fmaxf(a2, a3));
        float tot = a0 + a1 + a2 + a3, mn = fminf(fminf(a0, a1), fminf(a2, a3));
        float lo01 = fminf(a0, a1), hi01 = fmaxf(a0, a1), lo23 = fminf(a2, a3), hi23 = fmaxf(a2, a3);
        float m2 = fmaxf(fminf(hi01, hi23), fmaxf(lo01, lo23));
        (void)tot; (void)mn;
        float gs = m1 + m2;
        if (gs > bgs) { bgs = gs; bg = g; }
    }
    int i0 = 0; float v0 = -INFINITY;
#pragma unroll
    for (int j = 0; j < 4; ++j) { float v = bg == 0 ? sel[j] : bg == 1 ? sel[4 + j] : bg == 2 ? sel[8 + j] : sel[12 + j]; if (v > v0) { v0 = v; i0 = j; } }
    int i1 = 0; float v1 = -INFINITY;
#pragma unroll
    for (int j = 0; j < 4; ++j) { float v = bg == 0 ? sel[j] : bg == 1 ? sel[4 + j] : bg == 2 ? sel[8 + j] : sel[12 + j]; if (j != i0 && v > v1) { v1 = v; i1 = j; } }
    int e0 = bg * 4 + i0, e1 = bg * 4 + i1; float w0 = 0.f, w1 = 0.f;
#pragma unroll
    for (int e = 0; e < 16; ++e) { if (e == e0) w0 = s[e]; if (e == e1) w1 = s[e]; }
    float inv = 1.f / (w0 + w1);
    eidx[idx * 2] = e0; eidx[idx * 2 + 1] = e1; ewt[idx * 2] = w0 * inv; ewt[idx * 2 + 1] = w1 * inv;
}
NV_KERNEL(moe_hid_body, const float* h, const int* eidx, const float* w1, const float* w3, float* hid) {
    int j = (int)(idx % DE); long long ts = idx / DE; long long t = ts >> 1; int e = eidx[ts];
    const float* r = h + (size_t)t * D; const float* W1 = w1 + (size_t)e * D * DE; const float* W3 = w3 + (size_t)e * D * DE;
    float a = 0.f, b = 0.f;
    for (int k = 0; k < D; ++k) { float hv = r[k]; a += hv * W1[(size_t)k * DE + j]; b += hv * W3[(size_t)k * DE + j]; }
    hid[idx] = siluf(a) * b;
}
NV_KERNEL(moe_out_body, const float* hid, const int* eidx, const float* ewt, const float* w2, const float* mod, int b0, float* x) {
    int n = (int)(idx % D); long long t = idx / D; int b = b0 + (int)(t / S); float y = 0.f;
    for (int sl = 0; sl < 2; ++sl) { int e = eidx[t * 2 + sl]; const float* W2 = w2 + (size_t)e * DE * D; const float* hr = hid + ((size_t)t * 2 + sl) * DE; float acc = 0.f;
        for (int j = 0; j < DE; ++j) acc += hr[j] * W2[(size_t)j * D + n];
        y += ewt[t * 2 + sl] * acc; }
    x[idx] += mod[(size_t)b * 3072 + 2048 + n] * y;
}
NV_KERNEL(rk_mix_body, const float* h, const float* mu, float* xm) {
    int c = (int)(idx % D); long long t = idx / D; int tl = (int)(t % S);
    float hv = h[idx], hp = tl == 0 ? 0.f : h[idx - D];
    xm[idx] = hv + (hp - hv) * mu[c];
}
NV_KERNEL(rk_prep_body, const float* wl, const float* w2, const float* w0, const float* al, const float* a2, const float* a0,
          const float* vl, const float* v2, const float* v0, const float* vfirst, float* v, float* wd, float* av) {
    int c = (int)(idx % D); long long t = idx / D;
    float acc = 0.f; for (int j = 0; j < LW; ++j) acc += wl[t * LW + j] * w2[(size_t)j * D + c];
    float w = -softplusf(-(w0[c] + acc)) - 0.5f; wd[idx] = expf(-expf(w));
    acc = 0.f; for (int j = 0; j < LA; ++j) acc += al[t * LA + j] * a2[(size_t)j * D + c];
    av[idx] = sigm(a0[c] + acc);
    if (vl) { acc = 0.f; for (int j = 0; j < LV; ++j) acc += vl[t * LV + j] * v2[(size_t)j * D + c];
        float vv = v[idx]; v[idx] = vv + (vfirst[idx] - vv) * sigm(v0[c] + acc); }
}
#ifdef NV_PERSIST
#define NV_WKV_UNROLL _Pragma("unroll 4")
#else
#define NV_WKV_UNROLL _Pragma("unroll")
#endif
NV_KERNEL(wkv_body, const float* r, const float* wd, const float* k, const float* v, const float* av, const float* k_k, const float* k_a, float* y) {
    int vr = (int)(idx % HD); int hh = (int)((idx / HD) % RH); long long bl = idx / (HD * RH);
#ifdef NV_PERSIST
    extern __shared__ __attribute__((aligned(16))) unsigned char lds[];
    float* nv_lds = (float*)lds;
#define st(i) nv_lds[(i) * 512 + threadIdx.x]
#else
    float st_[HD];
#define st(i) st_[i]
#endif
NV_WKV_UNROLL
    for (int i = 0; i < HD; ++i) st(i) = 0.f;
    const float* kkw = k_k + hh * HD; const float* kaw = k_a + hh * HD;
    for (int t = 0; t < S; ++t) {
        size_t base = ((size_t)bl * S + t) * D + hh * HD;
        float nrm = 0.f;
NV_WKV_UNROLL
        for (int i = 0; i < HD; ++i) { float kv = k[base + i] * kkw[i]; nrm += kv * kv; }
        float inv = 1.f / fmaxf(sqrtf(nrm), 1e-12f);
        float sa = 0.f;
NV_WKV_UNROLL
        for (int i = 0; i < HD; ++i) { float kkv = k[base + i] * kkw[i] * inv; sa += st(i) * (-kkv); }
        float vv = v[base + vr], yv = 0.f;
NV_WKV_UNROLL
        for (int i = 0; i < HD; ++i) {
            float ko = k[base + i], a = av[base + i]; float kkv = ko * kkw[i] * inv; float kn = ko * (1.f + (a - 1.f) * kaw[i]);
            float sn = st(i) * wd[base + i] + sa * (kkv * a) + vv * kn; st(i) = sn;
            yv += sn * r[base + i];
        }
        y[base + vr] = yv;
    }
#undef st
}
NV_KERNEL(rk_post_body, const float* y, const float* r, const float* k, const float* v, const float* av, const float* k_a, const float* r_k,
          const float* lnw, const float* lnb, const float* gl, const float* g2, float* outA) {
    int hh = (int)(idx % RH); long long t = idx / RH; size_t base = (size_t)t * D + hh * HD;
    float mean = 0.f; for (int i = 0; i < HD; ++i) mean += y[base + i]; mean *= (1.f / HD);
    float var = 0.f; for (int i = 0; i < HD; ++i) { float d = y[base + i] - mean; var += d * d; } var *= (1.f / HD);
    float rstd = 1.f / sqrtf(var + 64e-5f);
    float rk = 0.f; for (int i = 0; i < HD; ++i) { int c = hh * HD + i; float kn = k[base + i] * (1.f + (av[base + i] - 1.f) * k_a[c]); rk += r[base + i] * kn * r_k[c]; }
    for (int i = 0; i < HD; ++i) { int c = hh * HD + i;
        float g = 0.f; for (int j = 0; j < LG; ++j) g += gl[t * LG + j] * g2[(size_t)j * D + c];
        float yy = (y[base + i] - mean) * rstd * lnw[c] + lnb[c] + rk * v[base + i];
        outA[base + i] = yy * g; }
}
NV_KERNEL(copy_body, const float* src, float* dst) { dst[idx] = src[idx]; }
NV_KERNEL(final_body, const float* x, const float* rinv, const float* g, float* out) { int c = (int)(idx % D); long long t = idx / D; out[idx] = x[idx] * rinv[t] * g[c]; }

#if !defined(CPU_EMU) && !defined(NV_PERSIST)
#define NV_WRAP(body, ...)
template <class F> __global__ void __launch_bounds__(256) generic_k(long long n, F f) { long long i = (long long)blockIdx.x * 256 + threadIdx.x; if (i < n) f(i); }
__global__ void __launch_bounds__(256) ada_body_k(long long n, const float* c, const float* w, const float* bia, float* mod) { long long i = (long long)blockIdx.x * 256 + threadIdx.x; if (i < n) ada_body(i, c, w, bia, mod); }
__global__ void __launch_bounds__(256) rms_body_k(long long n, const float* x, int ld, int nn, float* rinv) { long long i = (long long)blockIdx.x * 256 + threadIdx.x; if (i < n) rms_body(i, x, ld, nn, rinv); }
__global__ void __launch_bounds__(256) modnorm_body_k(long long n, const float* x, const float* rinv, const float* mod, int b0, float* h) { long long i = (long long)blockIdx.x * 256 + threadIdx.x; if (i < n) modnorm_body(i, x, rinv, mod, b0, h); }
__global__ void __launch_bounds__(256) gemm_body_k(long long n, const float* A, int lda, const float* Bm, int ldb, float* C, int ldc, int N, int K, int act) { long long i = (long long)blockIdx.x * 256 + threadIdx.x; if (i < n) gemm_body(i, A, lda, Bm, ldb, C, ldc, N, K, act); }
__global__ void __launch_bounds__(256) gemm_res_body_k(long long n, const float* A, int lda, const float* Bm, int K, const float* mod, int b0, float* x) { long long i = (long long)blockIdx.x * 256 + threadIdx.x; if (i < n) gemm_res_body(i, A, lda, Bm, K, mod, b0, x); }
__global__ void __launch_bounds__(256) attn_body_k(long long n, const float* proj, float* o) { long long i = (long long)blockIdx.x * 256 + threadIdx.x; if (i < n) attn_body(i, proj, o); }
__global__ void __launch_bounds__(256) sgu_gelu_body_k(long long n, float* proj) { long long i = (long long)blockIdx.x * 256 + threadIdx.x; if (i < n) sgu_gelu_body(i, proj); }
__global__ void __launch_bounds__(256) sgu_zn_body_k(long long n, float* proj, const float* rinvz, const float* ng) { long long i = (long long)blockIdx.x * 256 + threadIdx.x; if (i < n) sgu_zn_body(i, proj, rinvz, ng); }
__global__ void __launch_bounds__(256) sgu_mix_body_k(long long n, const float* proj, const float* w, const float* bs, float* o) { long long i = (long long)blockIdx.x * 256 + threadIdx.x; if (i < n) sgu_mix_body(i, proj, w, bs, o); }
__global__ void __launch_bounds__(256) router_body_k(long long n, const float* h, const float* rw, const float* rb, int* eidx, float* ewt) { long long i = (long long)blockIdx.x * 256 + threadIdx.x; if (i < n) router_body(i, h, rw, rb, eidx, ewt); }
__global__ void __launch_bounds__(256) moe_hid_body_k(long long n, const float* h, const int* eidx, const float* w1, const float* w3, float* hid) { long long i = (long long)blockIdx.x * 256 + threadIdx.x; if (i < n) moe_hid_body(i, h, eidx, w1, w3, hid); }
__global__ void __launch_bounds__(256) moe_out_body_k(long long n, const float* hid, const int* eidx, const float* ewt, const float* w2, const float* mod, int b0, float* x) { long long i = (long long)blockIdx.x * 256 + threadIdx.x; if (i < n) moe_out_body(i, hid, eidx, ewt, w2, mod, b0, x); }
__global__ void __launch_bounds__(256) rk_mix_body_k(long long n, const float* h, const float* mu, float* xm) { long long i = (long long)blockIdx.x * 256 + threadIdx.x; if (i < n) rk_mix_body(i, h, mu, xm); }
__global__ void __launch_bounds__(256) rk_prep_body_k(long long n, const float* wl, const float* w2, const float* w0, const float* al, const float* a2, const float* a0, const float* vl, const float* v2, const float* v0, const float* vfirst, float* v, float* wd, float* av) { long long i = (long long)blockIdx.x * 256 + threadIdx.x; if (i < n) rk_prep_body(i, wl, w2, w0, al, a2, a0, vl, v2, v0, vfirst, v, wd, av); }
__global__ void __launch_bounds__(256) wkv_body_k(long long n, const float* r, const float* wd, const float* k, const float* v, const float* av, const float* k_k, const float* k_a, float* y) { long long i = (long long)blockIdx.x * 256 + threadIdx.x; if (i < n) wkv_body(i, r, wd, k, v, av, k_k, k_a, y); }
__global__ void __launch_bounds__(256) rk_post_body_k(long long n, const float* y, const float* r, const float* k, const float* v, const float* av, const float* k_a, const float* r_k, const float* lnw, const float* lnb, const float* gl, const float* g2, float* outA) { long long i = (long long)blockIdx.x * 256 + threadIdx.x; if (i < n) rk_post_body(i, y, r, k, v, av, k_a, r_k, lnw, lnb, gl, g2, outA); }
__global__ void __launch_bounds__(256) copy_body_k(long long n, const float* src, float* dst) { long long i = (long long)blockIdx.x * 256 + threadIdx.x; if (i < n) copy_body(i, src, dst); }
__global__ void __launch_bounds__(256) final_body_k(long long n, const float* x, const float* rinv, const float* g, float* out) { long long i = (long long)blockIdx.x * 256 + threadIdx.x; if (i < n) final_body(i, x, rinv, g, out); }
#endif

#if defined(CPU_EMU)
#define NV_STREAM_ARG
#define NV_STREAM_PARAM
#define NV_FWD_QUAL static
#elif defined(NV_PERSIST)
#define NV_STREAM_ARG
#define NV_STREAM_PARAM , const XcdBarrier& nv_bar, long long nv_gtid, long long nv_nthr
#define NV_GRID_BARRIER() do { XcdBarrier b_; b_.bar = nv_bar.bar; b_.x = (unsigned)__builtin_amdgcn_readfirstlane((int)xb_xcc_id()); b_.st = nv_bar.st; xcd_barrier(b_); } while (0)
#define NV_FWD_QUAL __device__ __forceinline__
#else
#define NV_FWD_QUAL static
#define NV_STREAM_ARG , stream
#define NV_STREAM_PARAM , hipStream_t stream
#endif
NV_HD static inline size_t naive_ws_floats() { return (size_t)8 * Bn * 3072 + (size_t)TC * 6 + (size_t)TC * 320 + (size_t)Bn * S * D + (size_t)6 * TC * D; }

struct InPtrs { const float* p[34]; };
struct NvCtx {
    float *mod, *rinv, *rinvz, *ewt, *lwl, *lal, *lvl, *lgl, *vfirst, *big; int* eidx;
};
NV_FWD_QUAL NvCtx nv_ctx(float* ws, float* big = nullptr) {
    NvCtx c; float* p = ws;
    c.mod = p; p += (size_t)8 * Bn * 3072;
    c.rinv = p; p += TC; c.rinvz = p; p += TC;
    c.eidx = (int*)p; p += 2 * TC; c.ewt = p; p += 2 * TC;
    c.lwl = p; p += (size_t)TC * LW; c.lal = p; p += (size_t)TC * LA; c.lvl = p; p += (size_t)TC * LV; c.lgl = p; p += (size_t)TC * LG;
    c.vfirst = p; p += (size_t)Bn * S * D;
    c.big = big ? big : p; return c;
}
#ifdef NV_PERSIST
#define in(k) kin(k)
#else
#define in(k) ip.p[k]
#endif
NV_FWD_QUAL void nv_prologue(const InPtrs& ip, float* xw, const NvCtx& C NV_STREAM_PARAM) {
    NV_LAUNCH(copy_body, (size_t)Bn * S * D, in(0), xw);
    NV_LAUNCH(ada_body, (size_t)8 * Bn * 3072, in(1), in(2), in(3), C.mod);
}
NV_FWD_QUAL void nv_even(const InPtrs& ip, float* xw, const NvCtx& C, int layer NV_STREAM_PARAM) {
    const float *mix_w_in = in(4), *mix_w_out = in(5), *sgu_ng = in(6), *sgu_w = in(7), *sgu_b = in(8);
    const size_t BUF = (size_t)TC * D; float* h = C.big; float* proj = C.big + BUF; float* obuf = C.big + 4 * BUF; float* rinv = C.rinv; float* rinvz = C.rinvz;
    const int li = layer / 2;
    for (int b0 = 0; b0 < Bn; b0 += BC) {
        float* x = xw + (size_t)b0 * S * D;
        const float* m0 = C.mod + (size_t)(layer * 2 + 0) * Bn * 3072;
        NV_LAUNCH(rms_body, TC, x, D, D, rinv);
        NV_LAUNCH(modnorm_body, BUF, x, rinv, m0, b0, h);
        NV_LAUNCH(gemm_body, (size_t)TC * MIXIN, h, D, mix_w_in + (size_t)li * D * MIXIN, MIXIN, proj, MIXIN, MIXIN, D, 0);
        NV_LAUNCH(attn_body, (size_t)TC * NH * 4, proj, obuf);
        NV_LAUNCH(sgu_gelu_body, (size_t)TC * 1024, proj);
        NV_LAUNCH(rms_body, TC, proj + 3 * WA + WB, MIXIN, WB, rinvz);
        NV_LAUNCH(sgu_zn_body, (size_t)TC * WB, proj, rinvz, sgu_ng + li * WB);
        NV_LAUNCH(sgu_mix_body, (size_t)TC * WB, proj, sgu_w + (size_t)li * 8 * CH * CH, sgu_b + li * 8 * CH, obuf);
        NV_LAUNCH(gemm_res_body, BUF, obuf, D, mix_w_out + (size_t)li * D * D, D, m0, b0, x);
    }
}
NV_FWD_QUAL void nv_odd(const InPtrs& ip, float* xw, const NvCtx& C, int layer NV_STREAM_PARAM) {
    const float *mu = in(9), *w_rkv = in(10), *w_o = in(11), *w0 = in(12), *w1 = in(13), *w2 = in(14), *a0 = in(15), *a1 = in(16), *a2 = in(17), *v0 = in(18), *v1 = in(19), *v2 = in(20);
    const float *g1 = in(21), *g2 = in(22), *k_k = in(23), *k_a = in(24), *r_k = in(25), *ln_w = in(26), *ln_b = in(27);
    const size_t BUF = (size_t)TC * D; float* big = C.big; float* h = big; float* rinv = C.rinv;
    float* R = big + BUF, *Kb = big + 2 * BUF, *Vb = big + 3 * BUF, *XM = big + 4 * BUF, *Wd = big + 4 * BUF, *Av = big + 5 * BUF, *Y = big;
    float *lwl = C.lwl, *lal = C.lal, *lvl = C.lvl, *lgl = C.lgl;
    const int li = layer / 2;
    for (int b0 = 0; b0 < Bn; b0 += BC) {
        float* x = xw + (size_t)b0 * S * D;
        const float* m0 = C.mod + (size_t)(layer * 2 + 0) * Bn * 3072;
        NV_LAUNCH(rms_body, TC, x, D, D, rinv);
        NV_LAUNCH(modnorm_body, BUF, x, rinv, m0, b0, h);
        const float* muL = mu + (size_t)li * 6 * D;
        float* vf = C.vfirst + (size_t)b0 * S * D;
        NV_LAUNCH(rk_mix_body, BUF, h, muL + 0 * D, XM); NV_LAUNCH(gemm_body, BUF, XM, D, w_rkv + ((size_t)li * 3 + 0) * D * D, D, R, D, D, D, 0);
        NV_LAUNCH(rk_mix_body, BUF, h, muL + 1 * D, XM); NV_LAUNCH(gemm_body, (size_t)TC * LW, XM, D, w1 + (size_t)li * D * LW, LW, lwl, LW, LW, D, 1);
        NV_LAUNCH(rk_mix_body, BUF, h, muL + 2 * D, XM); NV_LAUNCH(gemm_body, BUF, XM, D, w_rkv + ((size_t)li * 3 + 1) * D * D, D, Kb, D, D, D, 0);
        NV_LAUNCH(rk_mix_body, BUF, h, muL + 3 * D, XM); NV_LAUNCH(gemm_body, BUF, XM, D, w_rkv + ((size_t)li * 3 + 2) * D * D, D, Vb, D, D, D, 0);
        if (li > 0) NV_LAUNCH(gemm_body, (size_t)TC * LV, XM, D, v1 + (size_t)(li - 1) * D * LV, LV, lvl, LV, LV, D, 0);
        NV_LAUNCH(rk_mix_body, BUF, h, muL + 4 * D, XM); NV_LAUNCH(gemm_body, (size_t)TC * LA, XM, D, a1 + (size_t)li * D * LA, LA, lal, LA, LA, D, 0);
        NV_LAUNCH(rk_mix_body, BUF, h, muL + 5 * D, XM); NV_LAUNCH(gemm_body, (size_t)TC * LG, XM, D, g1 + (size_t)li * D * LG, LG, lgl, LG, LG, D, 2);
        if (li == 0) {
            NV_LAUNCH(rk_prep_body, BUF, lwl, w2 + (size_t)li * LW * D, w0 + li * D, lal, a2 + (size_t)li * LA * D, a0 + li * D,
                      (const float*)nullptr, (const float*)nullptr, (const float*)nullptr, (const float*)nullptr, Vb, Wd, Av);
            NV_LAUNCH(copy_body, BUF, Vb, vf);
        } else {
            NV_LAUNCH(rk_prep_body, BUF, lwl, w2 + (size_t)li * LW * D, w0 + li * D, lal, a2 + (size_t)li * LA * D, a0 + li * D,
                      lvl, v2 + (size_t)(li - 1) * LV * D, v0 + (li - 1) * D, vf, Vb, Wd, Av);
        }
        NV_LAUNCH(wkv_body, (size_t)BC * RH * HD, R, Wd, Kb, Vb, Av, k_k + li * D, k_a + li * D, Y);
        NV_LAUNCH(rk_post_body, (size_t)TC * RH, Y, R, Kb, Vb, Av, k_a + li * D, r_k + li * D, ln_w + li * D, ln_b + li * D, lgl, g2 + (size_t)li * LG * D, Wd);
        NV_LAUNCH(gemm_res_body, BUF, Wd, D, w_o + (size_t)li * D * D, D, m0, b0, x);
    }
}
NV_FWD_QUAL void nv_moe(const InPtrs& ip, float* xw, const NvCtx& C, int layer NV_STREAM_PARAM) {
    const float *router_w = in(28), *router_b = in(29), *moe_w1 = in(30), *moe_w3 = in(31), *moe_w2 = in(32);
    const size_t BUF = (size_t)TC * D; float* h = C.big; float* hid = C.big + BUF; float* rinv = C.rinv;
    for (int b0 = 0; b0 < Bn; b0 += BC) {
        float* x = xw + (size_t)b0 * S * D;
        const float* m1 = C.mod + (size_t)(layer * 2 + 1) * Bn * 3072;
        NV_LAUNCH(rms_body, TC, x, D, D, rinv);
        NV_LAUNCH(modnorm_body, BUF, x, rinv, m1, b0, h);
        NV_LAUNCH(router_body, TC, h, router_w, router_b, C.eidx, C.ewt);
        NV_LAUNCH(moe_hid_body, (size_t)TC * 2 * DE, h, C.eidx, moe_w1 + (size_t)layer * NE * D * DE, moe_w3 + (size_t)layer * NE * D * DE, hid);
        NV_LAUNCH(moe_out_body, BUF, hid, C.eidx, C.ewt, moe_w2 + (size_t)layer * NE * DE * D, m1, b0, x);
    }
}
NV_FWD_QUAL void nv_final(const InPtrs& ip, float* xw, const NvCtx& C NV_STREAM_PARAM) {
    for (int b0 = 0; b0 < Bn; b0 += BC) {
        float* x = xw + (size_t)b0 * S * D;
        NV_LAUNCH(rms_body, TC, x, D, D, C.rinv);
        NV_LAUNCH(final_body, (size_t)TC * D, x, C.rinv, in(33), x);
    }
}
#undef in
#if defined(NV_PERSIST)
#define NV_PASS , nv_bar, nv_gtid, nv_nthr
#elif defined(CPU_EMU)
#define NV_PASS
#else
#define NV_PASS , stream
#endif
NV_FWD_QUAL void naive_forward(const InPtrs& ip, float* xw, float* ws NV_STREAM_PARAM) {
    const NvCtx C = nv_ctx(ws);
    nv_prologue(ip, xw, C NV_PASS);
    for (int layer = 0; layer < 4; ++layer) {
        if (layer % 2 == 0) nv_even(ip, xw, C, layer NV_PASS); else nv_odd(ip, xw, C, layer NV_PASS);
        nv_moe(ip, xw, C, layer NV_PASS);
    }
    nv_final(ip, xw, C NV_PASS);
}
}
namespace pg8 {
#define PG8_LAS __attribute__((address_space(3)))
typedef unsigned short bf16_t;
typedef short bf16x8 __attribute__((ext_vector_type(8)));
typedef float f32x4 __attribute__((ext_vector_type(4)));
typedef unsigned u32x4 __attribute__((ext_vector_type(4)));
constexpr int BM = 256, BK = 64, HALF = 128, HTB = HALF * BK * 2  , STAGE_BYTES = 8 * HTB, NXCD = 8, WGM = 8;

__host__ __device__ __forceinline__ int lds_byte(int r, int c) { const int st = (r >> 4) * 2 + (c >> 5), rr = r & 15, cc = c & 31, ob = rr * 64 + cc * 2; return st * 1024 + (ob ^ (((ob >> 9) & 1) << 5)); }
__host__ __device__ __forceinline__ void stage_rc(int b, int& R, int& C) { const int st = b / 1024, sb = b % 1024, swz = sb ^ (((sb >> 9) & 1) << 5); R = (st >> 1) * 16 + swz / 64; C = (st & 1) * 32 + (swz % 64) / 2; }
__host__ __device__ __forceinline__ int perm32(int rho) { const int n = rho >> 4, i = rho & 15; return 8 * (i >> 2) + 4 * n + (i & 3); }

struct Unit { int pm, pn; };
struct Gemm { int K; };
__device__ __forceinline__ unsigned cvt_pk_bf16(float lo, float hi) { unsigned r; asm volatile("v_cvt_pk_bf16_f32 %0, %1, %2" : "=v"(r) : "v"(lo), "v"(hi)); return r; }
typedef float f32x2 __attribute__((ext_vector_type(2)));
__device__ __forceinline__ f32x2 gelu_pk(f32x2 v) {
    const f32x2 av = __builtin_elementwise_abs(v), d = av * 0.2316418882f + 1.0f;
    f32x2 t; t.x = __builtin_amdgcn_rcpf(d.x); t.y = __builtin_amdgcn_rcpf(d.y);
    f32x2 q = t * 0.5307027145f + (-0.7265760135f); q = q * t + 0.7107068705f; q = q * t + (-0.142248368f); q = q * t + 0.127414796f; q = q * t;
    const f32x2 s = (v * v) * (-0.72134752044f);
    f32x2 e; e.x = __builtin_amdgcn_exp2f(s.x); e.y = __builtin_amdgcn_exp2f(s.y);
    const f32x2 m = v * (q * e), r = v - m;
    f32x2 o; o.x = v.x < 0.f ? m.x : r.x; o.y = v.y < 0.f ? m.y : r.y; return o;
}
template <class Epi, class Sched, bool ALIGN_EPI = false, bool SP2 = false>
__device__ __forceinline__ void gemm_phase(PG8_LAS unsigned char* lds, const Gemm g, const Sched& S, const Epi& E) {
    int tid_ = threadIdx.x; asm volatile("" : "+v"(tid_));
    const int tid = tid_, wid = __builtin_amdgcn_readfirstlane(tid >> 6), lane = tid & 63, wr = wid >> 2, wc = wid & 3, fr = lane & 15, fq = lane >> 4;
    int Kop = g.K; asm volatile("" : "+s"(Kop));
    const int K = Kop, nt = K / BK;
    unsigned voffA[2], voffB[2];
#pragma unroll
    for (int i = 0; i < 2; ++i) { int R, C; stage_rc(tid * 16 + i * 8192, R, C); const int Rb = Epi::PERM ? ((R & ~31) + perm32(R & 31)) : R;
        voffA[i] = (unsigned)(R * K + C) * 2u; voffB[i] = (unsigned)(Rb * K + C) * 2u; }
    const size_t kstep = (size_t)(BK * 2);
    const size_t hstep = (size_t)HALF * K * 2;
        const unsigned ldsw = (unsigned)wid * 1024u;
    const int aoff = lds_byte(wr * 64 + fr, fq * 8), boff = lds_byte(wc * 32 + fr, fq * 8);
#define PG8_SA(b, h) (((b) * 2 + (h)) * HTB)
#define PG8_SB(b, h) ((4 + (b) * 2 + (h)) * HTB)
#define PG8_STAGE(bufoff, gbase, voff) do { _Pragma("unroll") for (int _i = 0; _i < 2; ++_i) \
        __builtin_amdgcn_global_load_lds((const unsigned*)((const char*)(gbase) + (voff)[_i]), (PG8_LAS unsigned*)(lds + (bufoff) + ldsw + _i * 8192), 16, 0, 0); } while (0)
#define PG8_LDA(dst, b, h) do { _Pragma("unroll") for (int m = 0; m < 4; ++m) _Pragma("unroll") for (int k = 0; k < 2; ++k) dst[m][k] = *(const PG8_LAS bf16x8*)(lds + PG8_SA(b, h) + aoff + m * 2048 + k * 1024); } while (0)
#define PG8_LDB(dst, b, h) do { _Pragma("unroll") for (int n = 0; n < 2; ++n) _Pragma("unroll") for (int k = 0; k < 2; ++k) dst[n][k] = *(const PG8_LAS bf16x8*)(lds + PG8_SB(b, h) + boff + n * 2048 + k * 1024); } while (0)
#define PG8_MMA(ai, bj, At, Bt) do { __builtin_amdgcn_s_setprio(1); _Pragma("unroll") for (int m = 0; m < 4; ++m) _Pragma("unroll") for (int n = 0; n < 2; ++n) _Pragma("unroll") for (int k = 0; k < 2; ++k) \
        acc[ai][bj][m][n] = __builtin_amdgcn_mfma_f32_16x16x32_bf16(Bt[n][k], At[m][k], acc[ai][bj][m][n], 0, 0, 0); __builtin_amdgcn_s_setprio(0); } while (0)
#define PG8_WAIT_V(n) asm volatile("s_waitcnt vmcnt(" #n ")" ::: "memory")
#define PG8_WAIT_L(n) asm volatile("s_waitcnt lgkmcnt(" #n ")" ::: "memory")
#define PG8_BAR __builtin_amdgcn_s_barrier()
#define PG8_SCHED __builtin_amdgcn_sched_barrier(0)
    Unit cur, nxt; int ui = 0;
    if (!S.next(0, cur)) return;
    f32x4 acc[2][2][4][2];
#pragma unroll
    for (int a = 0; a < 2; ++a)
#pragma unroll
        for (int b = 0; b < 2; ++b)
#pragma unroll
            for (int m = 0; m < 4; ++m)
#pragma unroll
                for (int n = 0; n < 2; ++n) acc[a][b][m][n] = (f32x4){0.f, 0.f, 0.f, 0.f};
    bf16x8 At[4][2], B0[2][2], B1[2][2];
    const char* cA = S.a_base(cur); const char* cB = S.b_base(cur);
    S.a_ready(cur);
    if constexpr (SP2) {
        PG8_STAGE(PG8_SB(0, 0), cB, voffB); PG8_STAGE(PG8_SB(0, 1), cB + hstep, voffB); PG8_STAGE(PG8_SA(0, 0), cA, voffA); PG8_STAGE(PG8_SA(0, 1), cA + hstep, voffA);
        if (wr == 1) PG8_BAR;
        PG8_WAIT_V(2); PG8_BAR;
        PG8_STAGE(PG8_SB(1, 0), cB + kstep, voffB); PG8_STAGE(PG8_SA(1, 0), cA + kstep, voffA); PG8_STAGE(PG8_SB(1, 1), cB + hstep + kstep, voffB);
        PG8_WAIT_V(6); PG8_BAR;
    } else {
        PG8_STAGE(PG8_SB(0, 0), cB, voffB); PG8_STAGE(PG8_SA(0, 0), cA, voffA); PG8_STAGE(PG8_SB(0, 1), cB + hstep, voffB); PG8_STAGE(PG8_SA(0, 1), cA + hstep, voffA);
        if (wr == 1) PG8_BAR;
        PG8_WAIT_V(4); PG8_BAR;
        PG8_STAGE(PG8_SB(1, 0), cB + kstep, voffB); PG8_STAGE(PG8_SA(1, 0), cA + kstep, voffA); PG8_STAGE(PG8_SB(1, 1), cB + hstep + kstep, voffB);
        PG8_WAIT_V(6); PG8_BAR;
    }
    for (;;) {
        const bool has_next = S.next(ui + 1, nxt);
        const char* nA = has_next ? S.a_base(nxt) : cA; const char* nB = has_next ? S.b_base(nxt) : cB;
        for (int t = 0; t < nt; t += 2) {
            const bool last = (t == nt - 2);
            const char* a1 = cA + (size_t)(t + 1) * kstep;
            const char* a2 = last ? nA : cA + (size_t)(t + 2) * kstep; const char* b2 = last ? nB : cB + (size_t)(t + 2) * kstep;
            const char* a3 = a2 + kstep; const char* b3 = b2 + kstep;
            if (last && has_next) S.a_ready(nxt);
            if constexpr (SP2) {
            PG8_LDB(B0, 0, 0); PG8_LDB(B1, 0, 1); PG8_SCHED; PG8_LDA(At, 0, 0); PG8_STAGE(PG8_SA(1, 1), a1 + hstep, voffA);
            PG8_WAIT_V(8); PG8_WAIT_L(0); PG8_BAR; PG8_MMA(0, 0, At, B0); PG8_MMA(0, 1, At, B1); PG8_BAR; PG8_SCHED;
            PG8_LDA(At, 0, 1); PG8_STAGE(PG8_SB(0, 0), b2, voffB); PG8_STAGE(PG8_SB(0, 1), b2 + hstep, voffB); PG8_STAGE(PG8_SA(0, 0), a2, voffA);
            PG8_WAIT_V(8); PG8_WAIT_L(0); PG8_BAR; PG8_MMA(1, 0, At, B0); PG8_MMA(1, 1, At, B1); PG8_BAR; PG8_SCHED;
            PG8_LDB(B0, 1, 0); PG8_LDB(B1, 1, 1); PG8_SCHED; PG8_LDA(At, 1, 0); PG8_STAGE(PG8_SA(0, 1), a2 + hstep, voffA);
            PG8_WAIT_V(8); PG8_WAIT_L(0); PG8_BAR; PG8_MMA(0, 0, At, B0); PG8_MMA(0, 1, At, B1); PG8_BAR; PG8_SCHED;
            PG8_LDA(At, 1, 1); PG8_STAGE(PG8_SB(1, 0), b3, voffB); PG8_STAGE(PG8_SB(1, 1), b3 + hstep, voffB); PG8_STAGE(PG8_SA(1, 0), a3, voffA);
            PG8_WAIT_V(8); PG8_WAIT_L(0); PG8_BAR; PG8_MMA(1, 0, At, B0); PG8_MMA(1, 1, At, B1); PG8_BAR; PG8_SCHED;
            } else {
            PG8_LDB(B0, 0, 0); PG8_SCHED; PG8_LDA(At, 0, 0); PG8_STAGE(PG8_SA(1, 1), a1 + hstep, voffA);
            PG8_WAIT_L(8); PG8_BAR; PG8_WAIT_L(0); PG8_MMA(0, 0, At, B0); PG8_BAR; PG8_SCHED;
            PG8_LDB(B1, 0, 1); PG8_STAGE(PG8_SB(0, 0), b2, voffB);
            PG8_BAR; PG8_WAIT_L(0); PG8_MMA(0, 1, At, B1); PG8_BAR;
            PG8_LDA(At, 0, 1); PG8_STAGE(PG8_SA(0, 0), a2, voffA);
            PG8_BAR; PG8_WAIT_L(0); PG8_MMA(1, 0, At, B0); PG8_BAR; PG8_SCHED;
            PG8_STAGE(PG8_SB(0, 1), b2 + hstep, voffB);
            PG8_WAIT_V(6); PG8_BAR; PG8_MMA(1, 1, At, B1); PG8_BAR;
            PG8_LDB(B0, 1, 0); PG8_SCHED; PG8_LDA(At, 1, 0); PG8_STAGE(PG8_SA(0, 1), a2 + hstep, voffA);
            PG8_WAIT_L(8); PG8_BAR; PG8_WAIT_L(0); PG8_MMA(0, 0, At, B0); PG8_BAR; PG8_SCHED;
            PG8_LDB(B1, 1, 1); PG8_STAGE(PG8_SB(1, 0), b3, voffB);
            PG8_BAR; PG8_WAIT_L(0); PG8_MMA(0, 1, At, B1); PG8_BAR;
            PG8_LDA(At, 1, 1); PG8_STAGE(PG8_SA(1, 0), a3, voffA);
            PG8_BAR; PG8_WAIT_L(0); PG8_MMA(1, 0, At, B0); PG8_BAR; PG8_SCHED;
            PG8_STAGE(PG8_SB(1, 1), b3 + hstep, voffB);
            PG8_WAIT_V(6); PG8_BAR; PG8_MMA(1, 1, At, B1); PG8_BAR;
            }
        }
        if constexpr (ALIGN_EPI) { if (wr == 0) PG8_BAR; }
        if constexpr (!Epi::AFTER_DRAIN) { E(acc, cur, wr, wc, fr, fq); S.done(cur); }
        if (!has_next) break;
#pragma unroll
        for (int a = 0; a < 2; ++a)
#pragma unroll
            for (int b = 0; b < 2; ++b)
#pragma unroll
                for (int m = 0; m < 4; ++m)
#pragma unroll
                    for (int n = 0; n < 2; ++n) acc[a][b][m][n] = (f32x4){0.f, 0.f, 0.f, 0.f};
        cur = nxt; cA = nA; cB = nB; ++ui;
        if constexpr (ALIGN_EPI) { if (wr == 1) PG8_BAR; }
    }
    PG8_WAIT_V(0);
    if constexpr (!ALIGN_EPI) { if (wr == 0) PG8_BAR; }
    PG8_BAR;
    if constexpr (Epi::AFTER_DRAIN) { E.fused(acc, cur, wr, wc, fr, fq, lds, wid, lane); S.done(cur); }
#undef PG8_SA
#undef PG8_SB
#undef PG8_STAGE
#undef PG8_LDA
#undef PG8_LDB
#undef PG8_MMA
#undef PG8_WAIT_V
#undef PG8_WAIT_L
#undef PG8_BAR
#undef PG8_SCHED
}
}
namespace fm {
using pg8::bf16_t; using pg8::f32x4; using pg8::u32x4; using pg8::Unit;
typedef unsigned v4u __attribute__((ext_vector_type(4)));
typedef unsigned v2u __attribute__((ext_vector_type(2)));
constexpr int T = 16384, D = 1024, S = 2048, NB = 8, NWAVES = 8;
constexpr size_t MiB = 1u << 20;
constexpr size_t WS_CTL = 0, CTL_ZERO_BYTES = 64 * 1024;
constexpr size_t WS_SMALL = 1 * MiB;
constexpr size_t WS_NAIVE = 4 * MiB;
constexpr size_t WS_NAIVE_BIG = 120 * MiB;
constexpr size_t WS_WMIX = 80 * MiB;
constexpr size_t WS_WMOE = 120 * MiB;
constexpr size_t WS_XN = 144 * MiB;
constexpr size_t WS_R1 = 176 * MiB;
constexpr size_t WS_YS = WS_R1;
constexpr size_t WS_AG = WS_R1 + 64 * MiB + 4096;
constexpr size_t WS_HID = WS_R1 + 137 * MiB;
constexpr size_t WS_END = 400 * MiB;
constexpr size_t SM_TOKE = 0;
constexpr size_t SM_TOKW = 128 * 1024;
constexpr size_t SM_CNTG = 256 * 1024;
constexpr size_t SM_ROWINFO = 384 * 1024;
constexpr size_t SM_ROWW = 640 * 1024;
constexpr int MOE_ROWS_MAX = 2 * T + 16 * 256;
constexpr int LX_SEG = 1024, LX_TILEE = 1152, LX_BASE = 1792, LX_DPOS = 2048, LX_TE = 2560, LX_TW = 3072, LX_PS = 4096, LX_PB = 6144;

struct Ctx {
    LAS unsigned char* lds; int tid, lane, wave, G, wg, vcu;
};
__device__ __forceinline__ float wave_sum(float v) {
#pragma unroll
    for (int o = 1; o < 64; o <<= 1) v += __shfl_xor(v, o);
    return v;
}
__device__ __forceinline__ unsigned f2bf(float f) { unsigned u = __builtin_bit_cast(unsigned, f); return (u + 0x7fffu + ((u >> 16) & 1u)) >> 16; }
__device__ __forceinline__ unsigned pk2(float lo, float hi) { return f2bf(lo) | (f2bf(hi) << 16); }
__device__ __forceinline__ float bf2f(unsigned short b) { return __builtin_bit_cast(float, (unsigned)b << 16); }
__device__ __forceinline__ float bflo(unsigned w) { return __builtin_bit_cast(float, w << 16); }
__device__ __forceinline__ float bfhi(unsigned w) { return __builtin_bit_cast(float, w & 0xffff0000u); }
#define LDS_WAIT() asm volatile("s_waitcnt lgkmcnt(0)" ::: "memory")
__device__ __forceinline__ void transpose_item(const float* W, int N, bf16_t* WT, int ldk, int k0, int n0, int drow0, LAS float* scr, int lane) {
#pragma unroll 8
    for (int i = 0; i < 32; ++i) { const int kk = 2 * i + (lane >> 5); scr[kk * 33 + (lane & 31)] = W[(size_t)(k0 + kk) * N + n0 + (lane & 31)]; }
    LDS_WAIT(); asm volatile("" ::: "memory");
    const int c = lane & 7;
#pragma unroll
    for (int j = 0; j < 4; ++j) { const int n = (lane >> 3) + 8 * j; const LAS float* s = scr + (8 * c) * 33 + n;
        v4u o; o.x = pk2(s[0 * 33], s[1 * 33]); o.y = pk2(s[2 * 33], s[3 * 33]); o.z = pk2(s[4 * 33], s[5 * 33]); o.w = pk2(s[6 * 33], s[7 * 33]);
        *(v4u*)(WT + (size_t)(drow0 + n) * ldk + k0 + 8 * c) = o; }
    LDS_WAIT(); asm volatile("" ::: "memory");
}
__device__ __forceinline__ void transpose_item_pad(const float* W, int N, int nvalid, int kvalid, bf16_t* WT, int ldk, int k0, int n0, int drow0, LAS float* scr, int lane) {
#pragma unroll 8
    for (int i = 0; i < 32; ++i) { const int kk = 2 * i + (lane >> 5); const int n = n0 + (lane & 31); float v = 0.f; if (n < nvalid && (k0 + kk) < kvalid) v = W[(size_t)(k0 + kk) * N + n]; scr[kk * 33 + (lane & 31)] = v; }
    LDS_WAIT(); asm volatile("" ::: "memory");
    const int c = lane & 7;
#pragma unroll
    for (int j = 0; j < 4; ++j) { const int n = (lane >> 3) + 8 * j; const LAS float* s = scr + (8 * c) * 33 + n;
        v4u o; o.x = pk2(s[0 * 33], s[1 * 33]); o.y = pk2(s[2 * 33], s[3 * 33]); o.z = pk2(s[4 * 33], s[5 * 33]); o.w = pk2(s[6 * 33], s[7 * 33]);
        *(v4u*)(WT + (size_t)(drow0 + n) * ldk + k0 + 8 * c) = o; }
    LDS_WAIT(); asm volatile("" ::: "memory");
}
typedef float f32x2_c __attribute__((ext_vector_type(2))); typedef __bf16 bf16x2_c __attribute__((ext_vector_type(2)));
__device__ __forceinline__ unsigned cvtpk(float lo, float hi) { const f32x2_c v = {lo, hi}; const bf16x2_c b = __builtin_convertvector(v, bf16x2_c); return __builtin_bit_cast(unsigned, b); }
__device__ __forceinline__ float fast_sigmoid(float v) { return __builtin_amdgcn_rcpf(1.f + __expf(-v)); }
}
namespace fm {
__device__ __forceinline__ void moe_convert_weights(const Ctx& F_, const float* w1, const float* w3, const float* w2, int layer) {
    Ctx F = F_; asm volatile("" : "+v"(F.tid), "+v"(F.lane));
    unsigned char* const ws_ = kws();
    LAS float* scr = (LAS float*)(F.lds + F.wave * 8448);
    bf16_t* W13T = (bf16_t*)(ws_ + WS_WMOE); bf16_t* W2T = W13T + (size_t)16 * 512 * 1024;
    const int gw = F.wg * NWAVES + F.wave, NGW = F.G * NWAVES;
    for (int it = gw; it < 16 * 384; it += NGW) {
        const int e = it / 384, r = it % 384;
        const size_t eoff = (size_t)(layer * 16 + e);
        if (r < 256) {
            const int q = r & 127, kb = q >> 3, nb = q & 7, n0 = nb * 32;
            const float* W = (r < 128 ? w1 : w3) + eoff * 1024 * 256;
            transpose_item(W, 256, W13T + (size_t)e * 512 * 1024, 1024, kb * 64, n0, (n0 >> 7) * 256 + (n0 & 127) + (r < 128 ? 0 : 128), scr, F.lane);
        } else {
            const int q = r - 256, kb = q >> 5, nb = q & 31;
            transpose_item(w2 + eoff * 256 * 1024, 1024, W2T + (size_t)e * 1024 * 256, 256, kb * 64, nb * 32, nb * 32, scr, F.lane);
        }
    }
}
__device__ __forceinline__ void moe_route_phase(const Ctx& F_, const float* router_w, const float* router_b, int layer) {
    Ctx F = F_; asm volatile("" : "+v"(F.tid), "+v"(F.lane));
    unsigned char* const ws_ = kws(); const float* const x_ = kout(); const float* const mod_ = (const float*)(ws_ + WS_NAIVE);
    LAS float* rwT = (LAS float*)F.lds;
    LAS int* cnt = (LAS int*)(F.lds + 65536);
    for (int i = F.tid; i < 16384; i += NTHREADS) { const int e = i >> 10, c = i & 1023; rwT[i] = router_w[c * 16 + e]; }
    if (F.tid < 16) cnt[F.tid] = 0;
    __syncthreads();
    int* tok_e = (int*)(ws_ + WS_SMALL + SM_TOKE); float* tok_w = (float*)(ws_ + WS_SMALL + SM_TOKW);
    bf16_t* XN = (bf16_t*)(ws_ + WS_XN);
    const int row0 = F.wg * 64 + F.wave * 8, b = row0 / S;
    const float* m = mod_ + ((size_t)(layer * 2 + 1) * NB + b) * 3072;
    float rb[16];
#pragma unroll
    for (int e = 0; e < 16; ++e) rb[e] = router_b[e];
#pragma unroll 1
    for (int r = 0; r < 8; ++r) {
        const int row = row0 + r;
        const f32x4* xr = (const f32x4*)(x_ + (size_t)row * D) + F.lane;
        f32x4 v[4]; float ss = 0.f;
#pragma unroll
        for (int j = 0; j < 4; ++j) { v[j] = xr[64 * j]; ss += (v[j].x * v[j].x + v[j].y * v[j].y) + (v[j].z * v[j].z + v[j].w * v[j].w); }
        const float rinv = 1.0f / sqrtf(wave_sum(ss) * (1.f / D) + 1e-6f);
        unsigned long long* o8 = (unsigned long long*)(XN + (size_t)row * D) + F.lane;
#pragma unroll
        for (int j = 0; j < 4; ++j) {
            const f32x4 sh = ((const f32x4*)m)[64 * j + F.lane], sc = ((const f32x4*)(m + 1024))[64 * j + F.lane];
            v[j] = v[j] * rinv * (sc + 1.0f) + sh;
            o8[64 * j] = (unsigned long long)pk2(v[j].x, v[j].y) | ((unsigned long long)pk2(v[j].z, v[j].w) << 32);
        }
        asm volatile("" ::: "memory");
        float acc[16];
#pragma unroll
        for (int e = 0; e < 16; ++e) {
            float a = 0.f;
#pragma unroll
            for (int j = 0; j < 4; ++j) { const f32x4 w = *(const LAS f32x4*)(rwT + e * 1024 + 256 * j + 4 * F.lane); a += (v[j].x * w.x + v[j].y * w.y) + (v[j].z * w.z + v[j].w * w.w); }
            acc[e] = a;
            if ((e & 1) == 1) asm volatile("" ::: "memory");
        }
        float s[16], sel[16];
#pragma unroll
        for (int e = 0; e < 16; ++e) { const float lg = wave_sum(acc[e]); s[e] = 1.f / (1.f + expf(-lg)); sel[e] = s[e] + rb[e]; }
        int bg = 0; float bgs = -INFINITY;
#pragma unroll
        for (int g = 0; g < 4; ++g) {
            const float a0 = sel[4 * g], a1 = sel[4 * g + 1], a2 = sel[4 * g + 2], a3 = sel[4 * g + 3];
            const float m1 = fmaxf(fmaxf(a0, a1), fmaxf(a2, a3));
            const float lo01 = fminf(a0, a1), hi01 = fmaxf(a0, a1), lo23 = fminf(a2, a3), hi23 = fmaxf(a2, a3);
            const float m2 = fmaxf(fminf(hi01, hi23), fmaxf(lo01, lo23));
            const float gs = m1 + m2;
            if (gs > bgs) { bgs = gs; bg = g; }
        }
        float g0 = sel[0], g1 = sel[1], g2 = sel[2], g3 = sel[3], t0 = s[0], t1 = s[1], t2 = s[2], t3 = s[3];
#pragma unroll
        for (int g = 1; g < 4; ++g) if (bg == g) { g0 = sel[4 * g]; g1 = sel[4 * g + 1]; g2 = sel[4 * g + 2]; g3 = sel[4 * g + 3]; t0 = s[4 * g]; t1 = s[4 * g + 1]; t2 = s[4 * g + 2]; t3 = s[4 * g + 3]; }
        int i0 = 0; float v0 = g0, w0 = t0;
        if (g1 > v0) { v0 = g1; i0 = 1; w0 = t1; } if (g2 > v0) { v0 = g2; i0 = 2; w0 = t2; } if (g3 > v0) { v0 = g3; i0 = 3; w0 = t3; }
        int i1 = -1; float v1 = -INFINITY, w1 = 0.f;
        if (i0 != 0 && g0 > v1) { v1 = g0; i1 = 0; w1 = t0; } if (i0 != 1 && g1 > v1) { v1 = g1; i1 = 1; w1 = t1; }
        if (i0 != 2 && g2 > v1) { v1 = g2; i1 = 2; w1 = t2; } if (i0 != 3 && g3 > v1) { v1 = g3; i1 = 3; w1 = t3; }
        const int e0 = bg * 4 + i0, e1 = bg * 4 + i1; const float inv = 1.f / (w0 + w1);
        if (F.lane == 0) { tok_e[row * 2] = e0; tok_e[row * 2 + 1] = e1; tok_w[row * 2] = w0 * inv; tok_w[row * 2 + 1] = w1 * inv;
            __hip_atomic_fetch_add(cnt + e0, 1, __ATOMIC_RELAXED, __HIP_MEMORY_SCOPE_WORKGROUP); __hip_atomic_fetch_add(cnt + e1, 1, __ATOMIC_RELAXED, __HIP_MEMORY_SCOPE_WORKGROUP); }
    }
    __syncthreads();
    if (F.tid < 16) ((int*)(ws_ + WS_SMALL + SM_CNTG))[F.wg * 16 + F.tid] = cnt[F.tid];
}
__device__ __forceinline__ void moe_sort_phase(const Ctx& F_) {
    Ctx F = F_; asm volatile("" : "+v"(F.tid), "+v"(F.lane));
    unsigned char* const ws_ = kws();
    LAS unsigned char* X = F.lds + LDSCTL_OFF;
    LAS int* seg = (LAS int*)(X + LX_SEG); LAS int* tile_e = (LAS int*)(X + LX_TILEE); LAS int* base = (LAS int*)(X + LX_BASE); LAS int* dpos = (LAS int*)(X + LX_DPOS);
    LAS int* te = (LAS int*)(X + LX_TE); LAS float* tw = (LAS float*)(X + LX_TW); LAS int* ps = (LAS int*)(X + LX_PS); LAS int* pb = (LAS int*)(X + LX_PB);
    const int* cntG = (const int*)(ws_ + WS_SMALL + SM_CNTG);
    const int* tok_e = (const int*)(ws_ + WS_SMALL + SM_TOKE); const float* tok_w = (const float*)(ws_ + WS_SMALL + SM_TOKW);
    int* rowinfo = (int*)(ws_ + WS_SMALL + SM_ROWINFO); float* roww = (float*)(ws_ + WS_SMALL + SM_ROWW);
    { const int e = F.tid & 15, part = F.tid >> 4; int tot = 0, bef = 0;
#pragma unroll
        for (int i = 0; i < 8; ++i) { const int w = part * 8 + i; const int c = cntG[w * 16 + e]; tot += c; bef += (w < F.wg) ? c : 0; }
        ps[part * 16 + e] = tot; pb[part * 16 + e] = bef; }
    if (F.tid < 128) { te[F.tid] = tok_e[F.wg * 128 + F.tid]; tw[F.tid] = tok_w[F.wg * 128 + F.tid]; }
    __syncthreads();
    if (F.tid == 0) {
        int run = 0;
        for (int e = 0; e < 16; ++e) { int tot = 0, bef = 0; for (int p = 0; p < 32; ++p) { tot += ps[p * 16 + e]; bef += pb[p * 16 + e]; }
            seg[e] = run; base[e] = run + bef; ps[e] = tot; run += (tot + 255) & ~255; }
        seg[16] = run;
        for (int i = 0; i < 128; ++i) { const int e = te[i]; const int pos = base[e]; base[e] = pos + 1; dpos[i] = pos; rowinfo[pos] = (i & 1) * T + F.wg * 64 + (i >> 1); roww[pos] = tw[i]; }
    }
    __syncthreads();
    const int ntile = seg[16] >> 8;
    for (int t = F.tid; t < ntile; t += NTHREADS) { int e = 0;
#pragma unroll
        for (int k = 1; k < 16; ++k) e += (t * 256 >= seg[k]) ? 1 : 0;
        tile_e[t] = e; }
    if (F.wg < 16) { const int e = F.wg; for (int p = seg[e] + ps[e] + F.tid; p < seg[e + 1]; p += NTHREADS) rowinfo[p] = 2 * T; }
    const bf16_t* XN = (const bf16_t*)(ws_ + WS_XN); bf16_t* AG = (bf16_t*)(ws_ + WS_AG);
    for (int r = 0; r < 8; ++r) {
        const int lr = F.wave * 8 + r, row = F.wg * 64 + lr;
        const v4u* src = (const v4u*)(XN + (size_t)row * D) + F.lane; const v4u a = src[0], b = src[64];
        const int p0 = dpos[lr * 2], p1 = dpos[lr * 2 + 1];
        v4u* d0 = (v4u*)(AG + (size_t)p0 * D) + F.lane; v4u* d1 = (v4u*)(AG + (size_t)p1 * D) + F.lane;
        d0[0] = a; d0[64] = b; d1[0] = a; d1[64] = b;
    }
}
struct SchedMoe {
    const char* A; const char* Bw; size_t a_tile, b_exp, b_tile; int n_units, G, c, sh; const LAS int* tile_e;
    __device__ __forceinline__ bool next(int i, Unit& u) const { const long L = (long)i * G + c; if (L >= n_units) return false; u.pm = (int)(L >> sh); u.pn = (int)(L & ((1 << sh) - 1)); return true; }
    __device__ __forceinline__ const char* a_base(const Unit& u) const { return A + (size_t)u.pm * a_tile; }
    __device__ __forceinline__ const char* b_base(const Unit& u) const { const int e = __builtin_amdgcn_readfirstlane(tile_e[u.pm]); return Bw + (size_t)e * b_exp + (size_t)u.pn * b_tile; }
    __device__ __forceinline__ void a_ready(const Unit&) const {}
    __device__ __forceinline__ void done(const Unit&) const {}
};
struct EpiSwiglu {
    static constexpr bool PERM = true, AFTER_DRAIN = false;
    bf16_t* HID;
    __device__ __forceinline__ void operator()(const f32x4 (&acc)[2][2][4][2], const Unit& u, int wr, int wc, int fr, int fq) const {
        const int row0 = u.pm * 256 + wr * 64 + fr, col0 = u.pn * 128 + wc * 32 + 8 * fq;
#pragma unroll
        for (int ai = 0; ai < 2; ++ai)
#pragma unroll
            for (int m = 0; m < 4; ++m) {
                float h[8];
#pragma unroll
                for (int n = 0; n < 2; ++n)
#pragma unroll
                    for (int q = 0; q < 4; ++q) { const float a = acc[ai][0][m][n][q], g = acc[ai][1][m][n][q]; h[4 * n + q] = a * fast_sigmoid(a) * g; }
                u32x4 w; w.x = pg8::cvt_pk_bf16(h[0], h[1]); w.y = pg8::cvt_pk_bf16(h[2], h[3]); w.z = pg8::cvt_pk_bf16(h[4], h[5]); w.w = pg8::cvt_pk_bf16(h[6], h[7]);
                *(u32x4*)(HID + (size_t)(row0 + ai * 128 + m * 16) * 256 + col0) = w;
                asm volatile("" ::: "memory");
            }
    }
};
struct EpiMoeOut {
    static constexpr bool PERM = true, AFTER_DRAIN = false;
    const int* rowinfo; const float* roww; bf16_t* YS;
    __device__ __forceinline__ void operator()(const f32x4 (&acc)[2][2][4][2], const Unit& u, int wr, int wc, int fr, int fq) const {
        const int row0 = u.pm * 256 + wr * 64 + fr; const unsigned col0 = u.pn * 256 + wc * 32 + 8 * fq;
#pragma unroll
        for (int ai = 0; ai < 2; ++ai)
#pragma unroll
            for (int m = 0; m < 4; ++m) {
                const int r = row0 + ai * 128 + m * 16; const unsigned drow = (unsigned)rowinfo[r]; const float w = roww[r];
                bf16_t* dst = YS + (drow * 1024u + col0);
#pragma unroll
                for (int bj = 0; bj < 2; ++bj) { const f32x4 v0 = acc[ai][bj][m][0] * w, v1 = acc[ai][bj][m][1] * w;
                    u32x4 o; o.x = pg8::cvt_pk_bf16(v0[0], v0[1]); o.y = pg8::cvt_pk_bf16(v0[2], v0[3]); o.z = pg8::cvt_pk_bf16(v1[0], v1[1]); o.w = pg8::cvt_pk_bf16(v1[2], v1[3]);
                    *(u32x4*)(dst + bj * 128) = o; }
                asm volatile("" ::: "memory");
            }
    }
};
__device__ __forceinline__ void moe_gemm1_phase(const Ctx& F_) {
    Ctx F = F_; asm volatile("" : "+v"(F.tid), "+v"(F.lane));
    unsigned char* const ws_ = kws();
    LAS unsigned char* X = F.lds + LDSCTL_OFF; const LAS int* seg = (const LAS int*)(X + LX_SEG);
    const int ntile = __builtin_amdgcn_readfirstlane(seg[16]) >> 8;
    SchedMoe Sc{(const char*)(ws_ + WS_AG), (const char*)(ws_ + WS_WMOE), (size_t)256 * 1024 * 2, (size_t)512 * 1024 * 2, (size_t)256 * 1024 * 2, ntile * 2, F.G, F.vcu, 1, (const LAS int*)(X + LX_TILEE)};
    EpiSwiglu E{(bf16_t*)(ws_ + WS_HID)};
    pg8::gemm_phase<EpiSwiglu, SchedMoe, true, true>(F.lds, pg8::Gemm{1024}, Sc, E);
}
__device__ __forceinline__ void moe_gemm2_phase(const Ctx& F_) {
    Ctx F = F_; asm volatile("" : "+v"(F.tid), "+v"(F.lane));
    unsigned char* const ws_ = kws();
    LAS unsigned char* X = F.lds + LDSCTL_OFF; const LAS int* seg = (const LAS int*)(X + LX_SEG);
    const int ntile = __builtin_amdgcn_readfirstlane(seg[16]) >> 8;
    SchedMoe Sc{(const char*)(ws_ + WS_HID), (const char*)(ws_ + WS_WMOE) + (size_t)16 * 512 * 1024 * 2, (size_t)256 * 256 * 2, (size_t)1024 * 256 * 2, (size_t)256 * 256 * 2, ntile * 4, F.G, F.vcu, 2, (const LAS int*)(X + LX_TILEE)};
    EpiMoeOut E{(const int*)(ws_ + WS_SMALL + SM_ROWINFO), (const float*)(ws_ + WS_SMALL + SM_ROWW), (bf16_t*)(ws_ + WS_YS)};
    pg8::gemm_phase<EpiMoeOut, SchedMoe, true, true>(F.lds, pg8::Gemm{256}, Sc, E);
}
__device__ __forceinline__ void moe_combine_phase(const Ctx& F_, int layer) {
    Ctx F = F_; asm volatile("" : "+v"(F.tid), "+v"(F.lane));
    unsigned char* const ws_ = kws(); float* const x_ = kout(); const float* const mod_ = (const float*)(ws_ + WS_NAIVE);
    const bf16_t* YS = (const bf16_t*)(ws_ + WS_YS);
    const int row0 = F.wg * 64 + F.wave * 8, b = row0 / S;
    const float* m = mod_ + ((size_t)(layer * 2 + 1) * NB + b) * 3072 + 2048;
    f32x4 gt[4];
#pragma unroll
    for (int j = 0; j < 4; ++j) gt[j] = ((const f32x4*)m)[64 * j + F.lane];
    for (int r = 0; r < 8; ++r) {
        const int row = row0 + r;
        f32x4* xr = (f32x4*)(x_ + (size_t)row * D) + F.lane;
        const v2u* y0 = (const v2u*)(YS + (size_t)row * D) + F.lane; const v2u* y1 = (const v2u*)(YS + ((size_t)T + row) * D) + F.lane;
#pragma unroll
        for (int j = 0; j < 4; ++j) { const v2u a = y0[64 * j], c = y1[64 * j]; f32x4 v = xr[64 * j];
            v.x += gt[j].x * (bflo(a.x) + bflo(c.x)); v.y += gt[j].y * (bfhi(a.x) + bfhi(c.x)); v.z += gt[j].z * (bflo(a.y) + bflo(c.y)); v.w += gt[j].w * (bfhi(a.y) + bfhi(c.y));
            xr[64 * j] = v; }
    }
}
}
namespace fm {
typedef short bf16x8 __attribute__((ext_vector_type(8)));
typedef short s16x4 __attribute__((ext_vector_type(4)));
typedef float f32x16 __attribute__((ext_vector_type(16)));
typedef float f32x2 __attribute__((ext_vector_type(2)));
constexpr int PROJ_LD = 2560;
constexpr float QSCALE = 0.125f * 1.4426950408889634f;
constexpr size_t WM_EVEN_STRIDE = 8 * MiB;
constexpr size_t WM_WIN = 0, WM_WOUT = 5 * MiB, WM_SGUW = 7 * MiB;
constexpr size_t WS_PROJ = WS_R1;
constexpr size_t WS_O = WS_R1 + 80 * MiB;
constexpr size_t SM_ZSS = 1024 * 1024;

struct SchedStd {
    const char* A; const char* Bt; size_t tile_bytes; int nM, nN, nwg, G, c;
    __device__ __forceinline__ void init(const void* A_, const void* Bt_, int M, int N, int K, int G_, int c_) { A = (const char*)A_; Bt = (const char*)Bt_; tile_bytes = (size_t)256 * K * 2; nM = M / 256; nN = N / 256; nwg = nM * nN; G = G_; c = c_; }
    __device__ __forceinline__ bool next(int i, Unit& u) const {
        const long L = (long)i * G + c; if (L >= nwg) return false;
        int wgid = (int)L; { const int q = nwg / 8, r = nwg % 8, xcd = wgid % 8, off = wgid / 8; wgid = (xcd < r ? xcd * (q + 1) : r * (q + 1) + (xcd - r) * q) + off; }
        const int nig = 8 * nN, gid = wgid / nig, fm_ = gid * 8, gsz = (nM - fm_) < 8 ? (nM - fm_) : 8;
        u.pm = fm_ + ((wgid % nig) % gsz); u.pn = (wgid % nig) / gsz; return true;
    }
    __device__ __forceinline__ const char* a_base(const Unit& u) const { return A + (size_t)u.pm * tile_bytes; }
    __device__ __forceinline__ const char* b_base(const Unit& u) const { return Bt + (size_t)u.pn * tile_bytes; }
    __device__ __forceinline__ void a_ready(const Unit&) const {}
    __device__ __forceinline__ void done(const Unit&) const {}
};
__device__ __forceinline__ void even_convert_weights(const Ctx& F_, int li) {
    Ctx F = F_; asm volatile("" : "+v"(F.tid), "+v"(F.lane));
    unsigned char* const ws_ = kws();
    LAS float* scr = (LAS float*)(F.lds + F.wave * 8448);
    bf16_t* base = (bf16_t*)(ws_ + WS_WMIX + (size_t)li * WM_EVEN_STRIDE);
    bf16_t* WinT = base + WM_WIN / 2; bf16_t* WoutT = base + WM_WOUT / 2; bf16_t* SW = base + WM_SGUW / 2;
    const float* w_in = kin(4) + (size_t)li * 1024 * 2560; const float* w_out = kin(5) + (size_t)li * 1024 * 1024; const float* sw = kin(7) + (size_t)li * 8 * 128 * 128;
    const int gw = F.wg * NWAVES + F.wave, NGW = F.G * NWAVES;
    constexpr int I_IN = 16 * 80, I_OUT = 16 * 32;
    for (int it = gw; it < I_IN + I_OUT; it += NGW) {
        if (it < I_IN) { const int kb = it / 80, nb = it % 80; transpose_item(w_in, 2560, WinT, 1024, kb * 64, nb * 32, nb * 32, scr, F.lane); }
        else { const int r = it - I_IN, kb = r / 32, nb = r % 32; transpose_item(w_out, 1024, WoutT, 1024, kb * 64, nb * 32, nb * 32, scr, F.lane); }
    }
    for (int i = gw * 64 + F.lane; i < 8 * 128 * 128 / 4; i += NGW * 64) { const f32x4 v = ((const f32x4*)sw)[i]; v2u o; o.x = pk2(v.x, v.y); o.y = pk2(v.z, v.w); ((v2u*)SW)[i] = o; }
}
__device__ __forceinline__ void norm_phase(const Ctx& F_, int ls) {
    Ctx F = F_; asm volatile("" : "+v"(F.tid), "+v"(F.lane));
    unsigned char* const ws_ = kws(); const float* const x_ = kout(); const float* const mod_ = (const float*)(ws_ + WS_NAIVE);
    bf16_t* XN = (bf16_t*)(ws_ + WS_XN);
    const int row0 = F.wg * 64 + F.wave * 8, b = row0 / S;
    const float* m = mod_ + ((size_t)ls * NB + b) * 3072;
#pragma unroll 1
    for (int r = 0; r < 8; ++r) {
        const int row = row0 + r;
        const f32x4* xr = (const f32x4*)(x_ + (size_t)row * D) + F.lane;
        f32x4 v[4]; float ss = 0.f;
#pragma unroll
        for (int j = 0; j < 4; ++j) { v[j] = xr[64 * j]; ss += (v[j].x * v[j].x + v[j].y * v[j].y) + (v[j].z * v[j].z + v[j].w * v[j].w); }
        const float rinv = 1.0f / sqrtf(wave_sum(ss) * (1.f / D) + 1e-6f);
        unsigned long long* o8 = (unsigned long long*)(XN + (size_t)row * D) + F.lane;
#pragma unroll
        for (int j = 0; j < 4; ++j) {
            const f32x4 sh = ((const f32x4*)m)[64 * j + F.lane], sc = ((const f32x4*)(m + 1024))[64 * j + F.lane];
            const f32x4 h = v[j] * rinv * (sc + 1.0f) + sh;
            o8[64 * j] = (unsigned long long)pk2(h.x, h.y) | ((unsigned long long)pk2(h.z, h.w) << 32);
        }
    }
}
struct EpiInProj {
    static constexpr bool PERM = true, AFTER_DRAIN = false;
    bf16_t* P; float* zss;
    __device__ __forceinline__ void operator()(const f32x4 (&acc)[2][2][4][2], const Unit& u, int wr, int wc, int fr, int fq) const {
        const int row0 = u.pm * 256 + wr * 64 + fr, col0 = u.pn * 256 + wc * 32 + 8 * fq;
        const int kind = u.pn < 2 ? 0 : (u.pn < 6 ? 1 : (u.pn < 8 ? 2 : 3));
#pragma unroll
        for (int ai = 0; ai < 2; ++ai)
#pragma unroll
            for (int m = 0; m < 4; ++m) {
                const int row = row0 + ai * 128 + m * 16; bf16_t* rowp = P + (size_t)row * PROJ_LD + col0; float ssq = 0.f;
#pragma unroll
                for (int bj = 0; bj < 2; ++bj) {
                    f32x4 v0 = acc[ai][bj][m][0], v1 = acc[ai][bj][m][1];
                    if (kind == 0) { v0 = v0 * QSCALE; v1 = v1 * QSCALE; }
                    else if (kind >= 2) {
                        const f32x2 a = pg8::gelu_pk((f32x2){v0[0], v0[1]}), b = pg8::gelu_pk((f32x2){v0[2], v0[3]}), c = pg8::gelu_pk((f32x2){v1[0], v1[1]}), d = pg8::gelu_pk((f32x2){v1[2], v1[3]});
                        v0 = (f32x4){a.x, a.y, b.x, b.y}; v1 = (f32x4){c.x, c.y, d.x, d.y};
                        ssq += (v0[0] * v0[0] + v0[1] * v0[1]) + (v0[2] * v0[2] + v0[3] * v0[3]) + (v1[0] * v1[0] + v1[1] * v1[1]) + (v1[2] * v1[2] + v1[3] * v1[3]);
                    }
                    u32x4 w; w.x = pg8::cvt_pk_bf16(v0[0], v0[1]); w.y = pg8::cvt_pk_bf16(v0[2], v0[3]); w.z = pg8::cvt_pk_bf16(v1[0], v1[1]); w.w = pg8::cvt_pk_bf16(v1[2], v1[3]);
                    *(u32x4*)(rowp + bj * 128) = w;
                }
                if (kind == 3) { ssq += __shfl_xor(ssq, 16); ssq += __shfl_xor(ssq, 32); if (fq == 0) zss[(size_t)row * 8 + (u.pn - 8) * 4 + wc] = ssq; }
                asm volatile("" ::: "memory");
            }
    }
};
struct EpiResid {
    static constexpr bool PERM = false, AFTER_DRAIN = false;
    const float* xin; float* xout; const float* mod;
    __device__ __forceinline__ void operator()(const f32x4 (&acc)[2][2][4][2], const Unit& u, int wr, int wc, int fr, int fq) const {
        const int row0 = u.pm * 256 + wr * 64 + fr, col0 = u.pn * 256 + wc * 32 + 4 * fq, b = (u.pm * 256) / S;
        const float* g = mod + (size_t)b * 3072 + 2048 + col0;
        f32x4 gv[2][2];
#pragma unroll
        for (int bj = 0; bj < 2; ++bj)
#pragma unroll
            for (int n = 0; n < 2; ++n) gv[bj][n] = *(const f32x4*)(g + bj * 128 + n * 16);
#pragma unroll
        for (int ai = 0; ai < 2; ++ai)
#pragma unroll
            for (int m = 0; m < 4; ++m) { const size_t off = (size_t)(row0 + ai * 128 + m * 16) * D + col0;
#pragma unroll
                for (int bj = 0; bj < 2; ++bj)
#pragma unroll
                    for (int n = 0; n < 2; ++n) { const f32x4 xv = *(const f32x4*)(xin + off + bj * 128 + n * 16); *(f32x4*)(xout + off + bj * 128 + n * 16) = xv + gv[bj][n] * acc[ai][bj][m][n]; }
                asm volatile("" ::: "memory"); }
    }
};
__device__ __forceinline__ void even_inproj_phase(const Ctx& F_, int li) {
    Ctx F = F_; asm volatile("" : "+v"(F.tid), "+v"(F.lane));
    unsigned char* const ws_ = kws();
    SchedStd Sc; Sc.init(ws_ + WS_XN, ws_ + WS_WMIX + (size_t)li * WM_EVEN_STRIDE + WM_WIN, T, 2560, 1024, F.G, F.wg);
    EpiInProj E{(bf16_t*)(ws_ + WS_PROJ), (float*)(ws_ + WS_SMALL + SM_ZSS)};
    pg8::gemm_phase<EpiInProj, SchedStd, true, true>(F.lds, pg8::Gemm{1024}, Sc, E);
}
__device__ __forceinline__ void even_outproj_phase(const Ctx& F_, int layer) {
    Ctx F = F_; asm volatile("" : "+v"(F.tid), "+v"(F.lane));
    unsigned char* const ws_ = kws(); float* const x_ = kout();
    SchedStd Sc; Sc.init(ws_ + WS_O, ws_ + WS_WMIX + (size_t)(layer / 2) * WM_EVEN_STRIDE + WM_WOUT, T, 1024, 1024, F.G, F.wg);
    EpiResid E{x_, x_, (const float*)(ws_ + WS_NAIVE) + (size_t)(layer * 2) * NB * 3072};
    pg8::gemm_phase<EpiResid, SchedStd, true, true>(F.lds, pg8::Gemm{1024}, Sc, E);
}
__device__ __forceinline__ s16x4 tr_read(const LAS unsigned char* p) { typedef short v4i16_t __attribute__((ext_vector_type(4))); return __builtin_bit_cast(s16x4, __builtin_amdgcn_ds_read_tr16_b64_v4i16((LAS v4i16_t*)p)); }
constexpr int VPITCH = 144;
__device__ __forceinline__ void attn_task(const bf16_t* __restrict__ P, bf16_t* __restrict__ O, LAS unsigned char* vl, int b, int hh, int jt, int rq, int lane) {
    const int r32 = lane & 31, h2 = lane >> 5;
    const bf16_t* Pb = P + (size_t)b * S * PROJ_LD + hh * 64;
    const bf16_t* qrow = Pb + (size_t)(16 * (32 * jt + r32) + rq) * PROJ_LD + 8 * h2;
    bf16x8 qf[4];
#pragma unroll
    for (int ks = 0; ks < 4; ++ks) qf[ks] = *(const bf16x8*)(qrow + 16 * ks);
    float mrun = -INFINITY, lrun = 0.f; f32x16 o0, o1;
#pragma unroll
    for (int r = 0; r < 16; ++r) { o0[r] = 0.f; o1[r] = 0.f; }
    const int vkey = lane >> 3, vch = lane & 7;
    const int g4 = lane >> 4, i16 = lane & 15;
    const LAS unsigned char* trb = vl + (4 * h2 + (i16 >> 2)) * VPITCH + (16 * (g4 & 1) + 4 * (i16 & 3)) * 2;
#pragma unroll 1
    for (int c = 0; c < 16; ++c) {
        const int off = rq - c; const int W = (off == 0) ? 2048 : (((off & 3) == 0) ? 512 : 128);
        const int kt0 = (off == 0) ? 0 : (jt > 0 ? jt - 1 : 0);
#pragma unroll 1
        for (int kt = kt0; kt <= jt; ++kt) {
            const bf16_t* krow = Pb + (size_t)(16 * (32 * kt + r32) + c) * PROJ_LD + 512 + 8 * h2;
            bf16x8 kf[4];
#pragma unroll
            for (int ks = 0; ks < 4; ++ks) kf[ks] = *(const bf16x8*)(krow + 16 * ks);
            v4u vv[4];
#pragma unroll
            for (int it = 0; it < 4; ++it) vv[it] = *(const v4u*)(Pb + (size_t)(16 * (32 * kt + vkey + 8 * it) + c) * PROJ_LD + 1024 + 8 * vch);
            f32x16 s;
#pragma unroll
            for (int r = 0; r < 16; ++r) s[r] = 0.f;
#pragma unroll
            for (int ks = 0; ks < 4; ++ks) s = __builtin_amdgcn_mfma_f32_32x32x16_bf16(kf[ks], qf[ks], s, 0, 0, 0);
#pragma unroll
            for (int it = 0; it < 4; ++it) *(LAS v4u*)(vl + (vkey + 8 * it) * VPITCH + vch * 16) = vv[it];
            const int dbase = 16 * (32 * (jt - kt) + r32 - 4 * h2) + off;
            float tmax = -INFINITY;
#pragma unroll
            for (int r = 0; r < 16; ++r) {
                const int dlt = dbase - 16 * ((r & 3) + 8 * (r >> 2));
                const int mult = ((dlt >= 0 && dlt <= 128) ? 1 : 0) + ((W >= 512 && dlt >= 0 && dlt <= 512) ? 1 : 0) + ((W == 2048 && dlt >= 0) ? 1 : 0);
                const float lg = mult == 0 ? -INFINITY : (mult == 1 ? 0.f : (mult == 2 ? 1.f : 1.5849625007f));
                s[r] += lg; tmax = fmaxf(tmax, s[r]);
            }
            tmax = fmaxf(tmax, __shfl_xor(tmax, 32));
            const float mnew = fmaxf(mrun, tmax), msafe = (mnew == -INFINITY) ? 0.f : mnew;
            const float alpha = __builtin_amdgcn_exp2f(mrun - msafe);
            float psum = 0.f;
#pragma unroll
            for (int r = 0; r < 16; ++r) { s[r] = __builtin_amdgcn_exp2f(s[r] - msafe); psum += s[r]; }
            lrun = lrun * alpha + psum; mrun = mnew;
#pragma unroll
            for (int r = 0; r < 16; ++r) { o0[r] *= alpha; o1[r] *= alpha; }
            bf16x8 pf[2];
#pragma unroll
            for (int st = 0; st < 2; ++st) { v4u w; w.x = cvtpk(s[8 * st], s[8 * st + 1]); w.y = cvtpk(s[8 * st + 2], s[8 * st + 3]); w.z = cvtpk(s[8 * st + 4], s[8 * st + 5]); w.w = cvtpk(s[8 * st + 6], s[8 * st + 7]); pf[st] = __builtin_bit_cast(bf16x8, w); }
            asm volatile("s_waitcnt lgkmcnt(0)" ::: "memory");
#pragma unroll
            for (int st = 0; st < 2; ++st) {
                const s16x4 a0 = tr_read(trb + (16 * st) * VPITCH), a1 = tr_read(trb + (16 * st + 8) * VPITCH);
                const s16x4 b0 = tr_read(trb + (16 * st) * VPITCH + 64), b1 = tr_read(trb + (16 * st + 8) * VPITCH + 64);
                const bf16x8 A0 = (bf16x8){a0[0], a0[1], a0[2], a0[3], a1[0], a1[1], a1[2], a1[3]}, A1 = (bf16x8){b0[0], b0[1], b0[2], b0[3], b1[0], b1[1], b1[2], b1[3]};
                o0 = __builtin_amdgcn_mfma_f32_32x32x16_bf16(A0, pf[st], o0, 0, 0, 0);
                o1 = __builtin_amdgcn_mfma_f32_32x32x16_bf16(A1, pf[st], o1, 0, 0, 0);
            }
            asm volatile("s_waitcnt lgkmcnt(0)" ::: "memory");
        }
    }
    const float ltot = lrun + __shfl_xor(lrun, 32), inv = 1.0f / ltot;
    bf16_t* orow = O + ((size_t)b * S + 16 * (32 * jt + r32) + rq) * D + hh * 64 + 4 * h2;
#pragma unroll
    for (int gq = 0; gq < 4; ++gq) {
        v2u w0, w1; w0.x = cvtpk(o0[4 * gq] * inv, o0[4 * gq + 1] * inv); w0.y = cvtpk(o0[4 * gq + 2] * inv, o0[4 * gq + 3] * inv);
        w1.x = cvtpk(o1[4 * gq] * inv, o1[4 * gq + 1] * inv); w1.y = cvtpk(o1[4 * gq + 2] * inv, o1[4 * gq + 3] * inv);
        *(v2u*)(orow + 8 * gq) = w0; *(v2u*)(orow + 32 + 8 * gq) = w1;
    }
}
__device__ __forceinline__ unsigned mask_pair(unsigned x, int e0, int lim) { if (e0 > lim) x &= 0xffff0000u; if (e0 + 1 > lim) x &= 0x0000ffffu; return x; }
constexpr int ZPITCH = 128;
__device__ __forceinline__ void sgu_task(const bf16_t* __restrict__ P, bf16_t* __restrict__ O, const bf16_t* __restrict__ SW, const float* __restrict__ zss, const float* __restrict__ ng, const float* __restrict__ bs,
                                         LAS unsigned char* zl, int b, int ch, int g, int lane) {
    const int r32 = lane & 31, h2 = lane >> 5;
    const size_t t0 = (size_t)b * S + ch * 128;
    { const int chn = lane & 7; f32x4 n0 = *(const f32x4*)(ng + g * 64 + 8 * chn), n1 = *(const f32x4*)(ng + g * 64 + 8 * chn + 4);
#pragma unroll 4
        for (int it = 0; it < 16; ++it) { const int row = (lane >> 3) + 8 * it;
            const float* zp = zss + (t0 + row) * 8; const f32x4 p0 = *(const f32x4*)zp, p1 = *(const f32x4*)(zp + 4);
            const float ri = 1.0f / sqrtf(((p0.x + p0.y) + (p0.z + p0.w) + (p1.x + p1.y) + (p1.z + p1.w)) * (1.f / 512.f) + 1e-6f);
            const v4u z = *(const v4u*)(P + (t0 + row) * PROJ_LD + 2048 + g * 64 + 8 * chn);
            v4u o; o.x = pk2(bflo(z.x) * ri * n0.x, bfhi(z.x) * ri * n0.y); o.y = pk2(bflo(z.y) * ri * n0.z, bfhi(z.y) * ri * n0.w);
            o.z = pk2(bflo(z.z) * ri * n1.x, bfhi(z.z) * ri * n1.y); o.w = pk2(bflo(z.w) * ri * n1.z, bfhi(z.w) * ri * n1.w);
            *(LAS v4u*)(zl + row * ZPITCH + chn * 16) = o; } }
    asm volatile("s_waitcnt lgkmcnt(0)" ::: "memory");
    const int g4 = lane >> 4, i16 = lane & 15;
    const LAS unsigned char* trb = zl + (8 * h2 + (i16 >> 2)) * ZPITCH + (16 * (g4 & 1) + 4 * (i16 & 3)) * 2;
    const bf16_t* Wg = SW + (size_t)g * 128 * 128;
#pragma unroll 1
    for (int mt = 0; mt < 4; ++mt) {
        f32x16 a0, a1;
#pragma unroll
        for (int r = 0; r < 16; ++r) { a0[r] = 0.f; a1[r] = 0.f; }
        const int irow = 32 * mt + r32;
#pragma unroll 1
        for (int kt = 0; kt <= mt; ++kt) {
#pragma unroll
            for (int ks = 0; ks < 2; ++ks) {
                const int j0 = 32 * kt + 16 * ks + 8 * h2;
                v4u wv = *(const v4u*)(Wg + (size_t)irow * 128 + j0);
                if (kt == mt) {
                    const int lim = irow - j0;
                    wv.x = mask_pair(wv.x, 0, lim); wv.y = mask_pair(wv.y, 2, lim); wv.z = mask_pair(wv.z, 4, lim); wv.w = mask_pair(wv.w, 6, lim);
                }
                const bf16x8 af = __builtin_bit_cast(bf16x8, wv);
                const LAS unsigned char* tb = trb + (32 * kt + 16 * ks) * ZPITCH;
                const s16x4 x0 = tr_read(tb), x1 = tr_read(tb + 4 * ZPITCH), y0 = tr_read(tb + 64), y1 = tr_read(tb + 4 * ZPITCH + 64);
                const bf16x8 B0 = (bf16x8){x0[0], x0[1], x0[2], x0[3], x1[0], x1[1], x1[2], x1[3]}, B1 = (bf16x8){y0[0], y0[1], y0[2], y0[3], y1[0], y1[1], y1[2], y1[3]};
                a0 = __builtin_amdgcn_mfma_f32_32x32x16_bf16(af, B0, a0, 0, 0, 0);
                a1 = __builtin_amdgcn_mfma_f32_32x32x16_bf16(af, B1, a1, 0, 0, 0);
            }
        }
#pragma unroll
        for (int r = 0; r < 16; ++r) {
            const int i = 32 * mt + (r & 3) + 8 * (r >> 2) + 4 * h2; const float bb = bs[g * 128 + i];
            const bf16_t* up = P + (t0 + i) * PROJ_LD + 1536 + g * 64; bf16_t* op = O + (t0 + i) * D + 512 + g * 64;
            op[r32] = (bf16_t)f2bf(bf2f(up[r32]) * (a0[r] + bb)); op[32 + r32] = (bf16_t)f2bf(bf2f(up[32 + r32]) * (a1[r] + bb));
        }
    }
}
__device__ __forceinline__ void even_mix_phase(const Ctx& F_, int li) {
    Ctx F = F_; asm volatile("" : "+v"(F.tid), "+v"(F.lane));
    unsigned char* const ws_ = kws();
    const bf16_t* P = (const bf16_t*)(ws_ + WS_PROJ); bf16_t* O = (bf16_t*)(ws_ + WS_O);
    LAS unsigned char* wl = F.lds + F.wave * 16384;
    { const int b = F.wg >> 5, hh = (F.wg >> 2) & 7, jt = F.wg & 3;
        attn_task(P, O, wl, b, hh, jt, F.wave, F.lane);
        attn_task(P, O, wl, b, hh, jt, F.wave + 8, F.lane); }
    if (F.wave < 4) { const int task = F.wg * 4 + F.wave, b = task >> 7, ch = (task >> 3) & 15, g = task & 7;
        sgu_task(P, O, (const bf16_t*)(ws_ + WS_WMIX + (size_t)li * WM_EVEN_STRIDE + WM_SGUW), (const float*)(ws_ + WS_SMALL + SM_ZSS), kin(6) + li * 512, kin(8) + li * 8 * 128, wl, b, ch, g, F.lane); }
}
}
namespace fm {
constexpr size_t WM_ODD_BASE = 16 * MiB, WM_ODD_STRIDE = 12 * MiB, WM_WRKV = 0, WM_WLD = 6 * MiB, WM_WLU = 8 * MiB, WM_WO = 10 * MiB;
constexpr size_t WS_VFIRST = 16 * MiB;
constexpr size_t WS_LORA = 48 * MiB;
constexpr size_t WS_MIX = WS_R1;
constexpr size_t WS_WDEC = WS_R1, WS_AV = WS_R1 + 64 * MiB, WS_G = WS_R1 + 96 * MiB;
constexpr size_t WS_R = WS_R1 + 128 * MiB, WS_K = WS_R1 + 160 * MiB, WS_V = WS_R1 + 192 * MiB;
constexpr size_t WS_Y = WS_XN;

__device__ __forceinline__ void odd_convert_weights(const Ctx& F_, int li) {
    Ctx F = F_; asm volatile("" : "+v"(F.tid), "+v"(F.lane));
    unsigned char* const ws_ = kws();
    LAS float* scr = (LAS float*)(F.lds + F.wave * 8448);
    unsigned char* base = ws_ + WS_WMIX + WM_ODD_BASE + (size_t)li * WM_ODD_STRIDE;
    bf16_t* WRKV = (bf16_t*)(base + WM_WRKV); bf16_t* WLD = (bf16_t*)(base + WM_WLD); bf16_t* WLU = (bf16_t*)(base + WM_WLU); bf16_t* WO = (bf16_t*)(base + WM_WO);
    const float* w_rkv = kin(10) + (size_t)li * 3 * 1024 * 1024; const float* w_o = kin(11) + (size_t)li * 1024 * 1024;
    const float* w1 = kin(13) + (size_t)li * 1024 * 64; const float* a1 = kin(16) + (size_t)li * 1024 * 64; const float* g1 = kin(21) + (size_t)li * 1024 * 160;
    const float* v1 = kin(19);
    const float* w2 = kin(14) + (size_t)li * 64 * 1024; const float* a2 = kin(17) + (size_t)li * 64 * 1024; const float* g2 = kin(22) + (size_t)li * 160 * 1024; const float* v2 = kin(20);
    const int gw = F.wg * NWAVES + F.wave, NGW = F.G * NWAVES;
    constexpr int I_SQ = 16 * 32;
    constexpr int I_LD = 16 * 8;
    constexpr int I_LU = 4 * 32;
    constexpr int NIT = 4 * I_SQ + 4 * I_LD + 4 * I_LU;
    for (int it = gw; it < NIT; it += NGW) {
        int r = it;
        if (r < 4 * I_SQ) { const int mtx = r / I_SQ, q = r % I_SQ, kb = q / 32, nb = q % 32;
            if (mtx < 3) transpose_item(w_rkv + (size_t)mtx * 1024 * 1024, 1024, WRKV + (size_t)mtx * 1024 * 1024, 1024, kb * 64, nb * 32, nb * 32, scr, F.lane);
            else transpose_item(w_o, 1024, WO, 1024, kb * 64, nb * 32, nb * 32, scr, F.lane);
            continue; }
        r -= 4 * I_SQ;
        if (r < 4 * I_LD) { const int tl = r / I_LD, q = r % I_LD, kb = q / 8, nb = q % 8;
            const float* W = tl == 0 ? w1 : (tl == 1 ? a1 : (tl == 2 ? g1 : v1)); const int nv = tl == 0 ? 64 : (tl == 1 ? 64 : (tl == 2 ? 160 : (li > 0 ? 32 : 0)));
            transpose_item_pad(W, tl == 2 ? 160 : (tl == 3 ? 32 : 64), nv, 1024, WLD + (size_t)tl * 256 * 1024, 1024, kb * 64, nb * 32, nb * 32, scr, F.lane);
            continue; }
        r -= 4 * I_LD;
        { const int tl = r / I_LU, q = r % I_LU, kb = q / 32, nb = q % 32;
            const float* W = tl == 0 ? w2 : (tl == 1 ? a2 : (tl == 2 ? g2 : v2)); const int kv = tl == 0 ? 64 : (tl == 1 ? 64 : (tl == 2 ? 160 : (li > 0 ? 32 : 0)));
            transpose_item_pad(W, 1024, 1024, kv, WLU + (size_t)tl * 1024 * 256, 256, kb * 64, nb * 32, nb * 32, scr, F.lane); }
    }
}
template <int NMIX> __device__ __forceinline__ void odd_mix_phase(const Ctx& F_, int li, int m0, int m1, int m2, int m3) {
    Ctx F = F_; asm volatile("" : "+v"(F.tid), "+v"(F.lane));
    unsigned char* const ws_ = kws();
    const bf16_t* XN = (const bf16_t*)(ws_ + WS_XN); bf16_t* MIX = (bf16_t*)(ws_ + WS_MIX);
    const float* mu = kin(9) + (size_t)li * 6 * 1024;
    const int ids[4] = {m0, m1, m2, m3};
    const int row0 = F.wg * 64 + F.wave * 8;
    f32x4 hp[4];
    { const bool first = (row0 % S) == 0; const v2u* pr = (const v2u*)(XN + (size_t)(row0 - (first ? 0 : 1)) * D) + F.lane;
#pragma unroll
        for (int j = 0; j < 4; ++j) { const v2u w = pr[64 * j]; hp[j] = first ? (f32x4){0.f, 0.f, 0.f, 0.f} : (f32x4){bflo(w.x), bfhi(w.x), bflo(w.y), bfhi(w.y)}; } }
#pragma unroll 1
    for (int r = 0; r < 8; ++r) {
        const int row = row0 + r; const v2u* pr = (const v2u*)(XN + (size_t)row * D) + F.lane;
        f32x4 h[4];
#pragma unroll
        for (int j = 0; j < 4; ++j) { const v2u w = pr[64 * j]; h[j] = (f32x4){bflo(w.x), bfhi(w.x), bflo(w.y), bfhi(w.y)}; }
#pragma unroll
        for (int s = 0; s < NMIX; ++s) {
            v2u* po = (v2u*)(MIX + ((size_t)s * T + row) * D) + F.lane;
#pragma unroll
            for (int j = 0; j < 4; ++j) { const f32x4 m = ((const f32x4*)(mu + ids[s] * 1024))[64 * j + F.lane]; const f32x4 x = h[j] + (hp[j] - h[j]) * m;
                v2u o; o.x = pk2(x.x, x.y); o.y = pk2(x.z, x.w); po[64 * j] = o; }
        }
#pragma unroll
        for (int j = 0; j < 4; ++j) hp[j] = h[j];
    }
}
struct SchedMulti {
    const char* A; const char* Bt; size_t a_tile, a_sel_stride, b_tile; int nN, nwg, G, c, a_shift;
    __device__ __forceinline__ bool next(int i, Unit& u) const { const long L = (long)i * G + c; if (L >= nwg) return false; u.pm = (int)(L / nN); u.pn = (int)(L % nN); return true; }
    __device__ __forceinline__ const char* a_base(const Unit& u) const { return A + (size_t)(u.pn >> a_shift) * a_sel_stride + (size_t)u.pm * a_tile; }
    __device__ __forceinline__ const char* b_base(const Unit& u) const { return Bt + (size_t)u.pn * b_tile; }
    __device__ __forceinline__ void a_ready(const Unit&) const {}
    __device__ __forceinline__ void done(const Unit&) const {}
};
struct EpiRKV {
    static constexpr bool PERM = true, AFTER_DRAIN = false;
    unsigned char* ws; size_t offV;
    __device__ __forceinline__ void operator()(const f32x4 (&acc)[2][2][4][2], const Unit& u, int wr, int wc, int fr, int fq) const {
        const int row0 = u.pm * 256 + wr * 64 + fr, col0 = (u.pn & 3) * 256 + wc * 32 + 8 * fq; const int sel = u.pn >> 2;
        size_t boff = WS_R + (size_t)sel * (WS_K - WS_R); if (sel == 2) boff = offV;
        bf16_t* base = (bf16_t*)(ws + boff);
#pragma unroll
        for (int ai = 0; ai < 2; ++ai)
#pragma unroll
            for (int m = 0; m < 4; ++m) { bf16_t* rowp = base + (size_t)(row0 + ai * 128 + m * 16) * D + col0;
#pragma unroll
                for (int bj = 0; bj < 2; ++bj) { const f32x4 v0 = acc[ai][bj][m][0], v1 = acc[ai][bj][m][1];
                    u32x4 w; w.x = pg8::cvt_pk_bf16(v0[0], v0[1]); w.y = pg8::cvt_pk_bf16(v0[2], v0[3]); w.z = pg8::cvt_pk_bf16(v1[0], v1[1]); w.w = pg8::cvt_pk_bf16(v1[2], v1[3]);
                    *(u32x4*)(rowp + bj * 128) = w; }
                asm volatile("" ::: "memory"); }
    }
};
struct EpiLoraDown {
    static constexpr bool PERM = true, AFTER_DRAIN = false;
    bf16_t* L;
    __device__ __forceinline__ void operator()(const f32x4 (&acc)[2][2][4][2], const Unit& u, int wr, int wc, int fr, int fq) const {
        const int row0 = u.pm * 256 + wr * 64 + fr, col0 = wc * 32 + 8 * fq; const int act = u.pn == 0 ? 1 : (u.pn == 2 ? 2 : 0);
        bf16_t* base = L + (size_t)u.pn * T * 256;
#pragma unroll
        for (int ai = 0; ai < 2; ++ai)
#pragma unroll
            for (int m = 0; m < 4; ++m) { bf16_t* rowp = base + (size_t)(row0 + ai * 128 + m * 16) * 256 + col0;
#pragma unroll
                for (int bj = 0; bj < 2; ++bj) { float h[8];
#pragma unroll
                    for (int n = 0; n < 2; ++n)
#pragma unroll
                        for (int q = 0; q < 4; ++q) { float v = acc[ai][bj][m][n][q];
                            if (act == 1) v = 1.f - 2.f * __builtin_amdgcn_rcpf(1.f + __expf(2.f * v)); else if (act == 2) v = fast_sigmoid(v);
                            h[4 * n + q] = v; }
                    u32x4 w; w.x = pg8::cvt_pk_bf16(h[0], h[1]); w.y = pg8::cvt_pk_bf16(h[2], h[3]); w.z = pg8::cvt_pk_bf16(h[4], h[5]); w.w = pg8::cvt_pk_bf16(h[6], h[7]);
                    *(u32x4*)(rowp + bj * 128) = w; }
                asm volatile("" ::: "memory"); }
    }
};
struct EpiLoraUp {
    static constexpr bool PERM = true, AFTER_DRAIN = false;
    unsigned char* ws; const float* vecs;
    const float *w0, *a0, *v0;
    __device__ __forceinline__ void operator()(const f32x4 (&acc)[2][2][4][2], const Unit& u, int wr, int wc, int fr, int fq) const {
        const int row0 = u.pm * 256 + wr * 64 + fr, col0 = (u.pn & 3) * 256 + wc * 32 + 8 * fq; const int sub = u.pn >> 2;
        f32x4 bv[2][2];
#pragma unroll
        for (int bj = 0; bj < 2; ++bj)
#pragma unroll
            for (int n = 0; n < 2; ++n) { const int cc = col0 + bj * 128 + 4 * n; f32x4 t = (f32x4){0.f, 0.f, 0.f, 0.f};
                if (sub == 0) t = *(const f32x4*)(w0 + cc); else if (sub == 1) t = *(const f32x4*)(a0 + cc); else if (sub == 3) t = *(const f32x4*)(v0 + cc);
                bv[bj][n] = t; }
#pragma unroll
        for (int ai = 0; ai < 2; ++ai)
#pragma unroll
            for (int m = 0; m < 4; ++m) { const size_t off = (size_t)(row0 + ai * 128 + m * 16) * D + col0;
#pragma unroll
                for (int bj = 0; bj < 2; ++bj) {
                    f32x4 v0_ = acc[ai][bj][m][0] + bv[bj][0], v1_ = acc[ai][bj][m][1] + bv[bj][1];
                    if (sub == 0) {
#pragma unroll
                        for (int q = 0; q < 4; ++q) { v0_[q] = -0.8750387749f * fast_sigmoid(v0_[q]); v1_[q] = -0.8750387749f * fast_sigmoid(v1_[q]); }
                        u32x4 w; w.x = pg8::cvt_pk_bf16(v0_[0], v0_[1]); w.y = pg8::cvt_pk_bf16(v0_[2], v0_[3]); w.z = pg8::cvt_pk_bf16(v1_[0], v1_[1]); w.w = pg8::cvt_pk_bf16(v1_[2], v1_[3]);
                        *(u32x4*)((bf16_t*)(ws + WS_WDEC) + off + bj * 128) = w;
                    } else {
                        size_t doff = WS_AV; if (sub == 2) doff = WS_G; if (sub == 3) doff = WS_V;
                        if (sub == 1) {
#pragma unroll
                            for (int q = 0; q < 4; ++q) { v0_[q] = fast_sigmoid(v0_[q]); v1_[q] = fast_sigmoid(v1_[q]); }
                        } else if (sub == 3) {
                            const u32x4 vo = *(const u32x4*)((const bf16_t*)(ws + WS_V) + off + bj * 128), vf = *(const u32x4*)((const bf16_t*)(ws + WS_VFIRST) + off + bj * 128);
                            const f32x4 olo = (f32x4){bflo(vo.x), bfhi(vo.x), bflo(vo.y), bfhi(vo.y)}, ohi = (f32x4){bflo(vo.z), bfhi(vo.z), bflo(vo.w), bfhi(vo.w)};
                            const f32x4 flo = (f32x4){bflo(vf.x), bfhi(vf.x), bflo(vf.y), bfhi(vf.y)}, fhi = (f32x4){bflo(vf.z), bfhi(vf.z), bflo(vf.w), bfhi(vf.w)};
#pragma unroll
                            for (int q = 0; q < 4; ++q) { v0_[q] = olo[q] + (flo[q] - olo[q]) * fast_sigmoid(v0_[q]); v1_[q] = ohi[q] + (fhi[q] - ohi[q]) * fast_sigmoid(v1_[q]); }
                        }
                        u32x4 w; w.x = pg8::cvt_pk_bf16(v0_[0], v0_[1]); w.y = pg8::cvt_pk_bf16(v0_[2], v0_[3]); w.z = pg8::cvt_pk_bf16(v1_[0], v1_[1]); w.w = pg8::cvt_pk_bf16(v1_[2], v1_[3]);
                        *(u32x4*)((bf16_t*)(ws + doff) + off + bj * 128) = w;
                    }
                }
                asm volatile("" ::: "memory"); }
    }
};
__device__ __forceinline__ bf16_t* odd_vbuf(unsigned char* ws_, int li) { return (bf16_t*)(ws_ + (li == 0 ? WS_VFIRST : WS_V)); }
__device__ __forceinline__ void odd_gemm_rkv_phase(const Ctx& F_, int li) {
    Ctx F = F_; asm volatile("" : "+v"(F.tid), "+v"(F.lane));
    unsigned char* const ws_ = kws();
    SchedMulti Sc{(const char*)(ws_ + WS_MIX), (const char*)(ws_ + WS_WMIX + WM_ODD_BASE + (size_t)li * WM_ODD_STRIDE + WM_WRKV), (size_t)256 * 1024 * 2, (size_t)T * D * 2, (size_t)256 * 1024 * 2, 12, 64 * 12, F.G, F.vcu, 2};
    EpiRKV E{ws_, li == 0 ? WS_VFIRST : WS_V};
    pg8::gemm_phase<EpiRKV, SchedMulti, true, true>(F.lds, pg8::Gemm{1024}, Sc, E);
}
__device__ __forceinline__ void odd_gemm_loradown_phase(const Ctx& F_, int li) {
    Ctx F = F_; asm volatile("" : "+v"(F.tid), "+v"(F.lane));
    unsigned char* const ws_ = kws(); const int nN = li == 0 ? 3 : 4;
    SchedMulti Sc{(const char*)(ws_ + WS_MIX), (const char*)(ws_ + WS_WMIX + WM_ODD_BASE + (size_t)li * WM_ODD_STRIDE + WM_WLD), (size_t)256 * 1024 * 2, (size_t)T * D * 2, (size_t)256 * 1024 * 2, nN, 64 * nN, F.G, F.vcu, 0};
    EpiLoraDown E{(bf16_t*)(ws_ + WS_LORA)};
    pg8::gemm_phase<EpiLoraDown, SchedMulti, true, true>(F.lds, pg8::Gemm{1024}, Sc, E);
}
__device__ __forceinline__ void odd_gemm_loraup_phase(const Ctx& F_, int li) {
    Ctx F = F_; asm volatile("" : "+v"(F.tid), "+v"(F.lane));
    unsigned char* const ws_ = kws(); const int nN = li == 0 ? 12 : 16;
    SchedMulti Sc{(const char*)(ws_ + WS_LORA), (const char*)(ws_ + WS_WMIX + WM_ODD_BASE + (size_t)li * WM_ODD_STRIDE + WM_WLU), (size_t)256 * 256 * 2, (size_t)T * 256 * 2, (size_t)256 * 256 * 2, nN, 64 * nN, F.G, F.vcu, 2};
    EpiLoraUp E{ws_, nullptr, kin(12) + li * 1024, kin(15) + li * 1024, kin(18)};
    pg8::gemm_phase<EpiLoraUp, SchedMulti, true, true>(F.lds, pg8::Gemm{256}, Sc, E);
}
__device__ __forceinline__ void odd_gemm_wo_phase(const Ctx& F_, int layer) {
    Ctx F = F_; asm volatile("" : "+v"(F.tid), "+v"(F.lane));
    unsigned char* const ws_ = kws(); float* const x_ = kout();
    SchedStd Sc; Sc.init(ws_ + WS_Y, ws_ + WS_WMIX + WM_ODD_BASE + (size_t)(layer / 2) * WM_ODD_STRIDE + WM_WO, T, 1024, 1024, F.G, F.wg);
    EpiResid E{x_, x_, (const float*)(ws_ + WS_NAIVE) + (size_t)(layer * 2) * NB * 3072};
    pg8::gemm_phase<EpiResid, SchedStd, true, true>(F.lds, pg8::Gemm{1024}, Sc, E);
}
__device__ __forceinline__ void odd_prep_phase(const Ctx& F_, int li) {
    Ctx F = F_; asm volatile("" : "+v"(F.tid), "+v"(F.lane));
    unsigned char* const ws_ = kws();
    bf16_t* K = (bf16_t*)(ws_ + WS_K); const bf16_t* AV = (const bf16_t*)(ws_ + WS_AV); bf16_t* KK = (bf16_t*)(ws_ + WS_LORA);
    const float* k_k = kin(23) + li * 1024; const float* k_a = kin(24) + li * 1024;
    const int row0 = F.wg * 64 + F.wave * 8;
#pragma unroll 1
    for (int r = 0; r < 8; ++r) {
        const size_t ro = (size_t)(row0 + r) * D;
#pragma unroll
        for (int j = 0; j < 4; ++j) {
            const int e4 = 64 * j + F.lane;
            const v2u kw = ((const v2u*)(K + ro))[e4], aw = ((const v2u*)(AV + ro))[e4];
            const f32x4 kv = (f32x4){bflo(kw.x), bfhi(kw.x), bflo(kw.y), bfhi(kw.y)}, av = (f32x4){bflo(aw.x), bfhi(aw.x), bflo(aw.y), bfhi(aw.y)};
            const f32x4 kkv = kv * ((const f32x4*)k_k)[e4]; const f32x4 ka = ((const f32x4*)k_a)[e4];
            float ss = (kkv.x * kkv.x + kkv.y * kkv.y) + (kkv.z * kkv.z + kkv.w * kkv.w);
            ss += __shfl_xor(ss, 1); ss += __shfl_xor(ss, 2); ss += __shfl_xor(ss, 4); ss += __shfl_xor(ss, 8);
            const float inv = 1.0f / fmaxf(sqrtf(ss), 1e-12f);
            const f32x4 kn = kv * ((av - 1.0f) * ka + 1.0f), kq = kkv * inv;
            v2u o; o.x = pk2(kq.x, kq.y); o.y = pk2(kq.z, kq.w); ((v2u*)(KK + ro))[e4] = o;
            o.x = pk2(kn.x, kn.y); o.y = pk2(kn.z, kn.w); ((v2u*)(K + ro))[e4] = o;
        }
    }
}
__device__ __forceinline__ void odd_wkv_simple_phase(const Ctx& F_, int li) {
    Ctx F = F_; asm volatile("" : "+v"(F.tid), "+v"(F.lane));
    unsigned char* const ws_ = kws();
    const bf16_t* R = (const bf16_t*)(ws_ + WS_R); const bf16_t* K = (const bf16_t*)(ws_ + WS_K); const bf16_t* V = odd_vbuf(ws_, li); const bf16_t* AV = (const bf16_t*)(ws_ + WS_AV);
    const bf16_t* KK = (const bf16_t*)(ws_ + WS_LORA); const float* WD = (const float*)(ws_ + WS_WDEC); bf16_t* Y = (bf16_t*)(ws_ + WS_Y);
    LAS float* st = (LAS float*)F.lds;
    const int gt = F.wg * NTHREADS + F.tid;
    if (gt < NB * 16 * 64) {
        const int vr = gt & 63, hh = (gt >> 6) & 15, b = gt >> 10;
#pragma unroll 4
        for (int i = 0; i < 64; ++i) st[i * NTHREADS + F.tid] = 0.f;
        for (int t = 0; t < S; ++t) {
            const size_t base = ((size_t)b * S + t) * D + hh * 64;
            float sa = 0.f;
#pragma unroll 4
            for (int i = 0; i < 64; ++i) sa -= st[i * NTHREADS + F.tid] * bf2f(KK[base + i]);
            const float vv = bf2f(V[base + vr]); float yv = 0.f;
#pragma unroll 4
            for (int i = 0; i < 64; ++i) { const float kk = bf2f(KK[base + i]); const float sn = st[i * NTHREADS + F.tid] * WD[base + i] + sa * (kk * bf2f(AV[base + i])) + vv * bf2f(K[base + i]); st[i * NTHREADS + F.tid] = sn; yv += sn * bf2f(R[base + i]); }
            Y[base + vr] = (bf16_t)f2bf(yv);
        }
    }
}
__device__ __forceinline__ void odd_post_phase(const Ctx& F_, int li) {
    Ctx F = F_; asm volatile("" : "+v"(F.tid), "+v"(F.lane));
    unsigned char* const ws_ = kws();
    const bf16_t* R = (const bf16_t*)(ws_ + WS_R); const bf16_t* K = (const bf16_t*)(ws_ + WS_K); const bf16_t* V = odd_vbuf(ws_, li); const bf16_t* G = (const bf16_t*)(ws_ + WS_G); bf16_t* Y = (bf16_t*)(ws_ + WS_Y);
    const float* r_k = kin(25) + li * 1024; const float* ln_w = kin(26) + li * 1024; const float* ln_b = kin(27) + li * 1024;
    const int row0 = F.wg * 64 + F.wave * 8;
#pragma unroll 1
    for (int r = 0; r < 8; ++r) {
        const size_t ro = (size_t)(row0 + r) * D;
#pragma unroll
        for (int j = 0; j < 4; ++j) {
            const int e4 = 64 * j + F.lane;
            const v2u yw = ((const v2u*)(Y + ro))[e4], rw = ((const v2u*)(R + ro))[e4], kw = ((const v2u*)(K + ro))[e4], vw = ((const v2u*)(V + ro))[e4], gw_ = ((const v2u*)(G + ro))[e4];
            const f32x4 y = (f32x4){bflo(yw.x), bfhi(yw.x), bflo(yw.y), bfhi(yw.y)}, rr = (f32x4){bflo(rw.x), bfhi(rw.x), bflo(rw.y), bfhi(rw.y)}, kk = (f32x4){bflo(kw.x), bfhi(kw.x), bflo(kw.y), bfhi(kw.y)};
            const f32x4 vv = (f32x4){bflo(vw.x), bfhi(vw.x), bflo(vw.y), bfhi(vw.y)}, gg = (f32x4){bflo(gw_.x), bfhi(gw_.x), bflo(gw_.y), bfhi(gw_.y)};
            float s1 = (y.x + y.y) + (y.z + y.w);
            s1 += __shfl_xor(s1, 1); s1 += __shfl_xor(s1, 2); s1 += __shfl_xor(s1, 4); s1 += __shfl_xor(s1, 8);
            const float mean = s1 * (1.f / 64.f); const f32x4 d = y - mean;
            float s2 = (d.x * d.x + d.y * d.y) + (d.z * d.z + d.w * d.w);
            s2 += __shfl_xor(s2, 1); s2 += __shfl_xor(s2, 2); s2 += __shfl_xor(s2, 4); s2 += __shfl_xor(s2, 8);
            const float rstd = 1.0f / sqrtf(s2 * (1.f / 64.f) + 64e-5f);
            const f32x4 rk4 = rr * kk * ((const f32x4*)r_k)[e4]; float s3 = (rk4.x + rk4.y) + (rk4.z + rk4.w);
            s3 += __shfl_xor(s3, 1); s3 += __shfl_xor(s3, 2); s3 += __shfl_xor(s3, 4); s3 += __shfl_xor(s3, 8);
            const f32x4 o = (d * rstd * ((const f32x4*)ln_w)[e4] + ((const f32x4*)ln_b)[e4] + vv * s3) * gg;
            v2u w; w.x = pk2(o.x, o.y); w.y = pk2(o.z, o.w); ((v2u*)(Y + ro))[e4] = w;
        }
    }
}
}
namespace fm {
constexpr size_t WS_WKVS = WS_LORA;
constexpr size_t SM_RK = SM_ZSS;
constexpr int LX_WC = 8192;
constexpr float LOG2E = 1.4426950408889634f;
__device__ __forceinline__ bf16x8 pk8lo(const f32x16& a) { v4u w; w.x = cvtpk(a[0], a[1]); w.y = cvtpk(a[2], a[3]); w.z = cvtpk(a[4], a[5]); w.w = cvtpk(a[6], a[7]); return __builtin_bit_cast(bf16x8, w); }
__device__ __forceinline__ bf16x8 pk8hi(const f32x16& a) { v4u w; w.x = cvtpk(a[8], a[9]); w.y = cvtpk(a[10], a[11]); w.z = cvtpk(a[12], a[13]); w.w = cvtpk(a[14], a[15]); return __builtin_bit_cast(bf16x8, w); }
struct PH { bf16x8 f0, f1; };
__device__ __forceinline__ PH packh(const f32x16& a) { PH p; p.f0 = pk8lo(a); p.f1 = pk8hi(a); return p; }
__device__ __forceinline__ f32x16 zero16() { f32x16 z;
#pragma unroll
    for (int r = 0; r < 16; ++r) z[r] = 0.f; return z; }
#define MFMA32(a, b, c) __builtin_amdgcn_mfma_f32_32x32x16_bf16((a), (b), (c), 0, 0, 0)
__device__ __forceinline__ f32x16 ident16(int lane) { int l = lane; asm volatile("" : "+v"(l)); f32x16 z;
#pragma unroll
    for (int r = 0; r < 16; ++r) z[r] = (((r & 3) + 8 * (r >> 2) + 4 * (l >> 5)) == (l & 31)) ? 1.f : 0.f; return z; }
__device__ __forceinline__ f32x16 tt(const PH& U, const PH& W, f32x16 C) { C = MFMA32(U.f0, W.f0, C); C = MFMA32(U.f1, W.f1, C); return C; }
__device__ __forceinline__ bf16x8 colfrag(const LAS unsigned char* mat, int nt, int s, int lane) {
    const int g4 = lane >> 4, i16 = lane & 15, h2 = lane >> 5;
    const LAS unsigned char* p = mat + (16 * s + 4 * h2 + (i16 >> 2)) * 128 + (32 * nt + 16 * (g4 & 1) + 4 * (i16 & 3)) * 2;
    const s16x4 lo = tr_read(p), hi = tr_read(p + 8 * 128);
    return (bf16x8){lo[0], lo[1], lo[2], lo[3], hi[0], hi[1], hi[2], hi[3]};
}
__device__ __forceinline__ PH colph(const LAS unsigned char* mat, int nt, int lane) { PH p; p.f0 = colfrag(mat, nt, 0, lane); p.f1 = colfrag(mat, nt, 1, lane); return p; }
__device__ __forceinline__ f32x4 unpk4(v2u w) { return (f32x4){bflo(w.x), bfhi(w.x), bflo(w.y), bfhi(w.y)}; }
__device__ __forceinline__ v2u pk4(f32x4 v) { v2u o; o.x = cvtpk(v.x, v.y); o.y = cvtpk(v.z, v.w); return o; }
__device__ __forceinline__ void store_rowgroups(bf16_t* rowp  , const f32x16& a, int h2) {
#pragma unroll
    for (int g = 0; g < 4; ++g) *(v2u*)(rowp + 8 * g + 4 * h2) = pk4((f32x4){a[4 * g], a[4 * g + 1], a[4 * g + 2], a[4 * g + 3]});
}

__device__ __forceinline__ void wkv1_task(unsigned char* ws_, const float* k_k, const float* k_a, const float* r_k, int li, int b, int hh, int sc, LAS unsigned char* wl, LAS float* wct, int lane_in) {
    int lane = lane_in; int t32 = lane & 31, h2 = lane >> 5;
    const bf16_t* Rg = (const bf16_t*)(ws_ + WS_R); const bf16_t* Kg = (const bf16_t*)(ws_ + WS_K); const bf16_t* Vg = odd_vbuf(ws_, li);
    bf16_t* AVg = (bf16_t*)(ws_ + WS_AV); bf16_t* LWg = (bf16_t*)(ws_ + WS_WDEC); float* RKg = (float*)(ws_ + WS_SMALL + SM_RK);
    LAS unsigned char* ldsA = wl; LAS unsigned char* ldsB = wl + 4096; LAS unsigned char* ldsK = wl + 8192; LAS unsigned char* ldsV = wl + 12288;
    PH Gh[2][2], Hh[2][2];
    { const PH ip = packh(ident16(lane)), zp = packh(zero16()); Gh[0][0] = ip; Gh[1][1] = ip; Gh[0][1] = zp; Gh[1][0] = zp; Hh[0][0] = zp; Hh[0][1] = zp; Hh[1][0] = zp; Hh[1][1] = zp; }
#pragma unroll 1
    for (int j = 0; j < 4; ++j) {
        lane = lane_in; asm volatile("" : "+v"(lane)); t32 = lane & 31; h2 = lane >> 5;
        const size_t rowoff = ((size_t)b * S + sc * 128 + j * 32 + t32) * D + hh * 64;
        PH fA[2], fB[2], fK[2], fR[2];
        float inv;
        {
            float nrm = 0.f, rk = 0.f;
#pragma unroll
            for (int g = 0; g < 8; ++g) {
                const int k0 = 8 * g + 4 * h2;
                const f32x4 rr = unpk4(*(const v2u*)(Rg + rowoff + k0)), ko = unpk4(*(const v2u*)(Kg + rowoff + k0)), av = unpk4(*(const v2u*)(AVg + rowoff + k0));
                const f32x4 kkw = *(const f32x4*)(k_k + hh * 64 + k0), kaw = *(const f32x4*)(k_a + hh * 64 + k0), rkw = *(const f32x4*)(r_k + hh * 64 + k0);
                const f32x4 kq = ko * kkw; nrm += (kq.x * kq.x + kq.y * kq.y) + (kq.z * kq.z + kq.w * kq.w);
                const f32x4 t3 = rr * (ko * ((av - 1.0f) * kaw + 1.0f)) * rkw; rk += (t3.x + t3.y) + (t3.z + t3.w);
                *(LAS v2u*)(ldsV + t32 * 128 + k0 * 2) = *(const v2u*)(Vg + rowoff + k0);
            }
            nrm += __shfl_xor(nrm, 32); rk += __shfl_xor(rk, 32);
            if (h2 == 0) RKg[((size_t)b * S + sc * 128 + j * 32 + t32) * 16 + hh] = rk;
            inv = 1.0f / fmaxf(sqrtf(nrm), 1e-12f);
            asm volatile("" ::: "memory");
        }
#pragma unroll
        for (int ks = 0; ks < 4; ++ks) {
            float cum[8], lw0[8], kk1[8], aa[8], kpp[8], rr1[8];
#pragma unroll
            for (int gg = 0; gg < 2; ++gg) {
                const int g = 2 * ks + gg, k0 = 8 * g + 4 * h2;
                const f32x4 rr = unpk4(*(const v2u*)(Rg + rowoff + k0)), ko = unpk4(*(const v2u*)(Kg + rowoff + k0)), av = unpk4(*(const v2u*)(AVg + rowoff + k0)), lw = unpk4(*(const v2u*)(LWg + rowoff + k0));
                const f32x4 kkw = *(const f32x4*)(k_k + hh * 64 + k0), kaw = *(const f32x4*)(k_a + hh * 64 + k0);
                const f32x4 kq = ko * kkw * inv, kp = ko * ((av - 1.0f) * kaw + 1.0f);
#pragma unroll
                for (int q = 0; q < 4; ++q) { cum[4 * gg + q] = lw[q]; lw0[4 * gg + q] = lw[q]; kk1[4 * gg + q] = kq[q]; aa[4 * gg + q] = av[q]; kpp[4 * gg + q] = kp[q]; rr1[4 * gg + q] = rr[q]; }
            }
#pragma unroll
            for (int d = 1; d < 32; d <<= 1) {
#pragma unroll
                for (int e = 0; e < 8; ++e) { const float up = __shfl_up(cum[e], d, 32); cum[e] += (t32 >= d) ? up : 0.f; }
            }
            if (t32 == 31) {
#pragma unroll
                for (int gg = 0; gg < 2; ++gg) *(LAS f32x4*)(wct + 8 * (2 * ks + gg) + 4 * h2) = (f32x4){__builtin_amdgcn_exp2f(cum[4 * gg]), __builtin_amdgcn_exp2f(cum[4 * gg + 1]), __builtin_amdgcn_exp2f(cum[4 * gg + 2]), __builtin_amdgcn_exp2f(cum[4 * gg + 3])};
            }
            float a_[8], b_[8], k_[8], r_[8];
#pragma unroll
            for (int e = 0; e < 8; ++e) {
                const float wt = __builtin_amdgcn_exp2f(cum[e]), wp = __builtin_amdgcn_exp2f(cum[e] - lw0[e]), iw = __builtin_amdgcn_exp2f(-cum[e]);
                a_[e] = -kk1[e] * wp; b_[e] = kk1[e] * aa[e] * iw; k_[e] = kpp[e] * iw; r_[e] = rr1[e] * wt;
            }
            v4u pa, pb, pk, pr;
            pa.x = cvtpk(a_[0], a_[1]); pa.y = cvtpk(a_[2], a_[3]); pa.z = cvtpk(a_[4], a_[5]); pa.w = cvtpk(a_[6], a_[7]);
            pb.x = cvtpk(b_[0], b_[1]); pb.y = cvtpk(b_[2], b_[3]); pb.z = cvtpk(b_[4], b_[5]); pb.w = cvtpk(b_[6], b_[7]);
            pk.x = cvtpk(k_[0], k_[1]); pk.y = cvtpk(k_[2], k_[3]); pk.z = cvtpk(k_[4], k_[5]); pk.w = cvtpk(k_[6], k_[7]);
            pr.x = cvtpk(r_[0], r_[1]); pr.y = cvtpk(r_[2], r_[3]); pr.z = cvtpk(r_[4], r_[5]); pr.w = cvtpk(r_[6], r_[7]);
#pragma unroll
            for (int gg = 0; gg < 2; ++gg) {
                const int k0 = 8 * (2 * ks + gg) + 4 * h2;
                *(LAS v2u*)(ldsA + t32 * 128 + k0 * 2) = gg == 0 ? (v2u){pa.x, pa.y} : (v2u){pa.z, pa.w};
                *(LAS v2u*)(ldsB + t32 * 128 + k0 * 2) = gg == 0 ? (v2u){pb.x, pb.y} : (v2u){pb.z, pb.w};
                *(LAS v2u*)(ldsK + t32 * 128 + k0 * 2) = gg == 0 ? (v2u){pk.x, pk.y} : (v2u){pk.z, pk.w};
            }
            if ((ks & 1) == 0) { fA[ks >> 1].f0 = __builtin_bit_cast(bf16x8, pa); fB[ks >> 1].f0 = __builtin_bit_cast(bf16x8, pb); fK[ks >> 1].f0 = __builtin_bit_cast(bf16x8, pk); fR[ks >> 1].f0 = __builtin_bit_cast(bf16x8, pr); }
            else { fA[ks >> 1].f1 = __builtin_bit_cast(bf16x8, pa); fB[ks >> 1].f1 = __builtin_bit_cast(bf16x8, pb); fK[ks >> 1].f1 = __builtin_bit_cast(bf16x8, pk); fR[ks >> 1].f1 = __builtin_bit_cast(bf16x8, pr); }
            asm volatile("" ::: "memory");
        }
        asm volatile("s_waitcnt lgkmcnt(0)" ::: "memory");
        PH pN, pNT, pAakT, pArbT, pArkT; f32x16 PT;
        {
#define KPROD(dst, fa, fb, keep) { f32x16 acc_ = tt(fa[1], fb[1], tt(fa[0], fb[0], zero16())); _Pragma("unroll") for (int r = 0; r < 16; ++r) { const int rowi = (r & 3) + 8 * (r >> 2) + 4 * h2; acc_[r] = (keep) ? acc_[r] : 0.f; } dst; __builtin_amdgcn_sched_barrier(0); }
            KPROD(pN = packh(acc_), fA, fB, t32 < rowi)
            KPROD(PT = ident16(lane) + acc_; pNT = packh(acc_), fB, fA, rowi < t32)
            KPROD(pAakT = packh(acc_), fK, fA, rowi < t32)
            KPROD(pArbT = packh(acc_), fB, fR, rowi <= t32)
            KPROD(pArkT = packh(acc_), fK, fR, rowi <= t32)
#undef KPROD
        }
        {
            PH X = pN, XT = pNT;
#pragma unroll
            for (int step = 0; step < 4; ++step) {
                const f32x16 x2 = tt(XT, X, zero16());
                if (step < 3) { const f32x16 xt2 = tt(X, XT, zero16()); XT = packh(xt2); }
                X = packh(x2);
                PT = tt(X, packh(PT), PT);
            }
        }
        const PH pPT = packh(PT);
        PH pAp[2], pUl[2];
#pragma unroll
        for (int nt = 0; nt < 2; ++nt) {
            pAp[nt] = packh(tt(pPT, colph(ldsA, nt, lane), zero16()));
            const PH x1 = packh(tt(pAakT, colph(ldsV, nt, lane), zero16()));
            pUl[nt] = packh(tt(pPT, x1, zero16()));
        }
        PH pRp[2]; f32x16 YlT[2];
#pragma unroll
        for (int mt = 0; mt < 2; ++mt) {
            f32x16 c0;
#pragma unroll
            for (int q = 0; q < 8; ++q) { c0[q] = bf2f((unsigned short)fR[mt].f0[q]); c0[8 + q] = bf2f((unsigned short)fR[mt].f1[q]); }
            pRp[mt] = packh(tt(pAp[mt], pArbT, c0));
            YlT[mt] = tt(colph(ldsV, mt, lane), pArkT, tt(pUl[mt], pArbT, zero16()));
        }
#pragma unroll
        for (int mt = 0; mt < 2; ++mt) {
            const f32x16 rpp = tt(Gh[1][mt], pRp[1], tt(Gh[0][mt], pRp[0], zero16()));
            store_rowgroups(AVg + rowoff + 32 * mt, rpp, h2);
            const f32x16 yl = tt(Hh[1][mt], pRp[1], tt(Hh[0][mt], pRp[0], YlT[mt]));
            store_rowgroups(LWg + rowoff + 32 * mt, yl, h2);
        }
        lane = lane_in; asm volatile("" : "+v"(lane)); t32 = lane & 31; h2 = lane >> 5;
        PH pM[2][2];
#pragma unroll
        for (int mt = 0; mt < 2; ++mt)
#pragma unroll
            for (int nt = 0; nt < 2; ++nt) {
                f32x16 m = tt(pAp[mt], colph(ldsB, nt, lane), mt == nt ? ident16(lane) : zero16());
                const float wc = wct[32 * nt + t32];
#pragma unroll
                for (int r = 0; r < 16; ++r) m[r] *= wc;
                pM[mt][nt] = packh(m);
            }
#pragma unroll
        for (int nt = 0; nt < 2; ++nt) {
            PH gn[2], hn[2];
#pragma unroll
            for (int mt = 0; mt < 2; ++mt) {
                f32x16 hq = tt(colph(ldsK, mt, lane), colph(ldsV, nt, lane), tt(colph(ldsB, mt, lane), pUl[nt], zero16()));
#pragma unroll
                for (int g = 0; g < 4; ++g) { const f32x4 wc4 = *(const LAS f32x4*)(wct + 32 * mt + 8 * g + 4 * h2);
#pragma unroll
                    for (int q = 0; q < 4; ++q) hq[4 * g + q] *= wc4[q]; }
                hn[mt] = packh(tt(pM[1][mt], Hh[1][nt], tt(pM[0][mt], Hh[0][nt], hq)));
                gn[mt] = packh(tt(pM[1][mt], Gh[1][nt], tt(pM[0][mt], Gh[0][nt], zero16())));
            }
            Gh[0][nt] = gn[0]; Gh[1][nt] = gn[1]; Hh[0][nt] = hn[0]; Hh[1][nt] = hn[1];
        }
        asm volatile("s_waitcnt lgkmcnt(0)" ::: "memory");
    }
    lane = lane_in; asm volatile("" : "+v"(lane)); t32 = lane & 31; h2 = lane >> 5;
    unsigned char* outp = ws_ + WS_WKVS + ((size_t)((b * 16 + hh) * 16 + sc)) * 16384;
#pragma unroll
    for (int kt = 0; kt < 2; ++kt) {
#pragma unroll
        for (int mt = 0; mt < 2; ++mt) {
            const v4u w0 = __builtin_bit_cast(v4u, Gh[mt][kt].f0), w1 = __builtin_bit_cast(v4u, Gh[mt][kt].f1);
            LAS unsigned char* rowp = wl + 4096 * kt + t32 * 128 + (32 * mt + 4 * h2) * 2;
            *(LAS v2u*)(rowp + 0) = (v2u){w0.x, w0.y}; *(LAS v2u*)(rowp + 16) = (v2u){w0.z, w0.w}; *(LAS v2u*)(rowp + 32) = (v2u){w1.x, w1.y}; *(LAS v2u*)(rowp + 48) = (v2u){w1.z, w1.w};
        }
    }
    asm volatile("s_waitcnt lgkmcnt(0)" ::: "memory");
#pragma unroll
    for (int kt = 0; kt < 2; ++kt)
#pragma unroll
        for (int mt = 0; mt < 2; ++mt)
#pragma unroll
            for (int s = 0; s < 2; ++s) *(bf16x8*)(outp + ((size_t)((kt * 2 + mt) * 2 + s) * 64 + lane) * 16) = colfrag(wl + 4096 * kt, mt, s, lane);
#pragma unroll
    for (int mt = 0; mt < 2; ++mt)
#pragma unroll
        for (int nt = 0; nt < 2; ++nt) { *(bf16x8*)(outp + 8192 + ((size_t)((mt * 2 + nt) * 2 + 0) * 64 + lane) * 16) = Hh[mt][nt].f0; *(bf16x8*)(outp + 8192 + ((size_t)((mt * 2 + nt) * 2 + 1) * 64 + lane) * 16) = Hh[mt][nt].f1; }
    asm volatile("s_waitcnt lgkmcnt(0)" ::: "memory");
}
__device__ __forceinline__ void odd_wkv1_phase(const Ctx& F_, int li) {
    Ctx F = F_; asm volatile("" : "+v"(F.tid), "+v"(F.lane));
    unsigned char* const ws_ = kws();
    const int task = F.wg * NWAVES + F.wave;
    const int sc = task & 15, hh = (task >> 4) & 15, b = task >> 8;
    wkv1_task(ws_, kin(23) + li * 1024, kin(24) + li * 1024, kin(25) + li * 1024, li, b, hh, sc, F.lds + F.wave * 16384, (LAS float*)(F.lds + LDSCTL_OFF + LX_WC + F.wave * 256), F.lane);
}
__device__ __forceinline__ void odd_wkv2_phase(const Ctx& F_, int li) {
    Ctx F = F_; asm volatile("" : "+v"(F.tid), "+v"(F.lane));
    unsigned char* const ws_ = kws();
    if (F.wave != 0 || F.wg >= 128) return;
    const int lane = F.lane, t32 = lane & 31, h2 = lane >> 5, b = F.wg >> 4, hh = F.wg & 15;
    const bf16_t* RPP = (const bf16_t*)(ws_ + WS_AV); const bf16_t* YL = (const bf16_t*)(ws_ + WS_WDEC); const bf16_t* Vg = odd_vbuf(ws_, li); const bf16_t* Gg = (const bf16_t*)(ws_ + WS_G);
    const float* RKg = (const float*)(ws_ + WS_SMALL + SM_RK); bf16_t* OA = (bf16_t*)(ws_ + WS_Y);
    const float* ln_w = kin(26) + li * 1024 + hh * 64; const float* ln_b = kin(27) + li * 1024 + hh * 64;
    f32x16 Z[2][2];
#pragma unroll
    for (int a = 0; a < 2; ++a)
#pragma unroll
        for (int c = 0; c < 2; ++c) Z[a][c] = zero16();
#pragma unroll 1
    for (int sc = 0; sc < 16; ++sc) {
        const unsigned char* sp = ws_ + WS_WKVS + ((size_t)((b * 16 + hh) * 16 + sc)) * 16384;
        PH pZ[2][2];
#pragma unroll
        for (int a = 0; a < 2; ++a)
#pragma unroll
            for (int c = 0; c < 2; ++c) pZ[a][c] = packh(Z[a][c]);
#pragma unroll 1
        for (int j = 0; j < 4; ++j) {
            const size_t trow = (size_t)b * S + sc * 128 + j * 32 + t32, rowoff = trow * D + hh * 64;
            PH rp[2];
#pragma unroll
            for (int kt = 0; kt < 2; ++kt) {
                const v2u a0 = *(const v2u*)(RPP + rowoff + 32 * kt + 4 * h2), a1 = *(const v2u*)(RPP + rowoff + 32 * kt + 8 + 4 * h2), a2 = *(const v2u*)(RPP + rowoff + 32 * kt + 16 + 4 * h2), a3 = *(const v2u*)(RPP + rowoff + 32 * kt + 24 + 4 * h2);
                rp[kt].f0 = __builtin_bit_cast(bf16x8, (v4u){a0.x, a0.y, a1.x, a1.y}); rp[kt].f1 = __builtin_bit_cast(bf16x8, (v4u){a2.x, a2.y, a3.x, a3.y});
            }
            f32x16 y[2];
#pragma unroll
            for (int mt = 0; mt < 2; ++mt) {
                f32x16 c0;
#pragma unroll
                for (int g = 0; g < 4; ++g) { const f32x4 q4 = unpk4(*(const v2u*)(YL + rowoff + 32 * mt + 8 * g + 4 * h2)); c0[4 * g] = q4.x; c0[4 * g + 1] = q4.y; c0[4 * g + 2] = q4.z; c0[4 * g + 3] = q4.w; }
                y[mt] = tt(pZ[1][mt], rp[1], tt(pZ[0][mt], rp[0], c0));
            }
            float s1 = 0.f;
#pragma unroll
            for (int mt = 0; mt < 2; ++mt)
#pragma unroll
                for (int r = 0; r < 16; ++r) s1 += y[mt][r];
            s1 += __shfl_xor(s1, 32);
            const float mean = s1 * (1.f / 64.f); float s2 = 0.f;
#pragma unroll
            for (int mt = 0; mt < 2; ++mt)
#pragma unroll
                for (int r = 0; r < 16; ++r) { const float dd = y[mt][r] - mean; s2 += dd * dd; }
            s2 += __shfl_xor(s2, 32);
            const float rstd = 1.0f / sqrtf(s2 * (1.f / 64.f) + 64e-5f), rk = RKg[trow * 16 + hh];
#pragma unroll
            for (int mt = 0; mt < 2; ++mt)
#pragma unroll
                for (int g = 0; g < 4; ++g) { const int c0 = 32 * mt + 8 * g + 4 * h2;
                    const f32x4 vv = unpk4(*(const v2u*)(Vg + rowoff + c0)), gg = unpk4(*(const v2u*)(Gg + rowoff + c0)), lw = *(const f32x4*)(ln_w + c0), lb = *(const f32x4*)(ln_b + c0);
                    const f32x4 yy = (f32x4){y[mt][4 * g], y[mt][4 * g + 1], y[mt][4 * g + 2], y[mt][4 * g + 3]};
                    const f32x4 o = ((yy - mean) * rstd * lw + lb + vv * rk) * gg;
                    *(v2u*)(OA + rowoff + c0) = pk4(o); }
        }
        f32x16 Zn[2][2];
#pragma unroll
        for (int mt = 0; mt < 2; ++mt)
#pragma unroll
            for (int nt = 0; nt < 2; ++nt) {
                const bf16x8 h0 = *(const bf16x8*)(sp + 8192 + ((size_t)((mt * 2 + nt) * 2 + 0) * 64 + lane) * 16), h1 = *(const bf16x8*)(sp + 8192 + ((size_t)((mt * 2 + nt) * 2 + 1) * 64 + lane) * 16);
                f32x16 c0;
#pragma unroll
                for (int q = 0; q < 8; ++q) { c0[q] = bf2f((unsigned short)h0[q]); c0[8 + q] = bf2f((unsigned short)h1[q]); }
#pragma unroll
                for (int kt = 0; kt < 2; ++kt) { PH mf; mf.f0 = *(const bf16x8*)(sp + ((size_t)((kt * 2 + mt) * 2 + 0) * 64 + lane) * 16); mf.f1 = *(const bf16x8*)(sp + ((size_t)((kt * 2 + mt) * 2 + 1) * 64 + lane) * 16); c0 = tt(mf, pZ[kt][nt], c0); }
                Zn[mt][nt] = c0;
            }
#pragma unroll
        for (int a = 0; a < 2; ++a)
#pragma unroll
            for (int c = 0; c < 2; ++c) Z[a][c] = Zn[a][c];
    }
}
}
#ifndef FAST_MOE
#define FAST_MOE 1
#endif
#ifndef FAST_EVEN
#define FAST_EVEN 1
#endif
#ifndef FAST_ODD
#define FAST_ODD 1
#endif
struct Args { nv::InPtrs in; float* out; unsigned char* ws; };
__global__ void __launch_bounds__(NTHREADS, 2) mega_fwd(Args args) {
    extern __shared__ __attribute__((aligned(16))) unsigned char lds[];
    LAS unsigned char* L = (LAS unsigned char*)lds;
    for (int u = threadIdx.x; u < (LDS_BYTES - LDSCTL_OFF) / 4; u += NTHREADS) ((LAS unsigned*)(L + LDSCTL_OFF))[u] = 0u;
    __syncthreads();
    volatile LAS unsigned* MISC = (volatile LAS unsigned*)(L + MISC_OFF);
    const XcdBarrier bar = xcd_barrier_post((unsigned*)(kws() + fm::WS_CTL), MISC + 8);
    const long long nv_gtid = (long long)blockIdx.x * NTHREADS + threadIdx.x, nv_nthr = (long long)gridDim.x * NTHREADS;
    fm::Ctx F; F.lds = L; F.tid = threadIdx.x; F.lane = F.tid & 63; F.wave = __builtin_amdgcn_readfirstlane(F.tid >> 6);
    F.G = gridDim.x; F.wg = blockIdx.x; F.vcu = (F.G % 8 == 0) ? (F.wg % 8) * (F.G / 8) + F.wg / 8 : F.wg;
#define GRID_BAR() do { XcdBarrier b_; b_.bar = (unsigned*)(kws() + fm::WS_CTL); b_.x = (unsigned)__builtin_amdgcn_readfirstlane((int)xb_xcc_id()); b_.st = (volatile LAS unsigned*)(L + MISC_OFF) + 8; xcd_barrier(b_); } while (0)
#define NVC nv::nv_ctx((float*)(kws() + fm::WS_NAIVE), (float*)(kws() + fm::WS_NAIVE_BIG))
    nv::nv_prologue(args.in, kout(), NVC, bar, nv_gtid, nv_nthr);
#if FAST_EVEN
    fm::even_convert_weights(F, 0); fm::even_convert_weights(F, 1);
#endif
#if FAST_ODD
    fm::odd_convert_weights(F, 0); fm::odd_convert_weights(F, 1);
#endif
    GRID_BAR();
    for (int layer = 0; layer < 4; ++layer) {
#if FAST_EVEN
        if (layer % 2 == 0) {
            fm::norm_phase(F, layer * 2); GRID_BAR();
            fm::even_inproj_phase(F, layer / 2); GRID_BAR();
            fm::even_mix_phase(F, layer / 2); GRID_BAR();
            fm::even_outproj_phase(F, layer); GRID_BAR();
        }
#else
        if (layer % 2 == 0) nv::nv_even(args.in, kout(), NVC, layer, bar, nv_gtid, nv_nthr);
#endif
#if FAST_ODD
        if (layer % 2 == 1) {
            const int li = layer / 2;
            fm::norm_phase(F, layer * 2); GRID_BAR();
            fm::odd_mix_phase<3>(F, li, 0, 2, 3, 0); GRID_BAR();
            fm::odd_gemm_rkv_phase(F, li); GRID_BAR();
            fm::odd_mix_phase<4>(F, li, 1, 4, 5, 3); GRID_BAR();
            fm::odd_gemm_loradown_phase(F, li); GRID_BAR();
            fm::odd_gemm_loraup_phase(F, li); GRID_BAR();
            fm::odd_wkv1_phase(F, li); GRID_BAR();
            fm::odd_wkv2_phase(F, li); GRID_BAR();
            fm::odd_gemm_wo_phase(F, layer); GRID_BAR();
        }
#else
        if (layer % 2 == 1) nv::nv_odd(args.in, kout(), NVC, layer, bar, nv_gtid, nv_nthr);
#endif
#if FAST_MOE
        fm::moe_convert_weights(F, kin(30), kin(31), kin(32), layer);
        __syncthreads();
        fm::moe_route_phase(F, kin(28), kin(29), layer);
        GRID_BAR();
        fm::moe_sort_phase(F);
        GRID_BAR();
        fm::moe_gemm1_phase(F);
        GRID_BAR();
        fm::moe_gemm2_phase(F);
        GRID_BAR();
        fm::moe_combine_phase(F, layer);
        GRID_BAR();
#else
        nv::nv_moe(args.in, kout(), NVC, layer, bar, nv_gtid, nv_nthr);
#endif
    }
    nv::nv_final(args.in, kout(), NVC, bar, nv_gtid, nv_nthr);
}
extern "C" void kernel_launch(void* const* d_in, const int* in_sizes, int n_in, void* d_out, int out_size, void* d_ws, size_t ws_size, hipStream_t stream) {
    (void)in_sizes; (void)out_size;
    static int grid = 0;
    if (grid == 0) {
        int dev = 0, cus = 0, per_cu = 0;
        hipGetDevice(&dev); hipDeviceGetAttribute(&cus, hipDeviceAttributeMultiprocessorCount, dev);
        hipFuncSetAttribute((const void*)mega_fwd, hipFuncAttributeMaxDynamicSharedMemorySize, LDS_BYTES);
        hipOccupancyMaxActiveBlocksPerMultiprocessor(&per_cu, (const void*)mega_fwd, NTHREADS, LDS_BYTES);
        (void)hipGetLastError();
        grid = 256;
        if (per_cu < 1) fprintf(stderr, "kernel_launch: occupancy query says %d blocks/CU\n", per_cu);
        if (cus < 256 || n_in != 34 || ws_size < fm::WS_END) { fprintf(stderr, "kernel_launch: unexpected cus %d / n_in %d / ws %zu\n", cus, n_in, ws_size); grid = -1; }
    }
    if (grid < 0) return;
    hipMemsetAsync((char*)d_ws + fm::WS_CTL, 0, fm::CTL_ZERO_BYTES, stream);
    Args a{};
    for (int i = 0; i < 34; ++i) a.in.p[i] = (const float*)d_in[i];
    a.out = (float*)d_out; a.ws = (unsigned char*)d_ws;
    void* kargs[] = {&a};
    hipError_t e = hipLaunchCooperativeKernel((const void*)mega_fwd, dim3(grid), dim3(NTHREADS), kargs, LDS_BYTES, stream);
    if (e != hipSuccess) fprintf(stderr, "cooperative launch failed: %s (grid %d)\n", hipGetErrorString(e), grid);
}
```

```cpp
#include <hip/hip_runtime.h>
#include <stdint.h>
#include <stddef.h>
#include <math.h>
#include <stdio.h>
#define GAS __attribute__((address_space(1)))
#define LAS __attribute__((address_space(3)))
#define XB_TMO      128
#define XB_XCNT(j)  (256  + 64 * (j))
#define XB_XSUB(j)  (1280 + 64 * (j))
#define XB_XGEN(j)  (2304 + 64 * (j))
#define XB_TOP      3328
#define XB_TOPGEN   3392
#define XCD_BAR_WORDS 3456
#define XB_SPIN_CAP (1u << 22)
__device__ __forceinline__ unsigned xb_ld(unsigned* p)              { return __hip_atomic_load(p, __ATOMIC_RELAXED, __HIP_MEMORY_SCOPE_AGENT); }
__device__ __forceinline__ unsigned xb_add(unsigned* p, unsigned v) { return __hip_atomic_fetch_add(p, v, __ATOMIC_RELAXED, __HIP_MEMORY_SCOPE_AGENT); }
__device__ __forceinline__ unsigned xb_xcc_id() { return (unsigned)__builtin_amdgcn_s_getreg((3 << 11) | 20) & 0xFu; }
#define XB_SPIN(cond, bar) do { unsigned _sp = 0; while (cond) { __builtin_amdgcn_s_sleep(1); \
    if ((++_sp & 255u) == 0u) { if (xb_ld(&(bar)[XB_TMO])) break; if (_sp > XB_SPIN_CAP) { atomicAdd(&(bar)[XB_TMO], 1u); break; } } } } while (0)
struct XcdBarrier { unsigned* bar; unsigned x; volatile LAS unsigned* st; };
__device__ __forceinline__ XcdBarrier xcd_barrier_post(unsigned* bar, volatile LAS unsigned* st) {
    XcdBarrier b; b.bar = bar; b.x = xb_xcc_id(); b.st = st;
    if (threadIdx.x == 0) (void)xb_add(&bar[XB_XCNT(b.x)], 1u);
    return b;
}
__device__ __forceinline__ void xcd_barrier_complete(unsigned* bar, unsigned x, unsigned& nloc, unsigned& nx) {
    const unsigned G = gridDim.x * gridDim.y * gridDim.z;
    unsigned sum, cnt, mine, sp = 0u;
    for (;;) {
        sum = 0u; cnt = 0u; mine = 0u;
#pragma unroll
        for (unsigned j = 0; j < 16; ++j) { const unsigned c = xb_ld(&bar[XB_XCNT(j)]); sum += c; cnt += (c > 0u) ? 1u : 0u; mine = (j == x) ? c : mine; }
        if (sum == G) break;
        __builtin_amdgcn_s_sleep(1);
        if ((++sp & 255u) == 0u) { if (xb_ld(&bar[XB_TMO])) break; if (sp > XB_SPIN_CAP) { atomicAdd(&bar[XB_TMO], 1u); break; } }
    }
    nloc = mine > 0u ? mine : 1u; nx = cnt > 0u ? cnt : 1u;
}
__device__ __forceinline__ void xcd_barrier(const XcdBarrier& b) {
    asm volatile("s_waitcnt vmcnt(0)" ::: "memory");
    __syncthreads();
    if (threadIdx.x == 0) {
        unsigned* bar = b.bar;
        __builtin_amdgcn_s_waitcnt(0);
        unsigned nloc = b.st[0], nx = b.st[1];
        if (nloc == 0u) { xcd_barrier_complete(bar, b.x, nloc, nx); b.st[0] = nloc; b.st[1] = nx; }
        const unsigned old = xb_add(&bar[XB_XSUB(b.x)], 1u);
        const unsigned gen = old / nloc;
        if (old + 1u == (gen + 1u) * nloc) {
            __builtin_amdgcn_fence(__ATOMIC_RELEASE, "agent");
            asm volatile("s_waitcnt vmcnt(0)" ::: "memory");
            const unsigned og = xb_add(&bar[XB_TOP], 1u);
            const unsigned tg = og / nx;
            if (og + 1u == (tg + 1u) * nx) xb_add(&bar[XB_TOPGEN], 1u);
            else XB_SPIN(xb_ld(&bar[XB_TOPGEN]) == tg, bar);
            __builtin_amdgcn_fence(__ATOMIC_ACQUIRE, "agent");
            xb_add(&bar[XB_XGEN(b.x)], 1u);
            asm volatile("s_waitcnt vmcnt(0)" ::: "memory");
        } else {
            XB_SPIN(xb_ld(&bar[XB_XGEN(b.x)]) == gen, bar);
            __builtin_amdgcn_fence(__ATOMIC_ACQUIRE, "agent");
            asm volatile("s_waitcnt vmcnt(0)" ::: "memory");
        }
    }
    __syncthreads();
}
constexpr int RING_BYTES = 131072;
constexpr int LDSCTL_OFF = RING_BYTES;
constexpr int MISC_OFF = LDSCTL_OFF + 320;
constexpr int LDS_BYTES = 147456;
constexpr int NTHREADS = 512;

__device__ __forceinline__ const void* karg(int i) {
    const void* base = (const void*)__builtin_amdgcn_kernarg_segment_ptr();
    unsigned long long v;
    asm volatile("s_load_dwordx2 %0, %1, %2\n\ts_waitcnt lgkmcnt(0)" : "=s"(v) : "s"(base), "n"(i * 8) : "memory");
    return (const void*)v;
}
__device__ __forceinline__ const float* kin(int i) { return (const float*)karg(i); }
__device__ __forceinline__ float* kout() { return (float*)karg(34); }
__device__ __forceinline__ unsigned char* kws() { return (unsigned char*)karg(35); }
namespace pg8 {
#define PG8_LAS __attribute__((address_space(3)))
typedef unsigned short bf16_t;
typedef short bf16x8 __attribute__((ext_vector_type(8)));
typedef float f32x4 __attribute__((ext_vector_type(4)));
typedef unsigned u32x4 __attribute__((ext_vector_type(4)));
constexpr int BM = 256, BK = 64, HALF = 128, HTB = HALF * BK * 2  , STAGE_BYTES = 8 * HTB, NXCD = 8, WGM = 8;

__host__ __device__ __forceinline__ int lds_byte(int r, int c) { const int st = (r >> 4) * 2 + (c >> 5), rr = r & 15, cc = c & 31, ob = rr * 64 + cc * 2; return st * 1024 + (ob ^ (((ob >> 9) & 1) << 5)); }
__host__ __device__ __forceinline__ void stage_rc(int b, int& R, int& C) { const int st = b / 1024, sb = b % 1024, swz = sb ^ (((sb >> 9) & 1) << 5); R = (st >> 1) * 16 + swz / 64; C = (st & 1) * 32 + (swz % 64) / 2; }
__host__ __device__ __forceinline__ int perm32(int rho) { const int n = rho >> 4, i = rho & 15; return 8 * (i >> 2) + 4 * n + (i & 3); }

struct Unit { int pm, pn; };
struct Gemm { int K; };
__device__ __forceinline__ unsigned cvt_pk_bf16(float lo, float hi) { unsigned r; asm volatile("v_cvt_pk_bf16_f32 %0, %1, %2" : "=v"(r) : "v"(lo), "v"(hi)); return r; }
typedef float f32x2 __attribute__((ext_vector_type(2)));
__device__ __forceinline__ f32x2 gelu_pk(f32x2 v) {
    const f32x2 av = __builtin_elementwise_abs(v), d = av * 0.2316418882f + 1.0f;
    f32x2 t; t.x = __builtin_amdgcn_rcpf(d.x); t.y = __builtin_amdgcn_rcpf(d.y);
    f32x2 q = t * 0.5307027145f + (-0.7265760135f); q = q * t + 0.7107068705f; q = q * t + (-0.142248368f); q = q * t + 0.127414796f; q = q * t;
    const f32x2 s = (v * v) * (-0.72134752044f);
    f32x2 e; e.x = __builtin_amdgcn_exp2f(s.x); e.y = __builtin_amdgcn_exp2f(s.y);
    const f32x2 m = v * (q * e), r = v - m;
    f32x2 o; o.x = v.x < 0.f ? m.x : r.x; o.y = v.y < 0.f ? m.y : r.y; return o;
}
template <class Epi, class Sched, bool ALIGN_EPI = false, bool SP2 = false>
__device__ __forceinline__ void gemm_phase(PG8_LAS unsigned char* lds, const Gemm g, const Sched& S, const Epi& E) {
    int tid_ = threadIdx.x; asm volatile("" : "+v"(tid_));
    const int tid = tid_, wid = __builtin_amdgcn_readfirstlane(tid >> 6), lane = tid & 63, wr = wid >> 2, wc = wid & 3, fr = lane & 15, fq = lane >> 4;
    int Kop = g.K; asm volatile("" : "+s"(Kop));
    const int K = Kop, nt = K / BK;
    unsigned voffA[2], voffB[2];
#pragma unroll
    for (int i = 0; i < 2; ++i) { int R, C; stage_rc(tid * 16 + i * 8192, R, C); const int Rb = Epi::PERM ? ((R & ~31) + perm32(R & 31)) : R;
        voffA[i] = (unsigned)(R * K + C) * 2u; voffB[i] = (unsigned)(Rb * K + C) * 2u; }
    const size_t kstep = (size_t)(BK * 2);
    const size_t hstep = (size_t)HALF * K * 2;
        const unsigned ldsw = (unsigned)wid * 1024u;
    const int aoff = lds_byte(wr * 64 + fr, fq * 8), boff = lds_byte(wc * 32 + fr, fq * 8);
#define PG8_SA(b, h) (((b) * 2 + (h)) * HTB)
#define PG8_SB(b, h) ((4 + (b) * 2 + (h)) * HTB)
#define PG8_STAGE(bufoff, gbase, voff) do { _Pragma("unroll") for (int _i = 0; _i < 2; ++_i) \
        __builtin_amdgcn_global_load_lds((const unsigned*)((const char*)(gbase) + (voff)[_i]), (PG8_LAS unsigned*)(lds + (bufoff) + ldsw + _i * 8192), 16, 0, 0); } while (0)
#define PG8_LDA(dst, b, h) do { _Pragma("unroll") for (int m = 0; m < 4; ++m) _Pragma("unroll") for (int k = 0; k < 2; ++k) dst[m][k] = *(const PG8_LAS bf16x8*)(lds + PG8_SA(b, h) + aoff + m * 2048 + k * 1024); } while (0)
#define PG8_LDB(dst, b, h) do { _Pragma("unroll") for (int n = 0; n < 2; ++n) _Pragma("unroll") for (int k = 0; k < 2; ++k) dst[n][k] = *(const PG8_LAS bf16x8*)(lds + PG8_SB(b, h) + boff + n * 2048 + k * 1024); } while (0)
#define PG8_MMA(ai, bj, At, Bt) do { __builtin_amdgcn_s_setprio(1); _Pragma("unroll") for (int m = 0; m < 4; ++m) _Pragma("unroll") for (int n = 0; n < 2; ++n) _Pragma("unroll") for (int k = 0; k < 2; ++k) \
        acc[ai][bj][m][n] = __builtin_amdgcn_mfma_f32_16x16x32_bf16(Bt[n][k], At[m][k], acc[ai][bj][m][n], 0, 0, 0); __builtin_amdgcn_s_setprio(0); } while (0)
#define PG8_WAIT_V(n) asm volatile("s_waitcnt vmcnt(" #n ")" ::: "memory")
#define PG8_WAIT_L(n) asm volatile("s_waitcnt lgkmcnt(" #n ")" ::: "memory")
#define PG8_BAR __builtin_amdgcn_s_barrier()
#define PG8_SCHED __builtin_amdgcn_sched_barrier(0)
    Unit cur, nxt; int ui = 0;
    if (!S.next(0, cur)) return;
    f32x4 acc[2][2][4][2];
#pragma unroll
    for (int a = 0; a < 2; ++a)
#pragma unroll
        for (int b = 0; b < 2; ++b)
#pragma unroll
            for (int m = 0; m < 4; ++m)
#pragma unroll
                for (int n = 0; n < 2; ++n) acc[a][b][m][n] = (f32x4){0.f, 0.f, 0.f, 0.f};
    bf16x8 At[4][2], B0[2][2], B1[2][2];
    const char* cA = S.a_base(cur); const char* cB = S.b_base(cur);
    S.a_ready(cur);
    if constexpr (SP2) {
        PG8_STAGE(PG8_SB(0, 0), cB, voffB); PG8_STAGE(PG8_SB(0, 1), cB + hstep, voffB); PG8_STAGE(PG8_SA(0, 0), cA, voffA); PG8_STAGE(PG8_SA(0, 1), cA + hstep, voffA);
        if (wr == 1) PG8_BAR;
        PG8_WAIT_V(2); PG8_BAR;
        PG8_STAGE(PG8_SB(1, 0), cB + kstep, voffB); PG8_STAGE(PG8_SA(1, 0), cA + kstep, voffA); PG8_STAGE(PG8_SB(1, 1), cB + hstep + kstep, voffB);
        PG8_WAIT_V(6); PG8_BAR;
    } else {
        PG8_STAGE(PG8_SB(0, 0), cB, voffB); PG8_STAGE(PG8_SA(0, 0), cA, voffA); PG8_STAGE(PG8_SB(0, 1), cB + hstep, voffB); PG8_STAGE(PG8_SA(0, 1), cA + hstep, voffA);
        if (wr == 1) PG8_BAR;
        PG8_WAIT_V(4); PG8_BAR;
        PG8_STAGE(PG8_SB(1, 0), cB + kstep, voffB); PG8_STAGE(PG8_SA(1, 0), cA + kstep, voffA); PG8_STAGE(PG8_SB(1, 1), cB + hstep + kstep, voffB);
        PG8_WAIT_V(6); PG8_BAR;
    }
    for (;;) {
        const bool has_next = S.next(ui + 1, nxt);
        const char* nA = has_next ? S.a_base(nxt) : cA; const char* nB = has_next ? S.b_base(nxt) : cB;
        for (int t = 0; t < nt; t += 2) {
            const bool last = (t == nt - 2);
            const char* a1 = cA + (size_t)(t + 1) * kstep;
            const char* a2 = last ? nA : cA + (size_t)(t + 2) * kstep; const char* b2 = last ? nB : cB + (size_t)(t + 2) * kstep;
            const char* a3 = a2 + kstep; const char* b3 = b2 + kstep;
            if (last && has_next) S.a_ready(nxt);
            if constexpr (SP2) {
            PG8_LDB(B0, 0, 0); PG8_LDB(B1, 0, 1); PG8_SCHED; PG8_LDA(At, 0, 0); PG8_STAGE(PG8_SA(1, 1), a1 + hstep, voffA);
            PG8_WAIT_V(8); PG8_WAIT_L(0); PG8_BAR; PG8_MMA(0, 0, At, B0); PG8_MMA(0, 1, At, B1); PG8_BAR; PG8_SCHED;
            PG8_LDA(At, 0, 1); PG8_STAGE(PG8_SB(0, 0), b2, voffB); PG8_STAGE(PG8_SB(0, 1), b2 + hstep, voffB); PG8_STAGE(PG8_SA(0, 0), a2, voffA);
            PG8_WAIT_V(8); PG8_WAIT_L(0); PG8_BAR; PG8_MMA(1, 0, At, B0); PG8_MMA(1, 1, At, B1); PG8_BAR; PG8_SCHED;
            PG8_LDB(B0, 1, 0); PG8_LDB(B1, 1, 1); PG8_SCHED; PG8_LDA(At, 1, 0); PG8_STAGE(PG8_SA(0, 1), a2 + hstep, voffA);
            PG8_WAIT_V(8); PG8_WAIT_L(0); PG8_BAR; PG8_MMA(0, 0, At, B0); PG8_MMA(0, 1, At, B1); PG8_BAR; PG8_SCHED;
            PG8_LDA(At, 1, 1); PG8_STAGE(PG8_SB(1, 0), b3, voffB); PG8_STAGE(PG8_SB(1, 1), b3 + hstep, voffB); PG8_STAGE(PG8_SA(1, 0), a3, voffA);
            PG8_WAIT_V(8); PG8_WAIT_L(0); PG8_BAR; PG8_MMA(1, 0, At, B0); PG8_MMA(1, 1, At, B1); PG8_BAR; PG8_SCHED;
            } else {
            PG8_LDB(B0, 0, 0); PG8_SCHED; PG8_LDA(At, 0, 0); PG8_STAGE(PG8_SA(1, 1), a1 + hstep, voffA);
            PG8_WAIT_L(8); PG8_BAR; PG8_WAIT_L(0); PG8_MMA(0, 0, At, B0); PG8_BAR; PG8_SCHED;
            PG8_LDB(B1, 0, 1); PG8_STAGE(PG8_SB(0, 0), b2, voffB);
            PG8_BAR; PG8_WAIT_L(0); PG8_MMA(0, 1, At, B1); PG8_BAR;
            PG8_LDA(At, 0, 1); PG8_STAGE(PG8_SA(0, 0), a2, voffA);
            PG8_BAR; PG8_WAIT_L(0); PG8_MMA(1, 0, At, B0); PG8_BAR; PG8_SCHED;
            PG8_STAGE(PG8_SB(0, 1), b2 + hstep, voffB);
            PG8_WAIT_V(6); PG8_BAR; PG8_MMA(1, 1, At, B1); PG8_BAR;
            PG8_LDB(B0, 1, 0); PG8_SCHED; PG8_LDA(At, 1, 0); PG8_STAGE(PG8_SA(0, 1), a2 + hstep, voffA);
            PG8_WAIT_L(8); PG8_BAR; PG8_WAIT_L(0); PG8_MMA(0, 0, At, B0); PG8_BAR; PG8_SCHED;
            PG8_LDB(B1, 1, 1); PG8_STAGE(PG8_SB(1, 0), b3, voffB);
            PG8_BAR; PG8_WAIT_L(0); PG8_MMA(0, 1, At, B1); PG8_BAR;
            PG8_LDA(At, 1, 1); PG8_STAGE(PG8_SA(1, 0), a3, voffA);
            PG8_BAR; PG8_WAIT_L(0); PG8_MMA(1, 0, At, B0); PG8_BAR; PG8_SCHED;
            PG8_STAGE(PG8_SB(1, 1), b3 + hstep, voffB);
            PG8_WAIT_V(6); PG8_BAR; PG8_MMA(1, 1, At, B1); PG8_BAR;
            }
        }
        if constexpr (ALIGN_EPI) { if (wr == 0) PG8_BAR; }
        if constexpr (!Epi::AFTER_DRAIN) { E(acc, cur, wr, wc, fr, fq); S.done(cur); }
        if (!has_next) break;
#pragma unroll
        for (int a = 0; a < 2; ++a)
#pragma unroll
            for (int b = 0; b < 2; ++b)
#pragma unroll
                for (int m = 0; m < 4; ++m)
#pragma unroll
                    for (int n = 0; n < 2; ++n) acc[a][b][m][n] = (f32x4){0.f, 0.f, 0.f, 0.f};
        cur = nxt; cA = nA; cB = nB; ++ui;
        if constexpr (ALIGN_EPI) { if (wr == 1) PG8_BAR; }
    }
    PG8_WAIT_V(0);
    if constexpr (!ALIGN_EPI) { if (wr == 0) PG8_BAR; }
    PG8_BAR;
    if constexpr (Epi::AFTER_DRAIN) { E.fused(acc, cur, wr, wc, fr, fq, lds, wid, lane); S.done(cur); }
#undef PG8_SA
#undef PG8_SB
#undef PG8_STAGE
#undef PG8_LDA
#undef PG8_LDB
#undef PG8_MMA
#undef PG8_WAIT_V
#undef PG8_WAIT_L
#undef PG8_BAR
#undef PG8_SCHED
}
}
namespace fm {
using pg8::bf16_t; using pg8::f32x4; using pg8::u32x4; using pg8::Unit;
typedef unsigned v4u __attribute__((ext_vector_type(4)));
typedef unsigned v2u __attribute__((ext_vector_type(2)));
constexpr int T = 16384, D = 1024, S = 2048, NB = 8, NWAVES = 8;
constexpr size_t MiB = 1u << 20;
constexpr size_t WS_CTL = 0, CTL_ZERO_BYTES = 64 * 1024;
constexpr size_t WS_SMALL = 1 * MiB;
constexpr size_t WS_MOD = 4 * MiB;
constexpr size_t WS_WMIX = 80 * MiB;
constexpr size_t WS_WMOE = 120 * MiB;
constexpr size_t WS_XN = 144 * MiB;
constexpr size_t WS_R1 = 176 * MiB;
constexpr size_t WS_YS = WS_R1;
constexpr size_t WS_AG = WS_R1 + 64 * MiB + 4096;
constexpr size_t WS_HID = WS_R1 + 137 * MiB;
constexpr size_t WS_END = 400 * MiB;
constexpr size_t SM_TOKE = 0;
constexpr size_t SM_TOKW = 128 * 1024;
constexpr size_t SM_CNTG = 256 * 1024;
constexpr size_t SM_ROWINFO = 384 * 1024;
constexpr size_t SM_ROWW = 640 * 1024;
constexpr int MOE_ROWS_MAX = 2 * T + 16 * 256;
constexpr int LX_SEG = 1024, LX_TILEE = 1152, LX_BASE = 1792, LX_DPOS = 2048, LX_TE = 2560, LX_TW = 3072, LX_PS = 4096, LX_PB = 6144;

struct Ctx {
    LAS unsigned char* lds; int tid, lane, wave, G, wg, vcu;
};
__device__ __forceinline__ float wave_sum(float v) {
#pragma unroll
    for (int o = 1; o < 64; o <<= 1) v += __shfl_xor(v, o);
    return v;
}
__device__ __forceinline__ unsigned f2bf(float f) { unsigned u = __builtin_bit_cast(unsigned, f); return (u + 0x7fffu + ((u >> 16) & 1u)) >> 16; }
__device__ __forceinline__ unsigned pk2(float lo, float hi) { return f2bf(lo) | (f2bf(hi) << 16); }
__device__ __forceinline__ float bf2f(unsigned short b) { return __builtin_bit_cast(float, (unsigned)b << 16); }
__device__ __forceinline__ float bflo(unsigned w) { return __builtin_bit_cast(float, w << 16); }
__device__ __forceinline__ float bfhi(unsigned w) { return __builtin_bit_cast(float, w & 0xffff0000u); }
#define LDS_WAIT() asm volatile("s_waitcnt lgkmcnt(0)" ::: "memory")
__device__ __forceinline__ void transpose_item(const float* W, int N, bf16_t* WT, int ldk, int k0, int n0, int drow0, LAS float* scr, int lane) {
#pragma unroll 8
    for (int i = 0; i < 32; ++i) { const int kk = 2 * i + (lane >> 5); scr[kk * 33 + (lane & 31)] = W[(size_t)(k0 + kk) * N + n0 + (lane & 31)]; }
    LDS_WAIT(); asm volatile("" ::: "memory");
    const int c = lane & 7;
#pragma unroll
    for (int j = 0; j < 4; ++j) { const int n = (lane >> 3) + 8 * j; const LAS float* s = scr + (8 * c) * 33 + n;
        v4u o; o.x = pk2(s[0 * 33], s[1 * 33]); o.y = pk2(s[2 * 33], s[3 * 33]); o.z = pk2(s[4 * 33], s[5 * 33]); o.w = pk2(s[6 * 33], s[7 * 33]);
        *(v4u*)(WT + (size_t)(drow0 + n) * ldk + k0 + 8 * c) = o; }
    LDS_WAIT(); asm volatile("" ::: "memory");
}
__device__ __forceinline__ void transpose_item_pad(const float* W, int N, int nvalid, int kvalid, bf16_t* WT, int ldk, int k0, int n0, int drow0, LAS float* scr, int lane) {
#pragma unroll 8
    for (int i = 0; i < 32; ++i) { const int kk = 2 * i + (lane >> 5); const int n = n0 + (lane & 31); float v = 0.f; if (n < nvalid && (k0 + kk) < kvalid) v = W[(size_t)(k0 + kk) * N + n]; scr[kk * 33 + (lane & 31)] = v; }
    LDS_WAIT(); asm volatile("" ::: "memory");
    const int c = lane & 7;
#pragma unroll
    for (int j = 0; j < 4; ++j) { const int n = (lane >> 3) + 8 * j; const LAS float* s = scr + (8 * c) * 33 + n;
        v4u o; o.x = pk2(s[0 * 33], s[1 * 33]); o.y = pk2(s[2 * 33], s[3 * 33]); o.z = pk2(s[4 * 33], s[5 * 33]); o.w = pk2(s[6 * 33], s[7 * 33]);
        *(v4u*)(WT + (size_t)(drow0 + n) * ldk + k0 + 8 * c) = o; }
    LDS_WAIT(); asm volatile("" ::: "memory");
}
typedef float f32x2_c __attribute__((ext_vector_type(2))); typedef __bf16 bf16x2_c __attribute__((ext_vector_type(2)));
__device__ __forceinline__ unsigned cvtpk(float lo, float hi) { const f32x2_c v = {lo, hi}; const bf16x2_c b = __builtin_convertvector(v, bf16x2_c); return __builtin_bit_cast(unsigned, b); }
__device__ __forceinline__ float fast_sigmoid(float v) { return __builtin_amdgcn_rcpf(1.f + __expf(-v)); }
}
namespace fm {
__device__ __forceinline__ void moe_convert_weights(const Ctx& F_, const float* w1, const float* w3, const float* w2, int layer) {
    Ctx F = F_; asm volatile("" : "+v"(F.tid), "+v"(F.lane));
    unsigned char* const ws_ = kws();
    LAS float* scr = (LAS float*)(F.lds + F.wave * 8448);
    bf16_t* W13T = (bf16_t*)(ws_ + WS_WMOE); bf16_t* W2T = W13T + (size_t)16 * 512 * 1024;
    const int gw = F.wg * NWAVES + F.wave, NGW = F.G * NWAVES;
    for (int it = gw; it < 16 * 384; it += NGW) {
        const int e = it / 384, r = it % 384;
        const size_t eoff = (size_t)(layer * 16 + e);
        if (r < 256) {
            const int q = r & 127, kb = q >> 3, nb = q & 7, n0 = nb * 32;
            const float* W = (r < 128 ? w1 : w3) + eoff * 1024 * 256;
            transpose_item(W, 256, W13T + (size_t)e * 512 * 1024, 1024, kb * 64, n0, (n0 >> 7) * 256 + (n0 & 127) + (r < 128 ? 0 : 128), scr, F.lane);
        } else {
            const int q = r - 256, kb = q >> 5, nb = q & 31;
            transpose_item(w2 + eoff * 256 * 1024, 1024, W2T + (size_t)e * 1024 * 256, 256, kb * 64, nb * 32, nb * 32, scr, F.lane);
        }
    }
}
__device__ __forceinline__ void moe_route_phase(const Ctx& F_, const float* router_w, const float* router_b, int layer) {
    Ctx F = F_; asm volatile("" : "+v"(F.tid), "+v"(F.lane));
    unsigned char* const ws_ = kws(); const float* const x_ = kout(); const float* const mod_ = (const float*)(ws_ + WS_MOD);
    LAS float* rwT = (LAS float*)F.lds;
    LAS int* cnt = (LAS int*)(F.lds + 65536);
    for (int i = F.tid; i < 16384; i += NTHREADS) { const int e = i >> 10, c = i & 1023; rwT[i] = router_w[c * 16 + e]; }
    if (F.tid < 16) cnt[F.tid] = 0;
    __syncthreads();
    int* tok_e = (int*)(ws_ + WS_SMALL + SM_TOKE); float* tok_w = (float*)(ws_ + WS_SMALL + SM_TOKW);
    bf16_t* XN = (bf16_t*)(ws_ + WS_XN);
    const int row0 = F.wg * 64 + F.wave * 8, b = row0 / S;
    const float* m = mod_ + ((size_t)(layer * 2 + 1) * NB + b) * 3072;
    float rb[16];
#pragma unroll
    for (int e = 0; e < 16; ++e) rb[e] = router_b[e];
#pragma unroll 1
    for (int r = 0; r < 8; ++r) {
        const int row = row0 + r;
        const f32x4* xr = (const f32x4*)(x_ + (size_t)row * D) + F.lane;
        f32x4 v[4]; float ss = 0.f;
#pragma unroll
        for (int j = 0; j < 4; ++j) { v[j] = xr[64 * j]; ss += (v[j].x * v[j].x + v[j].y * v[j].y) + (v[j].z * v[j].z + v[j].w * v[j].w); }
        const float rinv = 1.0f / sqrtf(wave_sum(ss) * (1.f / D) + 1e-6f);
        unsigned long long* o8 = (unsigned long long*)(XN + (size_t)row * D) + F.lane;
#pragma unroll
        for (int j = 0; j < 4; ++j) {
            const f32x4 sh = ((const f32x4*)m)[64 * j + F.lane], sc = ((const f32x4*)(m + 1024))[64 * j + F.lane];
            v[j] = v[j] * rinv * (sc + 1.0f) + sh;
            o8[64 * j] = (unsigned long long)pk2(v[j].x, v[j].y) | ((unsigned long long)pk2(v[j].z, v[j].w) << 32);
        }
        asm volatile("" ::: "memory");
        float acc[16];
#pragma unroll
        for (int e = 0; e < 16; ++e) {
            float a = 0.f;
#pragma unroll
            for (int j = 0; j < 4; ++j) { const f32x4 w = *(const LAS f32x4*)(rwT + e * 1024 + 256 * j + 4 * F.lane); a += (v[j].x * w.x + v[j].y * w.y) + (v[j].z * w.z + v[j].w * w.w); }
            acc[e] = a;
            if ((e & 1) == 1) asm volatile("" ::: "memory");
        }
        float s[16], sel[16];
#pragma unroll
        for (int e = 0; e < 16; ++e) { const float lg = wave_sum(acc[e]); s[e] = 1.f / (1.f + expf(-lg)); sel[e] = s[e] + rb[e]; }
        int bg = 0; float bgs = -INFINITY;
#pragma unroll
        for (int g = 0; g < 4; ++g) {
            const float a0 = sel[4 * g], a1 = sel[4 * g + 1], a2 = sel[4 * g + 2], a3 = sel[4 * g + 3];
            const float m1 = fmaxf(fmaxf(a0, a1), fmaxf(a2, a3));
            const float lo01 = fminf(a0, a1), hi01 = fmaxf(a0, a1), lo23 = fminf(a2, a3), hi23 = fmaxf(a2, a3);
            const float m2 = fmaxf(fminf(hi01, hi23), fmaxf(lo01, lo23));
            const float gs = m1 + m2;
            if (gs > bgs) { bgs = gs; bg = g; }
        }
        float g0 = sel[0], g1 = sel[1], g2 = sel[2], g3 = sel[3], t0 = s[0], t1 = s[1], t2 = s[2], t3 = s[3];
#pragma unroll
        for (int g = 1; g < 4; ++g) if (bg == g) { g0 = sel[4 * g]; g1 = sel[4 * g + 1]; g2 = sel[4 * g + 2]; g3 = sel[4 * g + 3]; t0 = s[4 * g]; t1 = s[4 * g + 1]; t2 = s[4 * g + 2]; t3 = s[4 * g + 3]; }
        int i0 = 0; float v0 = g0, w0 = t0;
        if (g1 > v0) { v0 = g1; i0 = 1; w0 = t1; } if (g2 > v0) { v0 = g2; i0 = 2; w0 = t2; } if (g3 > v0) { v0 = g3; i0 = 3; w0 = t3; }
        int i1 = -1; float v1 = -INFINITY, w1 = 0.f;
        if (i0 != 0 && g0 > v1) { v1 = g0; i1 = 0; w1 = t0; } if (i0 != 1 && g1 > v1) { v1 = g1; i1 = 1; w1 = t1; }
        if (i0 != 2 && g2 > v1) { v1 = g2; i1 = 2; w1 = t2; } if (i0 != 3 && g3 > v1) { v1 = g3; i1 = 3; w1 = t3; }
        const int e0 = bg * 4 + i0, e1 = bg * 4 + i1; const float inv = 1.f / (w0 + w1);
        if (F.lane == 0) { tok_e[row * 2] = e0; tok_e[row * 2 + 1] = e1; tok_w[row * 2] = w0 * inv; tok_w[row * 2 + 1] = w1 * inv;
            __hip_atomic_fetch_add(cnt + e0, 1, __ATOMIC_RELAXED, __HIP_MEMORY_SCOPE_WORKGROUP); __hip_atomic_fetch_add(cnt + e1, 1, __ATOMIC_RELAXED, __HIP_MEMORY_SCOPE_WORKGROUP); }
    }
    __syncthreads();
    if (F.tid < 16) ((int*)(ws_ + WS_SMALL + SM_CNTG))[F.wg * 16 + F.tid] = cnt[F.tid];
}
__device__ __forceinline__ void moe_sort_phase(const Ctx& F_) {
    Ctx F = F_; asm volatile("" : "+v"(F.tid), "+v"(F.lane));
    unsigned char* const ws_ = kws();
    LAS unsigned char* X = F.lds + LDSCTL_OFF;
    LAS int* seg = (LAS int*)(X + LX_SEG); LAS int* tile_e = (LAS int*)(X + LX_TILEE); LAS int* base = (LAS int*)(X + LX_BASE); LAS int* dpos = (LAS int*)(X + LX_DPOS);
    LAS int* te = (LAS int*)(X + LX_TE); LAS float* tw = (LAS float*)(X + LX_TW); LAS int* ps = (LAS int*)(X + LX_PS); LAS int* pb = (LAS int*)(X + LX_PB);
    const int* cntG = (const int*)(ws_ + WS_SMALL + SM_CNTG);
    const int* tok_e = (const int*)(ws_ + WS_SMALL + SM_TOKE); const float* tok_w = (const float*)(ws_ + WS_SMALL + SM_TOKW);
    int* rowinfo = (int*)(ws_ + WS_SMALL + SM_ROWINFO); float* roww = (float*)(ws_ + WS_SMALL + SM_ROWW);
    { const int e = F.tid & 15, part = F.tid >> 4; int tot = 0, bef = 0;
#pragma unroll
        for (int i = 0; i < 8; ++i) { const int w = part * 8 + i; const int c = cntG[w * 16 + e]; tot += c; bef += (w < F.wg) ? c : 0; }
        ps[part * 16 + e] = tot; pb[part * 16 + e] = bef; }
    if (F.tid < 128) { te[F.tid] = tok_e[F.wg * 128 + F.tid]; tw[F.tid] = tok_w[F.wg * 128 + F.tid]; }
    __syncthreads();
    if (F.tid == 0) {
        int run = 0;
        for (int e = 0; e < 16; ++e) { int tot = 0, bef = 0; for (int p = 0; p < 32; ++p) { tot += ps[p * 16 + e]; bef += pb[p * 16 + e]; }
            seg[e] = run; base[e] = run + bef; ps[e] = tot; run += (tot + 255) & ~255; }
        seg[16] = run;
        for (int i = 0; i < 128; ++i) { const int e = te[i]; const int pos = base[e]; base[e] = pos + 1; dpos[i] = pos; rowinfo[pos] = (i & 1) * T + F.wg * 64 + (i >> 1); roww[pos] = tw[i]; }
    }
    __syncthreads();
    const int ntile = seg[16] >> 8;
    for (int t = F.tid; t < ntile; t += NTHREADS) { int e = 0;
#pragma unroll
        for (int k = 1; k < 16; ++k) e += (t * 256 >= seg[k]) ? 1 : 0;
        tile_e[t] = e; }
    if (F.wg < 16) { const int e = F.wg; for (int p = seg[e] + ps[e] + F.tid; p < seg[e + 1]; p += NTHREADS) rowinfo[p] = 2 * T; }
    const bf16_t* XN = (const bf16_t*)(ws_ + WS_XN); bf16_t* AG = (bf16_t*)(ws_ + WS_AG);
    for (int r = 0; r < 8; ++r) {
        const int lr = F.wave * 8 + r, row = F.wg * 64 + lr;
        const v4u* src = (const v4u*)(XN + (size_t)row * D) + F.lane; const v4u a = src[0], b = src[64];
        const int p0 = dpos[lr * 2], p1 = dpos[lr * 2 + 1];
        v4u* d0 = (v4u*)(AG + (size_t)p0 * D) + F.lane; v4u* d1 = (v4u*)(AG + (size_t)p1 * D) + F.lane;
        d0[0] = a; d0[64] = b; d1[0] = a; d1[64] = b;
    }
}
struct SchedMoe {
    const char* A; const char* Bw; size_t a_tile, b_exp, b_tile; int n_units, G, c, sh; const LAS int* tile_e;
    __device__ __forceinline__ bool next(int i, Unit& u) const { const long L = (long)i * G + c; if (L >= n_units) return false; u.pm = (int)(L >> sh); u.pn = (int)(L & ((1 << sh) - 1)); return true; }
    __device__ __forceinline__ const char* a_base(const Unit& u) const { return A + (size_t)u.pm * a_tile; }
    __device__ __forceinline__ const char* b_base(const Unit& u) const { const int e = __builtin_amdgcn_readfirstlane(tile_e[u.pm]); return Bw + (size_t)e * b_exp + (size_t)u.pn * b_tile; }
    __device__ __forceinline__ void a_ready(const Unit&) const {}
    __device__ __forceinline__ void done(const Unit&) const {}
};
struct EpiSwiglu {
    static constexpr bool PERM = true, AFTER_DRAIN = false;
    bf16_t* HID;
    __device__ __forceinline__ void operator()(const f32x4 (&acc)[2][2][4][2], const Unit& u, int wr, int wc, int fr, int fq) const {
        const int row0 = u.pm * 256 + wr * 64 + fr, col0 = u.pn * 128 + wc * 32 + 8 * fq;
#pragma unroll
        for (int ai = 0; ai < 2; ++ai)
#pragma unroll
            for (int m = 0; m < 4; ++m) {
                float h[8];
#pragma unroll
                for (int n = 0; n < 2; ++n)
#pragma unroll
                    for (int q = 0; q < 4; ++q) { const float a = acc[ai][0][m][n][q], g = acc[ai][1][m][n][q]; h[4 * n + q] = a * fast_sigmoid(a) * g; }
                u32x4 w; w.x = pg8::cvt_pk_bf16(h[0], h[1]); w.y = pg8::cvt_pk_bf16(h[2], h[3]); w.z = pg8::cvt_pk_bf16(h[4], h[5]); w.w = pg8::cvt_pk_bf16(h[6], h[7]);
                *(u32x4*)(HID + (size_t)(row0 + ai * 128 + m * 16) * 256 + col0) = w;
                asm volatile("" ::: "memory");
            }
    }
};
struct EpiMoeOut {
    static constexpr bool PERM = true, AFTER_DRAIN = false;
    const int* rowinfo; const float* roww; bf16_t* YS;
    __device__ __forceinline__ void operator()(const f32x4 (&acc)[2][2][4][2], const Unit& u, int wr, int wc, int fr, int fq) const {
        const int row0 = u.pm * 256 + wr * 64 + fr; const unsigned col0 = u.pn * 256 + wc * 32 + 8 * fq;
#pragma unroll
        for (int ai = 0; ai < 2; ++ai)
#pragma unroll
            for (int m = 0; m < 4; ++m) {
                const int r = row0 + ai * 128 + m * 16; const unsigned drow = (unsigned)rowinfo[r]; const float w = roww[r];
                bf16_t* dst = YS + (drow * 1024u + col0);
#pragma unroll
                for (int bj = 0; bj < 2; ++bj) { const f32x4 v0 = acc[ai][bj][m][0] * w, v1 = acc[ai][bj][m][1] * w;
                    u32x4 o; o.x = pg8::cvt_pk_bf16(v0[0], v0[1]); o.y = pg8::cvt_pk_bf16(v0[2], v0[3]); o.z = pg8::cvt_pk_bf16(v1[0], v1[1]); o.w = pg8::cvt_pk_bf16(v1[2], v1[3]);
                    *(u32x4*)(dst + bj * 128) = o; }
                asm volatile("" ::: "memory");
            }
    }
};
__device__ __forceinline__ void moe_gemm1_phase(const Ctx& F_) {
    Ctx F = F_; asm volatile("" : "+v"(F.tid), "+v"(F.lane));
    unsigned char* const ws_ = kws();
    LAS unsigned char* X = F.lds + LDSCTL_OFF; const LAS int* seg = (const LAS int*)(X + LX_SEG);
    const int ntile = __builtin_amdgcn_readfirstlane(seg[16]) >> 8;
    SchedMoe Sc{(const char*)(ws_ + WS_AG), (const char*)(ws_ + WS_WMOE), (size_t)256 * 1024 * 2, (size_t)512 * 1024 * 2, (size_t)256 * 1024 * 2, ntile * 2, F.G, F.vcu, 1, (const LAS int*)(X + LX_TILEE)};
    EpiSwiglu E{(bf16_t*)(ws_ + WS_HID)};
    pg8::gemm_phase<EpiSwiglu, SchedMoe, true, true>(F.lds, pg8::Gemm{1024}, Sc, E);
}
__device__ __forceinline__ void moe_gemm2_phase(const Ctx& F_) {
    Ctx F = F_; asm volatile("" : "+v"(F.tid), "+v"(F.lane));
    unsigned char* const ws_ = kws();
    LAS unsigned char* X = F.lds + LDSCTL_OFF; const LAS int* seg = (const LAS int*)(X + LX_SEG);
    const int ntile = __builtin_amdgcn_readfirstlane(seg[16]) >> 8;
    SchedMoe Sc{(const char*)(ws_ + WS_HID), (const char*)(ws_ + WS_WMOE) + (size_t)16 * 512 * 1024 * 2, (size_t)256 * 256 * 2, (size_t)1024 * 256 * 2, (size_t)256 * 256 * 2, ntile * 4, F.G, F.vcu, 2, (const LAS int*)(X + LX_TILEE)};
    EpiMoeOut E{(const int*)(ws_ + WS_SMALL + SM_ROWINFO), (const float*)(ws_ + WS_SMALL + SM_ROWW), (bf16_t*)(ws_ + WS_YS)};
    pg8::gemm_phase<EpiMoeOut, SchedMoe, true, true>(F.lds, pg8::Gemm{256}, Sc, E);
}
}
namespace fm {
typedef short bf16x8 __attribute__((ext_vector_type(8)));
typedef short s16x4 __attribute__((ext_vector_type(4)));
typedef float f32x16 __attribute__((ext_vector_type(16)));
typedef float f32x2 __attribute__((ext_vector_type(2)));
constexpr int PROJ_LD = 2560;
constexpr float QSCALE = 0.125f * 1.4426950408889634f;
constexpr size_t WM_EVEN_STRIDE = 8 * MiB;
constexpr size_t WM_WIN = 0, WM_WOUT = 5 * MiB, WM_SGUW = 7 * MiB;
constexpr size_t WS_PROJ = WS_R1;
constexpr size_t WS_O = WS_R1 + 80 * MiB;
constexpr size_t SM_ZSS = 1024 * 1024;

struct SchedStd {
    const char* A; const char* Bt; size_t tile_bytes; int nM, nN, nwg, G, c;
    __device__ __forceinline__ void init(const void* A_, const void* Bt_, int M, int N, int K, int G_, int c_) { A = (const char*)A_; Bt = (const char*)Bt_; tile_bytes = (size_t)256 * K * 2; nM = M / 256; nN = N / 256; nwg = nM * nN; G = G_; c = c_; }
    __device__ __forceinline__ bool next(int i, Unit& u) const {
        const long L = (long)i * G + c; if (L >= nwg) return false;
        int wgid = (int)L; { const int q = nwg / 8, r = nwg % 8, xcd = wgid % 8, off = wgid / 8; wgid = (xcd < r ? xcd * (q + 1) : r * (q + 1) + (xcd - r) * q) + off; }
        const int nig = 8 * nN, gid = wgid / nig, fm_ = gid * 8, gsz = (nM - fm_) < 8 ? (nM - fm_) : 8;
        u.pm = fm_ + ((wgid % nig) % gsz); u.pn = (wgid % nig) / gsz; return true;
    }
    __device__ __forceinline__ const char* a_base(const Unit& u) const { return A + (size_t)u.pm * tile_bytes; }
    __device__ __forceinline__ const char* b_base(const Unit& u) const { return Bt + (size_t)u.pn * tile_bytes; }
    __device__ __forceinline__ void a_ready(const Unit&) const {}
    __device__ __forceinline__ void done(const Unit&) const {}
};
__device__ __forceinline__ void even_convert_weights(const Ctx& F_, int li) {
    Ctx F = F_; asm volatile("" : "+v"(F.tid), "+v"(F.lane));
    unsigned char* const ws_ = kws();
    LAS float* scr = (LAS float*)(F.lds + F.wave * 8448);
    bf16_t* base = (bf16_t*)(ws_ + WS_WMIX + (size_t)li * WM_EVEN_STRIDE);
    bf16_t* WinT = base + WM_WIN / 2; bf16_t* WoutT = base + WM_WOUT / 2; bf16_t* SW = base + WM_SGUW / 2;
    const float* w_in = kin(4) + (size_t)li * 1024 * 2560; const float* w_out = kin(5) + (size_t)li * 1024 * 1024; const float* sw = kin(7) + (size_t)li * 8 * 128 * 128;
    const int gw = F.wg * NWAVES + F.wave, NGW = F.G * NWAVES;
    constexpr int I_IN = 16 * 80, I_OUT = 16 * 32;
    for (int it = gw; it < I_IN + I_OUT; it += NGW) {
        if (it < I_IN) { const int kb = it / 80, nb = it % 80; transpose_item(w_in, 2560, WinT, 1024, kb * 64, nb * 32, nb * 32, scr, F.lane); }
        else { const int r = it - I_IN, kb = r / 32, nb = r % 32; transpose_item(w_out, 1024, WoutT, 1024, kb * 64, nb * 32, nb * 32, scr, F.lane); }
    }
    for (int i = gw * 64 + F.lane; i < 8 * 128 * 128 / 4; i += NGW * 64) { const f32x4 v = ((const f32x4*)sw)[i]; v2u o; o.x = pk2(v.x, v.y); o.y = pk2(v.z, v.w); ((v2u*)SW)[i] = o; }
}
struct EpiInProj {
    static constexpr bool PERM = true, AFTER_DRAIN = false;
    bf16_t* P; float* zss;
    __device__ __forceinline__ void operator()(const f32x4 (&acc)[2][2][4][2], const Unit& u, int wr, int wc, int fr, int fq) const {
        const int row0 = u.pm * 256 + wr * 64 + fr, col0 = u.pn * 256 + wc * 32 + 8 * fq;
        const int kind = u.pn < 2 ? 0 : (u.pn < 6 ? 1 : (u.pn < 8 ? 2 : 3));
#pragma unroll
        for (int ai = 0; ai < 2; ++ai)
#pragma unroll
            for (int m = 0; m < 4; ++m) {
                const int row = row0 + ai * 128 + m * 16; bf16_t* rowp = P + (size_t)row * PROJ_LD + col0; float ssq = 0.f;
#pragma unroll
                for (int bj = 0; bj < 2; ++bj) {
                    f32x4 v0 = acc[ai][bj][m][0], v1 = acc[ai][bj][m][1];
                    if (kind == 0) { v0 = v0 * QSCALE; v1 = v1 * QSCALE; }
                    else if (kind >= 2) {
                        const f32x2 a = pg8::gelu_pk((f32x2){v0[0], v0[1]}), b = pg8::gelu_pk((f32x2){v0[2], v0[3]}), c = pg8::gelu_pk((f32x2){v1[0], v1[1]}), d = pg8::gelu_pk((f32x2){v1[2], v1[3]});
                        v0 = (f32x4){a.x, a.y, b.x, b.y}; v1 = (f32x4){c.x, c.y, d.x, d.y};
                        ssq += (v0[0] * v0[0] + v0[1] * v0[1]) + (v0[2] * v0[2] + v0[3] * v0[3]) + (v1[0] * v1[0] + v1[1] * v1[1]) + (v1[2] * v1[2] + v1[3] * v1[3]);
                    }
                    u32x4 w; w.x = pg8::cvt_pk_bf16(v0[0], v0[1]); w.y = pg8::cvt_pk_bf16(v0[2], v0[3]); w.z = pg8::cvt_pk_bf16(v1[0], v1[1]); w.w = pg8::cvt_pk_bf16(v1[2], v1[3]);
                    *(u32x4*)(rowp + bj * 128) = w;
                }
                if (kind == 3) { ssq += __shfl_xor(ssq, 16); ssq += __shfl_xor(ssq, 32); if (fq == 0) zss[(size_t)row * 8 + (u.pn - 8) * 4 + wc] = ssq; }
                asm volatile("" ::: "memory");
            }
    }
};
struct EpiResid {
    static constexpr bool PERM = false, AFTER_DRAIN = false;
    const float* xin; float* xout; const float* mod;
    __device__ __forceinline__ void operator()(const f32x4 (&acc)[2][2][4][2], const Unit& u, int wr, int wc, int fr, int fq) const {
        const int row0 = u.pm * 256 + wr * 64 + fr, col0 = u.pn * 256 + wc * 32 + 4 * fq, b = (u.pm * 256) / S;
        const float* g = mod + (size_t)b * 3072 + 2048 + col0;
        f32x4 gv[2][2];
#pragma unroll
        for (int bj = 0; bj < 2; ++bj)
#pragma unroll
            for (int n = 0; n < 2; ++n) gv[bj][n] = *(const f32x4*)(g + bj * 128 + n * 16);
#pragma unroll
        for (int ai = 0; ai < 2; ++ai)
#pragma unroll
            for (int m = 0; m < 4; ++m) { const size_t off = (size_t)(row0 + ai * 128 + m * 16) * D + col0;
#pragma unroll
                for (int bj = 0; bj < 2; ++bj)
#pragma unroll
                    for (int n = 0; n < 2; ++n) { const f32x4 xv = *(const f32x4*)(xin + off + bj * 128 + n * 16); *(f32x4*)(xout + off + bj * 128 + n * 16) = xv + gv[bj][n] * acc[ai][bj][m][n]; }
                asm volatile("" ::: "memory"); }
    }
};
__device__ __forceinline__ void even_inproj_phase(const Ctx& F_, int li) {
    Ctx F = F_; asm volatile("" : "+v"(F.tid), "+v"(F.lane));
    unsigned char* const ws_ = kws();
    SchedStd Sc; Sc.init(ws_ + WS_XN, ws_ + WS_WMIX + (size_t)li * WM_EVEN_STRIDE + WM_WIN, T, 2560, 1024, F.G, F.wg);
    EpiInProj E{(bf16_t*)(ws_ + WS_PROJ), (float*)(ws_ + WS_SMALL + SM_ZSS)};
    pg8::gemm_phase<EpiInProj, SchedStd, true, true>(F.lds, pg8::Gemm{1024}, Sc, E);
}
__device__ __forceinline__ void even_outproj_phase(const Ctx& F_, int layer, const float* xin) {
    Ctx F = F_; asm volatile("" : "+v"(F.tid), "+v"(F.lane));
    unsigned char* const ws_ = kws(); float* const x_ = kout();
    SchedStd Sc; Sc.init(ws_ + WS_O, ws_ + WS_WMIX + (size_t)(layer / 2) * WM_EVEN_STRIDE + WM_WOUT, T, 1024, 1024, F.G, F.wg);
    EpiResid E{xin, x_, (const float*)(ws_ + WS_MOD) + (size_t)(layer * 2) * NB * 3072};
    pg8::gemm_phase<EpiResid, SchedStd, true, true>(F.lds, pg8::Gemm{1024}, Sc, E);
}
__device__ __forceinline__ s16x4 tr_read(const LAS unsigned char* p) { typedef short v4i16_t __attribute__((ext_vector_type(4))); return __builtin_bit_cast(s16x4, __builtin_amdgcn_ds_read_tr16_b64_v4i16((LAS v4i16_t*)p)); }
constexpr int VPITCH = 144;
__device__ __forceinline__ void attn_task(const bf16_t* __restrict__ P, bf16_t* __restrict__ O, LAS unsigned char* vl, int b, int hh, int jt, int rq, int lane) {
    const int r32 = lane & 31, h2 = lane >> 5;
    const bf16_t* Pb = P + (size_t)b * S * PROJ_LD + hh * 64;
    const bf16_t* qrow = Pb + (size_t)(16 * (32 * jt + r32) + rq) * PROJ_LD + 8 * h2;
    bf16x8 qf[4];
#pragma unroll
    for (int ks = 0; ks < 4; ++ks) qf[ks] = *(const bf16x8*)(qrow + 16 * ks);
    float mrun = -INFINITY, lrun = 0.f; f32x16 o0, o1;
#pragma unroll
    for (int r = 0; r < 16; ++r) { o0[r] = 0.f; o1[r] = 0.f; }
    const int vkey = lane >> 3, vch = lane & 7;
    const int g4 = lane >> 4, i16 = lane & 15;
    const LAS unsigned char* trb = vl + (4 * h2 + (i16 >> 2)) * VPITCH + (16 * (g4 & 1) + 4 * (i16 & 3)) * 2;
#pragma unroll 1
    for (int c = 0; c < 16; ++c) {
        const int off = rq - c; const int W = (off == 0) ? 2048 : (((off & 3) == 0) ? 512 : 128);
        const int kt0 = (off == 0) ? 0 : (jt > 0 ? jt - 1 : 0);
#pragma unroll 1
        for (int kt = kt0; kt <= jt; ++kt) {
            const bf16_t* krow = Pb + (size_t)(16 * (32 * kt + r32) + c) * PROJ_LD + 512 + 8 * h2;
            bf16x8 kf[4];
#pragma unroll
            for (int ks = 0; ks < 4; ++ks) kf[ks] = *(const bf16x8*)(krow + 16 * ks);
            v4u vv[4];
#pragma unroll
            for (int it = 0; it < 4; ++it) vv[it] = *(const v4u*)(Pb + (size_t)(16 * (32 * kt + vkey + 8 * it) + c) * PROJ_LD + 1024 + 8 * vch);
            f32x16 s;
#pragma unroll
            for (int r = 0; r < 16; ++r) s[r] = 0.f;
#pragma unroll
            for (int ks = 0; ks < 4; ++ks) s = __builtin_amdgcn_mfma_f32_32x32x16_bf16(kf[ks], qf[ks], s, 0, 0, 0);
#pragma unroll
            for (int it = 0; it < 4; ++it) *(LAS v4u*)(vl + (vkey + 8 * it) * VPITCH + vch * 16) = vv[it];
            const int dbase = 16 * (32 * (jt - kt) + r32 - 4 * h2) + off;
            float tmax = -INFINITY;
#pragma unroll
            for (int r = 0; r < 16; ++r) {
                const int dlt = dbase - 16 * ((r & 3) + 8 * (r >> 2));
                const int mult = ((dlt >= 0 && dlt <= 128) ? 1 : 0) + ((W >= 512 && dlt >= 0 && dlt <= 512) ? 1 : 0) + ((W == 2048 && dlt >= 0) ? 1 : 0);
                const float lg = mult == 0 ? -INFINITY : (mult == 1 ? 0.f : (mult == 2 ? 1.f : 1.5849625007f));
                s[r] += lg; tmax = fmaxf(tmax, s[r]);
            }
            tmax = fmaxf(tmax, __shfl_xor(tmax, 32));
            const float mnew = fmaxf(mrun, tmax), msafe = (mnew == -INFINITY) ? 0.f : mnew;
            const float alpha = __builtin_amdgcn_exp2f(mrun - msafe);
            float psum = 0.f;
#pragma unroll
            for (int r = 0; r < 16; ++r) { s[r] = __builtin_amdgcn_exp2f(s[r] - msafe); psum += s[r]; }
            lrun = lrun * alpha + psum; mrun = mnew;
#pragma unroll
            for (int r = 0; r < 16; ++r) { o0[r] *= alpha; o1[r] *= alpha; }
            bf16x8 pf[2];
#pragma unroll
            for (int st = 0; st < 2; ++st) { v4u w; w.x = cvtpk(s[8 * st], s[8 * st + 1]); w.y = cvtpk(s[8 * st + 2], s[8 * st + 3]); w.z = cvtpk(s[8 * st + 4], s[8 * st + 5]); w.w = cvtpk(s[8 * st + 6], s[8 * st + 7]); pf[st] = __builtin_bit_cast(bf16x8, w); }
            asm volatile("s_waitcnt lgkmcnt(0)" ::: "memory");
#pragma unroll
            for (int st = 0; st < 2; ++st) {
                const s16x4 a0 = tr_read(trb + (16 * st) * VPITCH), a1 = tr_read(trb + (16 * st + 8) * VPITCH);
                const s16x4 b0 = tr_read(trb + (16 * st) * VPITCH + 64), b1 = tr_read(trb + (16 * st + 8) * VPITCH + 64);
                const bf16x8 A0 = (bf16x8){a0[0], a0[1], a0[2], a0[3], a1[0], a1[1], a1[2], a1[3]}, A1 = (bf16x8){b0[0], b0[1], b0[2], b0[3], b1[0], b1[1], b1[2], b1[3]};
                o0 = __builtin_amdgcn_mfma_f32_32x32x16_bf16(A0, pf[st], o0, 0, 0, 0);
                o1 = __builtin_amdgcn_mfma_f32_32x32x16_bf16(A1, pf[st], o1, 0, 0, 0);
            }
            asm volatile("s_waitcnt lgkmcnt(0)" ::: "memory");
        }
    }
    const float ltot = lrun + __shfl_xor(lrun, 32), inv = 1.0f / ltot;
    bf16_t* orow = O + ((size_t)b * S + 16 * (32 * jt + r32) + rq) * D + hh * 64 + 4 * h2;
#pragma unroll
    for (int gq = 0; gq < 4; ++gq) {
        v2u w0, w1; w0.x = cvtpk(o0[4 * gq] * inv, o0[4 * gq + 1] * inv); w0.y = cvtpk(o0[4 * gq + 2] * inv, o0[4 * gq + 3] * inv);
        w1.x = cvtpk(o1[4 * gq] * inv, o1[4 * gq + 1] * inv); w1.y = cvtpk(o1[4 * gq + 2] * inv, o1[4 * gq + 3] * inv);
        *(v2u*)(orow + 8 * gq) = w0; *(v2u*)(orow + 32 + 8 * gq) = w1;
    }
}
__device__ __forceinline__ unsigned mask_pair(unsigned x, int e0, int lim) { if (e0 > lim) x &= 0xffff0000u; if (e0 + 1 > lim) x &= 0x0000ffffu; return x; }
constexpr int ZPITCH = 128;
__device__ __forceinline__ void sgu_task(const bf16_t* __restrict__ P, bf16_t* __restrict__ O, const bf16_t* __restrict__ SW, const float* __restrict__ zss, const float* __restrict__ ng, const float* __restrict__ bs,
                                         LAS unsigned char* zl, int b, int ch, int g, int lane) {
    const int r32 = lane & 31, h2 = lane >> 5;
    const size_t t0 = (size_t)b * S + ch * 128;
    { const int chn = lane & 7; f32x4 n0 = *(const f32x4*)(ng + g * 64 + 8 * chn), n1 = *(const f32x4*)(ng + g * 64 + 8 * chn + 4);
#pragma unroll 4
        for (int it = 0; it < 16; ++it) { const int row = (lane >> 3) + 8 * it;
            const float* zp = zss + (t0 + row) * 8; const f32x4 p0 = *(const f32x4*)zp, p1 = *(const f32x4*)(zp + 4);
            const float ri = 1.0f / sqrtf(((p0.x + p0.y) + (p0.z + p0.w) + (p1.x + p1.y) + (p1.z + p1.w)) * (1.f / 512.f) + 1e-6f);
            const v4u z = *(const v4u*)(P + (t0 + row) * PROJ_LD + 2048 + g * 64 + 8 * chn);
            v4u o; o.x = pk2(bflo(z.x) * ri * n0.x, bfhi(z.x) * ri * n0.y); o.y = pk2(bflo(z.y) * ri * n0.z, bfhi(z.y) * ri * n0.w);
            o.z = pk2(bflo(z.z) * ri * n1.x, bfhi(z.z) * ri * n1.y); o.w = pk2(bflo(z.w) * ri * n1.z, bfhi(z.w) * ri * n1.w);
            *(LAS v4u*)(zl + row * ZPITCH + chn * 16) = o; } }
    asm volatile("s_waitcnt lgkmcnt(0)" ::: "memory");
    const int g4 = lane >> 4, i16 = lane & 15;
    const LAS unsigned char* trb = zl + (8 * h2 + (i16 >> 2)) * ZPITCH + (16 * (g4 & 1) + 4 * (i16 & 3)) * 2;
    const bf16_t* Wg = SW + (size_t)g * 128 * 128;
#pragma unroll 1
    for (int mt = 0; mt < 4; ++mt) {
        f32x16 a0, a1;
#pragma unroll
        for (int r = 0; r < 16; ++r) { a0[r] = 0.f; a1[r] = 0.f; }
        const int irow = 32 * mt + r32;
#pragma unroll 1
        for (int kt = 0; kt <= mt; ++kt) {
#pragma unroll
            for (int ks = 0; ks < 2; ++ks) {
                const int j0 = 32 * kt + 16 * ks + 8 * h2;
                v4u wv = *(const v4u*)(Wg + (size_t)irow * 128 + j0);
                if (kt == mt) {
                    const int lim = irow - j0;
                    wv.x = mask_pair(wv.x, 0, lim); wv.y = mask_pair(wv.y, 2, lim); wv.z = mask_pair(wv.z, 4, lim); wv.w = mask_pair(wv.w, 6, lim);
                }
                const bf16x8 af = __builtin_bit_cast(bf16x8, wv);
                const LAS unsigned char* tb = trb + (32 * kt + 16 * ks) * ZPITCH;
                const s16x4 x0 = tr_read(tb), x1 = tr_read(tb + 4 * ZPITCH), y0 = tr_read(tb + 64), y1 = tr_read(tb + 4 * ZPITCH + 64);
                const bf16x8 B0 = (bf16x8){x0[0], x0[1], x0[2], x0[3], x1[0], x1[1], x1[2], x1[3]}, B1 = (bf16x8){y0[0], y0[1], y0[2], y0[3], y1[0], y1[1], y1[2], y1[3]};
                a0 = __builtin_amdgcn_mfma_f32_32x32x16_bf16(af, B0, a0, 0, 0, 0);
                a1 = __builtin_amdgcn_mfma_f32_32x32x16_bf16(af, B1, a1, 0, 0, 0);
            }
        }
#pragma unroll
        for (int r = 0; r < 16; ++r) {
            const int i = 32 * mt + (r & 3) + 8 * (r >> 2) + 4 * h2; const float bb = bs[g * 128 + i];
            const bf16_t* up = P + (t0 + i) * PROJ_LD + 1536 + g * 64; bf16_t* op = O + (t0 + i) * D + 512 + g * 64;
            op[r32] = (bf16_t)f2bf(bf2f(up[r32]) * (a0[r] + bb)); op[32 + r32] = (bf16_t)f2bf(bf2f(up[32 + r32]) * (a1[r] + bb));
        }
    }
}
__device__ __forceinline__ void even_mix_phase(const Ctx& F_, int li) {
    Ctx F = F_; asm volatile("" : "+v"(F.tid), "+v"(F.lane));
    unsigned char* const ws_ = kws();
    const bf16_t* P = (const bf16_t*)(ws_ + WS_PROJ); bf16_t* O = (bf16_t*)(ws_ + WS_O);
    LAS unsigned char* wl = F.lds + F.wave * 16384;
    { const int b = F.wg >> 5, hh = (F.wg >> 2) & 7, jt = F.wg & 3;
        attn_task(P, O, wl, b, hh, jt, F.wave, F.lane);
        attn_task(P, O, wl, b, hh, jt, F.wave + 8, F.lane); }
    if (F.wave < 4) { const int task = F.wg * 4 + F.wave, b = task >> 7, ch = (task >> 3) & 15, g = task & 7;
        sgu_task(P, O, (const bf16_t*)(ws_ + WS_WMIX + (size_t)li * WM_EVEN_STRIDE + WM_SGUW), (const float*)(ws_ + WS_SMALL + SM_ZSS), kin(6) + li * 512, kin(8) + li * 8 * 128, wl, b, ch, g, F.lane); }
}
}
namespace fm {
constexpr size_t WM_ODD_BASE = 16 * MiB, WM_ODD_STRIDE = 12 * MiB, WM_WRKV = 0, WM_WLD = 6 * MiB, WM_WLU = 8 * MiB, WM_WO = 10 * MiB;
constexpr size_t WS_VFIRST = 16 * MiB;
constexpr size_t WS_LORA = 48 * MiB;
constexpr size_t WS_MIX = WS_R1;
constexpr size_t WS_WDEC = WS_R1, WS_AV = WS_R1 + 64 * MiB, WS_G = WS_R1 + 96 * MiB;
constexpr size_t WS_R = WS_R1 + 128 * MiB, WS_K = WS_R1 + 160 * MiB, WS_V = WS_R1 + 192 * MiB;
constexpr size_t WS_Y = WS_XN;

__device__ __forceinline__ void odd_convert_weights(const Ctx& F_, int li) {
    Ctx F = F_; asm volatile("" : "+v"(F.tid), "+v"(F.lane));
    unsigned char* const ws_ = kws();
    LAS float* scr = (LAS float*)(F.lds + F.wave * 8448);
    unsigned char* base = ws_ + WS_WMIX + WM_ODD_BASE + (size_t)li * WM_ODD_STRIDE;
    bf16_t* WRKV = (bf16_t*)(base + WM_WRKV); bf16_t* WLD = (bf16_t*)(base + WM_WLD); bf16_t* WLU = (bf16_t*)(base + WM_WLU); bf16_t* WO = (bf16_t*)(base + WM_WO);
    const float* w_rkv = kin(10) + (size_t)li * 3 * 1024 * 1024; const float* w_o = kin(11) + (size_t)li * 1024 * 1024;
    const float* w1 = kin(13) + (size_t)li * 1024 * 64; const float* a1 = kin(16) + (size_t)li * 1024 * 64; const float* g1 = kin(21) + (size_t)li * 1024 * 160;
    const float* v1 = kin(19);
    const float* w2 = kin(14) + (size_t)li * 64 * 1024; const float* a2 = kin(17) + (size_t)li * 64 * 1024; const float* g2 = kin(22) + (size_t)li * 160 * 1024; const float* v2 = kin(20);
    const int gw = F.wg * NWAVES + F.wave, NGW = F.G * NWAVES;
    constexpr int I_SQ = 16 * 32;
    constexpr int I_LD = 16 * 8;
    constexpr int I_LU = 4 * 32;
    constexpr int NIT = 4 * I_SQ + 4 * I_LD + 4 * I_LU;
    for (int it = gw; it < NIT; it += NGW) {
        int r = it;
        if (r < 4 * I_SQ) { const int mtx = r / I_SQ, q = r % I_SQ, kb = q / 32, nb = q % 32;
            if (mtx < 3) transpose_item(w_rkv + (size_t)mtx * 1024 * 1024, 1024, WRKV + (size_t)mtx * 1024 * 1024, 1024, kb * 64, nb * 32, nb * 32, scr, F.lane);
            else transpose_item(w_o, 1024, WO, 1024, kb * 64, nb * 32, nb * 32, scr, F.lane);
            continue; }
        r -= 4 * I_SQ;
        if (r < 4 * I_LD) { const int tl = r / I_LD, q = r % I_LD, kb = q / 8, nb = q % 8;
            const float* W = tl == 0 ? w1 : (tl == 1 ? a1 : (tl == 2 ? g1 : v1)); const int nv = tl == 0 ? 64 : (tl == 1 ? 64 : (tl == 2 ? 160 : (li > 0 ? 32 : 0)));
            transpose_item_pad(W, tl == 2 ? 160 : (tl == 3 ? 32 : 64), nv, 1024, WLD + (size_t)tl * 256 * 1024, 1024, kb * 64, nb * 32, nb * 32, scr, F.lane);
            continue; }
        r -= 4 * I_LD;
        { const int tl = r / I_LU, q = r % I_LU, kb = q / 32, nb = q % 32;
            const float* W = tl == 0 ? w2 : (tl == 1 ? a2 : (tl == 2 ? g2 : v2)); const int kv = tl == 0 ? 64 : (tl == 1 ? 64 : (tl == 2 ? 160 : (li > 0 ? 32 : 0)));
            transpose_item_pad(W, 1024, 1024, kv, WLU + (size_t)tl * 1024 * 256, 256, kb * 64, nb * 32, nb * 32, scr, F.lane); }
    }
}
template <int NMIX> __device__ __forceinline__ void odd_mix_phase(const Ctx& F_, int li, int m0, int m1, int m2, int m3) {
    Ctx F = F_; asm volatile("" : "+v"(F.tid), "+v"(F.lane));
    unsigned char* const ws_ = kws();
    const bf16_t* XN = (const bf16_t*)(ws_ + WS_XN); bf16_t* MIX = (bf16_t*)(ws_ + WS_MIX);
    const float* mu = kin(9) + (size_t)li * 6 * 1024;
    const int ids[4] = {m0, m1, m2, m3};
    const int row0 = F.wg * 64 + F.wave * 8;
    f32x4 hp[4];
    { const bool first = (row0 % S) == 0; const v2u* pr = (const v2u*)(XN + (size_t)(row0 - (first ? 0 : 1)) * D) + F.lane;
#pragma unroll
        for (int j = 0; j < 4; ++j) { const v2u w = pr[64 * j]; hp[j] = first ? (f32x4){0.f, 0.f, 0.f, 0.f} : (f32x4){bflo(w.x), bfhi(w.x), bflo(w.y), bfhi(w.y)}; } }
#pragma unroll 1
    for (int r = 0; r < 8; ++r) {
        const int row = row0 + r; const v2u* pr = (const v2u*)(XN + (size_t)row * D) + F.lane;
        f32x4 h[4];
#pragma unroll
        for (int j = 0; j < 4; ++j) { const v2u w = pr[64 * j]; h[j] = (f32x4){bflo(w.x), bfhi(w.x), bflo(w.y), bfhi(w.y)}; }
#pragma unroll
        for (int s = 0; s < NMIX; ++s) {
            v2u* po = (v2u*)(MIX + ((size_t)s * T + row) * D) + F.lane;
#pragma unroll
            for (int j = 0; j < 4; ++j) { const f32x4 m = ((const f32x4*)(mu + ids[s] * 1024))[64 * j + F.lane]; const f32x4 x = h[j] + (hp[j] - h[j]) * m;
                v2u o; o.x = pk2(x.x, x.y); o.y = pk2(x.z, x.w); po[64 * j] = o; }
        }
#pragma unroll
        for (int j = 0; j < 4; ++j) hp[j] = h[j];
    }
}
struct SchedMulti {
    const char* A; const char* Bt; size_t a_tile, a_sel_stride, b_tile; int nN, nwg, G, c, a_shift;
    __device__ __forceinline__ bool next(int i, Unit& u) const { const long L = (long)i * G + c; if (L >= nwg) return false; u.pm = (int)(L / nN); u.pn = (int)(L % nN); return true; }
    __device__ __forceinline__ const char* a_base(const Unit& u) const { return A + (size_t)(u.pn >> a_shift) * a_sel_stride + (size_t)u.pm * a_tile; }
    __device__ __forceinline__ const char* b_base(const Unit& u) const { return Bt + (size_t)u.pn * b_tile; }
    __device__ __forceinline__ void a_ready(const Unit&) const {}
    __device__ __forceinline__ void done(const Unit&) const {}
};
struct EpiRKV {
    static constexpr bool PERM = true, AFTER_DRAIN = false;
    unsigned char* ws; size_t offV;
    __device__ __forceinline__ void operator()(const f32x4 (&acc)[2][2][4][2], const Unit& u, int wr, int wc, int fr, int fq) const {
        const int row0 = u.pm * 256 + wr * 64 + fr, col0 = (u.pn & 3) * 256 + wc * 32 + 8 * fq; const int sel = u.pn >> 2;
        size_t boff = WS_R + (size_t)sel * (WS_K - WS_R); if (sel == 2) boff = offV;
        bf16_t* base = (bf16_t*)(ws + boff);
#pragma unroll
        for (int ai = 0; ai < 2; ++ai)
#pragma unroll
            for (int m = 0; m < 4; ++m) { bf16_t* rowp = base + (size_t)(row0 + ai * 128 + m * 16) * D + col0;
#pragma unroll
                for (int bj = 0; bj < 2; ++bj) { const f32x4 v0 = acc[ai][bj][m][0], v1 = acc[ai][bj][m][1];
                    u32x4 w; w.x = pg8::cvt_pk_bf16(v0[0], v0[1]); w.y = pg8::cvt_pk_bf16(v0[2], v0[3]); w.z = pg8::cvt_pk_bf16(v1[0], v1[1]); w.w = pg8::cvt_pk_bf16(v1[2], v1[3]);
                    *(u32x4*)(rowp + bj * 128) = w; }
                asm volatile("" ::: "memory"); }
    }
};
struct EpiLoraDown {
    static constexpr bool PERM = true, AFTER_DRAIN = false;
    bf16_t* L;
    __device__ __forceinline__ void operator()(const f32x4 (&acc)[2][2][4][2], const Unit& u, int wr, int wc, int fr, int fq) const {
        const int row0 = u.pm * 256 + wr * 64 + fr, col0 = wc * 32 + 8 * fq; const int act = u.pn == 0 ? 1 : (u.pn == 2 ? 2 : 0);
        bf16_t* base = L + (size_t)u.pn * T * 256;
#pragma unroll
        for (int ai = 0; ai < 2; ++ai)
#pragma unroll
            for (int m = 0; m < 4; ++m) { bf16_t* rowp = base + (size_t)(row0 + ai * 128 + m * 16) * 256 + col0;
#pragma unroll
                for (int bj = 0; bj < 2; ++bj) { float h[8];
#pragma unroll
                    for (int n = 0; n < 2; ++n)
#pragma unroll
                        for (int q = 0; q < 4; ++q) { float v = acc[ai][bj][m][n][q];
                            if (act == 1) v = 1.f - 2.f * __builtin_amdgcn_rcpf(1.f + __expf(2.f * v)); else if (act == 2) v = fast_sigmoid(v);
                            h[4 * n + q] = v; }
                    u32x4 w; w.x = pg8::cvt_pk_bf16(h[0], h[1]); w.y = pg8::cvt_pk_bf16(h[2], h[3]); w.z = pg8::cvt_pk_bf16(h[4], h[5]); w.w = pg8::cvt_pk_bf16(h[6], h[7]);
                    *(u32x4*)(rowp + bj * 128) = w; }
                asm volatile("" ::: "memory"); }
    }
};
struct EpiLoraUp {
    static constexpr bool PERM = true, AFTER_DRAIN = false;
    unsigned char* ws; const float* vecs;
    const float *w0, *a0, *v0;
    __device__ __forceinline__ void operator()(const f32x4 (&acc)[2][2][4][2], const Unit& u, int wr, int wc, int fr, int fq) const {
        const int row0 = u.pm * 256 + wr * 64 + fr, col0 = (u.pn & 3) * 256 + wc * 32 + 8 * fq; const int sub = u.pn >> 2;
        f32x4 bv[2][2];
#pragma unroll
        for (int bj = 0; bj < 2; ++bj)
#pragma unroll
            for (int n = 0; n < 2; ++n) { const int cc = col0 + bj * 128 + 4 * n; f32x4 t = (f32x4){0.f, 0.f, 0.f, 0.f};
                if (sub == 0) t = *(const f32x4*)(w0 + cc); else if (sub == 1) t = *(const f32x4*)(a0 + cc); else if (sub == 3) t = *(const f32x4*)(v0 + cc);
                bv[bj][n] = t; }
#pragma unroll
        for (int ai = 0; ai < 2; ++ai)
#pragma unroll
            for (int m = 0; m < 4; ++m) { const size_t off = (size_t)(row0 + ai * 128 + m * 16) * D + col0;
#pragma unroll
                for (int bj = 0; bj < 2; ++bj) {
                    f32x4 v0_ = acc[ai][bj][m][0] + bv[bj][0], v1_ = acc[ai][bj][m][1] + bv[bj][1];
                    if (sub == 0) {
#pragma unroll
                        for (int q = 0; q < 4; ++q) { v0_[q] = -0.8750387749f * fast_sigmoid(v0_[q]); v1_[q] = -0.8750387749f * fast_sigmoid(v1_[q]); }
                        u32x4 w; w.x = pg8::cvt_pk_bf16(v0_[0], v0_[1]); w.y = pg8::cvt_pk_bf16(v0_[2], v0_[3]); w.z = pg8::cvt_pk_bf16(v1_[0], v1_[1]); w.w = pg8::cvt_pk_bf16(v1_[2], v1_[3]);
                        *(u32x4*)((bf16_t*)(ws + WS_WDEC) + off + bj * 128) = w;
                    } else {
                        size_t doff = WS_AV; if (sub == 2) doff = WS_G; if (sub == 3) doff = WS_V;
                        if (sub == 1) {
#pragma unroll
                            for (int q = 0; q < 4; ++q) { v0_[q] = fast_sigmoid(v0_[q]); v1_[q] = fast_sigmoid(v1_[q]); }
                        } else if (sub == 3) {
                            const u32x4 vo = *(const u32x4*)((const bf16_t*)(ws + WS_V) + off + bj * 128), vf = *(const u32x4*)((const bf16_t*)(ws + WS_VFIRST) + off + bj * 128);
                            const f32x4 olo = (f32x4){bflo(vo.x), bfhi(vo.x), bflo(vo.y), bfhi(vo.y)}, ohi = (f32x4){bflo(vo.z), bfhi(vo.z), bflo(vo.w), bfhi(vo.w)};
                            const f32x4 flo = (f32x4){bflo(vf.x), bfhi(vf.x), bflo(vf.y), bfhi(vf.y)}, fhi = (f32x4){bflo(vf.z), bfhi(vf.z), bflo(vf.w), bfhi(vf.w)};
#pragma unroll
                            for (int q = 0; q < 4; ++q) { v0_[q] = olo[q] + (flo[q] - olo[q]) * fast_sigmoid(v0_[q]); v1_[q] = ohi[q] + (fhi[q] - ohi[q]) * fast_sigmoid(v1_[q]); }
                        }
                        u32x4 w; w.x = pg8::cvt_pk_bf16(v0_[0], v0_[1]); w.y = pg8::cvt_pk_bf16(v0_[2], v0_[3]); w.z = pg8::cvt_pk_bf16(v1_[0], v1_[1]); w.w = pg8::cvt_pk_bf16(v1_[2], v1_[3]);
                        *(u32x4*)((bf16_t*)(ws + doff) + off + bj * 128) = w;
                    }
                }
                asm volatile("" ::: "memory"); }
    }
};
__device__ __forceinline__ bf16_t* odd_vbuf(unsigned char* ws_, int li) { return (bf16_t*)(ws_ + (li == 0 ? WS_VFIRST : WS_V)); }
__device__ __forceinline__ void odd_gemm_rkv_phase(const Ctx& F_, int li) {
    Ctx F = F_; asm volatile("" : "+v"(F.tid), "+v"(F.lane));
    unsigned char* const ws_ = kws();
    SchedMulti Sc{(const char*)(ws_ + WS_MIX), (const char*)(ws_ + WS_WMIX + WM_ODD_BASE + (size_t)li * WM_ODD_STRIDE + WM_WRKV), (size_t)256 * 1024 * 2, (size_t)T * D * 2, (size_t)256 * 1024 * 2, 12, 64 * 12, F.G, F.vcu, 2};
    EpiRKV E{ws_, li == 0 ? WS_VFIRST : WS_V};
    pg8::gemm_phase<EpiRKV, SchedMulti, true, true>(F.lds, pg8::Gemm{1024}, Sc, E);
}
__device__ __forceinline__ void odd_gemm_loradown_phase(const Ctx& F_, int li) {
    Ctx F = F_; asm volatile("" : "+v"(F.tid), "+v"(F.lane));
    unsigned char* const ws_ = kws(); const int nN = li == 0 ? 3 : 4;
    SchedMulti Sc{(const char*)(ws_ + WS_MIX), (const char*)(ws_ + WS_WMIX + WM_ODD_BASE + (size_t)li * WM_ODD_STRIDE + WM_WLD), (size_t)256 * 1024 * 2, (size_t)T * D * 2, (size_t)256 * 1024 * 2, nN, 64 * nN, F.G, F.vcu, 0};
    EpiLoraDown E{(bf16_t*)(ws_ + WS_LORA)};
    pg8::gemm_phase<EpiLoraDown, SchedMulti, true, true>(F.lds, pg8::Gemm{1024}, Sc, E);
}
__device__ __forceinline__ void odd_gemm_loraup_phase(const Ctx& F_, int li) {
    Ctx F = F_; asm volatile("" : "+v"(F.tid), "+v"(F.lane));
    unsigned char* const ws_ = kws(); const int nN = li == 0 ? 12 : 16;
    SchedMulti Sc{(const char*)(ws_ + WS_LORA), (const char*)(ws_ + WS_WMIX + WM_ODD_BASE + (size_t)li * WM_ODD_STRIDE + WM_WLU), (size_t)256 * 256 * 2, (size_t)T * 256 * 2, (size_t)256 * 256 * 2, nN, 64 * nN, F.G, F.vcu, 2};
    EpiLoraUp E{ws_, nullptr, kin(12) + li * 1024, kin(15) + li * 1024, kin(18)};
    pg8::gemm_phase<EpiLoraUp, SchedMulti, true, true>(F.lds, pg8::Gemm{256}, Sc, E);
}
__device__ __forceinline__ void odd_gemm_wo_phase(const Ctx& F_, int layer) {
    Ctx F = F_; asm volatile("" : "+v"(F.tid), "+v"(F.lane));
    unsigned char* const ws_ = kws(); float* const x_ = kout();
    SchedStd Sc; Sc.init(ws_ + WS_Y, ws_ + WS_WMIX + WM_ODD_BASE + (size_t)(layer / 2) * WM_ODD_STRIDE + WM_WO, T, 1024, 1024, F.G, F.wg);
    EpiResid E{x_, x_, (const float*)(ws_ + WS_MOD) + (size_t)(layer * 2) * NB * 3072};
    pg8::gemm_phase<EpiResid, SchedStd, true, true>(F.lds, pg8::Gemm{1024}, Sc, E);
}
__device__ __forceinline__ void odd_prep_phase(const Ctx& F_, int li) {
    Ctx F = F_; asm volatile("" : "+v"(F.tid), "+v"(F.lane));
    unsigned char* const ws_ = kws();
    bf16_t* K = (bf16_t*)(ws_ + WS_K); const bf16_t* AV = (const bf16_t*)(ws_ + WS_AV); bf16_t* KK = (bf16_t*)(ws_ + WS_LORA);
    const float* k_k = kin(23) + li * 1024; const float* k_a = kin(24) + li * 1024;
    const int row0 = F.wg * 64 + F.wave * 8;
#pragma unroll 1
    for (int r = 0; r < 8; ++r) {
        const size_t ro = (size_t)(row0 + r) * D;
#pragma unroll
        for (int j = 0; j < 4; ++j) {
            const int e4 = 64 * j + F.lane;
            const v2u kw = ((const v2u*)(K + ro))[e4], aw = ((const v2u*)(AV + ro))[e4];
            const f32x4 kv = (f32x4){bflo(kw.x), bfhi(kw.x), bflo(kw.y), bfhi(kw.y)}, av = (f32x4){bflo(aw.x), bfhi(aw.x), bflo(aw.y), bfhi(aw.y)};
            const f32x4 kkv = kv * ((const f32x4*)k_k)[e4]; const f32x4 ka = ((const f32x4*)k_a)[e4];
            float ss = (kkv.x * kkv.x + kkv.y * kkv.y) + (kkv.z * kkv.z + kkv.w * kkv.w);
            ss += __shfl_xor(ss, 1); ss += __shfl_xor(ss, 2); ss += __shfl_xor(ss, 4); ss += __shfl_xor(ss, 8);
            const float inv = 1.0f / fmaxf(sqrtf(ss), 1e-12f);
            const f32x4 kn = kv * ((av - 1.0f) * ka + 1.0f), kq = kkv * inv;
            v2u o; o.x = pk2(kq.x, kq.y); o.y = pk2(kq.z, kq.w); ((v2u*)(KK + ro))[e4] = o;
            o.x = pk2(kn.x, kn.y); o.y = pk2(kn.z, kn.w); ((v2u*)(K + ro))[e4] = o;
        }
    }
}
__device__ __forceinline__ void odd_wkv_simple_phase(const Ctx& F_, int li) {
    Ctx F = F_; asm volatile("" : "+v"(F.tid), "+v"(F.lane));
    unsigned char* const ws_ = kws();
    const bf16_t* R = (const bf16_t*)(ws_ + WS_R); const bf16_t* K = (const bf16_t*)(ws_ + WS_K); const bf16_t* V = odd_vbuf(ws_, li); const bf16_t* AV = (const bf16_t*)(ws_ + WS_AV);
    const bf16_t* KK = (const bf16_t*)(ws_ + WS_LORA); const float* WD = (const float*)(ws_ + WS_WDEC); bf16_t* Y = (bf16_t*)(ws_ + WS_Y);
    LAS float* st = (LAS float*)F.lds;
    const int gt = F.wg * NTHREADS + F.tid;
    if (gt < NB * 16 * 64) {
        const int vr = gt & 63, hh = (gt >> 6) & 15, b = gt >> 10;
#pragma unroll 4
        for (int i = 0; i < 64; ++i) st[i * NTHREADS + F.tid] = 0.f;
        for (int t = 0; t < S; ++t) {
            const size_t base = ((size_t)b * S + t) * D + hh * 64;
            float sa = 0.f;
#pragma unroll 4
            for (int i = 0; i < 64; ++i) sa -= st[i * NTHREADS + F.tid] * bf2f(KK[base + i]);
            const float vv = bf2f(V[base + vr]); float yv = 0.f;
#pragma unroll 4
            for (int i = 0; i < 64; ++i) { const float kk = bf2f(KK[base + i]); const float sn = st[i * NTHREADS + F.tid] * WD[base + i] + sa * (kk * bf2f(AV[base + i])) + vv * bf2f(K[base + i]); st[i * NTHREADS + F.tid] = sn; yv += sn * bf2f(R[base + i]); }
            Y[base + vr] = (bf16_t)f2bf(yv);
        }
    }
}
__device__ __forceinline__ void odd_post_phase(const Ctx& F_, int li) {
    Ctx F = F_; asm volatile("" : "+v"(F.tid), "+v"(F.lane));
    unsigned char* const ws_ = kws();
    const bf16_t* R = (const bf16_t*)(ws_ + WS_R); const bf16_t* K = (const bf16_t*)(ws_ + WS_K); const bf16_t* V = odd_vbuf(ws_, li); const bf16_t* G = (const bf16_t*)(ws_ + WS_G); bf16_t* Y = (bf16_t*)(ws_ + WS_Y);
    const float* r_k = kin(25) + li * 1024; const float* ln_w = kin(26) + li * 1024; const float* ln_b = kin(27) + li * 1024;
    const int row0 = F.wg * 64 + F.wave * 8;
#pragma unroll 1
    for (int r = 0; r < 8; ++r) {
        const size_t ro = (size_t)(row0 + r) * D;
#pragma unroll
        for (int j = 0; j < 4; ++j) {
            const int e4 = 64 * j + F.lane;
            const v2u yw = ((const v2u*)(Y + ro))[e4], rw = ((const v2u*)(R + ro))[e4], kw = ((const v2u*)(K + ro))[e4], vw = ((const v2u*)(V + ro))[e4], gw_ = ((const v2u*)(G + ro))[e4];
            const f32x4 y = (f32x4){bflo(yw.x), bfhi(yw.x), bflo(yw.y), bfhi(yw.y)}, rr = (f32x4){bflo(rw.x), bfhi(rw.x), bflo(rw.y), bfhi(rw.y)}, kk = (f32x4){bflo(kw.x), bfhi(kw.x), bflo(kw.y), bfhi(kw.y)};
            const f32x4 vv = (f32x4){bflo(vw.x), bfhi(vw.x), bflo(vw.y), bfhi(vw.y)}, gg = (f32x4){bflo(gw_.x), bfhi(gw_.x), bflo(gw_.y), bfhi(gw_.y)};
            float s1 = (y.x + y.y) + (y.z + y.w);
            s1 += __shfl_xor(s1, 1); s1 += __shfl_xor(s1, 2); s1 += __shfl_xor(s1, 4); s1 += __shfl_xor(s1, 8);
            const float mean = s1 * (1.f / 64.f); const f32x4 d = y - mean;
            float s2 = (d.x * d.x + d.y * d.y) + (d.z * d.z + d.w * d.w);
            s2 += __shfl_xor(s2, 1); s2 += __shfl_xor(s2, 2); s2 += __shfl_xor(s2, 4); s2 += __shfl_xor(s2, 8);
            const float rstd = 1.0f / sqrtf(s2 * (1.f / 64.f) + 64e-5f);
            const f32x4 rk4 = rr * kk * ((const f32x4*)r_k)[e4]; float s3 = (rk4.x + rk4.y) + (rk4.z + rk4.w);
            s3 += __shfl_xor(s3, 1); s3 += __shfl_xor(s3, 2); s3 += __shfl_xor(s3, 4); s3 += __shfl_xor(s3, 8);
            const f32x4 o = (d * rstd * ((const f32x4*)ln_w)[e4] + ((const f32x4*)ln_b)[e4] + vv * s3) * gg;
            v2u w; w.x = pk2(o.x, o.y); w.y = pk2(o.z, o.w); ((v2u*)(Y + ro))[e4] = w;
        }
    }
}
}
namespace fm {
constexpr size_t WS_WKVS = WS_LORA;
constexpr size_t SM_RK = SM_ZSS;
constexpr int LX_WC = 8192;
constexpr float LOG2E = 1.4426950408889634f;
__device__ __forceinline__ bf16x8 pk8lo(const f32x16& a) { v4u w; w.x = cvtpk(a[0], a[1]); w.y = cvtpk(a[2], a[3]); w.z = cvtpk(a[4], a[5]); w.w = cvtpk(a[6], a[7]); return __builtin_bit_cast(bf16x8, w); }
__device__ __forceinline__ bf16x8 pk8hi(const f32x16& a) { v4u w; w.x = cvtpk(a[8], a[9]); w.y = cvtpk(a[10], a[11]); w.z = cvtpk(a[12], a[13]); w.w = cvtpk(a[14], a[15]); return __builtin_bit_cast(bf16x8, w); }
struct PH { bf16x8 f0, f1; };
__device__ __forceinline__ PH packh(const f32x16& a) { PH p; p.f0 = pk8lo(a); p.f1 = pk8hi(a); return p; }
__device__ __forceinline__ f32x16 zero16() { f32x16 z;
#pragma unroll
    for (int r = 0; r < 16; ++r) z[r] = 0.f; return z; }
#define MFMA32(a, b, c) __builtin_amdgcn_mfma_f32_32x32x16_bf16((a), (b), (c), 0, 0, 0)
__device__ __forceinline__ f32x16 ident16(int lane) { int l = lane; asm volatile("" : "+v"(l)); f32x16 z;
#pragma unroll
    for (int r = 0; r < 16; ++r) z[r] = (((r & 3) + 8 * (r >> 2) + 4 * (l >> 5)) == (l & 31)) ? 1.f : 0.f; return z; }
__device__ __forceinline__ f32x16 tt(const PH& U, const PH& W, f32x16 C) { C = MFMA32(U.f0, W.f0, C); C = MFMA32(U.f1, W.f1, C); return C; }
__device__ __forceinline__ bf16x8 colfrag(const LAS unsigned char* mat, int nt, int s, int lane) {
    const int g4 = lane >> 4, i16 = lane & 15, h2 = lane >> 5;
    const LAS unsigned char* p = mat + (16 * s + 4 * h2 + (i16 >> 2)) * 128 + (32 * nt + 16 * (g4 & 1) + 4 * (i16 & 3)) * 2;
    const s16x4 lo = tr_read(p), hi = tr_read(p + 8 * 128);
    return (bf16x8){lo[0], lo[1], lo[2], lo[3], hi[0], hi[1], hi[2], hi[3]};
}
__device__ __forceinline__ PH colph(const LAS unsigned char* mat, int nt, int lane) { PH p; p.f0 = colfrag(mat, nt, 0, lane); p.f1 = colfrag(mat, nt, 1, lane); return p; }
__device__ __forceinline__ f32x4 unpk4(v2u w) { return (f32x4){bflo(w.x), bfhi(w.x), bflo(w.y), bfhi(w.y)}; }
__device__ __forceinline__ v2u pk4(f32x4 v) { v2u o; o.x = cvtpk(v.x, v.y); o.y = cvtpk(v.z, v.w); return o; }
__device__ __forceinline__ void store_rowgroups(bf16_t* rowp  , const f32x16& a, int h2) {
#pragma unroll
    for (int g = 0; g < 4; ++g) *(v2u*)(rowp + 8 * g + 4 * h2) = pk4((f32x4){a[4 * g], a[4 * g + 1], a[4 * g + 2], a[4 * g + 3]});
}

__device__ __forceinline__ void wkv1_task(unsigned char* ws_, const float* k_k, const float* k_a, const float* r_k, int li, int b, int hh, int sc, LAS unsigned char* wl, LAS float* wct, int lane_in) {
    int lane = lane_in; int t32 = lane & 31, h2 = lane >> 5;
    const bf16_t* Rg = (const bf16_t*)(ws_ + WS_R); const bf16_t* Kg = (const bf16_t*)(ws_ + WS_K); const bf16_t* Vg = odd_vbuf(ws_, li);
    bf16_t* AVg = (bf16_t*)(ws_ + WS_AV); bf16_t* LWg = (bf16_t*)(ws_ + WS_WDEC); float* RKg = (float*)(ws_ + WS_SMALL + SM_RK);
    LAS unsigned char* ldsA = wl; LAS unsigned char* ldsB = wl + 4096; LAS unsigned char* ldsK = wl + 8192; LAS unsigned char* ldsV = wl + 12288;
    PH Gh[2][2], Hh[2][2];
    { const PH ip = packh(ident16(lane)), zp = packh(zero16()); Gh[0][0] = ip; Gh[1][1] = ip; Gh[0][1] = zp; Gh[1][0] = zp; Hh[0][0] = zp; Hh[0][1] = zp; Hh[1][0] = zp; Hh[1][1] = zp; }
#pragma unroll 1
    for (int j = 0; j < 4; ++j) {
        lane = lane_in; asm volatile("" : "+v"(lane)); t32 = lane & 31; h2 = lane >> 5;
        const size_t rowoff = ((size_t)b * S + sc * 128 + j * 32 + t32) * D + hh * 64;
        PH fA[2], fB[2], fK[2], fR[2];
        float inv;
        {
            float nrm = 0.f, rk = 0.f;
#pragma unroll
            for (int g = 0; g < 8; ++g) {
                const int k0 = 8 * g + 4 * h2;
                const f32x4 rr = unpk4(*(const v2u*)(Rg + rowoff + k0)), ko = unpk4(*(const v2u*)(Kg + rowoff + k0)), av = unpk4(*(const v2u*)(AVg + rowoff + k0));
                const f32x4 kkw = *(const f32x4*)(k_k + hh * 64 + k0), kaw = *(const f32x4*)(k_a + hh * 64 + k0), rkw = *(const f32x4*)(r_k + hh * 64 + k0);
                const f32x4 kq = ko * kkw; nrm += (kq.x * kq.x + kq.y * kq.y) + (kq.z * kq.z + kq.w * kq.w);
                const f32x4 t3 = rr * (ko * ((av - 1.0f) * kaw + 1.0f)) * rkw; rk += (t3.x + t3.y) + (t3.z + t3.w);
                *(LAS v2u*)(ldsV + t32 * 128 + k0 * 2) = *(const v2u*)(Vg + rowoff + k0);
            }
            nrm += __shfl_xor(nrm, 32); rk += __shfl_xor(rk, 32);
            if (h2 == 0) RKg[((size_t)b * S + sc * 128 + j * 32 + t32) * 16 + hh] = rk;
            inv = 1.0f / fmaxf(sqrtf(nrm), 1e-12f);
            asm volatile("" ::: "memory");
        }
#pragma unroll
        for (int ks = 0; ks < 4; ++ks) {
            float cum[8], lw0[8], kk1[8], aa[8], kpp[8], rr1[8];
#pragma unroll
            for (int gg = 0; gg < 2; ++gg) {
                const int g = 2 * ks + gg, k0 = 8 * g + 4 * h2;
                const f32x4 rr = unpk4(*(const v2u*)(Rg + rowoff + k0)), ko = unpk4(*(const v2u*)(Kg + rowoff + k0)), av = unpk4(*(const v2u*)(AVg + rowoff + k0)), lw = unpk4(*(const v2u*)(LWg + rowoff + k0));
                const f32x4 kkw = *(const f32x4*)(k_k + hh * 64 + k0), kaw = *(const f32x4*)(k_a + hh * 64 + k0);
                const f32x4 kq = ko * kkw * inv, kp = ko * ((av - 1.0f) * kaw + 1.0f);
#pragma unroll
                for (int q = 0; q < 4; ++q) { cum[4 * gg + q] = lw[q]; lw0[4 * gg + q] = lw[q]; kk1[4 * gg + q] = kq[q]; aa[4 * gg + q] = av[q]; kpp[4 * gg + q] = kp[q]; rr1[4 * gg + q] = rr[q]; }
            }
#pragma unroll
            for (int d = 1; d < 32; d <<= 1) {
#pragma unroll
                for (int e = 0; e < 8; ++e) { const float up = __shfl_up(cum[e], d, 32); cum[e] += (t32 >= d) ? up : 0.f; }
            }
            if (t32 == 31) {
#pragma unroll
                for (int gg = 0; gg < 2; ++gg) *(LAS f32x4*)(wct + 8 * (2 * ks + gg) + 4 * h2) = (f32x4){__builtin_amdgcn_exp2f(cum[4 * gg]), __builtin_amdgcn_exp2f(cum[4 * gg + 1]), __builtin_amdgcn_exp2f(cum[4 * gg + 2]), __builtin_amdgcn_exp2f(cum[4 * gg + 3])};
            }
            float a_[8], b_[8], k_[8], r_[8];
#pragma unroll
            for (int e = 0; e < 8; ++e) {
                const float wt = __builtin_amdgcn_exp2f(cum[e]), wp = __builtin_amdgcn_exp2f(cum[e] - lw0[e]), iw = __builtin_amdgcn_exp2f(-cum[e]);
                a_[e] = -kk1[e] * wp; b_[e] = kk1[e] * aa[e] * iw; k_[e] = kpp[e] * iw; r_[e] = rr1[e] * wt;
            }
            v4u pa, pb, pk, pr;
            pa.x = cvtpk(a_[0], a_[1]); pa.y = cvtpk(a_[2], a_[3]); pa.z = cvtpk(a_[4], a_[5]); pa.w = cvtpk(a_[6], a_[7]);
            pb.x = cvtpk(b_[0], b_[1]); pb.y = cvtpk(b_[2], b_[3]); pb.z = cvtpk(b_[4], b_[5]); pb.w = cvtpk(b_[6], b_[7]);
            pk.x = cvtpk(k_[0], k_[1]); pk.y = cvtpk(k_[2], k_[3]); pk.z = cvtpk(k_[4], k_[5]); pk.w = cvtpk(k_[6], k_[7]);
            pr.x = cvtpk(r_[0], r_[1]); pr.y = cvtpk(r_[2], r_[3]); pr.z = cvtpk(r_[4], r_[5]); pr.w = cvtpk(r_[6], r_[7]);
#pragma unroll
            for (int gg = 0; gg < 2; ++gg) {
                const int k0 = 8 * (2 * ks + gg) + 4 * h2;
                *(LAS v2u*)(ldsA + t32 * 128 + k0 * 2) = gg == 0 ? (v2u){pa.x, pa.y} : (v2u){pa.z, pa.w};
                *(LAS v2u*)(ldsB + t32 * 128 + k0 * 2) = gg == 0 ? (v2u){pb.x, pb.y} : (v2u){pb.z, pb.w};
                *(LAS v2u*)(ldsK + t32 * 128 + k0 * 2) = gg == 0 ? (v2u){pk.x, pk.y} : (v2u){pk.z, pk.w};
            }
            if ((ks & 1) == 0) { fA[ks >> 1].f0 = __builtin_bit_cast(bf16x8, pa); fB[ks >> 1].f0 = __builtin_bit_cast(bf16x8, pb); fK[ks >> 1].f0 = __builtin_bit_cast(bf16x8, pk); fR[ks >> 1].f0 = __builtin_bit_cast(bf16x8, pr); }
            else { fA[ks >> 1].f1 = __builtin_bit_cast(bf16x8, pa); fB[ks >> 1].f1 = __builtin_bit_cast(bf16x8, pb); fK[ks >> 1].f1 = __builtin_bit_cast(bf16x8, pk); fR[ks >> 1].f1 = __builtin_bit_cast(bf16x8, pr); }
            asm volatile("" ::: "memory");
        }
        asm volatile("s_waitcnt lgkmcnt(0)" ::: "memory");
        PH pN, pNT, pAakT, pArbT, pArkT; f32x16 PT;
        {
#define KPROD(dst, fa, fb, keep) { f32x16 acc_ = tt(fa[1], fb[1], tt(fa[0], fb[0], zero16())); _Pragma("unroll") for (int r = 0; r < 16; ++r) { const int rowi = (r & 3) + 8 * (r >> 2) + 4 * h2; acc_[r] = (keep) ? acc_[r] : 0.f; } dst; __builtin_amdgcn_sched_barrier(0); }
            KPROD(pN = packh(acc_), fA, fB, t32 < rowi)
            KPROD(PT = ident16(lane) + acc_; pNT = packh(acc_), fB, fA, rowi < t32)
            KPROD(pAakT = packh(acc_), fK, fA, rowi < t32)
            KPROD(pArbT = packh(acc_), fB, fR, rowi <= t32)
            KPROD(pArkT = packh(acc_), fK, fR, rowi <= t32)
#undef KPROD
        }
        {
            PH X = pN, XT = pNT;
#pragma unroll
            for (int step = 0; step < 4; ++step) {
                const f32x16 x2 = tt(XT, X, zero16());
                if (step < 3) { const f32x16 xt2 = tt(X, XT, zero16()); XT = packh(xt2); }
                X = packh(x2);
                PT = tt(X, packh(PT), PT);
            }
        }
        const PH pPT = packh(PT);
        PH pAp[2], pUl[2];
#pragma unroll
        for (int nt = 0; nt < 2; ++nt) {
            pAp[nt] = packh(tt(pPT, colph(ldsA, nt, lane), zero16()));
            const PH x1 = packh(tt(pAakT, colph(ldsV, nt, lane), zero16()));
            pUl[nt] = packh(tt(pPT, x1, zero16()));
        }
        PH pRp[2]; f32x16 YlT[2];
#pragma unroll
        for (int mt = 0; mt < 2; ++mt) {
            f32x16 c0;
#pragma unroll
            for (int q = 0; q < 8; ++q) { c0[q] = bf2f((unsigned short)fR[mt].f0[q]); c0[8 + q] = bf2f((unsigned short)fR[mt].f1[q]); }
            pRp[mt] = packh(tt(pAp[mt], pArbT, c0));
            YlT[mt] = tt(colph(ldsV, mt, lane), pArkT, tt(pUl[mt], pArbT, zero16()));
        }
#pragma unroll
        for (int mt = 0; mt < 2; ++mt) {
            const f32x16 rpp = tt(Gh[1][mt], pRp[1], tt(Gh[0][mt], pRp[0], zero16()));
            store_rowgroups(AVg + rowoff + 32 * mt, rpp, h2);
            const f32x16 yl = tt(Hh[1][mt], pRp[1], tt(Hh[0][mt], pRp[0], YlT[mt]));
            store_rowgroups(LWg + rowoff + 32 * mt, yl, h2);
        }
        lane = lane_in; asm volatile("" : "+v"(lane)); t32 = lane & 31; h2 = lane >> 5;
        PH pM[2][2];
#pragma unroll
        for (int mt = 0; mt < 2; ++mt)
#pragma unroll
            for (int nt = 0; nt < 2; ++nt) {
                f32x16 m = tt(pAp[mt], colph(ldsB, nt, lane), mt == nt ? ident16(lane) : zero16());
                const float wc = wct[32 * nt + t32];
#pragma unroll
                for (int r = 0; r < 16; ++r) m[r] *= wc;
                pM[mt][nt] = packh(m);
            }
#pragma unroll
        for (int nt = 0; nt < 2; ++nt) {
            PH gn[2], hn[2];
#pragma unroll
            for (int mt = 0; mt < 2; ++mt) {
                f32x16 hq = tt(colph(ldsK, mt, lane), colph(ldsV, nt, lane), tt(colph(ldsB, mt, lane), pUl[nt], zero16()));
#pragma unroll
                for (int g = 0; g < 4; ++g) { const f32x4 wc4 = *(const LAS f32x4*)(wct + 32 * mt + 8 * g + 4 * h2);
#pragma unroll
                    for (int q = 0; q < 4; ++q) hq[4 * g + q] *= wc4[q]; }
                hn[mt] = packh(tt(pM[1][mt], Hh[1][nt], tt(pM[0][mt], Hh[0][nt], hq)));
                gn[mt] = packh(tt(pM[1][mt], Gh[1][nt], tt(pM[0][mt], Gh[0][nt], zero16())));
            }
            Gh[0][nt] = gn[0]; Gh[1][nt] = gn[1]; Hh[0][nt] = hn[0]; Hh[1][nt] = hn[1];
        }
        asm volatile("s_waitcnt lgkmcnt(0)" ::: "memory");
    }
    lane = lane_in; asm volatile("" : "+v"(lane)); t32 = lane & 31; h2 = lane >> 5;
    unsigned char* outp = ws_ + WS_WKVS + ((size_t)((b * 16 + hh) * 16 + sc)) * 16384;
#pragma unroll
    for (int kt = 0; kt < 2; ++kt) {
#pragma unroll
        for (int mt = 0; mt < 2; ++mt) {
            const v4u w0 = __builtin_bit_cast(v4u, Gh[mt][kt].f0), w1 = __builtin_bit_cast(v4u, Gh[mt][kt].f1);
            LAS unsigned char* rowp = wl + 4096 * kt + t32 * 128 + (32 * mt + 4 * h2) * 2;
            *(LAS v2u*)(rowp + 0) = (v2u){w0.x, w0.y}; *(LAS v2u*)(rowp + 16) = (v2u){w0.z, w0.w}; *(LAS v2u*)(rowp + 32) = (v2u){w1.x, w1.y}; *(LAS v2u*)(rowp + 48) = (v2u){w1.z, w1.w};
        }
    }
    asm volatile("s_waitcnt lgkmcnt(0)" ::: "memory");
#pragma unroll
    for (int kt = 0; kt < 2; ++kt)
#pragma unroll
        for (int mt = 0; mt < 2; ++mt)
#pragma unroll
            for (int s = 0; s < 2; ++s) *(bf16x8*)(outp + ((size_t)((kt * 2 + mt) * 2 + s) * 64 + lane) * 16) = colfrag(wl + 4096 * kt, mt, s, lane);
#pragma unroll
    for (int mt = 0; mt < 2; ++mt)
#pragma unroll
        for (int nt = 0; nt < 2; ++nt) { *(bf16x8*)(outp + 8192 + ((size_t)((mt * 2 + nt) * 2 + 0) * 64 + lane) * 16) = Hh[mt][nt].f0; *(bf16x8*)(outp + 8192 + ((size_t)((mt * 2 + nt) * 2 + 1) * 64 + lane) * 16) = Hh[mt][nt].f1; }
    asm volatile("s_waitcnt lgkmcnt(0)" ::: "memory");
}
__device__ __forceinline__ void odd_wkv1_phase(const Ctx& F_, int li) {
    Ctx F = F_; asm volatile("" : "+v"(F.tid), "+v"(F.lane));
    unsigned char* const ws_ = kws();
    const int task = F.wg * NWAVES + F.wave;
    const int sc = task & 15, hh = (task >> 4) & 15, b = task >> 8;
    wkv1_task(ws_, kin(23) + li * 1024, kin(24) + li * 1024, kin(25) + li * 1024, li, b, hh, sc, F.lds + F.wave * 16384, (LAS float*)(F.lds + LDSCTL_OFF + LX_WC + F.wave * 256), F.lane);
}
__device__ __forceinline__ void odd_wkv2_phase(const Ctx& F_, int li) {
    Ctx F = F_; asm volatile("" : "+v"(F.tid), "+v"(F.lane));
    unsigned char* const ws_ = kws();
    if (F.wave != 0 || F.wg >= 128) return;
    const int lane = F.lane, t32 = lane & 31, h2 = lane >> 5, b = F.wg >> 4, hh = F.wg & 15;
    const bf16_t* RPP = (const bf16_t*)(ws_ + WS_AV); const bf16_t* YL = (const bf16_t*)(ws_ + WS_WDEC); const bf16_t* Vg = odd_vbuf(ws_, li); const bf16_t* Gg = (const bf16_t*)(ws_ + WS_G);
    const float* RKg = (const float*)(ws_ + WS_SMALL + SM_RK); bf16_t* OA = (bf16_t*)(ws_ + WS_Y);
    const float* ln_w = kin(26) + li * 1024 + hh * 64; const float* ln_b = kin(27) + li * 1024 + hh * 64;
    f32x16 Z[2][2];
#pragma unroll
    for (int a = 0; a < 2; ++a)
#pragma unroll
        for (int c = 0; c < 2; ++c) Z[a][c] = zero16();
#pragma unroll 1
    for (int sc = 0; sc < 16; ++sc) {
        const unsigned char* sp = ws_ + WS_WKVS + ((size_t)((b * 16 + hh) * 16 + sc)) * 16384;
        PH pZ[2][2];
#pragma unroll
        for (int a = 0; a < 2; ++a)
#pragma unroll
            for (int c = 0; c < 2; ++c) pZ[a][c] = packh(Z[a][c]);
#pragma unroll 1
        for (int j = 0; j < 4; ++j) {
            const size_t trow = (size_t)b * S + sc * 128 + j * 32 + t32, rowoff = trow * D + hh * 64;
            PH rp[2];
#pragma unroll
            for (int kt = 0; kt < 2; ++kt) {
                const v2u a0 = *(const v2u*)(RPP + rowoff + 32 * kt + 4 * h2), a1 = *(const v2u*)(RPP + rowoff + 32 * kt + 8 + 4 * h2), a2 = *(const v2u*)(RPP + rowoff + 32 * kt + 16 + 4 * h2), a3 = *(const v2u*)(RPP + rowoff + 32 * kt + 24 + 4 * h2);
                rp[kt].f0 = __builtin_bit_cast(bf16x8, (v4u){a0.x, a0.y, a1.x, a1.y}); rp[kt].f1 = __builtin_bit_cast(bf16x8, (v4u){a2.x, a2.y, a3.x, a3.y});
            }
            f32x16 y[2];
#pragma unroll
            for (int mt = 0; mt < 2; ++mt) {
                f32x16 c0;
#pragma unroll
                for (int g = 0; g < 4; ++g) { const f32x4 q4 = unpk4(*(const v2u*)(YL + rowoff + 32 * mt + 8 * g + 4 * h2)); c0[4 * g] = q4.x; c0[4 * g + 1] = q4.y; c0[4 * g + 2] = q4.z; c0[4 * g + 3] = q4.w; }
                y[mt] = tt(pZ[1][mt], rp[1], tt(pZ[0][mt], rp[0], c0));
            }
            float s1 = 0.f;
#pragma unroll
            for (int mt = 0; mt < 2; ++mt)
#pragma unroll
                for (int r = 0; r < 16; ++r) s1 += y[mt][r];
            s1 += __shfl_xor(s1, 32);
            const float mean = s1 * (1.f / 64.f); float s2 = 0.f;
#pragma unroll
            for (int mt = 0; mt < 2; ++mt)
#pragma unroll
                for (int r = 0; r < 16; ++r) { const float dd = y[mt][r] - mean; s2 += dd * dd; }
            s2 += __shfl_xor(s2, 32);
            const float rstd = 1.0f / sqrtf(s2 * (1.f / 64.f) + 64e-5f), rk = RKg[trow * 16 + hh];
#pragma unroll
            for (int mt = 0; mt < 2; ++mt)
#pragma unroll
                for (int g = 0; g < 4; ++g) { const int c0 = 32 * mt + 8 * g + 4 * h2;
                    const f32x4 vv = unpk4(*(const v2u*)(Vg + rowoff + c0)), gg = unpk4(*(const v2u*)(Gg + rowoff + c0)), lw = *(const f32x4*)(ln_w + c0), lb = *(const f32x4*)(ln_b + c0);
                    const f32x4 yy = (f32x4){y[mt][4 * g], y[mt][4 * g + 1], y[mt][4 * g + 2], y[mt][4 * g + 3]};
                    const f32x4 o = ((yy - mean) * rstd * lw + lb + vv * rk) * gg;
                    *(v2u*)(OA + rowoff + c0) = pk4(o); }
        }
        f32x16 Zn[2][2];
#pragma unroll
        for (int mt = 0; mt < 2; ++mt)
#pragma unroll
            for (int nt = 0; nt < 2; ++nt) {
                const bf16x8 h0 = *(const bf16x8*)(sp + 8192 + ((size_t)((mt * 2 + nt) * 2 + 0) * 64 + lane) * 16), h1 = *(const bf16x8*)(sp + 8192 + ((size_t)((mt * 2 + nt) * 2 + 1) * 64 + lane) * 16);
                f32x16 c0;
#pragma unroll
                for (int q = 0; q < 8; ++q) { c0[q] = bf2f((unsigned short)h0[q]); c0[8 + q] = bf2f((unsigned short)h1[q]); }
#pragma unroll
                for (int kt = 0; kt < 2; ++kt) { PH mf; mf.f0 = *(const bf16x8*)(sp + ((size_t)((kt * 2 + mt) * 2 + 0) * 64 + lane) * 16); mf.f1 = *(const bf16x8*)(sp + ((size_t)((kt * 2 + mt) * 2 + 1) * 64 + lane) * 16); c0 = tt(mf, pZ[kt][nt], c0); }
                Zn[mt][nt] = c0;
            }
#pragma unroll
        for (int a = 0; a < 2; ++a)
#pragma unroll
            for (int c = 0; c < 2; ++c) Z[a][c] = Zn[a][c];
    }
}
}
namespace fm {
__device__ __forceinline__ void ada_phase(const Ctx& F_) {
    Ctx F = F_; asm volatile("" : "+v"(F.tid), "+v"(F.lane));
    unsigned char* const ws_ = kws(); const float* c = kin(1); const float* ada_w = kin(2); const float* ada_b = kin(3);
    float* mod = (float*)(ws_ + WS_MOD);
    LAS float* cs = (LAS float*)F.lds;
    LAS float* part = (LAS float*)(F.lds + 32768);
    for (int i = F.tid; i < 8 * 1024; i += NTHREADS) { const float v = c[i]; cs[i] = v / (1.f + __expf(-v)); }
    __syncthreads();
#pragma unroll 1
    for (int task = F.wg; task < 8 * 48; task += F.G) {
        const int ls = task / 48, n0 = (task % 48) * 64;
        const float* W = ada_w + ((size_t)ls * 1024 + F.wave * 128) * 3072 + n0 + F.lane;
        float acc[8];
#pragma unroll
        for (int b = 0; b < 8; ++b) acc[b] = 0.f;
#pragma unroll 1
        for (int k0 = 0; k0 < 128; k0 += 16) {
            float w[16];
#pragma unroll
            for (int i = 0; i < 16; ++i) w[i] = W[(size_t)(k0 + i) * 3072];
#pragma unroll
            for (int i = 0; i < 16; ++i)
#pragma unroll
                for (int b = 0; b < 8; ++b) acc[b] += cs[b * 1024 + F.wave * 128 + k0 + i] * w[i];
        }
#pragma unroll
        for (int b = 0; b < 8; ++b) part[(F.wave * 8 + b) * 64 + F.lane] = acc[b];
        __syncthreads();
        { const int b = F.tid >> 6, l = F.tid & 63; float s = 0.f;
#pragma unroll
            for (int w8 = 0; w8 < 8; ++w8) s += part[(w8 * 8 + b) * 64 + l];
            mod[((size_t)ls * NB + b) * 3072 + n0 + l] = s + ada_b[ls * 3072 + n0 + l]; }
        __syncthreads();
    }
}
__device__ __forceinline__ void norm_phase(const Ctx& F_, int ls, int comb, const float* xsrc) {
    Ctx F = F_; asm volatile("" : "+v"(F.tid), "+v"(F.lane));
    unsigned char* const ws_ = kws(); float* const xo = kout(); const float* const mod_ = (const float*)(ws_ + WS_MOD);
    bf16_t* XN = (bf16_t*)(ws_ + WS_XN); const bf16_t* YS = (const bf16_t*)(ws_ + WS_YS);
    const int row0 = F.wg * 64 + F.wave * 8, b = row0 / S;
    const float* m = mod_ + ((size_t)ls * NB + b) * 3072;
    const float* gm = mod_ + ((size_t)(comb < 0 ? 0 : comb * 2 + 1) * NB + b) * 3072 + 2048;
#pragma unroll 1
    for (int r = 0; r < 8; ++r) {
        const int row = row0 + r;
        const f32x4* xr = (const f32x4*)(xsrc + (size_t)row * D) + F.lane;
        f32x4 v[4]; float ss = 0.f;
#pragma unroll
        for (int j = 0; j < 4; ++j) v[j] = xr[64 * j];
        if (comb >= 0) {
            const v2u* y0 = (const v2u*)(YS + (size_t)row * D) + F.lane; const v2u* y1 = (const v2u*)(YS + ((size_t)T + row) * D) + F.lane;
            f32x4* xw = (f32x4*)(xo + (size_t)row * D) + F.lane;
#pragma unroll
            for (int j = 0; j < 4; ++j) { const v2u a = y0[64 * j], c = y1[64 * j]; const f32x4 g = ((const f32x4*)gm)[64 * j + F.lane];
                v[j].x += g.x * (bflo(a.x) + bflo(c.x)); v[j].y += g.y * (bfhi(a.x) + bfhi(c.x)); v[j].z += g.z * (bflo(a.y) + bflo(c.y)); v[j].w += g.w * (bfhi(a.y) + bfhi(c.y));
                xw[64 * j] = v[j]; }
        }
#pragma unroll
        for (int j = 0; j < 4; ++j) ss += (v[j].x * v[j].x + v[j].y * v[j].y) + (v[j].z * v[j].z + v[j].w * v[j].w);
        const float rinv = 1.0f / sqrtf(wave_sum(ss) * (1.f / D) + 1e-6f);
        unsigned long long* o8 = (unsigned long long*)(XN + (size_t)row * D) + F.lane;
#pragma unroll
        for (int j = 0; j < 4; ++j) {
            const f32x4 sh = ((const f32x4*)m)[64 * j + F.lane], sc = ((const f32x4*)(m + 1024))[64 * j + F.lane];
            const f32x4 h = v[j] * rinv * (sc + 1.0f) + sh;
            o8[64 * j] = (unsigned long long)pk2(h.x, h.y) | ((unsigned long long)pk2(h.z, h.w) << 32);
        }
    }
}
__device__ __forceinline__ void final_phase(const Ctx& F_) {
    Ctx F = F_; asm volatile("" : "+v"(F.tid), "+v"(F.lane));
    unsigned char* const ws_ = kws(); float* const xo = kout(); const float* const mod_ = (const float*)(ws_ + WS_MOD); const float* fg = kin(33);
    const bf16_t* YS = (const bf16_t*)(ws_ + WS_YS);
    const int row0 = F.wg * 64 + F.wave * 8, b = row0 / S;
    const float* gm = mod_ + ((size_t)(3 * 2 + 1) * NB + b) * 3072 + 2048;
#pragma unroll 1
    for (int r = 0; r < 8; ++r) {
        const int row = row0 + r;
        f32x4* xr = (f32x4*)(xo + (size_t)row * D) + F.lane;
        const v2u* y0 = (const v2u*)(YS + (size_t)row * D) + F.lane; const v2u* y1 = (const v2u*)(YS + ((size_t)T + row) * D) + F.lane;
        f32x4 v[4]; float ss = 0.f;
#pragma unroll
        for (int j = 0; j < 4; ++j) { v[j] = xr[64 * j]; const v2u a = y0[64 * j], c = y1[64 * j]; const f32x4 g = ((const f32x4*)gm)[64 * j + F.lane];
            v[j].x += g.x * (bflo(a.x) + bflo(c.x)); v[j].y += g.y * (bfhi(a.x) + bfhi(c.x)); v[j].z += g.z * (bflo(a.y) + bflo(c.y)); v[j].w += g.w * (bfhi(a.y) + bfhi(c.y));
            ss += (v[j].x * v[j].x + v[j].y * v[j].y) + (v[j].z * v[j].z + v[j].w * v[j].w); }
        const float rinv = 1.0f / sqrtf(wave_sum(ss) * (1.f / D) + 1e-6f);
#pragma unroll
        for (int j = 0; j < 4; ++j) xr[64 * j] = v[j] * rinv * ((const f32x4*)fg)[64 * j + F.lane];
    }
}
}
struct Args { const float* in[34]; float* out; unsigned char* ws; };
__global__ void __launch_bounds__(NTHREADS, 2) mega_fwd(Args args) {
    (void)args;
    extern __shared__ __attribute__((aligned(16))) unsigned char lds[];
    LAS unsigned char* L = (LAS unsigned char*)lds;
    for (int u = threadIdx.x; u < (LDS_BYTES - LDSCTL_OFF) / 4; u += NTHREADS) ((LAS unsigned*)(L + LDSCTL_OFF))[u] = 0u;
    __syncthreads();
    (void)xcd_barrier_post((unsigned*)(kws() + fm::WS_CTL), (volatile LAS unsigned*)(L + MISC_OFF) + 8);
    fm::Ctx F; F.lds = L; F.tid = threadIdx.x; F.lane = F.tid & 63; F.wave = __builtin_amdgcn_readfirstlane(F.tid >> 6);
    F.G = gridDim.x; F.wg = blockIdx.x; F.vcu = (F.G % 8 == 0) ? (F.wg % 8) * (F.G / 8) + F.wg / 8 : F.wg;
#define GRID_BAR() do { XcdBarrier b_; b_.bar = (unsigned*)(kws() + fm::WS_CTL); b_.x = (unsigned)__builtin_amdgcn_readfirstlane((int)xb_xcc_id()); b_.st = (volatile LAS unsigned*)(L + MISC_OFF) + 8; xcd_barrier(b_); } while (0)
    fm::ada_phase(F);
    fm::even_convert_weights(F, 0); fm::even_convert_weights(F, 1);
    fm::odd_convert_weights(F, 0); fm::odd_convert_weights(F, 1);
    GRID_BAR();
#pragma unroll 1
    for (int layer = 0; layer < 4; ++layer) {
        const float* xsrc = layer == 0 ? kin(0) : (const float*)kout();
        fm::moe_convert_weights(F, kin(30), kin(31), kin(32), layer);
        __syncthreads();
        fm::norm_phase(F, layer * 2, layer - 1, xsrc); GRID_BAR();
        if (layer % 2 == 0) {
            fm::even_inproj_phase(F, layer / 2); GRID_BAR();
            fm::even_mix_phase(F, layer / 2); GRID_BAR();
            fm::even_outproj_phase(F, layer, xsrc); GRID_BAR();
        } else {
            const int li = layer / 2;
            fm::odd_mix_phase<3>(F, li, 0, 2, 3, 0); GRID_BAR();
            fm::odd_gemm_rkv_phase(F, li); GRID_BAR();
            fm::odd_mix_phase<4>(F, li, 1, 4, 5, 3); GRID_BAR();
            fm::odd_gemm_loradown_phase(F, li); GRID_BAR();
            fm::odd_gemm_loraup_phase(F, li); GRID_BAR();
            fm::odd_wkv1_phase(F, li); GRID_BAR();
            fm::odd_wkv2_phase(F, li); GRID_BAR();
            fm::odd_gemm_wo_phase(F, layer); GRID_BAR();
        }
        fm::moe_route_phase(F, kin(28), kin(29), layer); GRID_BAR();
        fm::moe_sort_phase(F); GRID_BAR();
        fm::moe_gemm1_phase(F); GRID_BAR();
        fm::moe_gemm2_phase(F); GRID_BAR();
    }
    fm::final_phase(F);
}
extern "C" void kernel_launch(void* const* d_in, const int* in_sizes, int n_in, void* d_out, int out_size, void* d_ws, size_t ws_size, hipStream_t stream) {
    (void)in_sizes; (void)out_size;
    static int grid = 0;
    if (grid == 0) {
        int dev = 0, cus = 0, per_cu = 0;
        hipGetDevice(&dev); hipDeviceGetAttribute(&cus, hipDeviceAttributeMultiprocessorCount, dev);
        hipFuncSetAttribute((const void*)mega_fwd, hipFuncAttributeMaxDynamicSharedMemorySize, LDS_BYTES);
        hipOccupancyMaxActiveBlocksPerMultiprocessor(&per_cu, (const void*)mega_fwd, NTHREADS, LDS_BYTES);
        (void)hipGetLastError();
        grid = 256;
        if (per_cu < 1) fprintf(stderr, "kernel_launch: occupancy query says %d blocks/CU\n", per_cu);
        if (cus < 256 || n_in != 34 || ws_size < fm::WS_END) { fprintf(stderr, "kernel_launch: unexpected cus %d / n_in %d / ws %zu\n", cus, n_in, ws_size); grid = -1; }
    }
    if (grid < 0) return;
    hipMemsetAsync((char*)d_ws + fm::WS_CTL, 0, fm::CTL_ZERO_BYTES, stream);
    Args a{};
    for (int i = 0; i < 34; ++i) a.in[i] = (const float*)d_in[i];
    a.out = (float*)d_out; a.ws = (unsigned char*)d_ws;
    void* kargs[] = {&a};
    hipError_t e = hipLaunchCooperativeKernel((const void*)mega_fwd, dim3(grid), dim3(NTHREADS), kargs, LDS_BYTES, stream);
    if (e != hipSuccess) fprintf(stderr, "cooperative launch failed: %s (grid %d)\n", hipGetErrorString(e), grid);
}
```

```cpp
#include <hip/hip_runtime.h>
#include <stdint.h>
#include <stddef.h>
#include <math.h>
#include <stdio.h>
#define GAS __attribute__((address_space(1)))
#define LAS __attribute__((address_space(3)))
#define XB_TMO      128
#define XB_XCNT(j)  (256  + 64 * (j))
#define XB_XSUB(j)  (1280 + 64 * (j))
#define XB_XGEN(j)  (2304 + 64 * (j))
#define XB_TOP      3328
#define XB_TOPGEN   3392
#define XCD_BAR_WORDS 3456
#define XB_SPIN_CAP (1u << 22)
__device__ __forceinline__ unsigned xb_ld(unsigned* p)              { return __hip_atomic_load(p, __ATOMIC_RELAXED, __HIP_MEMORY_SCOPE_AGENT); }
__device__ __forceinline__ unsigned xb_add(unsigned* p, unsigned v) { return __hip_atomic_fetch_add(p, v, __ATOMIC_RELAXED, __HIP_MEMORY_SCOPE_AGENT); }
__device__ __forceinline__ unsigned xb_xcc_id() { return (unsigned)__builtin_amdgcn_s_getreg((3 << 11) | 20) & 0xFu; }
#define XB_SPIN(cond, bar) do { unsigned _sp = 0; while (cond) { __builtin_amdgcn_s_sleep(1); \
    if ((++_sp & 255u) == 0u) { if (xb_ld(&(bar)[XB_TMO])) break; if (_sp > XB_SPIN_CAP) { atomicAdd(&(bar)[XB_TMO], 1u); break; } } } } while (0)
struct XcdBarrier { unsigned* bar; unsigned x; volatile LAS unsigned* st; };
__device__ __forceinline__ XcdBarrier xcd_barrier_post(unsigned* bar, volatile LAS unsigned* st) {
    XcdBarrier b; b.bar = bar; b.x = xb_xcc_id(); b.st = st;
    if (threadIdx.x == 0) (void)xb_add(&bar[XB_XCNT(b.x)], 1u);
    return b;
}
__device__ __forceinline__ void xcd_barrier_complete(unsigned* bar, unsigned x, unsigned& nloc, unsigned& nx) {
    const unsigned G = gridDim.x * gridDim.y * gridDim.z;
    unsigned sum, cnt, mine, sp = 0u;
    for (;;) {
        sum = 0u; cnt = 0u; mine = 0u;
#pragma unroll
        for (unsigned j = 0; j < 16; ++j) { const unsigned c = xb_ld(&bar[XB_XCNT(j)]); sum += c; cnt += (c > 0u) ? 1u : 0u; mine = (j == x) ? c : mine; }
        if (sum == G) break;
        __builtin_amdgcn_s_sleep(1);
        if ((++sp & 255u) == 0u) { if (xb_ld(&bar[XB_TMO])) break; if (sp > XB_SPIN_CAP) { atomicAdd(&bar[XB_TMO], 1u); break; } }
    }
    nloc = mine > 0u ? mine : 1u; nx = cnt > 0u ? cnt : 1u;
}
__device__ __forceinline__ void xcd_barrier(const XcdBarrier& b) {
    asm volatile("s_waitcnt vmcnt(0)" ::: "memory");
    __syncthreads();
    if (threadIdx.x == 0) {
        unsigned* bar = b.bar;
        __builtin_amdgcn_s_waitcnt(0);
        unsigned nloc = b.st[0], nx = b.st[1];
        if (nloc == 0u) { xcd_barrier_complete(bar, b.x, nloc, nx); b.st[0] = nloc; b.st[1] = nx; }
        const unsigned old = xb_add(&bar[XB_XSUB(b.x)], 1u);
        const unsigned gen = old / nloc;
        if (old + 1u == (gen + 1u) * nloc) {
            __builtin_amdgcn_fence(__ATOMIC_RELEASE, "agent");
            asm volatile("s_waitcnt vmcnt(0)" ::: "memory");
            const unsigned og = xb_add(&bar[XB_TOP], 1u);
            const unsigned tg = og / nx;
            if (og + 1u == (tg + 1u) * nx) xb_add(&bar[XB_TOPGEN], 1u);
            else XB_SPIN(xb_ld(&bar[XB_TOPGEN]) == tg, bar);
            __builtin_amdgcn_fence(__ATOMIC_ACQUIRE, "agent");
            xb_add(&bar[XB_XGEN(b.x)], 1u);
            asm volatile("s_waitcnt vmcnt(0)" ::: "memory");
        } else {
            XB_SPIN(xb_ld(&bar[XB_XGEN(b.x)]) == gen, bar);
            __builtin_amdgcn_fence(__ATOMIC_ACQUIRE, "agent");
            asm volatile("s_waitcnt vmcnt(0)" ::: "memory");
        }
    }
    __syncthreads();
}
constexpr int RING_BYTES = 131072;
constexpr int LDSCTL_OFF = RING_BYTES;
constexpr int MISC_OFF = LDSCTL_OFF + 320;
constexpr int LDS_BYTES = 147456;
constexpr int NTHREADS = 512;

__device__ __forceinline__ const void* karg(int i) {
    const void* base = (const void*)__builtin_amdgcn_kernarg_segment_ptr();
    unsigned long long v;
    asm volatile("s_load_dwordx2 %0, %1, %2\n\ts_waitcnt lgkmcnt(0)" : "=s"(v) : "s"(base), "n"(i * 8) : "memory");
    return (const void*)v;
}
__device__ __forceinline__ const float* kin(int i) { return (const float*)karg(i); }
__device__ __forceinline__ float* kout() { return (float*)karg(34); }
__device__ __forceinline__ unsigned char* kws() { return (unsigned char*)karg(35); }
namespace pg8 {
#define PG8_LAS __attribute__((address_space(3)))
typedef unsigned short bf16_t;
typedef short bf16x8 __attribute__((ext_vector_type(8)));
typedef float f32x4 __attribute__((ext_vector_type(4)));
typedef unsigned u32x4 __attribute__((ext_vector_type(4)));
constexpr int BM = 256, BK = 64, HALF = 128, HTB = HALF * BK * 2  , STAGE_BYTES = 8 * HTB, NXCD = 8, WGM = 8;

__host__ __device__ __forceinline__ int lds_byte(int r, int c) { const int st = (r >> 4) * 2 + (c >> 5), rr = r & 15, cc = c & 31, ob = rr * 64 + cc * 2; return st * 1024 + (ob ^ (((ob >> 9) & 1) << 5)); }
__host__ __device__ __forceinline__ void stage_rc(int b, int& R, int& C) { const int st = b / 1024, sb = b % 1024, swz = sb ^ (((sb >> 9) & 1) << 5); R = (st >> 1) * 16 + swz / 64; C = (st & 1) * 32 + (swz % 64) / 2; }
__host__ __device__ __forceinline__ int perm32(int rho) { const int n = rho >> 4, i = rho & 15; return 8 * (i >> 2) + 4 * n + (i & 3); }

struct Unit { int pm, pn; };
struct Gemm { int K; };
__device__ __forceinline__ unsigned cvt_pk_bf16(float lo, float hi) { unsigned r; asm volatile("v_cvt_pk_bf16_f32 %0, %1, %2" : "=v"(r) : "v"(lo), "v"(hi)); return r; }
typedef float f32x2 __attribute__((ext_vector_type(2)));
__device__ __forceinline__ f32x2 gelu_pk(f32x2 v) {
    const f32x2 av = __builtin_elementwise_abs(v), d = av * 0.2316418882f + 1.0f;
    f32x2 t; t.x = __builtin_amdgcn_rcpf(d.x); t.y = __builtin_amdgcn_rcpf(d.y);
    f32x2 q = t * 0.5307027145f + (-0.7265760135f); q = q * t + 0.7107068705f; q = q * t + (-0.142248368f); q = q * t + 0.127414796f; q = q * t;
    const f32x2 s = (v * v) * (-0.72134752044f);
    f32x2 e; e.x = __builtin_amdgcn_exp2f(s.x); e.y = __builtin_amdgcn_exp2f(s.y);
    const f32x2 m = v * (q * e), r = v - m;
    f32x2 o; o.x = v.x < 0.f ? m.x : r.x; o.y = v.y < 0.f ? m.y : r.y; return o;
}
template <class Epi, class Sched, bool ALIGN_EPI = false, bool SP2 = false, bool GA = false  >
__device__ __forceinline__ void gemm_phase(PG8_LAS unsigned char* lds, const Gemm g, const Sched& S, const Epi& E) {
    int tid_ = threadIdx.x; asm volatile("" : "+v"(tid_));
    const int tid = tid_, wid = __builtin_amdgcn_readfirstlane(tid >> 6), lane = tid & 63, wr = wid >> 2, wc = wid & 3, fr = lane & 15, fq = lane >> 4;
    int Kop = g.K; asm volatile("" : "+s"(Kop));
    const int K = Kop, nt = K / BK;
    unsigned voffA[2], voffB[2];
#pragma unroll
    for (int i = 0; i < 2; ++i) { int R, C; stage_rc(tid * 16 + i * 8192, R, C); const int Rb = Epi::PERM ? ((R & ~31) + perm32(R & 31)) : R;
        voffA[i] = (unsigned)(R * K + C) * 2u; voffB[i] = (unsigned)(Rb * K + C) * 2u; }
    int stR[2], stC[2];
#pragma unroll
    for (int i = 0; i < 2; ++i) stage_rc(tid * 16 + i * 8192, stR[i], stC[i]);
    unsigned vAc[2][2], vAn[2][2];
#pragma unroll
    for (int h = 0; h < 2; ++h)
#pragma unroll
        for (int i = 0; i < 2; ++i) { vAc[h][i] = voffA[i] + (unsigned)h * (unsigned)(HALF * K * 2); vAn[h][i] = vAc[h][i]; }
    const size_t kstep = (size_t)(BK * 2);
    const size_t hstep = (size_t)HALF * K * 2;
        const unsigned ldsw = (unsigned)wid * 1024u;
    const int aoff = lds_byte(wr * 64 + fr, fq * 8), boff = lds_byte(wc * 32 + fr, fq * 8);
#define PG8_SA(b, h) (((b) * 2 + (h)) * HTB)
#define PG8_SB(b, h) ((4 + (b) * 2 + (h)) * HTB)
#define PG8_STAGE(bufoff, gbase, voff) do { _Pragma("unroll") for (int _i = 0; _i < 2; ++_i) \
        __builtin_amdgcn_global_load_lds((const unsigned*)((const char*)(gbase) + (voff)[_i]), (PG8_LAS unsigned*)(lds + (bufoff) + ldsw + _i * 8192), 16, 0, 0); } while (0)
#define PG8_LDA(dst, b, h) do { _Pragma("unroll") for (int m = 0; m < 4; ++m) _Pragma("unroll") for (int k = 0; k < 2; ++k) dst[m][k] = *(const PG8_LAS bf16x8*)(lds + PG8_SA(b, h) + aoff + m * 2048 + k * 1024); } while (0)
#define PG8_LDB(dst, b, h) do { _Pragma("unroll") for (int n = 0; n < 2; ++n) _Pragma("unroll") for (int k = 0; k < 2; ++k) dst[n][k] = *(const PG8_LAS bf16x8*)(lds + PG8_SB(b, h) + boff + n * 2048 + k * 1024); } while (0)
#define PG8_MMA(ai, bj, At, Bt) do { __builtin_amdgcn_s_setprio(1); _Pragma("unroll") for (int m = 0; m < 4; ++m) _Pragma("unroll") for (int n = 0; n < 2; ++n) _Pragma("unroll") for (int k = 0; k < 2; ++k) \
        acc[ai][bj][m][n] = __builtin_amdgcn_mfma_f32_16x16x32_bf16(Bt[n][k], At[m][k], acc[ai][bj][m][n], 0, 0, 0); __builtin_amdgcn_s_setprio(0); } while (0)
#define PG8_WAIT_V(n) asm volatile("s_waitcnt vmcnt(" #n ")" ::: "memory")
#define PG8_WAIT_L(n) asm volatile("s_waitcnt lgkmcnt(" #n ")" ::: "memory")
#define PG8_BAR __builtin_amdgcn_s_barrier()
#define PG8_SCHED __builtin_amdgcn_sched_barrier(0)
    Unit cur, nxt; int ui = 0;
    if (!S.next(0, cur)) return;
    f32x4 acc[2][2][4][2];
#pragma unroll
    for (int a = 0; a < 2; ++a)
#pragma unroll
        for (int b = 0; b < 2; ++b)
#pragma unroll
            for (int m = 0; m < 4; ++m)
#pragma unroll
                for (int n = 0; n < 2; ++n) acc[a][b][m][n] = (f32x4){0.f, 0.f, 0.f, 0.f};
    bf16x8 At[4][2], B0[2][2], B1[2][2];
    const char* cA = S.a_base(cur); const char* cB = S.b_base(cur);
    if constexpr (GA) {
#pragma unroll
        for (int h = 0; h < 2; ++h)
#pragma unroll
            for (int i = 0; i < 2; ++i) vAc[h][i] = S.a_rowoff(cur, h * HALF + stR[i]) + (unsigned)stC[i] * 2u;
    }
    S.a_ready(cur);
    if constexpr (SP2) {
        PG8_STAGE(PG8_SB(0, 0), cB, voffB); PG8_STAGE(PG8_SB(0, 1), cB + hstep, voffB); PG8_STAGE(PG8_SA(0, 0), cA, vAc[0]); PG8_STAGE(PG8_SA(0, 1), cA, vAc[1]);
        if (wr == 1) PG8_BAR;
        PG8_WAIT_V(2); PG8_BAR;
        PG8_STAGE(PG8_SB(1, 0), cB + kstep, voffB); PG8_STAGE(PG8_SA(1, 0), cA + kstep, vAc[0]); PG8_STAGE(PG8_SB(1, 1), cB + hstep + kstep, voffB);
        PG8_WAIT_V(6); PG8_BAR;
    } else {
        PG8_STAGE(PG8_SB(0, 0), cB, voffB); PG8_STAGE(PG8_SA(0, 0), cA, vAc[0]); PG8_STAGE(PG8_SB(0, 1), cB + hstep, voffB); PG8_STAGE(PG8_SA(0, 1), cA, vAc[1]);
        if (wr == 1) PG8_BAR;
        PG8_WAIT_V(4); PG8_BAR;
        PG8_STAGE(PG8_SB(1, 0), cB + kstep, voffB); PG8_STAGE(PG8_SA(1, 0), cA + kstep, vAc[0]); PG8_STAGE(PG8_SB(1, 1), cB + hstep + kstep, voffB);
        PG8_WAIT_V(6); PG8_BAR;
    }
    for (;;) {
        const bool has_next = S.next(ui + 1, nxt);
        if constexpr (GA) { if (has_next) {
#pragma unroll
            for (int h = 0; h < 2; ++h)
#pragma unroll
                for (int i = 0; i < 2; ++i) vAn[h][i] = S.a_rowoff(nxt, h * HALF + stR[i]) + (unsigned)stC[i] * 2u;
        } else {
#pragma unroll
            for (int h = 0; h < 2; ++h)
#pragma unroll
                for (int i = 0; i < 2; ++i) vAn[h][i] = vAc[h][i];
        } }
        const char* nA = has_next ? S.a_base(nxt) : cA; const char* nB = has_next ? S.b_base(nxt) : cB;
        for (int t = 0; t < nt; t += 2) {
            const bool last = (t == nt - 2);
            unsigned vS0[2], vS1[2];
            vS0[0] = last ? vAn[0][0] : vAc[0][0]; vS0[1] = last ? vAn[0][1] : vAc[0][1]; vS1[0] = last ? vAn[1][0] : vAc[1][0]; vS1[1] = last ? vAn[1][1] : vAc[1][1];
            const char* a1 = cA + (size_t)(t + 1) * kstep;
            const char* a2 = last ? nA : cA + (size_t)(t + 2) * kstep; const char* b2 = last ? nB : cB + (size_t)(t + 2) * kstep;
            const char* a3 = a2 + kstep; const char* b3 = b2 + kstep;
            if (last && has_next) S.a_ready(nxt);
            if constexpr (SP2) {
            PG8_LDB(B0, 0, 0); PG8_LDB(B1, 0, 1); PG8_SCHED; PG8_LDA(At, 0, 0); PG8_STAGE(PG8_SA(1, 1), a1, vAc[1]);
            PG8_WAIT_V(8); PG8_WAIT_L(0); PG8_BAR; PG8_MMA(0, 0, At, B0); PG8_MMA(0, 1, At, B1); PG8_BAR; PG8_SCHED;
            PG8_LDA(At, 0, 1); PG8_STAGE(PG8_SB(0, 0), b2, voffB); PG8_STAGE(PG8_SB(0, 1), b2 + hstep, voffB); PG8_STAGE(PG8_SA(0, 0), a2, vS0);
            PG8_WAIT_V(8); PG8_WAIT_L(0); PG8_BAR; PG8_MMA(1, 0, At, B0); PG8_MMA(1, 1, At, B1); PG8_BAR; PG8_SCHED;
            PG8_LDB(B0, 1, 0); PG8_LDB(B1, 1, 1); PG8_SCHED; PG8_LDA(At, 1, 0); PG8_STAGE(PG8_SA(0, 1), a2, vS1);
            PG8_WAIT_V(8); PG8_WAIT_L(0); PG8_BAR; PG8_MMA(0, 0, At, B0); PG8_MMA(0, 1, At, B1); PG8_BAR; PG8_SCHED;
            PG8_LDA(At, 1, 1); PG8_STAGE(PG8_SB(1, 0), b3, voffB); PG8_STAGE(PG8_SB(1, 1), b3 + hstep, voffB); PG8_STAGE(PG8_SA(1, 0), a3, vS0);
            PG8_WAIT_V(8); PG8_WAIT_L(0); PG8_BAR; PG8_MMA(1, 0, At, B0); PG8_MMA(1, 1, At, B1); PG8_BAR; PG8_SCHED;
            } else {
            PG8_LDB(B0, 0, 0); PG8_SCHED; PG8_LDA(At, 0, 0); PG8_STAGE(PG8_SA(1, 1), a1, vAc[1]);
            PG8_WAIT_L(8); PG8_BAR; PG8_WAIT_L(0); PG8_MMA(0, 0, At, B0); PG8_BAR; PG8_SCHED;
            PG8_LDB(B1, 0, 1); PG8_STAGE(PG8_SB(0, 0), b2, voffB);
            PG8_BAR; PG8_WAIT_L(0); PG8_MMA(0, 1, At, B1); PG8_BAR;
            PG8_LDA(At, 0, 1); PG8_STAGE(PG8_SA(0, 0), a2, vS0);
            PG8_BAR; PG8_WAIT_L(0); PG8_MMA(1, 0, At, B0); PG8_BAR; PG8_SCHED;
            PG8_STAGE(PG8_SB(0, 1), b2 + hstep, voffB);
            PG8_WAIT_V(6); PG8_BAR; PG8_MMA(1, 1, At, B1); PG8_BAR;
            PG8_LDB(B0, 1, 0); PG8_SCHED; PG8_LDA(At, 1, 0); PG8_STAGE(PG8_SA(0, 1), a2, vS1);
            PG8_WAIT_L(8); PG8_BAR; PG8_WAIT_L(0); PG8_MMA(0, 0, At, B0); PG8_BAR; PG8_SCHED;
            PG8_LDB(B1, 1, 1); PG8_STAGE(PG8_SB(1, 0), b3, voffB);
            PG8_BAR; PG8_WAIT_L(0); PG8_MMA(0, 1, At, B1); PG8_BAR;
            PG8_LDA(At, 1, 1); PG8_STAGE(PG8_SA(1, 0), a3, vS0);
            PG8_BAR; PG8_WAIT_L(0); PG8_MMA(1, 0, At, B0); PG8_BAR; PG8_SCHED;
            PG8_STAGE(PG8_SB(1, 1), b3 + hstep, voffB);
            PG8_WAIT_V(6); PG8_BAR; PG8_MMA(1, 1, At, B1); PG8_BAR;
            }
        }
        if constexpr (ALIGN_EPI) { if (wr == 0) PG8_BAR; }
        if constexpr (!Epi::AFTER_DRAIN) { E(acc, cur, wr, wc, fr, fq); S.done(cur); }
        if (!has_next) break;
#pragma unroll
        for (int a = 0; a < 2; ++a)
#pragma unroll
            for (int b = 0; b < 2; ++b)
#pragma unroll
                for (int m = 0; m < 4; ++m)
#pragma unroll
                    for (int n = 0; n < 2; ++n) acc[a][b][m][n] = (f32x4){0.f, 0.f, 0.f, 0.f};
        cur = nxt; cA = nA; cB = nB; ++ui;
#pragma unroll
        for (int h = 0; h < 2; ++h)
#pragma unroll
            for (int i = 0; i < 2; ++i) vAc[h][i] = vAn[h][i];
        if constexpr (ALIGN_EPI) { if (wr == 1) PG8_BAR; }
    }
    PG8_WAIT_V(0);
    if constexpr (!ALIGN_EPI) { if (wr == 0) PG8_BAR; }
    PG8_BAR;
    if constexpr (Epi::AFTER_DRAIN) { E.fused(acc, cur, wr, wc, fr, fq, lds, wid, lane); S.done(cur); }
#undef PG8_SA
#undef PG8_SB
#undef PG8_STAGE
#undef PG8_LDA
#undef PG8_LDB
#undef PG8_MMA
#undef PG8_WAIT_V
#undef PG8_WAIT_L
#undef PG8_BAR
#undef PG8_SCHED
}
}
namespace fm {
using pg8::bf16_t; using pg8::f32x4; using pg8::u32x4; using pg8::Unit;
typedef unsigned v4u __attribute__((ext_vector_type(4)));
typedef unsigned v2u __attribute__((ext_vector_type(2)));
constexpr int T = 16384, D = 1024, S = 2048, NB = 8, NWAVES = 8;
constexpr size_t MiB = 1u << 20;
constexpr size_t WS_CTL = 0, CTL_ZERO_BYTES = 64 * 1024;
constexpr size_t WS_SMALL = 1 * MiB;
constexpr size_t WS_MOD = 4 * MiB;
constexpr size_t WS_WMIX = 80 * MiB;
constexpr size_t WS_WMOE = 120 * MiB;
constexpr size_t WS_XN = 144 * MiB;
constexpr size_t WS_R1 = 176 * MiB;
constexpr size_t WS_YS = WS_R1;
constexpr size_t WS_AG = WS_R1 + 64 * MiB + 4096;
constexpr size_t WS_HID = WS_R1 + 137 * MiB;
constexpr size_t WS_END = 400 * MiB;
constexpr size_t SM_TOKE = 0;
constexpr size_t SM_TOKW = 128 * 1024;
constexpr size_t SM_CNTG = 256 * 1024;
constexpr size_t SM_ROWINFO = 384 * 1024;
constexpr size_t SM_ROWW = 640 * 1024;
constexpr size_t SM_ROWTOK = 832 * 1024;
constexpr int MOE_ROWS_MAX = 2 * T + 16 * 256;
constexpr int LX_SEG = 1024, LX_TILEE = 1152, LX_BASE = 1792, LX_DPOS = 2048, LX_TE = 2560, LX_TW = 3072, LX_PS = 4096, LX_PB = 6144;

struct Ctx {
    LAS unsigned char* lds; int tid, lane, wave, G, wg, vcu;
};
__device__ __forceinline__ float wave_sum(float v) {
#pragma unroll
    for (int o = 1; o < 64; o <<= 1) v += __shfl_xor(v, o);
    return v;
}
__device__ __forceinline__ unsigned f2bf(float f) { unsigned u = __builtin_bit_cast(unsigned, f); return (u + 0x7fffu + ((u >> 16) & 1u)) >> 16; }

typedef float f32x2_c __attribute__((ext_vector_type(2))); typedef __bf16 bf16x2_c __attribute__((ext_vector_type(2)));
__device__ __forceinline__ unsigned cvtpk(float lo, float hi) { const f32x2_c v = {lo, hi}; const bf16x2_c b = __builtin_convertvector(v, bf16x2_c); return __builtin_bit_cast(unsigned, b); }
__device__ __forceinline__ unsigned pk2(float lo, float hi) { return cvtpk(lo, hi); }
__device__ __forceinline__ float bf2f(unsigned short b) { return __builtin_bit_cast(float, (unsigned)b << 16); }
__device__ __forceinline__ float bflo(unsigned w) { return __builtin_bit_cast(float, w << 16); }
__device__ __forceinline__ float bfhi(unsigned w) { return __builtin_bit_cast(float, w & 0xffff0000u); }
#define LDS_WAIT() asm volatile("s_waitcnt lgkmcnt(0)" ::: "memory")
__device__ __forceinline__ void transpose_item(const float* W, int N, bf16_t* WT, int ldk, int k0, int n0, int drow0, LAS float* scr, int lane) {
#pragma unroll 8
    for (int i = 0; i < 32; ++i) { const int kk = 2 * i + (lane >> 5); scr[kk * 33 + (lane & 31)] = W[(size_t)(k0 + kk) * N + n0 + (lane & 31)]; }
    LDS_WAIT(); asm volatile("" ::: "memory");
    const int c = lane & 7;
#pragma unroll
    for (int j = 0; j < 4; ++j) { const int n = (lane >> 3) + 8 * j; const LAS float* s = scr + (8 * c) * 33 + n;
        v4u o; o.x = pk2(s[0 * 33], s[1 * 33]); o.y = pk2(s[2 * 33], s[3 * 33]); o.z = pk2(s[4 * 33], s[5 * 33]); o.w = pk2(s[6 * 33], s[7 * 33]);
        *(v4u*)(WT + (size_t)(drow0 + n) * ldk + k0 + 8 * c) = o; }
    LDS_WAIT(); asm volatile("" ::: "memory");
}
__device__ __forceinline__ void transpose_item_pad(const float* W, int N, int nvalid, int kvalid, bf16_t* WT, int ldk, int k0, int n0, int drow0, LAS float* scr, int lane) {
#pragma unroll 8
    for (int i = 0; i < 32; ++i) { const int kk = 2 * i + (lane >> 5); const int n = n0 + (lane & 31); float v = 0.f; if (n < nvalid && (k0 + kk) < kvalid) v = W[(size_t)(k0 + kk) * N + n]; scr[kk * 33 + (lane & 31)] = v; }
    LDS_WAIT(); asm volatile("" ::: "memory");
    const int c = lane & 7;
#pragma unroll
    for (int j = 0; j < 4; ++j) { const int n = (lane >> 3) + 8 * j; const LAS float* s = scr + (8 * c) * 33 + n;
        v4u o; o.x = pk2(s[0 * 33], s[1 * 33]); o.y = pk2(s[2 * 33], s[3 * 33]); o.z = pk2(s[4 * 33], s[5 * 33]); o.w = pk2(s[6 * 33], s[7 * 33]);
        *(v4u*)(WT + (size_t)(drow0 + n) * ldk + k0 + 8 * c) = o; }
    LDS_WAIT(); asm volatile("" ::: "memory");
}
__device__ __forceinline__ float fast_sigmoid(float v) { return __builtin_amdgcn_rcpf(1.f + __expf(-v)); }
}
namespace fm {
__device__ __forceinline__ void moe_convert_weights(const Ctx& F_, const float* w1, const float* w3, const float* w2, int layer) {
    Ctx F = F_; asm volatile("" : "+v"(F.tid), "+v"(F.lane));
    unsigned char* const ws_ = kws();
    LAS float* scr = (LAS float*)(F.lds + F.wave * 8448);
    bf16_t* W13T = (bf16_t*)(ws_ + WS_WMOE); bf16_t* W2T = W13T + (size_t)16 * 512 * 1024;
    const int gw = F.wg * NWAVES + F.wave, NGW = F.G * NWAVES;
    for (int it = gw; it < 16 * 384; it += NGW) {
        const int e = it / 384, r = it % 384;
        const size_t eoff = (size_t)(layer * 16 + e);
        if (r < 256) {
            const int q = r & 127, kb = q >> 3, nb = q & 7, n0 = nb * 32;
            const float* W = (r < 128 ? w1 : w3) + eoff * 1024 * 256;
            transpose_item(W, 256, W13T + (size_t)e * 512 * 1024, 1024, kb * 64, n0, (n0 >> 7) * 256 + (n0 & 127) + (r < 128 ? 0 : 128), scr, F.lane);
        } else {
            const int q = r - 256, kb = q >> 5, nb = q & 31;
            transpose_item(w2 + eoff * 256 * 1024, 1024, W2T + (size_t)e * 1024 * 256, 256, kb * 64, nb * 32, nb * 32, scr, F.lane);
        }
    }
}
__device__ __forceinline__ void moe_route_phase(const Ctx& F_, const float* router_w, const float* router_b, int layer) {
    Ctx F = F_; asm volatile("" : "+v"(F.tid), "+v"(F.lane));
    unsigned char* const ws_ = kws(); const float* const x_ = kout(); const float* const mod_ = (const float*)(ws_ + WS_MOD);
    LAS float* rwT = (LAS float*)F.lds;
    LAS int* cnt = (LAS int*)(F.lds + 65536);
    LAS float* tab = (LAS float*)(F.lds + 65536 + 256 + F.wave * 512);
    for (int i = F.tid; i < 16384; i += NTHREADS) rwT[(i & 15) * 1024 + (i >> 4)] = router_w[i];
    if (F.tid < 16) cnt[F.tid] = 0;
    __syncthreads();
    int* tok_e = (int*)(ws_ + WS_SMALL + SM_TOKE); float* tok_w = (float*)(ws_ + WS_SMALL + SM_TOKW);
    bf16_t* XN = (bf16_t*)(ws_ + WS_XN);
    const int row0 = F.wg * 64 + F.wave * 8, b = row0 / S;
    const float* m = mod_ + ((size_t)(layer * 2 + 1) * NB + b) * 3072;
    const bool b5 = (F.lane & 32) != 0, b4 = (F.lane & 16) != 0, b3 = (F.lane & 8) != 0, b2 = (F.lane & 4) != 0;
    f32x4 vn[4];
#pragma unroll
    for (int j = 0; j < 4; ++j) vn[j] = ((const f32x4*)(x_ + (size_t)row0 * D) + F.lane)[64 * j];
#pragma unroll 1
    for (int r = 0; r < 8; ++r) {
        const int row = row0 + r;
        f32x4 v[4]; float ss = 0.f;
#pragma unroll
        for (int j = 0; j < 4; ++j) { v[j] = vn[j]; ss += (v[j].x * v[j].x + v[j].y * v[j].y) + (v[j].z * v[j].z + v[j].w * v[j].w); }
        { const f32x4* xr = (const f32x4*)(x_ + (size_t)(row0 + (r < 7 ? r + 1 : r)) * D) + F.lane;
#pragma unroll
            for (int j = 0; j < 4; ++j) vn[j] = xr[64 * j]; }
        const float rinv = 1.0f / sqrtf(wave_sum(ss) * (1.f / D) + 1e-6f);
        unsigned long long* o8 = (unsigned long long*)(XN + (size_t)row * D) + F.lane;
#pragma unroll
        for (int j = 0; j < 4; ++j) {
            const f32x4 sh = ((const f32x4*)m)[64 * j + F.lane], sc = ((const f32x4*)(m + 1024))[64 * j + F.lane];
            v[j] = v[j] * rinv * (sc + 1.0f) + sh;
            o8[64 * j] = (unsigned long long)pk2(v[j].x, v[j].y) | ((unsigned long long)pk2(v[j].z, v[j].w) << 32);
        }
        asm volatile("" ::: "memory");
        float acc[16];
#pragma unroll
        for (int e = 0; e < 16; ++e) {
            float a = 0.f;
#pragma unroll
            for (int j = 0; j < 4; ++j) { const f32x4 w = *(const LAS f32x4*)(rwT + e * 1024 + 256 * j + 4 * F.lane); a += (v[j].x * w.x + v[j].y * w.y) + (v[j].z * w.z + v[j].w * w.w); }
            acc[e] = a;
            if ((e & 1) == 1) asm volatile("" ::: "memory");
        }
        float a8[8], a4[4], a2[2], a1;
#pragma unroll
        for (int i = 0; i < 8; ++i) { const float send = b5 ? acc[i] : acc[8 + i]; const float keep = b5 ? acc[8 + i] : acc[i]; a8[i] = keep + __shfl_xor(send, 32); }
#pragma unroll
        for (int i = 0; i < 4; ++i) { const float send = b4 ? a8[i] : a8[4 + i]; const float keep = b4 ? a8[4 + i] : a8[i]; a4[i] = keep + __shfl_xor(send, 16); }
#pragma unroll
        for (int i = 0; i < 2; ++i) { const float send = b3 ? a4[i] : a4[2 + i]; const float keep = b3 ? a4[2 + i] : a4[i]; a2[i] = keep + __shfl_xor(send, 8); }
        { const float send = b2 ? a2[0] : a2[1]; const float keep = b2 ? a2[1] : a2[0]; a1 = keep + __shfl_xor(send, 4); }
        a1 += __shfl_xor(a1, 2); a1 += __shfl_xor(a1, 1);
        const float sg = __builtin_amdgcn_rcpf(1.f + __expf(-a1));
        if ((F.lane & 3) == 0) tab[r * 16 + (F.lane >> 2)] = sg;
    }
    asm volatile("s_waitcnt lgkmcnt(0)" ::: "memory");
    if (F.lane < 8) {
        const int row = row0 + F.lane;
        float s[16], sel[16];
#pragma unroll
        for (int q = 0; q < 4; ++q) { const f32x4 t4 = *(const LAS f32x4*)(tab + F.lane * 16 + 4 * q); s[4 * q] = t4.x; s[4 * q + 1] = t4.y; s[4 * q + 2] = t4.z; s[4 * q + 3] = t4.w; }
#pragma unroll
        for (int e = 0; e < 16; ++e) sel[e] = s[e] + router_b[e];
        int bg = 0; float bgs = -INFINITY;
#pragma unroll
        for (int g = 0; g < 4; ++g) {
            const float a0 = sel[4 * g], a1_ = sel[4 * g + 1], a2_ = sel[4 * g + 2], a3 = sel[4 * g + 3];
            const float m1 = fmaxf(fmaxf(a0, a1_), fmaxf(a2_, a3));
            const float lo01 = fminf(a0, a1_), hi01 = fmaxf(a0, a1_), lo23 = fminf(a2_, a3), hi23 = fmaxf(a2_, a3);
            const float m2 = fmaxf(fminf(hi01, hi23), fmaxf(lo01, lo23));
            const float gs = m1 + m2;
            if (gs > bgs) { bgs = gs; bg = g; }
        }
        float g0 = sel[0], g1 = sel[1], g2 = sel[2], g3 = sel[3], t0 = s[0], t1 = s[1], t2 = s[2], t3 = s[3];
#pragma unroll
        for (int g = 1; g < 4; ++g) if (bg == g) { g0 = sel[4 * g]; g1 = sel[4 * g + 1]; g2 = sel[4 * g + 2]; g3 = sel[4 * g + 3]; t0 = s[4 * g]; t1 = s[4 * g + 1]; t2 = s[4 * g + 2]; t3 = s[4 * g + 3]; }
        int i0 = 0; float v0 = g0, w0 = t0;
        if (g1 > v0) { v0 = g1; i0 = 1; w0 = t1; } if (g2 > v0) { v0 = g2; i0 = 2; w0 = t2; } if (g3 > v0) { v0 = g3; i0 = 3; w0 = t3; }
        int i1 = -1; float v1 = -INFINITY, w1 = 0.f;
        if (i0 != 0 && g0 > v1) { v1 = g0; i1 = 0; w1 = t0; } if (i0 != 1 && g1 > v1) { v1 = g1; i1 = 1; w1 = t1; }
        if (i0 != 2 && g2 > v1) { v1 = g2; i1 = 2; w1 = t2; } if (i0 != 3 && g3 > v1) { v1 = g3; i1 = 3; w1 = t3; }
        const int e0 = bg * 4 + i0, e1 = bg * 4 + i1; const float inv = 1.f / (w0 + w1);
        tok_e[row * 2] = e0; tok_e[row * 2 + 1] = e1; tok_w[row * 2] = w0 * inv; tok_w[row * 2 + 1] = w1 * inv;
        __hip_atomic_fetch_add(cnt + e0, 1, __ATOMIC_RELAXED, __HIP_MEMORY_SCOPE_WORKGROUP); __hip_atomic_fetch_add(cnt + e1, 1, __ATOMIC_RELAXED, __HIP_MEMORY_SCOPE_WORKGROUP);
    }
    __syncthreads();
    if (F.tid < 16) ((int*)(ws_ + WS_SMALL + SM_CNTG))[F.wg * 16 + F.tid] = cnt[F.tid];
}
__device__ __forceinline__ void moe_sort_phase(const Ctx& F_) {
    Ctx F = F_; asm volatile("" : "+v"(F.tid), "+v"(F.lane));
    unsigned char* const ws_ = kws();
    LAS unsigned char* X = F.lds + LDSCTL_OFF;
    LAS int* seg = (LAS int*)(X + LX_SEG); LAS int* tile_e = (LAS int*)(X + LX_TILEE); LAS int* base = (LAS int*)(X + LX_BASE);
    LAS int* te = (LAS int*)(X + LX_TE); LAS float* tw = (LAS float*)(X + LX_TW); LAS int* ps = (LAS int*)(X + LX_PS); LAS int* pb = (LAS int*)(X + LX_PB); LAS int* tot16 = (LAS int*)(X + LX_DPOS);
    const int* cntG = (const int*)(ws_ + WS_SMALL + SM_CNTG);
    const int* tok_e = (const int*)(ws_ + WS_SMALL + SM_TOKE); const float* tok_w = (const float*)(ws_ + WS_SMALL + SM_TOKW);
    int* rowinfo = (int*)(ws_ + WS_SMALL + SM_ROWINFO); float* roww = (float*)(ws_ + WS_SMALL + SM_ROWW); int* rowtok = (int*)(ws_ + WS_SMALL + SM_ROWTOK);
    { const int e = F.tid & 15, part = F.tid >> 4; int tot = 0, bef = 0;
#pragma unroll
        for (int i = 0; i < 8; ++i) { const int w = part * 8 + i; const int c = cntG[w * 16 + e]; tot += c; bef += (w < F.wg) ? c : 0; }
        ps[part * 16 + e] = tot; pb[part * 16 + e] = bef; }
    if (F.tid < 128) { te[F.tid] = tok_e[F.wg * 128 + F.tid]; tw[F.tid] = tok_w[F.wg * 128 + F.tid]; }
    __syncthreads();
    if (F.tid < 16) { int tot = 0, bef = 0;
#pragma unroll 8
        for (int p = 0; p < 32; ++p) { tot += ps[p * 16 + F.tid]; bef += pb[p * 16 + F.tid]; }
        base[F.tid] = bef; tot16[F.tid] = tot; }
    __syncthreads();
    if (F.tid == 0) { int run = 0;
        for (int e = 0; e < 16; ++e) { const int tot = tot16[e]; seg[e] = run; base[e] += run; run += (tot + 255) & ~255; }
        seg[16] = run; }
    __syncthreads();
    if (F.wave == 0) {
#pragma unroll 1
        for (int pass = 0; pass < 2; ++pass) {
            const int i = pass * 64 + F.lane, e = te[i]; int pos = 0;
#pragma unroll 1
            for (int ee = 0; ee < 16; ++ee) {
                const unsigned long long mk = __ballot(e == ee); const int b0 = base[ee];
                if (e == ee) pos = b0 + __popcll(mk & ((1ull << F.lane) - 1ull));
                if (F.lane == 0) base[ee] = b0 + __popcll(mk);
            }
            rowinfo[pos] = (i & 1) * T + F.wg * 64 + (i >> 1); roww[pos] = tw[i]; rowtok[pos] = F.wg * 64 + (i >> 1);
        }
    }
    const int ntile = seg[16] >> 8;
    for (int t = F.tid; t < ntile; t += NTHREADS) { int e = 0;
#pragma unroll
        for (int k = 1; k < 16; ++k) e += (t * 256 >= seg[k]) ? 1 : 0;
        tile_e[t] = e; }
    if (F.wg < 16) { const int e = F.wg; for (int p = seg[e] + tot16[e] + F.tid; p < seg[e + 1]; p += NTHREADS) { rowinfo[p] = 2 * T; rowtok[p] = 0; } }
}
struct SchedMoe {
    const char* A; const char* Bw; size_t a_tile, b_exp, b_tile; int n_units, G, c, sh; const LAS int* tile_e; const int* rowtok;
    __device__ __forceinline__ unsigned a_rowoff(const Unit& u, int r) const { return (unsigned)rowtok[u.pm * 256 + r] * 2048u; }
    __device__ __forceinline__ bool next(int i, Unit& u) const { const long L = (long)i * G + c; if (L >= n_units) return false; u.pm = (int)(L >> sh); u.pn = (int)(L & ((1 << sh) - 1)); return true; }
    __device__ __forceinline__ const char* a_base(const Unit& u) const { return A + (size_t)u.pm * a_tile; }
    __device__ __forceinline__ const char* b_base(const Unit& u) const { const int e = __builtin_amdgcn_readfirstlane(tile_e[u.pm]); return Bw + (size_t)e * b_exp + (size_t)u.pn * b_tile; }
    __device__ __forceinline__ void a_ready(const Unit&) const {}
    __device__ __forceinline__ void done(const Unit&) const {}
};
struct EpiSwiglu {
    static constexpr bool PERM = true, AFTER_DRAIN = false;
    bf16_t* HID;
    __device__ __forceinline__ void operator()(const f32x4 (&acc)[2][2][4][2], const Unit& u, int wr, int wc, int fr, int fq) const {
        const int row0 = u.pm * 256 + wr * 64 + fr, col0 = u.pn * 128 + wc * 32 + 8 * fq;
#pragma unroll
        for (int ai = 0; ai < 2; ++ai)
#pragma unroll
            for (int m = 0; m < 4; ++m) {
                float h[8];
#pragma unroll
                for (int n = 0; n < 2; ++n)
#pragma unroll
                    for (int q = 0; q < 4; ++q) { const float a = acc[ai][0][m][n][q], g = acc[ai][1][m][n][q]; h[4 * n + q] = a * fast_sigmoid(a) * g; }
                u32x4 w; w.x = pg8::cvt_pk_bf16(h[0], h[1]); w.y = pg8::cvt_pk_bf16(h[2], h[3]); w.z = pg8::cvt_pk_bf16(h[4], h[5]); w.w = pg8::cvt_pk_bf16(h[6], h[7]);
                *(u32x4*)(HID + (size_t)(row0 + ai * 128 + m * 16) * 256 + col0) = w;
                asm volatile("" ::: "memory");
            }
    }
};
struct EpiMoeOut {
    static constexpr bool PERM = true, AFTER_DRAIN = false;
    const int* rowinfo; const float* roww; bf16_t* YS;
    __device__ __forceinline__ void operator()(const f32x4 (&acc)[2][2][4][2], const Unit& u, int wr, int wc, int fr, int fq) const {
        const int row0 = u.pm * 256 + wr * 64 + fr; const unsigned col0 = u.pn * 256 + wc * 32 + 8 * fq;
#pragma unroll
        for (int ai = 0; ai < 2; ++ai)
#pragma unroll
            for (int m = 0; m < 4; ++m) {
                const int r = row0 + ai * 128 + m * 16; const unsigned drow = (unsigned)rowinfo[r]; const float w = roww[r];
                bf16_t* dst = YS + (drow * 1024u + col0);
#pragma unroll
                for (int bj = 0; bj < 2; ++bj) { const f32x4 v0 = acc[ai][bj][m][0] * w, v1 = acc[ai][bj][m][1] * w;
                    u32x4 o; o.x = pg8::cvt_pk_bf16(v0[0], v0[1]); o.y = pg8::cvt_pk_bf16(v0[2], v0[3]); o.z = pg8::cvt_pk_bf16(v1[0], v1[1]); o.w = pg8::cvt_pk_bf16(v1[2], v1[3]);
                    *(u32x4*)(dst + bj * 128) = o; }
                asm volatile("" ::: "memory");
            }
    }
};
__device__ __forceinline__ void moe_gemm1_phase(const Ctx& F_) {
    Ctx F = F_; asm volatile("" : "+v"(F.tid), "+v"(F.lane));
    unsigned char* const ws_ = kws();
    LAS unsigned char* X = F.lds + LDSCTL_OFF; const LAS int* seg = (const LAS int*)(X + LX_SEG);
    const int ntile = __builtin_amdgcn_readfirstlane(seg[16]) >> 8;
    SchedMoe Sc{(const char*)(ws_ + WS_XN), (const char*)(ws_ + WS_WMOE), (size_t)0, (size_t)512 * 1024 * 2, (size_t)256 * 1024 * 2, ntile * 2, F.G, F.vcu, 1, (const LAS int*)(X + LX_TILEE), (const int*)(ws_ + WS_SMALL + SM_ROWTOK)};
    EpiSwiglu E{(bf16_t*)(ws_ + WS_HID)};
    pg8::gemm_phase<EpiSwiglu, SchedMoe, true, true, true>(F.lds, pg8::Gemm{1024}, Sc, E);
}
__device__ __forceinline__ void moe_gemm2_phase(const Ctx& F_) {
    Ctx F = F_; asm volatile("" : "+v"(F.tid), "+v"(F.lane));
    unsigned char* const ws_ = kws();
    LAS unsigned char* X = F.lds + LDSCTL_OFF; const LAS int* seg = (const LAS int*)(X + LX_SEG);
    const int ntile = __builtin_amdgcn_readfirstlane(seg[16]) >> 8;
    SchedMoe Sc{(const char*)(ws_ + WS_HID), (const char*)(ws_ + WS_WMOE) + (size_t)16 * 512 * 1024 * 2, (size_t)256 * 256 * 2, (size_t)1024 * 256 * 2, (size_t)256 * 256 * 2, ntile * 4, F.G, F.vcu, 2, (const LAS int*)(X + LX_TILEE), nullptr};
    EpiMoeOut E{(const int*)(ws_ + WS_SMALL + SM_ROWINFO), (const float*)(ws_ + WS_SMALL + SM_ROWW), (bf16_t*)(ws_ + WS_YS)};
    pg8::gemm_phase<EpiMoeOut, SchedMoe, true, true>(F.lds, pg8::Gemm{256}, Sc, E);
}
}
namespace fm {
typedef short bf16x8 __attribute__((ext_vector_type(8)));
typedef short s16x4 __attribute__((ext_vector_type(4)));
typedef float f32x16 __attribute__((ext_vector_type(16)));
typedef float f32x2 __attribute__((ext_vector_type(2)));
constexpr int PROJ_LD = 2560;
constexpr float QSCALE = 0.125f * 1.4426950408889634f;
constexpr size_t WM_EVEN_STRIDE = 8 * MiB;
constexpr size_t WM_WIN = 0, WM_WOUT = 5 * MiB, WM_SGUW = 7 * MiB;
constexpr size_t WS_PROJ = WS_R1;
constexpr size_t WS_O = WS_R1 + 80 * MiB;
constexpr size_t SM_ZSS = 1024 * 1024;

struct SchedStd {
    const char* A; const char* Bt; size_t tile_bytes; int nM, nN, nwg, G, c;
    __device__ __forceinline__ void init(const void* A_, const void* Bt_, int M, int N, int K, int G_, int c_) { A = (const char*)A_; Bt = (const char*)Bt_; tile_bytes = (size_t)256 * K * 2; nM = M / 256; nN = N / 256; nwg = nM * nN; G = G_; c = c_; }
    __device__ __forceinline__ bool next(int i, Unit& u) const {
        const long L = (long)i * G + c; if (L >= nwg) return false;
        int wgid = (int)L; { const int q = nwg / 8, r = nwg % 8, xcd = wgid % 8, off = wgid / 8; wgid = (xcd < r ? xcd * (q + 1) : r * (q + 1) + (xcd - r) * q) + off; }
        const int nig = 8 * nN, gid = wgid / nig, fm_ = gid * 8, gsz = (nM - fm_) < 8 ? (nM - fm_) : 8;
        u.pm = fm_ + ((wgid % nig) % gsz); u.pn = (wgid % nig) / gsz; return true;
    }
    __device__ __forceinline__ const char* a_base(const Unit& u) const { return A + (size_t)u.pm * tile_bytes; }
    __device__ __forceinline__ const char* b_base(const Unit& u) const { return Bt + (size_t)u.pn * tile_bytes; }
    __device__ __forceinline__ void a_ready(const Unit&) const {}
    __device__ __forceinline__ void done(const Unit&) const {}
};
__device__ __forceinline__ void even_convert_weights(const Ctx& F_, int li) {
    Ctx F = F_; asm volatile("" : "+v"(F.tid), "+v"(F.lane));
    unsigned char* const ws_ = kws();
    LAS float* scr = (LAS float*)(F.lds + F.wave * 8448);
    bf16_t* base = (bf16_t*)(ws_ + WS_WMIX + (size_t)li * WM_EVEN_STRIDE);
    bf16_t* WinT = base + WM_WIN / 2; bf16_t* WoutT = base + WM_WOUT / 2; bf16_t* SW = base + WM_SGUW / 2;
    const float* w_in = kin(4) + (size_t)li * 1024 * 2560; const float* w_out = kin(5) + (size_t)li * 1024 * 1024; const float* sw = kin(7) + (size_t)li * 8 * 128 * 128;
    const int gw = F.wg * NWAVES + F.wave, NGW = F.G * NWAVES;
    constexpr int I_IN = 16 * 80, I_OUT = 16 * 32;
    for (int it = gw; it < I_IN + I_OUT; it += NGW) {
        if (it < I_IN) { const int kb = it / 80, nb = it % 80; transpose_item(w_in, 2560, WinT, 1024, kb * 64, nb * 32, nb * 32, scr, F.lane); }
        else { const int r = it - I_IN, kb = r / 32, nb = r % 32; transpose_item(w_out, 1024, WoutT, 1024, kb * 64, nb * 32, nb * 32, scr, F.lane); }
    }
    for (int i = gw * 64 + F.lane; i < 8 * 128 * 128 / 4; i += NGW * 64) { const f32x4 v = ((const f32x4*)sw)[i]; v2u o; o.x = pk2(v.x, v.y); o.y = pk2(v.z, v.w); ((v2u*)SW)[i] = o; }
}
struct EpiInProj {
    static constexpr bool PERM = true, AFTER_DRAIN = false;
    bf16_t* P; float* zss;
    __device__ __forceinline__ void operator()(const f32x4 (&acc)[2][2][4][2], const Unit& u, int wr, int wc, int fr, int fq) const {
        const int row0 = u.pm * 256 + wr * 64 + fr, col0 = u.pn * 256 + wc * 32 + 8 * fq;
        const int kind = u.pn < 2 ? 0 : (u.pn < 6 ? 1 : (u.pn < 8 ? 2 : 3));
#pragma unroll
        for (int ai = 0; ai < 2; ++ai)
#pragma unroll
            for (int m = 0; m < 4; ++m) {
                const int row = row0 + ai * 128 + m * 16; bf16_t* rowp = P + (size_t)row * PROJ_LD + col0; float ssq = 0.f;
#pragma unroll
                for (int bj = 0; bj < 2; ++bj) {
                    f32x4 v0 = acc[ai][bj][m][0], v1 = acc[ai][bj][m][1];
                    if (kind == 0) { v0 = v0 * QSCALE; v1 = v1 * QSCALE; }
                    else if (kind >= 2) {
                        const f32x2 a = pg8::gelu_pk((f32x2){v0[0], v0[1]}), b = pg8::gelu_pk((f32x2){v0[2], v0[3]}), c = pg8::gelu_pk((f32x2){v1[0], v1[1]}), d = pg8::gelu_pk((f32x2){v1[2], v1[3]});
                        v0 = (f32x4){a.x, a.y, b.x, b.y}; v1 = (f32x4){c.x, c.y, d.x, d.y};
                        ssq += (v0[0] * v0[0] + v0[1] * v0[1]) + (v0[2] * v0[2] + v0[3] * v0[3]) + (v1[0] * v1[0] + v1[1] * v1[1]) + (v1[2] * v1[2] + v1[3] * v1[3]);
                    }
                    u32x4 w; w.x = pg8::cvt_pk_bf16(v0[0], v0[1]); w.y = pg8::cvt_pk_bf16(v0[2], v0[3]); w.z = pg8::cvt_pk_bf16(v1[0], v1[1]); w.w = pg8::cvt_pk_bf16(v1[2], v1[3]);
                    *(u32x4*)(rowp + bj * 128) = w;
                }
                if (kind == 3) { ssq += __shfl_xor(ssq, 16); ssq += __shfl_xor(ssq, 32); if (fq == 0) zss[(size_t)row * 8 + (u.pn - 8) * 4 + wc] = ssq; }
                asm volatile("" ::: "memory");
            }
    }
};
struct EpiResid {
    static constexpr bool PERM = false, AFTER_DRAIN = false;
    const float* xin; float* xout; const float* mod;
    __device__ __forceinline__ void operator()(const f32x4 (&acc)[2][2][4][2], const Unit& u, int wr, int wc, int fr, int fq) const {
        const int row0 = u.pm * 256 + wr * 64 + fr, col0 = u.pn * 256 + wc * 32 + 4 * fq, b = (u.pm * 256) / S;
        const float* g = mod + (size_t)b * 3072 + 2048 + col0;
        f32x4 gv[2][2];
#pragma unroll
        for (int bj = 0; bj < 2; ++bj)
#pragma unroll
            for (int n = 0; n < 2; ++n) gv[bj][n] = *(const f32x4*)(g + bj * 128 + n * 16);
#pragma unroll
        for (int ai = 0; ai < 2; ++ai)
#pragma unroll
            for (int m = 0; m < 4; ++m) { const size_t off = (size_t)(row0 + ai * 128 + m * 16) * D + col0;
#pragma unroll
                for (int bj = 0; bj < 2; ++bj)
#pragma unroll
                    for (int n = 0; n < 2; ++n) { const f32x4 xv = *(const f32x4*)(xin + off + bj * 128 + n * 16); *(f32x4*)(xout + off + bj * 128 + n * 16) = xv + gv[bj][n] * acc[ai][bj][m][n]; }
                asm volatile("" ::: "memory"); }
    }
};
__device__ __forceinline__ void even_inproj_phase(const Ctx& F_, int li) {
    Ctx F = F_; asm volatile("" : "+v"(F.tid), "+v"(F.lane));
    unsigned char* const ws_ = kws();
    SchedStd Sc; Sc.init(ws_ + WS_XN, ws_ + WS_WMIX + (size_t)li * WM_EVEN_STRIDE + WM_WIN, T, 2560, 1024, F.G, F.wg);
    EpiInProj E{(bf16_t*)(ws_ + WS_PROJ), (float*)(ws_ + WS_SMALL + SM_ZSS)};
    pg8::gemm_phase<EpiInProj, SchedStd, true, true>(F.lds, pg8::Gemm{1024}, Sc, E);
}
__device__ __forceinline__ void even_outproj_phase(const Ctx& F_, int layer, const float* xin) {
    Ctx F = F_; asm volatile("" : "+v"(F.tid), "+v"(F.lane));
    unsigned char* const ws_ = kws(); float* const x_ = kout();
    SchedStd Sc; Sc.init(ws_ + WS_O, ws_ + WS_WMIX + (size_t)(layer / 2) * WM_EVEN_STRIDE + WM_WOUT, T, 1024, 1024, F.G, F.wg);
    EpiResid E{xin, x_, (const float*)(ws_ + WS_MOD) + (size_t)(layer * 2) * NB * 3072};
    pg8::gemm_phase<EpiResid, SchedStd, true, true>(F.lds, pg8::Gemm{1024}, Sc, E);
}
__device__ __forceinline__ s16x4 tr_read(const LAS unsigned char* p) { typedef short v4i16_t __attribute__((ext_vector_type(4))); return __builtin_bit_cast(s16x4, __builtin_amdgcn_ds_read_tr16_b64_v4i16((LAS v4i16_t*)p)); }
constexpr int VPITCH = 144;
__device__ __forceinline__ void attn_task(const bf16_t* __restrict__ P, bf16_t* __restrict__ O, LAS unsigned char* vl, int b, int hh, int jt, int rq, int lane) {
    const int r32 = lane & 31, h2 = lane >> 5;
    const bf16_t* Pb = P + (size_t)b * S * PROJ_LD + hh * 64;
    const bf16_t* qrow = Pb + (size_t)(16 * (32 * jt + r32) + rq) * PROJ_LD + 8 * h2;
    bf16x8 qf[4];
#pragma unroll
    for (int ks = 0; ks < 4; ++ks) qf[ks] = *(const bf16x8*)(qrow + 16 * ks);
    float mrun = -INFINITY, lrun = 0.f; f32x16 o0, o1;
#pragma unroll
    for (int r = 0; r < 16; ++r) { o0[r] = 0.f; o1[r] = 0.f; }
    const int vkey = lane >> 3, vch = lane & 7;
    const int g4 = lane >> 4, i16 = lane & 15;
    const LAS unsigned char* trb = vl + (4 * h2 + (i16 >> 2)) * VPITCH + (16 * (g4 & 1) + 4 * (i16 & 3)) * 2;
    const int ktmin = jt > 0 ? jt - 1 : 0;
    int cc = 0, kt = 0;
    bf16x8 kf[4]; v4u vv[4];
    { const int c = rq;
        const bf16_t* krow = Pb + (size_t)(16 * (32 * kt + r32) + c) * PROJ_LD + 512 + 8 * h2;
#pragma unroll
        for (int ks = 0; ks < 4; ++ks) kf[ks] = *(const bf16x8*)(krow + 16 * ks);
#pragma unroll
        for (int it = 0; it < 4; ++it) vv[it] = *(const v4u*)(Pb + (size_t)(16 * (32 * kt + vkey + 8 * it) + c) * PROJ_LD + 1024 + 8 * vch); }
#pragma unroll 1
    for (;;) {
        int ncc = cc, nkt = kt + 1;
        if (nkt > jt) { ncc = cc + 1; nkt = ktmin; }
        const bool more = ncc < 16;
        bf16x8 nkf[4]; v4u nvv[4];
        { const int c = (rq + (more ? ncc : cc)) & 15, k2 = more ? nkt : kt;
            const bf16_t* krow = Pb + (size_t)(16 * (32 * k2 + r32) + c) * PROJ_LD + 512 + 8 * h2;
#pragma unroll
            for (int ks = 0; ks < 4; ++ks) nkf[ks] = *(const bf16x8*)(krow + 16 * ks);
#pragma unroll
            for (int it = 0; it < 4; ++it) nvv[it] = *(const v4u*)(Pb + (size_t)(16 * (32 * k2 + vkey + 8 * it) + c) * PROJ_LD + 1024 + 8 * vch); }
        const int c = (rq + cc) & 15, off = rq - c;
        const int typ = (cc == 0) ? 2 : (((off & 3) == 0) ? 1 : 0);
        f32x16 s;
#pragma unroll
        for (int r = 0; r < 16; ++r) s[r] = 0.f;
#pragma unroll
        for (int ks = 0; ks < 4; ++ks) s = __builtin_amdgcn_mfma_f32_32x32x16_bf16(kf[ks], qf[ks], s, 0, 0, 0);
#pragma unroll
        for (int it = 0; it < 4; ++it) *(LAS v4u*)(vl + (vkey + 8 * it) * VPITCH + vch * 16) = vv[it];
        const int dbase = 16 * (32 * (jt - kt) + r32 - 4 * h2) + off;
        float tmax = -INFINITY;
        if (typ == 0) {
#pragma unroll
            for (int r = 0; r < 16; ++r) { const int dlt = dbase - 16 * ((r & 3) + 8 * (r >> 2)); s[r] = (dlt >= 0 && dlt <= 128) ? s[r] : -INFINITY; tmax = fmaxf(tmax, s[r]); }
        } else if (typ == 1) {
#pragma unroll
            for (int r = 0; r < 16; ++r) { const int dlt = dbase - 16 * ((r & 3) + 8 * (r >> 2)); const float v = s[r] + ((dlt <= 128) ? 1.f : 0.f); s[r] = (dlt >= 0 && dlt <= 512) ? v : -INFINITY; tmax = fmaxf(tmax, s[r]); }
        } else {
#pragma unroll
            for (int r = 0; r < 16; ++r) { const int dlt = dbase - 16 * ((r & 3) + 8 * (r >> 2)); const float v = s[r] + ((dlt <= 128) ? 1.5849625007f : ((dlt <= 512) ? 1.f : 0.f)); s[r] = (dlt >= 0) ? v : -INFINITY; tmax = fmaxf(tmax, s[r]); }
        }
        tmax = fmaxf(tmax, __shfl_xor(tmax, 32));
        const float mnew = fmaxf(mrun, tmax), msafe = (mnew == -INFINITY) ? 0.f : mnew;
        const float alpha = __builtin_amdgcn_exp2f(mrun - msafe);
        float psum = 0.f;
#pragma unroll
        for (int r = 0; r < 16; ++r) { s[r] = __builtin_amdgcn_exp2f(s[r] - msafe); psum += s[r]; }
        lrun = lrun * alpha + psum;
        if (!__all(mnew == mrun)) {
#pragma unroll
            for (int r = 0; r < 16; ++r) { o0[r] *= alpha; o1[r] *= alpha; }
        }
        mrun = mnew;
        bf16x8 pf[2];
#pragma unroll
        for (int st = 0; st < 2; ++st) { v4u w; w.x = cvtpk(s[8 * st], s[8 * st + 1]); w.y = cvtpk(s[8 * st + 2], s[8 * st + 3]); w.z = cvtpk(s[8 * st + 4], s[8 * st + 5]); w.w = cvtpk(s[8 * st + 6], s[8 * st + 7]); pf[st] = __builtin_bit_cast(bf16x8, w); }
#pragma unroll
        for (int st = 0; st < 2; ++st) {
            const s16x4 a0 = tr_read(trb + (16 * st) * VPITCH), a1 = tr_read(trb + (16 * st + 8) * VPITCH);
            const s16x4 b0 = tr_read(trb + (16 * st) * VPITCH + 64), b1 = tr_read(trb + (16 * st + 8) * VPITCH + 64);
            const bf16x8 A0 = (bf16x8){a0[0], a0[1], a0[2], a0[3], a1[0], a1[1], a1[2], a1[3]}, A1 = (bf16x8){b0[0], b0[1], b0[2], b0[3], b1[0], b1[1], b1[2], b1[3]};
            o0 = __builtin_amdgcn_mfma_f32_32x32x16_bf16(A0, pf[st], o0, 0, 0, 0);
            o1 = __builtin_amdgcn_mfma_f32_32x32x16_bf16(A1, pf[st], o1, 0, 0, 0);
        }
        if (!more) break;
        cc = ncc; kt = nkt;
#pragma unroll
        for (int ks = 0; ks < 4; ++ks) kf[ks] = nkf[ks];
#pragma unroll
        for (int it = 0; it < 4; ++it) vv[it] = nvv[it];
    }
    const float ltot = lrun + __shfl_xor(lrun, 32), inv = 1.0f / ltot;
    bf16_t* orow = O + ((size_t)b * S + 16 * (32 * jt + r32) + rq) * D + hh * 64 + 4 * h2;
#pragma unroll
    for (int gq = 0; gq < 4; ++gq) {
        v2u w0, w1; w0.x = cvtpk(o0[4 * gq] * inv, o0[4 * gq + 1] * inv); w0.y = cvtpk(o0[4 * gq + 2] * inv, o0[4 * gq + 3] * inv);
        w1.x = cvtpk(o1[4 * gq] * inv, o1[4 * gq + 1] * inv); w1.y = cvtpk(o1[4 * gq + 2] * inv, o1[4 * gq + 3] * inv);
        *(v2u*)(orow + 8 * gq) = w0; *(v2u*)(orow + 32 + 8 * gq) = w1;
    }
}
__device__ __forceinline__ unsigned mask_pair(unsigned x, int e0, int lim) { if (e0 > lim) x &= 0xffff0000u; if (e0 + 1 > lim) x &= 0x0000ffffu; return x; }
constexpr int ZPITCH = 128;
__device__ __forceinline__ void sgu_task(const bf16_t* __restrict__ P, bf16_t* __restrict__ O, const bf16_t* __restrict__ SW, const float* __restrict__ zss, const float* __restrict__ ng, const float* __restrict__ bs,
                                         LAS unsigned char* zl, int b, int ch, int g, int lane) {
    const int r32 = lane & 31, h2 = lane >> 5;
    const size_t t0 = (size_t)b * S + ch * 128;
    { const int chn = lane & 7; f32x4 n0 = *(const f32x4*)(ng + g * 64 + 8 * chn), n1 = *(const f32x4*)(ng + g * 64 + 8 * chn + 4);
#pragma unroll 4
        for (int it = 0; it < 16; ++it) { const int row = (lane >> 3) + 8 * it;
            const float* zp = zss + (t0 + row) * 8; const f32x4 p0 = *(const f32x4*)zp, p1 = *(const f32x4*)(zp + 4);
            const float ri = 1.0f / sqrtf(((p0.x + p0.y) + (p0.z + p0.w) + (p1.x + p1.y) + (p1.z + p1.w)) * (1.f / 512.f) + 1e-6f);
            const v4u z = *(const v4u*)(P + (t0 + row) * PROJ_LD + 2048 + g * 64 + 8 * chn);
            v4u o; o.x = pk2(bflo(z.x) * ri * n0.x, bfhi(z.x) * ri * n0.y); o.y = pk2(bflo(z.y) * ri * n0.z, bfhi(z.y) * ri * n0.w);
            o.z = pk2(bflo(z.z) * ri * n1.x, bfhi(z.z) * ri * n1.y); o.w = pk2(bflo(z.w) * ri * n1.z, bfhi(z.w) * ri * n1.w);
            *(LAS v4u*)(zl + row * ZPITCH + chn * 16) = o; } }
    asm volatile("s_waitcnt lgkmcnt(0)" ::: "memory");
    const int g4 = lane >> 4, i16 = lane & 15;
    const LAS unsigned char* trb = zl + (8 * h2 + (i16 >> 2)) * ZPITCH + (16 * (g4 & 1) + 4 * (i16 & 3)) * 2;
    const bf16_t* Wg = SW + (size_t)g * 128 * 128;
#pragma unroll 1
    for (int mt = 0; mt < 4; ++mt) {
        f32x16 a0, a1;
#pragma unroll
        for (int r = 0; r < 16; ++r) { a0[r] = 0.f; a1[r] = 0.f; }
        const int irow = 32 * mt + r32;
#pragma unroll 1
        for (int kt = 0; kt <= mt; ++kt) {
#pragma unroll
            for (int ks = 0; ks < 2; ++ks) {
                const int j0 = 32 * kt + 16 * ks + 8 * h2;
                v4u wv = *(const v4u*)(Wg + (size_t)irow * 128 + j0);
                if (kt == mt) {
                    const int lim = irow - j0;
                    wv.x = mask_pair(wv.x, 0, lim); wv.y = mask_pair(wv.y, 2, lim); wv.z = mask_pair(wv.z, 4, lim); wv.w = mask_pair(wv.w, 6, lim);
                }
                const bf16x8 af = __builtin_bit_cast(bf16x8, wv);
                const LAS unsigned char* tb = trb + (32 * kt + 16 * ks) * ZPITCH;
                const s16x4 x0 = tr_read(tb), x1 = tr_read(tb + 4 * ZPITCH), y0 = tr_read(tb + 64), y1 = tr_read(tb + 4 * ZPITCH + 64);
                const bf16x8 B0 = (bf16x8){x0[0], x0[1], x0[2], x0[3], x1[0], x1[1], x1[2], x1[3]}, B1 = (bf16x8){y0[0], y0[1], y0[2], y0[3], y1[0], y1[1], y1[2], y1[3]};
                a0 = __builtin_amdgcn_mfma_f32_32x32x16_bf16(af, B0, a0, 0, 0, 0);
                a1 = __builtin_amdgcn_mfma_f32_32x32x16_bf16(af, B1, a1, 0, 0, 0);
            }
        }
#pragma unroll
        for (int r = 0; r < 16; ++r) {
            const int i = 32 * mt + (r & 3) + 8 * (r >> 2) + 4 * h2; const float bb = bs[g * 128 + i];
            const bf16_t* up = P + (t0 + i) * PROJ_LD + 1536 + g * 64; bf16_t* op = O + (t0 + i) * D + 512 + g * 64;
            op[r32] = (bf16_t)f2bf(bf2f(up[r32]) * (a0[r] + bb)); op[32 + r32] = (bf16_t)f2bf(bf2f(up[32 + r32]) * (a1[r] + bb));
        }
    }
}
__device__ __forceinline__ void even_mix_phase(const Ctx& F_, int li) {
    Ctx F = F_; asm volatile("" : "+v"(F.tid), "+v"(F.lane));
    unsigned char* const ws_ = kws();
    const bf16_t* P = (const bf16_t*)(ws_ + WS_PROJ); bf16_t* O = (bf16_t*)(ws_ + WS_O);
    LAS unsigned char* wl = F.lds + F.wave * 16384;
    { const int b = F.wg >> 5, hh = (F.wg >> 2) & 7, jt = F.wg & 3;
        attn_task(P, O, wl, b, hh, jt, F.wave, F.lane);
        attn_task(P, O, wl, b, hh, jt, F.wave + 8, F.lane); }
    if (F.wave < 4) { const int task = F.wg * 4 + F.wave, b = task >> 7, ch = (task >> 3) & 15, g = task & 7;
        sgu_task(P, O, (const bf16_t*)(ws_ + WS_WMIX + (size_t)li * WM_EVEN_STRIDE + WM_SGUW), (const float*)(ws_ + WS_SMALL + SM_ZSS), kin(6) + li * 512, kin(8) + li * 8 * 128, wl, b, ch, g, F.lane); }
}
}
namespace fm {
constexpr size_t WM_ODD_BASE = 16 * MiB, WM_ODD_STRIDE = 12 * MiB, WM_WRKV = 0, WM_WLD = 6 * MiB, WM_WLU = 8 * MiB, WM_WO = 10 * MiB;
constexpr size_t WS_VFIRST = 16 * MiB;
constexpr size_t WS_LORA = 48 * MiB;
constexpr size_t WS_MIX = WS_R1;
constexpr size_t WS_WDEC = WS_R1, WS_AV = WS_R1 + 64 * MiB, WS_G = WS_R1 + 96 * MiB;
constexpr size_t WS_R = WS_R1 + 128 * MiB, WS_K = WS_R1 + 160 * MiB, WS_V = WS_R1 + 192 * MiB;
constexpr size_t WS_Y = WS_XN;

__device__ __forceinline__ void odd_convert_weights(const Ctx& F_, int li) {
    Ctx F = F_; asm volatile("" : "+v"(F.tid), "+v"(F.lane));
    unsigned char* const ws_ = kws();
    LAS float* scr = (LAS float*)(F.lds + F.wave * 8448);
    unsigned char* base = ws_ + WS_WMIX + WM_ODD_BASE + (size_t)li * WM_ODD_STRIDE;
    bf16_t* WRKV = (bf16_t*)(base + WM_WRKV); bf16_t* WLD = (bf16_t*)(base + WM_WLD); bf16_t* WLU = (bf16_t*)(base + WM_WLU); bf16_t* WO = (bf16_t*)(base + WM_WO);
    const float* w_rkv = kin(10) + (size_t)li * 3 * 1024 * 1024; const float* w_o = kin(11) + (size_t)li * 1024 * 1024;
    const float* w1 = kin(13) + (size_t)li * 1024 * 64; const float* a1 = kin(16) + (size_t)li * 1024 * 64; const float* g1 = kin(21) + (size_t)li * 1024 * 160;
    const float* v1 = kin(19);
    const float* w2 = kin(14) + (size_t)li * 64 * 1024; const float* a2 = kin(17) + (size_t)li * 64 * 1024; const float* g2 = kin(22) + (size_t)li * 160 * 1024; const float* v2 = kin(20);
    const int gw = F.wg * NWAVES + F.wave, NGW = F.G * NWAVES;
    constexpr int I_SQ = 16 * 32;
    constexpr int I_LD = 16 * 8;
    constexpr int I_LU = 4 * 32;
    constexpr int NIT = 4 * I_SQ + 4 * I_LD + 4 * I_LU;
    for (int it = gw; it < NIT; it += NGW) {
        int r = it;
        if (r < 4 * I_SQ) { const int mtx = r / I_SQ, q = r % I_SQ, kb = q / 32, nb = q % 32;
            if (mtx < 3) transpose_item(w_rkv + (size_t)mtx * 1024 * 1024, 1024, WRKV + (size_t)mtx * 1024 * 1024, 1024, kb * 64, nb * 32, nb * 32, scr, F.lane);
            else transpose_item(w_o, 1024, WO, 1024, kb * 64, nb * 32, nb * 32, scr, F.lane);
            continue; }
        r -= 4 * I_SQ;
        if (r < 4 * I_LD) { const int tl = r / I_LD, q = r % I_LD, kb = q / 8, nb = q % 8;
            const float* W = tl == 0 ? w1 : (tl == 1 ? a1 : (tl == 2 ? g1 : v1)); const int nv = tl == 0 ? 64 : (tl == 1 ? 64 : (tl == 2 ? 160 : (li > 0 ? 32 : 0)));
            transpose_item_pad(W, tl == 2 ? 160 : (tl == 3 ? 32 : 64), nv, 1024, WLD + (size_t)tl * 256 * 1024, 1024, kb * 64, nb * 32, nb * 32, scr, F.lane);
            continue; }
        r -= 4 * I_LD;
        { const int tl = r / I_LU, q = r % I_LU, kb = q / 32, nb = q % 32;
            const float* W = tl == 0 ? w2 : (tl == 1 ? a2 : (tl == 2 ? g2 : v2)); const int kv = tl == 0 ? 64 : (tl == 1 ? 64 : (tl == 2 ? 160 : (li > 0 ? 32 : 0)));
            transpose_item_pad(W, 1024, 1024, kv, WLU + (size_t)tl * 1024 * 256, 256, kb * 64, nb * 32, nb * 32, scr, F.lane); }
    }
}
template <int NMIX> __device__ __forceinline__ void odd_mix_phase(const Ctx& F_, int li, int m0, int m1, int m2, int m3) {
    Ctx F = F_; asm volatile("" : "+v"(F.tid), "+v"(F.lane));
    unsigned char* const ws_ = kws();
    const bf16_t* XN = (const bf16_t*)(ws_ + WS_XN); bf16_t* MIX = (bf16_t*)(ws_ + WS_MIX);
    const float* mu = kin(9) + (size_t)li * 6 * 1024;
    const int ids[4] = {m0, m1, m2, m3};
    const int row0 = F.wg * 64 + F.wave * 8;
    f32x4 hp[4];
    { const bool first = (row0 % S) == 0; const v2u* pr = (const v2u*)(XN + (size_t)(row0 - (first ? 0 : 1)) * D) + F.lane;
#pragma unroll
        for (int j = 0; j < 4; ++j) { const v2u w = pr[64 * j]; hp[j] = first ? (f32x4){0.f, 0.f, 0.f, 0.f} : (f32x4){bflo(w.x), bfhi(w.x), bflo(w.y), bfhi(w.y)}; } }
#pragma unroll 1
    for (int r = 0; r < 8; ++r) {
        const int row = row0 + r; const v2u* pr = (const v2u*)(XN + (size_t)row * D) + F.lane;
        f32x4 h[4];
#pragma unroll
        for (int j = 0; j < 4; ++j) { const v2u w = pr[64 * j]; h[j] = (f32x4){bflo(w.x), bfhi(w.x), bflo(w.y), bfhi(w.y)}; }
#pragma unroll
        for (int s = 0; s < NMIX; ++s) {
            v2u* po = (v2u*)(MIX + ((size_t)s * T + row) * D) + F.lane;
#pragma unroll
            for (int j = 0; j < 4; ++j) { const f32x4 m = ((const f32x4*)(mu + ids[s] * 1024))[64 * j + F.lane]; const f32x4 x = h[j] + (hp[j] - h[j]) * m;
                v2u o; o.x = pk2(x.x, x.y); o.y = pk2(x.z, x.w); po[64 * j] = o; }
        }
#pragma unroll
        for (int j = 0; j < 4; ++j) hp[j] = h[j];
    }
}
struct SchedMulti {
    const char* A; const char* Bt; size_t a_tile, a_sel_stride, b_tile; int nN, nwg, G, c, a_shift;
    __device__ __forceinline__ bool next(int i, Unit& u) const { const long L = (long)i * G + c; if (L >= nwg) return false; u.pm = (int)(L / nN); u.pn = (int)(L % nN); return true; }
    __device__ __forceinline__ const char* a_base(const Unit& u) const { return A + (size_t)(u.pn >> a_shift) * a_sel_stride + (size_t)u.pm * a_tile; }
    __device__ __forceinline__ const char* b_base(const Unit& u) const { return Bt + (size_t)u.pn * b_tile; }
    __device__ __forceinline__ void a_ready(const Unit&) const {}
    __device__ __forceinline__ void done(const Unit&) const {}
};
struct EpiRKV {
    static constexpr bool PERM = true, AFTER_DRAIN = false;
    unsigned char* ws; size_t offV;
    __device__ __forceinline__ void operator()(const f32x4 (&acc)[2][2][4][2], const Unit& u, int wr, int wc, int fr, int fq) const {
        const int row0 = u.pm * 256 + wr * 64 + fr, col0 = (u.pn & 3) * 256 + wc * 32 + 8 * fq; const int sel = u.pn >> 2;
        size_t boff = WS_R + (size_t)sel * (WS_K - WS_R); if (sel == 2) boff = offV;
        bf16_t* base = (bf16_t*)(ws + boff);
#pragma unroll
        for (int ai = 0; ai < 2; ++ai)
#pragma unroll
            for (int m = 0; m < 4; ++m) { bf16_t* rowp = base + (size_t)(row0 + ai * 128 + m * 16) * D + col0;
#pragma unroll
                for (int bj = 0; bj < 2; ++bj) { const f32x4 v0 = acc[ai][bj][m][0], v1 = acc[ai][bj][m][1];
                    u32x4 w; w.x = pg8::cvt_pk_bf16(v0[0], v0[1]); w.y = pg8::cvt_pk_bf16(v0[2], v0[3]); w.z = pg8::cvt_pk_bf16(v1[0], v1[1]); w.w = pg8::cvt_pk_bf16(v1[2], v1[3]);
                    *(u32x4*)(rowp + bj * 128) = w; }
                asm volatile("" ::: "memory"); }
    }
};
struct EpiLoraDown {
    static constexpr bool PERM = true, AFTER_DRAIN = false;
    bf16_t* L;
    __device__ __forceinline__ void operator()(const f32x4 (&acc)[2][2][4][2], const Unit& u, int wr, int wc, int fr, int fq) const {
        const int row0 = u.pm * 256 + wr * 64 + fr, col0 = wc * 32 + 8 * fq; const int act = u.pn == 0 ? 1 : (u.pn == 2 ? 2 : 0);
        bf16_t* base = L + (size_t)u.pn * T * 256;
#pragma unroll
        for (int ai = 0; ai < 2; ++ai)
#pragma unroll
            for (int m = 0; m < 4; ++m) { bf16_t* rowp = base + (size_t)(row0 + ai * 128 + m * 16) * 256 + col0;
#pragma unroll
                for (int bj = 0; bj < 2; ++bj) { float h[8];
#pragma unroll
                    for (int n = 0; n < 2; ++n)
#pragma unroll
                        for (int q = 0; q < 4; ++q) { float v = acc[ai][bj][m][n][q];
                            if (act == 1) v = 1.f - 2.f * __builtin_amdgcn_rcpf(1.f + __expf(2.f * v)); else if (act == 2) v = fast_sigmoid(v);
                            h[4 * n + q] = v; }
                    u32x4 w; w.x = pg8::cvt_pk_bf16(h[0], h[1]); w.y = pg8::cvt_pk_bf16(h[2], h[3]); w.z = pg8::cvt_pk_bf16(h[4], h[5]); w.w = pg8::cvt_pk_bf16(h[6], h[7]);
                    *(u32x4*)(rowp + bj * 128) = w; }
                asm volatile("" ::: "memory"); }
    }
};
struct EpiLoraUp {
    static constexpr bool PERM = true, AFTER_DRAIN = false;
    unsigned char* ws; const float* vecs;
    const float *w0, *a0, *v0;
    __device__ __forceinline__ void operator()(const f32x4 (&acc)[2][2][4][2], const Unit& u, int wr, int wc, int fr, int fq) const {
        const int row0 = u.pm * 256 + wr * 64 + fr, col0 = (u.pn & 3) * 256 + wc * 32 + 8 * fq; const int sub = u.pn >> 2;
        f32x4 bv[2][2];
#pragma unroll
        for (int bj = 0; bj < 2; ++bj)
#pragma unroll
            for (int n = 0; n < 2; ++n) { const int cc = col0 + bj * 128 + 4 * n; f32x4 t = (f32x4){0.f, 0.f, 0.f, 0.f};
                if (sub == 0) t = *(const f32x4*)(w0 + cc); else if (sub == 1) t = *(const f32x4*)(a0 + cc); else if (sub == 3) t = *(const f32x4*)(v0 + cc);
                bv[bj][n] = t; }
#pragma unroll
        for (int ai = 0; ai < 2; ++ai)
#pragma unroll
            for (int m = 0; m < 4; ++m) { const size_t off = (size_t)(row0 + ai * 128 + m * 16) * D + col0;
#pragma unroll
                for (int bj = 0; bj < 2; ++bj) {
                    f32x4 v0_ = acc[ai][bj][m][0] + bv[bj][0], v1_ = acc[ai][bj][m][1] + bv[bj][1];
                    if (sub == 0) {
#pragma unroll
                        for (int q = 0; q < 4; ++q) { v0_[q] = -0.8750387749f * fast_sigmoid(v0_[q]); v1_[q] = -0.8750387749f * fast_sigmoid(v1_[q]); }
                        u32x4 w; w.x = pg8::cvt_pk_bf16(v0_[0], v0_[1]); w.y = pg8::cvt_pk_bf16(v0_[2], v0_[3]); w.z = pg8::cvt_pk_bf16(v1_[0], v1_[1]); w.w = pg8::cvt_pk_bf16(v1_[2], v1_[3]);
                        *(u32x4*)((bf16_t*)(ws + WS_WDEC) + off + bj * 128) = w;
                    } else {
                        size_t doff = WS_AV; if (sub == 2) doff = WS_G; if (sub == 3) doff = WS_V;
                        if (sub == 1) {
#pragma unroll
                            for (int q = 0; q < 4; ++q) { v0_[q] = fast_sigmoid(v0_[q]); v1_[q] = fast_sigmoid(v1_[q]); }
                        } else if (sub == 3) {
                            const u32x4 vo = *(const u32x4*)((const bf16_t*)(ws + WS_V) + off + bj * 128), vf = *(const u32x4*)((const bf16_t*)(ws + WS_VFIRST) + off + bj * 128);
                            const f32x4 olo = (f32x4){bflo(vo.x), bfhi(vo.x), bflo(vo.y), bfhi(vo.y)}, ohi = (f32x4){bflo(vo.z), bfhi(vo.z), bflo(vo.w), bfhi(vo.w)};
                            const f32x4 flo = (f32x4){bflo(vf.x), bfhi(vf.x), bflo(vf.y), bfhi(vf.y)}, fhi = (f32x4){bflo(vf.z), bfhi(vf.z), bflo(vf.w), bfhi(vf.w)};
#pragma unroll
                            for (int q = 0; q < 4; ++q) { v0_[q] = olo[q] + (flo[q] - olo[q]) * fast_sigmoid(v0_[q]); v1_[q] = ohi[q] + (fhi[q] - ohi[q]) * fast_sigmoid(v1_[q]); }
                        }
                        u32x4 w; w.x = pg8::cvt_pk_bf16(v0_[0], v0_[1]); w.y = pg8::cvt_pk_bf16(v0_[2], v0_[3]); w.z = pg8::cvt_pk_bf16(v1_[0], v1_[1]); w.w = pg8::cvt_pk_bf16(v1_[2], v1_[3]);
                        *(u32x4*)((bf16_t*)(ws + doff) + off + bj * 128) = w;
                    }
                }
                asm volatile("" ::: "memory"); }
    }
};
__device__ __forceinline__ bf16_t* odd_vbuf(unsigned char* ws_, int li) { return (bf16_t*)(ws_ + (li == 0 ? WS_VFIRST : WS_V)); }
__device__ __forceinline__ void odd_gemm_rkv_phase(const Ctx& F_, int li) {
    Ctx F = F_; asm volatile("" : "+v"(F.tid), "+v"(F.lane));
    unsigned char* const ws_ = kws();
    SchedMulti Sc{(const char*)(ws_ + WS_MIX), (const char*)(ws_ + WS_WMIX + WM_ODD_BASE + (size_t)li * WM_ODD_STRIDE + WM_WRKV), (size_t)256 * 1024 * 2, (size_t)T * D * 2, (size_t)256 * 1024 * 2, 12, 64 * 12, F.G, F.vcu, 2};
    EpiRKV E{ws_, li == 0 ? WS_VFIRST : WS_V};
    pg8::gemm_phase<EpiRKV, SchedMulti, true, true>(F.lds, pg8::Gemm{1024}, Sc, E);
}
__device__ __forceinline__ void odd_gemm_loradown_phase(const Ctx& F_, int li) {
    Ctx F = F_; asm volatile("" : "+v"(F.tid), "+v"(F.lane));
    unsigned char* const ws_ = kws(); const int nN = li == 0 ? 3 : 4;
    SchedMulti Sc{(const char*)(ws_ + WS_MIX), (const char*)(ws_ + WS_WMIX + WM_ODD_BASE + (size_t)li * WM_ODD_STRIDE + WM_WLD), (size_t)256 * 1024 * 2, (size_t)T * D * 2, (size_t)256 * 1024 * 2, nN, 64 * nN, F.G, F.vcu, 0};
    EpiLoraDown E{(bf16_t*)(ws_ + WS_LORA)};
    pg8::gemm_phase<EpiLoraDown, SchedMulti, true, true>(F.lds, pg8::Gemm{1024}, Sc, E);
}
__device__ __forceinline__ void odd_gemm_loraup_phase(const Ctx& F_, int li) {
    Ctx F = F_; asm volatile("" : "+v"(F.tid), "+v"(F.lane));
    unsigned char* const ws_ = kws(); const int nN = li == 0 ? 12 : 16;
    SchedMulti Sc{(const char*)(ws_ + WS_LORA), (const char*)(ws_ + WS_WMIX + WM_ODD_BASE + (size_t)li * WM_ODD_STRIDE + WM_WLU), (size_t)256 * 256 * 2, (size_t)T * 256 * 2, (size_t)256 * 256 * 2, nN, 64 * nN, F.G, F.vcu, 2};
    EpiLoraUp E{ws_, nullptr, kin(12) + li * 1024, kin(15) + li * 1024, kin(18)};
    pg8::gemm_phase<EpiLoraUp, SchedMulti, true, true>(F.lds, pg8::Gemm{256}, Sc, E);
}
__device__ __forceinline__ void odd_gemm_wo_phase(const Ctx& F_, int layer) {
    Ctx F = F_; asm volatile("" : "+v"(F.tid), "+v"(F.lane));
    unsigned char* const ws_ = kws(); float* const x_ = kout();
    SchedStd Sc; Sc.init(ws_ + WS_Y, ws_ + WS_WMIX + WM_ODD_BASE + (size_t)(layer / 2) * WM_ODD_STRIDE + WM_WO, T, 1024, 1024, F.G, F.wg);
    EpiResid E{x_, x_, (const float*)(ws_ + WS_MOD) + (size_t)(layer * 2) * NB * 3072};
    pg8::gemm_phase<EpiResid, SchedStd, true, true>(F.lds, pg8::Gemm{1024}, Sc, E);
}
__device__ __forceinline__ void odd_prep_phase(const Ctx& F_, int li) {
    Ctx F = F_; asm volatile("" : "+v"(F.tid), "+v"(F.lane));
    unsigned char* const ws_ = kws();
    bf16_t* K = (bf16_t*)(ws_ + WS_K); const bf16_t* AV = (const bf16_t*)(ws_ + WS_AV); bf16_t* KK = (bf16_t*)(ws_ + WS_LORA);
    const float* k_k = kin(23) + li * 1024; const float* k_a = kin(24) + li * 1024;
    const int row0 = F.wg * 64 + F.wave * 8;
#pragma unroll 1
    for (int r = 0; r < 8; ++r) {
        const size_t ro = (size_t)(row0 + r) * D;
#pragma unroll
        for (int j = 0; j < 4; ++j) {
            const int e4 = 64 * j + F.lane;
            const v2u kw = ((const v2u*)(K + ro))[e4], aw = ((const v2u*)(AV + ro))[e4];
            const f32x4 kv = (f32x4){bflo(kw.x), bfhi(kw.x), bflo(kw.y), bfhi(kw.y)}, av = (f32x4){bflo(aw.x), bfhi(aw.x), bflo(aw.y), bfhi(aw.y)};
            const f32x4 kkv = kv * ((const f32x4*)k_k)[e4]; const f32x4 ka = ((const f32x4*)k_a)[e4];
            float ss = (kkv.x * kkv.x + kkv.y * kkv.y) + (kkv.z * kkv.z + kkv.w * kkv.w);
            ss += __shfl_xor(ss, 1); ss += __shfl_xor(ss, 2); ss += __shfl_xor(ss, 4); ss += __shfl_xor(ss, 8);
            const float inv = 1.0f / fmaxf(sqrtf(ss), 1e-12f);
            const f32x4 kn = kv * ((av - 1.0f) * ka + 1.0f), kq = kkv * inv;
            v2u o; o.x = pk2(kq.x, kq.y); o.y = pk2(kq.z, kq.w); ((v2u*)(KK + ro))[e4] = o;
            o.x = pk2(kn.x, kn.y); o.y = pk2(kn.z, kn.w); ((v2u*)(K + ro))[e4] = o;
        }
    }
}
__device__ __forceinline__ void odd_wkv_simple_phase(const Ctx& F_, int li) {
    Ctx F = F_; asm volatile("" : "+v"(F.tid), "+v"(F.lane));
    unsigned char* const ws_ = kws();
    const bf16_t* R = (const bf16_t*)(ws_ + WS_R); const bf16_t* K = (const bf16_t*)(ws_ + WS_K); const bf16_t* V = odd_vbuf(ws_, li); const bf16_t* AV = (const bf16_t*)(ws_ + WS_AV);
    const bf16_t* KK = (const bf16_t*)(ws_ + WS_LORA); const float* WD = (const float*)(ws_ + WS_WDEC); bf16_t* Y = (bf16_t*)(ws_ + WS_Y);
    LAS float* st = (LAS float*)F.lds;
    const int gt = F.wg * NTHREADS + F.tid;
    if (gt < NB * 16 * 64) {
        const int vr = gt & 63, hh = (gt >> 6) & 15, b = gt >> 10;
#pragma unroll 4
        for (int i = 0; i < 64; ++i) st[i * NTHREADS + F.tid] = 0.f;
        for (int t = 0; t < S; ++t) {
            const size_t base = ((size_t)b * S + t) * D + hh * 64;
            float sa = 0.f;
#pragma unroll 4
            for (int i = 0; i < 64; ++i) sa -= st[i * NTHREADS + F.tid] * bf2f(KK[base + i]);
            const float vv = bf2f(V[base + vr]); float yv = 0.f;
#pragma unroll 4
            for (int i = 0; i < 64; ++i) { const float kk = bf2f(KK[base + i]); const float sn = st[i * NTHREADS + F.tid] * WD[base + i] + sa * (kk * bf2f(AV[base + i])) + vv * bf2f(K[base + i]); st[i * NTHREADS + F.tid] = sn; yv += sn * bf2f(R[base + i]); }
            Y[base + vr] = (bf16_t)f2bf(yv);
        }
    }
}
__device__ __forceinline__ void odd_post_phase(const Ctx& F_, int li) {
    Ctx F = F_; asm volatile("" : "+v"(F.tid), "+v"(F.lane));
    unsigned char* const ws_ = kws();
    const bf16_t* R = (const bf16_t*)(ws_ + WS_R); const bf16_t* K = (const bf16_t*)(ws_ + WS_K); const bf16_t* V = odd_vbuf(ws_, li); const bf16_t* G = (const bf16_t*)(ws_ + WS_G); bf16_t* Y = (bf16_t*)(ws_ + WS_Y);
    const float* r_k = kin(25) + li * 1024; const float* ln_w = kin(26) + li * 1024; const float* ln_b = kin(27) + li * 1024;
    const int row0 = F.wg * 64 + F.wave * 8;
#pragma unroll 1
    for (int r = 0; r < 8; ++r) {
        const size_t ro = (size_t)(row0 + r) * D;
#pragma unroll
        for (int j = 0; j < 4; ++j) {
            const int e4 = 64 * j + F.lane;
            const v2u yw = ((const v2u*)(Y + ro))[e4], rw = ((const v2u*)(R + ro))[e4], kw = ((const v2u*)(K + ro))[e4], vw = ((const v2u*)(V + ro))[e4], gw_ = ((const v2u*)(G + ro))[e4];
            const f32x4 y = (f32x4){bflo(yw.x), bfhi(yw.x), bflo(yw.y), bfhi(yw.y)}, rr = (f32x4){bflo(rw.x), bfhi(rw.x), bflo(rw.y), bfhi(rw.y)}, kk = (f32x4){bflo(kw.x), bfhi(kw.x), bflo(kw.y), bfhi(kw.y)};
            const f32x4 vv = (f32x4){bflo(vw.x), bfhi(vw.x), bflo(vw.y), bfhi(vw.y)}, gg = (f32x4){bflo(gw_.x), bfhi(gw_.x), bflo(gw_.y), bfhi(gw_.y)};
            float s1 = (y.x + y.y) + (y.z + y.w);
            s1 += __shfl_xor(s1, 1); s1 += __shfl_xor(s1, 2); s1 += __shfl_xor(s1, 4); s1 += __shfl_xor(s1, 8);
            const float mean = s1 * (1.f / 64.f); const f32x4 d = y - mean;
            float s2 = (d.x * d.x + d.y * d.y) + (d.z * d.z + d.w * d.w);
            s2 += __shfl_xor(s2, 1); s2 += __shfl_xor(s2, 2); s2 += __shfl_xor(s2, 4); s2 += __shfl_xor(s2, 8);
            const float rstd = 1.0f / sqrtf(s2 * (1.f / 64.f) + 64e-5f);
            const f32x4 rk4 = rr * kk * ((const f32x4*)r_k)[e4]; float s3 = (rk4.x + rk4.y) + (rk4.z + rk4.w);
            s3 += __shfl_xor(s3, 1); s3 += __shfl_xor(s3, 2); s3 += __shfl_xor(s3, 4); s3 += __shfl_xor(s3, 8);
            const f32x4 o = (d * rstd * ((const f32x4*)ln_w)[e4] + ((const f32x4*)ln_b)[e4] + vv * s3) * gg;
            v2u w; w.x = pk2(o.x, o.y); w.y = pk2(o.z, o.w); ((v2u*)(Y + ro))[e4] = w;
        }
    }
}
}
namespace fm {
constexpr size_t WS_ZS = WS_R1 + 32 * MiB;
constexpr size_t WS_WKVS = WS_LORA;
constexpr size_t SM_RK = SM_ZSS;
constexpr int LX_WC = 8192;
constexpr float LOG2E = 1.4426950408889634f;
__device__ __forceinline__ bf16x8 pk8lo(const f32x16& a) { v4u w; w.x = cvtpk(a[0], a[1]); w.y = cvtpk(a[2], a[3]); w.z = cvtpk(a[4], a[5]); w.w = cvtpk(a[6], a[7]); return __builtin_bit_cast(bf16x8, w); }
__device__ __forceinline__ bf16x8 pk8hi(const f32x16& a) { v4u w; w.x = cvtpk(a[8], a[9]); w.y = cvtpk(a[10], a[11]); w.z = cvtpk(a[12], a[13]); w.w = cvtpk(a[14], a[15]); return __builtin_bit_cast(bf16x8, w); }
struct PH { bf16x8 f0, f1; };
__device__ __forceinline__ PH packh(const f32x16& a) { PH p; p.f0 = pk8lo(a); p.f1 = pk8hi(a); return p; }
__device__ __forceinline__ f32x16 zero16() { f32x16 z;
#pragma unroll
    for (int r = 0; r < 16; ++r) z[r] = 0.f; return z; }
#define MFMA32(a, b, c) __builtin_amdgcn_mfma_f32_32x32x16_bf16((a), (b), (c), 0, 0, 0)
__device__ __forceinline__ f32x16 ident16(int lane) { int l = lane; asm volatile("" : "+v"(l)); f32x16 z;
#pragma unroll
    for (int r = 0; r < 16; ++r) z[r] = (((r & 3) + 8 * (r >> 2) + 4 * (l >> 5)) == (l & 31)) ? 1.f : 0.f; return z; }
__device__ __forceinline__ f32x16 tt(const PH& U, const PH& W, f32x16 C) { C = MFMA32(U.f0, W.f0, C); C = MFMA32(U.f1, W.f1, C); return C; }
__device__ __forceinline__ bf16x8 colfrag(const LAS unsigned char* mat, int nt, int s, int lane) {
    const int g4 = lane >> 4, i16 = lane & 15, h2 = lane >> 5;
    const LAS unsigned char* p = mat + (16 * s + 4 * h2 + (i16 >> 2)) * 128 + (32 * nt + 16 * (g4 & 1) + 4 * (i16 & 3)) * 2;
    const s16x4 lo = tr_read(p), hi = tr_read(p + 8 * 128);
    return (bf16x8){lo[0], lo[1], lo[2], lo[3], hi[0], hi[1], hi[2], hi[3]};
}
__device__ __forceinline__ PH colph(const LAS unsigned char* mat, int nt, int lane) { PH p; p.f0 = colfrag(mat, nt, 0, lane); p.f1 = colfrag(mat, nt, 1, lane); return p; }
__device__ __forceinline__ f32x4 unpk4(v2u w) { return (f32x4){bflo(w.x), bfhi(w.x), bflo(w.y), bfhi(w.y)}; }
__device__ __forceinline__ v2u pk4(f32x4 v) { v2u o; o.x = cvtpk(v.x, v.y); o.y = cvtpk(v.z, v.w); return o; }
__device__ __forceinline__ void store_rowgroups(bf16_t* rowp  , const f32x16& a, int h2) {
#pragma unroll
    for (int g = 0; g < 4; ++g) *(v2u*)(rowp + 8 * g + 4 * h2) = pk4((f32x4){a[4 * g], a[4 * g + 1], a[4 * g + 2], a[4 * g + 3]});
}

__device__ __forceinline__ void wkv1_task(unsigned char* ws_, const float* k_k, const float* k_a, const float* r_k, int li, int b, int hh, int sc, LAS unsigned char* wl, LAS float* wct, int lane_in, bool dry = false) {
    int lane = lane_in; int t32 = lane & 31, h2 = lane >> 5;
    const bf16_t* Rg = (const bf16_t*)(ws_ + WS_R); const bf16_t* Kg = (const bf16_t*)(ws_ + WS_K); const bf16_t* Vg = odd_vbuf(ws_, li);
    bf16_t* AVg = (bf16_t*)(ws_ + WS_AV); bf16_t* LWg = (bf16_t*)(ws_ + WS_WDEC); float* RKg = (float*)(ws_ + WS_SMALL + SM_RK);
    LAS unsigned char* ldsA = wl; LAS unsigned char* ldsB = wl + 4096; LAS unsigned char* ldsK = wl + 8192; LAS unsigned char* ldsV = wl + 12288;
    PH Gh[2][2], Hh[2][2];
    { const PH ip = packh(ident16(lane)), zp = packh(zero16()); Gh[0][0] = ip; Gh[1][1] = ip; Gh[0][1] = zp; Gh[1][0] = zp; Hh[0][0] = zp; Hh[0][1] = zp; Hh[1][0] = zp; Hh[1][1] = zp; }
#pragma unroll 1
    for (int j = 0; j < 4; ++j) {
        lane = lane_in; asm volatile("" : "+v"(lane)); t32 = lane & 31; h2 = lane >> 5;
        const size_t rowoff = ((size_t)b * S + sc * 128 + j * 32 + t32) * D + hh * 64;
        PH fA[2], fB[2], fK[2], fR[2];
        float inv;
        {
            float nrm = 0.f, rk = 0.f;
#pragma unroll
            for (int g = 0; g < 8; ++g) {
                const int k0 = 8 * g + 4 * h2;
                const f32x4 rr = unpk4(*(const v2u*)(Rg + rowoff + k0)), ko = unpk4(*(const v2u*)(Kg + rowoff + k0)), av = unpk4(*(const v2u*)(AVg + rowoff + k0));
                const f32x4 kkw = *(const f32x4*)(k_k + hh * 64 + k0), kaw = *(const f32x4*)(k_a + hh * 64 + k0), rkw = *(const f32x4*)(r_k + hh * 64 + k0);
                const f32x4 kq = ko * kkw; nrm += (kq.x * kq.x + kq.y * kq.y) + (kq.z * kq.z + kq.w * kq.w);
                const f32x4 t3 = rr * (ko * ((av - 1.0f) * kaw + 1.0f)) * rkw; rk += (t3.x + t3.y) + (t3.z + t3.w);
                *(LAS v2u*)(ldsV + t32 * 128 + k0 * 2) = *(const v2u*)(Vg + rowoff + k0);
            }
            nrm += __shfl_xor(nrm, 32); rk += __shfl_xor(rk, 32);
            if (h2 == 0 && !dry) RKg[((size_t)b * S + sc * 128 + j * 32 + t32) * 16 + hh] = rk;
            inv = 1.0f / fmaxf(sqrtf(nrm), 1e-12f);
            asm volatile("" ::: "memory");
        }
#pragma unroll
        for (int ks = 0; ks < 4; ++ks) {
            float cum[8], lw0[8], kk1[8], aa[8], kpp[8], rr1[8];
#pragma unroll
            for (int gg = 0; gg < 2; ++gg) {
                const int g = 2 * ks + gg, k0 = 8 * g + 4 * h2;
                const f32x4 rr = unpk4(*(const v2u*)(Rg + rowoff + k0)), ko = unpk4(*(const v2u*)(Kg + rowoff + k0)), av = unpk4(*(const v2u*)(AVg + rowoff + k0)), lw = unpk4(*(const v2u*)(LWg + rowoff + k0));
                const f32x4 kkw = *(const f32x4*)(k_k + hh * 64 + k0), kaw = *(const f32x4*)(k_a + hh * 64 + k0);
                const f32x4 kq = ko * kkw * inv, kp = ko * ((av - 1.0f) * kaw + 1.0f);
#pragma unroll
                for (int q = 0; q < 4; ++q) { cum[4 * gg + q] = lw[q]; lw0[4 * gg + q] = lw[q]; kk1[4 * gg + q] = kq[q]; aa[4 * gg + q] = av[q]; kpp[4 * gg + q] = kp[q]; rr1[4 * gg + q] = rr[q]; }
            }
#pragma unroll
            for (int d = 1; d < 32; d <<= 1) {
#pragma unroll
                for (int e = 0; e < 8; ++e) { const float up = __shfl_up(cum[e], d, 32); cum[e] += (t32 >= d) ? up : 0.f; }
            }
            if (t32 == 31) {
#pragma unroll
                for (int gg = 0; gg < 2; ++gg) *(LAS f32x4*)(wct + 8 * (2 * ks + gg) + 4 * h2) = (f32x4){__builtin_amdgcn_exp2f(cum[4 * gg]), __builtin_amdgcn_exp2f(cum[4 * gg + 1]), __builtin_amdgcn_exp2f(cum[4 * gg + 2]), __builtin_amdgcn_exp2f(cum[4 * gg + 3])};
            }
            float a_[8], b_[8], k_[8], r_[8];
#pragma unroll
            for (int e = 0; e < 8; ++e) {
                const float wt = __builtin_amdgcn_exp2f(cum[e]), wp = __builtin_amdgcn_exp2f(cum[e] - lw0[e]), iw = __builtin_amdgcn_exp2f(-cum[e]);
                a_[e] = -kk1[e] * wp; b_[e] = kk1[e] * aa[e] * iw; k_[e] = kpp[e] * iw; r_[e] = rr1[e] * wt;
            }
            v4u pa, pb, pk, pr;
            pa.x = cvtpk(a_[0], a_[1]); pa.y = cvtpk(a_[2], a_[3]); pa.z = cvtpk(a_[4], a_[5]); pa.w = cvtpk(a_[6], a_[7]);
            pb.x = cvtpk(b_[0], b_[1]); pb.y = cvtpk(b_[2], b_[3]); pb.z = cvtpk(b_[4], b_[5]); pb.w = cvtpk(b_[6], b_[7]);
            pk.x = cvtpk(k_[0], k_[1]); pk.y = cvtpk(k_[2], k_[3]); pk.z = cvtpk(k_[4], k_[5]); pk.w = cvtpk(k_[6], k_[7]);
            pr.x = cvtpk(r_[0], r_[1]); pr.y = cvtpk(r_[2], r_[3]); pr.z = cvtpk(r_[4], r_[5]); pr.w = cvtpk(r_[6], r_[7]);
#pragma unroll
            for (int gg = 0; gg < 2; ++gg) {
                const int k0 = 8 * (2 * ks + gg) + 4 * h2;
                *(LAS v2u*)(ldsA + t32 * 128 + k0 * 2) = gg == 0 ? (v2u){pa.x, pa.y} : (v2u){pa.z, pa.w};
                *(LAS v2u*)(ldsB + t32 * 128 + k0 * 2) = gg == 0 ? (v2u){pb.x, pb.y} : (v2u){pb.z, pb.w};
                *(LAS v2u*)(ldsK + t32 * 128 + k0 * 2) = gg == 0 ? (v2u){pk.x, pk.y} : (v2u){pk.z, pk.w};
            }
            if ((ks & 1) == 0) { fA[ks >> 1].f0 = __builtin_bit_cast(bf16x8, pa); fB[ks >> 1].f0 = __builtin_bit_cast(bf16x8, pb); fK[ks >> 1].f0 = __builtin_bit_cast(bf16x8, pk); fR[ks >> 1].f0 = __builtin_bit_cast(bf16x8, pr); }
            else { fA[ks >> 1].f1 = __builtin_bit_cast(bf16x8, pa); fB[ks >> 1].f1 = __builtin_bit_cast(bf16x8, pb); fK[ks >> 1].f1 = __builtin_bit_cast(bf16x8, pk); fR[ks >> 1].f1 = __builtin_bit_cast(bf16x8, pr); }
            asm volatile("" ::: "memory");
        }
        asm volatile("s_waitcnt lgkmcnt(0)" ::: "memory");
        PH pN, pNT, pAakT, pArbT, pArkT; f32x16 PT;
        {
#define KPROD(dst, fa, fb, keep) { f32x16 acc_ = tt(fa[1], fb[1], tt(fa[0], fb[0], zero16())); _Pragma("unroll") for (int r = 0; r < 16; ++r) { const int rowi = (r & 3) + 8 * (r >> 2) + 4 * h2; acc_[r] = (keep) ? acc_[r] : 0.f; } dst; __builtin_amdgcn_sched_barrier(0); }
            KPROD(pN = packh(acc_), fA, fB, t32 < rowi)
            KPROD(PT = ident16(lane) + acc_; pNT = packh(acc_), fB, fA, rowi < t32)
            KPROD(pAakT = packh(acc_), fK, fA, rowi < t32)
            KPROD(pArbT = packh(acc_), fB, fR, rowi <= t32)
            KPROD(pArkT = packh(acc_), fK, fR, rowi <= t32)
#undef KPROD
        }
        {
            PH X = pN, XT = pNT;
#pragma unroll
            for (int step = 0; step < 4; ++step) {
                const f32x16 x2 = tt(XT, X, zero16());
                if (step < 3) { const f32x16 xt2 = tt(X, XT, zero16()); XT = packh(xt2); }
                X = packh(x2);
                PT = tt(X, packh(PT), PT);
            }
        }
        const PH pPT = packh(PT);
        PH pAp[2], pUl[2];
#pragma unroll
        for (int nt = 0; nt < 2; ++nt) {
            pAp[nt] = packh(tt(pPT, colph(ldsA, nt, lane), zero16()));
            const PH x1 = packh(tt(pAakT, colph(ldsV, nt, lane), zero16()));
            pUl[nt] = packh(tt(pPT, x1, zero16()));
        }
        PH pRp[2]; f32x16 YlT[2];
#pragma unroll
        for (int mt = 0; mt < 2; ++mt) {
            f32x16 c0;
#pragma unroll
            for (int q = 0; q < 8; ++q) { c0[q] = bf2f((unsigned short)fR[mt].f0[q]); c0[8 + q] = bf2f((unsigned short)fR[mt].f1[q]); }
            pRp[mt] = packh(tt(pAp[mt], pArbT, c0));
            YlT[mt] = tt(colph(ldsV, mt, lane), pArkT, tt(pUl[mt], pArbT, zero16()));
        }
#pragma unroll
        for (int mt = 0; mt < 2; ++mt) {
            const f32x16 rpp = tt(Gh[1][mt], pRp[1], tt(Gh[0][mt], pRp[0], zero16()));
            if (!dry) store_rowgroups(AVg + rowoff + 32 * mt, rpp, h2); else asm volatile("" :: "v"(rpp));
            const f32x16 yl = tt(Hh[1][mt], pRp[1], tt(Hh[0][mt], pRp[0], YlT[mt]));
            if (!dry) store_rowgroups(LWg + rowoff + 32 * mt, yl, h2); else asm volatile("" :: "v"(yl));
        }
        lane = lane_in; asm volatile("" : "+v"(lane)); t32 = lane & 31; h2 = lane >> 5;
        PH pM[2][2];
#pragma unroll
        for (int mt = 0; mt < 2; ++mt)
#pragma unroll
            for (int nt = 0; nt < 2; ++nt) {
                f32x16 m = tt(pAp[mt], colph(ldsB, nt, lane), mt == nt ? ident16(lane) : zero16());
                const float wc = wct[32 * nt + t32];
#pragma unroll
                for (int r = 0; r < 16; ++r) m[r] *= wc;
                pM[mt][nt] = packh(m);
            }
#pragma unroll
        for (int nt = 0; nt < 2; ++nt) {
            PH gn[2], hn[2];
#pragma unroll
            for (int mt = 0; mt < 2; ++mt) {
                f32x16 hq = tt(colph(ldsK, mt, lane), colph(ldsV, nt, lane), tt(colph(ldsB, mt, lane), pUl[nt], zero16()));
#pragma unroll
                for (int g = 0; g < 4; ++g) { const f32x4 wc4 = *(const LAS f32x4*)(wct + 32 * mt + 8 * g + 4 * h2);
#pragma unroll
                    for (int q = 0; q < 4; ++q) hq[4 * g + q] *= wc4[q]; }
                hn[mt] = packh(tt(pM[1][mt], Hh[1][nt], tt(pM[0][mt], Hh[0][nt], hq)));
                gn[mt] = packh(tt(pM[1][mt], Gh[1][nt], tt(pM[0][mt], Gh[0][nt], zero16())));
            }
            Gh[0][nt] = gn[0]; Gh[1][nt] = gn[1]; Hh[0][nt] = hn[0]; Hh[1][nt] = hn[1];
        }
        asm volatile("s_waitcnt lgkmcnt(0)" ::: "memory");
    }
    lane = lane_in; asm volatile("" : "+v"(lane)); t32 = lane & 31; h2 = lane >> 5;
    unsigned char* outp = ws_ + (dry ? WS_ZS : WS_WKVS) + ((size_t)((b * 16 + hh) * 16 + sc)) * (dry ? 0 : 16384);
#pragma unroll
    for (int kt = 0; kt < 2; ++kt) {
#pragma unroll
        for (int mt = 0; mt < 2; ++mt) {
            const v4u w0 = __builtin_bit_cast(v4u, Gh[mt][kt].f0), w1 = __builtin_bit_cast(v4u, Gh[mt][kt].f1);
            LAS unsigned char* rowp = wl + 4096 * kt + t32 * 128 + (32 * mt + 4 * h2) * 2;
            *(LAS v2u*)(rowp + 0) = (v2u){w0.x, w0.y}; *(LAS v2u*)(rowp + 16) = (v2u){w0.z, w0.w}; *(LAS v2u*)(rowp + 32) = (v2u){w1.x, w1.y}; *(LAS v2u*)(rowp + 48) = (v2u){w1.z, w1.w};
        }
    }
    asm volatile("s_waitcnt lgkmcnt(0)" ::: "memory");
#pragma unroll
    for (int kt = 0; kt < 2; ++kt)
#pragma unroll
        for (int mt = 0; mt < 2; ++mt)
#pragma unroll
            for (int s = 0; s < 2; ++s) *(bf16x8*)(outp + ((size_t)((kt * 2 + mt) * 2 + s) * 64 + lane) * 16) = colfrag(wl + 4096 * kt, mt, s, lane);
#pragma unroll
    for (int mt = 0; mt < 2; ++mt)
#pragma unroll
        for (int nt = 0; nt < 2; ++nt) { *(bf16x8*)(outp + 8192 + ((size_t)((mt * 2 + nt) * 2 + 0) * 64 + lane) * 16) = Hh[mt][nt].f0; *(bf16x8*)(outp + 8192 + ((size_t)((mt * 2 + nt) * 2 + 1) * 64 + lane) * 16) = Hh[mt][nt].f1; }
    asm volatile("s_waitcnt lgkmcnt(0)" ::: "memory");
}
__device__ __forceinline__ void odd_wkv1_phase(const Ctx& F_, int li) {
    Ctx F = F_; asm volatile("" : "+v"(F.tid), "+v"(F.lane));
    unsigned char* const ws_ = kws();
    const int task = F.wg * NWAVES + F.wave;
    const int sc = task & 15, hh = (task >> 4) & 15, b = task >> 8;
#ifdef EXP_W1
    wkv1_task(ws_, kin(23) + li * 1024, kin(24) + li * 1024, kin(25) + li * 1024, li, b, hh, sc, F.lds + F.wave * 16384, (LAS float*)(F.lds + LDSCTL_OFF + LX_WC + F.wave * 256), F.lane, true);
#endif
    wkv1_task(ws_, kin(23) + li * 1024, kin(24) + li * 1024, kin(25) + li * 1024, li, b, hh, sc, F.lds + F.wave * 16384, (LAS float*)(F.lds + LDSCTL_OFF + LX_WC + F.wave * 256), F.lane);
}
__device__ __forceinline__ void odd_wkv2a_phase(const Ctx& F_) {
    Ctx F = F_; asm volatile("" : "+v"(F.tid), "+v"(F.lane));
    unsigned char* const ws_ = kws();
    if (F.wave != 0 || F.wg >= 128) return;
    const int lane = F.lane, b = F.wg >> 4, hh = F.wg & 15;
    f32x16 Z[2][2];
#pragma unroll
    for (int a = 0; a < 2; ++a)
#pragma unroll
        for (int c = 0; c < 2; ++c) Z[a][c] = zero16();
    const unsigned char* sp0 = ws_ + WS_WKVS + ((size_t)((b * 16 + hh) * 16)) * 16384; unsigned char* zp0 = ws_ + WS_ZS + ((size_t)((b * 16 + hh) * 16)) * 8192;
    bf16x8 mf[8], hf[8];
#pragma unroll
    for (int i = 0; i < 8; ++i) { mf[i] = *(const bf16x8*)(sp0 + ((size_t)i * 64 + lane) * 16); hf[i] = *(const bf16x8*)(sp0 + 8192 + ((size_t)i * 64 + lane) * 16); }
#pragma unroll 1
    for (int sc = 0; sc < 16; ++sc) {
        PH pZ[2][2];
#pragma unroll
        for (int a = 0; a < 2; ++a)
#pragma unroll
            for (int c = 0; c < 2; ++c) { pZ[a][c] = packh(Z[a][c]); *(bf16x8*)(zp0 + (size_t)sc * 8192 + ((size_t)((a * 2 + c) * 2 + 0) * 64 + lane) * 16) = pZ[a][c].f0; *(bf16x8*)(zp0 + (size_t)sc * 8192 + ((size_t)((a * 2 + c) * 2 + 1) * 64 + lane) * 16) = pZ[a][c].f1; }
        bf16x8 mn[8], hn[8]; const unsigned char* spn = sp0 + (size_t)(sc < 15 ? sc + 1 : sc) * 16384;
#pragma unroll
        for (int i = 0; i < 8; ++i) { mn[i] = *(const bf16x8*)(spn + ((size_t)i * 64 + lane) * 16); hn[i] = *(const bf16x8*)(spn + 8192 + ((size_t)i * 64 + lane) * 16); }
#pragma unroll
        for (int mt = 0; mt < 2; ++mt)
#pragma unroll
            for (int nt = 0; nt < 2; ++nt) {
                f32x16 c0;
#pragma unroll
                for (int q = 0; q < 8; ++q) { c0[q] = bf2f((unsigned short)hf[(mt * 2 + nt) * 2][q]); c0[8 + q] = bf2f((unsigned short)hf[(mt * 2 + nt) * 2 + 1][q]); }
#pragma unroll
                for (int kt = 0; kt < 2; ++kt) { PH m_; m_.f0 = mf[(kt * 2 + mt) * 2]; m_.f1 = mf[(kt * 2 + mt) * 2 + 1]; c0 = tt(m_, pZ[kt][nt], c0); }
                Z[mt][nt] = c0;
            }
#pragma unroll
        for (int i = 0; i < 8; ++i) { mf[i] = mn[i]; hf[i] = hn[i]; }
    }
}
__device__ __forceinline__ void odd_wkv2b_phase(const Ctx& F_, int li) {
    Ctx F = F_; asm volatile("" : "+v"(F.tid), "+v"(F.lane));
    unsigned char* const ws_ = kws();
    const int task = F.wg * NWAVES + F.wave, sc = task & 15, hh = (task >> 4) & 15, b = task >> 8;
    const int lane = F.lane, t32 = lane & 31, h2 = lane >> 5;
    const bf16_t* RPP = (const bf16_t*)(ws_ + WS_AV); const bf16_t* YL = (const bf16_t*)(ws_ + WS_WDEC); const bf16_t* Vg = odd_vbuf(ws_, li); const bf16_t* Gg = (const bf16_t*)(ws_ + WS_G);
    const float* RKg = (const float*)(ws_ + WS_SMALL + SM_RK); bf16_t* OA = (bf16_t*)(ws_ + WS_Y);
    const float* ln_w = kin(26) + li * 1024 + hh * 64; const float* ln_b = kin(27) + li * 1024 + hh * 64;
    const unsigned char* zp = ws_ + WS_ZS + ((size_t)((b * 16 + hh) * 16 + sc)) * 8192;
    PH pZ[2][2];
#pragma unroll
    for (int a = 0; a < 2; ++a)
#pragma unroll
        for (int c = 0; c < 2; ++c) { pZ[a][c].f0 = *(const bf16x8*)(zp + ((size_t)((a * 2 + c) * 2 + 0) * 64 + lane) * 16); pZ[a][c].f1 = *(const bf16x8*)(zp + ((size_t)((a * 2 + c) * 2 + 1) * 64 + lane) * 16); }
#pragma unroll 1
    for (int j = 0; j < 4; ++j) {
        const size_t trow = (size_t)b * S + sc * 128 + j * 32 + t32, rowoff = trow * D + hh * 64;
        PH rp[2];
#pragma unroll
        for (int kt = 0; kt < 2; ++kt) {
            const v2u a0 = *(const v2u*)(RPP + rowoff + 32 * kt + 4 * h2), a1 = *(const v2u*)(RPP + rowoff + 32 * kt + 8 + 4 * h2), a2 = *(const v2u*)(RPP + rowoff + 32 * kt + 16 + 4 * h2), a3 = *(const v2u*)(RPP + rowoff + 32 * kt + 24 + 4 * h2);
            rp[kt].f0 = __builtin_bit_cast(bf16x8, (v4u){a0.x, a0.y, a1.x, a1.y}); rp[kt].f1 = __builtin_bit_cast(bf16x8, (v4u){a2.x, a2.y, a3.x, a3.y});
        }
        f32x16 y[2];
#pragma unroll
        for (int mt = 0; mt < 2; ++mt) {
            f32x16 c0;
#pragma unroll
            for (int g = 0; g < 4; ++g) { const f32x4 q4 = unpk4(*(const v2u*)(YL + rowoff + 32 * mt + 8 * g + 4 * h2)); c0[4 * g] = q4.x; c0[4 * g + 1] = q4.y; c0[4 * g + 2] = q4.z; c0[4 * g + 3] = q4.w; }
            y[mt] = tt(pZ[1][mt], rp[1], tt(pZ[0][mt], rp[0], c0));
        }
        float s1 = 0.f;
#pragma unroll
        for (int mt = 0; mt < 2; ++mt)
#pragma unroll
            for (int r = 0; r < 16; ++r) s1 += y[mt][r];
        s1 += __shfl_xor(s1, 32);
        const float mean = s1 * (1.f / 64.f); float s2 = 0.f;
#pragma unroll
        for (int mt = 0; mt < 2; ++mt)
#pragma unroll
            for (int r = 0; r < 16; ++r) { const float dd = y[mt][r] - mean; s2 += dd * dd; }
        s2 += __shfl_xor(s2, 32);
        const float rstd = 1.0f / sqrtf(s2 * (1.f / 64.f) + 64e-5f), rk = RKg[trow * 16 + hh];
#pragma unroll
        for (int mt = 0; mt < 2; ++mt)
#pragma unroll
            for (int g = 0; g < 4; ++g) { const int c0 = 32 * mt + 8 * g + 4 * h2;
                const f32x4 vv = unpk4(*(const v2u*)(Vg + rowoff + c0)), gg = unpk4(*(const v2u*)(Gg + rowoff + c0)), lw = *(const f32x4*)(ln_w + c0), lb = *(const f32x4*)(ln_b + c0);
                const f32x4 yy = (f32x4){y[mt][4 * g], y[mt][4 * g + 1], y[mt][4 * g + 2], y[mt][4 * g + 3]};
                const f32x4 o = ((yy - mean) * rstd * lw + lb + vv * rk) * gg;
                *(v2u*)(OA + rowoff + c0) = pk4(o); }
    }
}
}
namespace fm {
__device__ __forceinline__ void ada_phase(const Ctx& F_) {
    Ctx F = F_; asm volatile("" : "+v"(F.tid), "+v"(F.lane));
    unsigned char* const ws_ = kws(); const float* c = kin(1); const float* ada_w = kin(2); const float* ada_b = kin(3);
    float* mod = (float*)(ws_ + WS_MOD);
    LAS float* cs = (LAS float*)F.lds;
    LAS float* part = (LAS float*)(F.lds + 32768);
    for (int i = F.tid; i < 8 * 1024; i += NTHREADS) { const float v = c[i]; cs[i] = v / (1.f + __expf(-v)); }
    __syncthreads();
#pragma unroll 1
    for (int task = F.wg; task < 8 * 48; task += F.G) {
        const int ls = task / 48, n0 = (task % 48) * 64;
        const float* W = ada_w + ((size_t)ls * 1024 + F.wave * 128) * 3072 + n0 + F.lane;
        float acc[8];
#pragma unroll
        for (int b = 0; b < 8; ++b) acc[b] = 0.f;
#pragma unroll 1
        for (int k0 = 0; k0 < 128; k0 += 16) {
            float w[16];
#pragma unroll
            for (int i = 0; i < 16; ++i) w[i] = W[(size_t)(k0 + i) * 3072];
#pragma unroll
            for (int i = 0; i < 16; ++i)
#pragma unroll
                for (int b = 0; b < 8; ++b) acc[b] += cs[b * 1024 + F.wave * 128 + k0 + i] * w[i];
        }
#pragma unroll
        for (int b = 0; b < 8; ++b) part[(F.wave * 8 + b) * 64 + F.lane] = acc[b];
        __syncthreads();
        { const int b = F.tid >> 6, l = F.tid & 63; float s = 0.f;
#pragma unroll
            for (int w8 = 0; w8 < 8; ++w8) s += part[(w8 * 8 + b) * 64 + l];
            mod[((size_t)ls * NB + b) * 3072 + n0 + l] = s + ada_b[ls * 3072 + n0 + l]; }
        __syncthreads();
    }
}
__device__ __forceinline__ void norm_phase(const Ctx& F_, int ls, int comb, const float* xsrc) {
    Ctx F = F_; asm volatile("" : "+v"(F.tid), "+v"(F.lane));
    unsigned char* const ws_ = kws(); float* const xo = kout(); const float* const mod_ = (const float*)(ws_ + WS_MOD);
    bf16_t* XN = (bf16_t*)(ws_ + WS_XN); const bf16_t* YS = (const bf16_t*)(ws_ + WS_YS);
    const int row0 = F.wg * 64 + F.wave * 8, b = row0 / S;
    const float* m = mod_ + ((size_t)ls * NB + b) * 3072;
    const float* gm = mod_ + ((size_t)(comb < 0 ? 0 : comb * 2 + 1) * NB + b) * 3072 + 2048;
    f32x4 vn[4]; v2u an[4], cn[4];
#pragma unroll
    for (int j = 0; j < 4; ++j) { vn[j] = ((const f32x4*)(xsrc + (size_t)row0 * D) + F.lane)[64 * j]; an[j] = (v2u){0u, 0u}; cn[j] = (v2u){0u, 0u}; }
    if (comb >= 0) {
#pragma unroll
        for (int j = 0; j < 4; ++j) { an[j] = ((const v2u*)(YS + (size_t)row0 * D) + F.lane)[64 * j]; cn[j] = ((const v2u*)(YS + ((size_t)T + row0) * D) + F.lane)[64 * j]; }
    }
#pragma unroll 1
    for (int r = 0; r < 8; ++r) {
        const int row = row0 + r, rown = row0 + (r < 7 ? r + 1 : r);
        f32x4 v[4]; v2u ya[4], yc[4]; float ss = 0.f;
#pragma unroll
        for (int j = 0; j < 4; ++j) { v[j] = vn[j]; ya[j] = an[j]; yc[j] = cn[j]; }
#pragma unroll
        for (int j = 0; j < 4; ++j) vn[j] = ((const f32x4*)(xsrc + (size_t)rown * D) + F.lane)[64 * j];
        if (comb >= 0) {
#pragma unroll
            for (int j = 0; j < 4; ++j) { an[j] = ((const v2u*)(YS + (size_t)rown * D) + F.lane)[64 * j]; cn[j] = ((const v2u*)(YS + ((size_t)T + rown) * D) + F.lane)[64 * j]; }
            f32x4* xw = (f32x4*)(xo + (size_t)row * D) + F.lane;
#pragma unroll
            for (int j = 0; j < 4; ++j) { const v2u a = ya[j], c = yc[j]; const f32x4 g = ((const f32x4*)gm)[64 * j + F.lane];
                v[j].x += g.x * (bflo(a.x) + bflo(c.x)); v[j].y += g.y * (bfhi(a.x) + bfhi(c.x)); v[j].z += g.z * (bflo(a.y) + bflo(c.y)); v[j].w += g.w * (bfhi(a.y) + bfhi(c.y));
                xw[64 * j] = v[j]; }
        }
#pragma unroll
        for (int j = 0; j < 4; ++j) ss += (v[j].x * v[j].x + v[j].y * v[j].y) + (v[j].z * v[j].z + v[j].w * v[j].w);
        const float rinv = 1.0f / sqrtf(wave_sum(ss) * (1.f / D) + 1e-6f);
        unsigned long long* o8 = (unsigned long long*)(XN + (size_t)row * D) + F.lane;
#pragma unroll
        for (int j = 0; j < 4; ++j) {
            const f32x4 sh = ((const f32x4*)m)[64 * j + F.lane], sc = ((const f32x4*)(m + 1024))[64 * j + F.lane];
            const f32x4 h = v[j] * rinv * (sc + 1.0f) + sh;
            o8[64 * j] = (unsigned long long)pk2(h.x, h.y) | ((unsigned long long)pk2(h.z, h.w) << 32);
        }
    }
}
__device__ __forceinline__ void final_phase(const Ctx& F_) {
    Ctx F = F_; asm volatile("" : "+v"(F.tid), "+v"(F.lane));
    unsigned char* const ws_ = kws(); float* const xo = kout(); const float* const mod_ = (const float*)(ws_ + WS_MOD); const float* fg = kin(33);
    const bf16_t* YS = (const bf16_t*)(ws_ + WS_YS);
    const int row0 = F.wg * 64 + F.wave * 8, b = row0 / S;
    const float* gm = mod_ + ((size_t)(3 * 2 + 1) * NB + b) * 3072 + 2048;
#pragma unroll 1
    for (int r = 0; r < 8; ++r) {
        const int row = row0 + r;
        f32x4* xr = (f32x4*)(xo + (size_t)row * D) + F.lane;
        const v2u* y0 = (const v2u*)(YS + (size_t)row * D) + F.lane; const v2u* y1 = (const v2u*)(YS + ((size_t)T + row) * D) + F.lane;
        f32x4 v[4]; float ss = 0.f;
#pragma unroll
        for (int j = 0; j < 4; ++j) { v[j] = xr[64 * j]; const v2u a = y0[64 * j], c = y1[64 * j]; const f32x4 g = ((const f32x4*)gm)[64 * j + F.lane];
            v[j].x += g.x * (bflo(a.x) + bflo(c.x)); v[j].y += g.y * (bfhi(a.x) + bfhi(c.x)); v[j].z += g.z * (bflo(a.y) + bflo(c.y)); v[j].w += g.w * (bfhi(a.y) + bfhi(c.y));
            ss += (v[j].x * v[j].x + v[j].y * v[j].y) + (v[j].z * v[j].z + v[j].w * v[j].w); }
        const float rinv = 1.0f / sqrtf(wave_sum(ss) * (1.f / D) + 1e-6f);
#pragma unroll
        for (int j = 0; j < 4; ++j) xr[64 * j] = v[j] * rinv * ((const f32x4*)fg)[64 * j + F.lane];
    }
}
}
struct Args { const float* in[34]; float* out; unsigned char* ws; };
__global__ void __launch_bounds__(NTHREADS, 2) mega_fwd(Args args) {
    (void)args;
    extern __shared__ __attribute__((aligned(16))) unsigned char lds[];
    LAS unsigned char* L = (LAS unsigned char*)lds;
    for (int u = threadIdx.x; u < (LDS_BYTES - LDSCTL_OFF) / 4; u += NTHREADS) ((LAS unsigned*)(L + LDSCTL_OFF))[u] = 0u;
    __syncthreads();
    (void)xcd_barrier_post((unsigned*)(kws() + fm::WS_CTL), (volatile LAS unsigned*)(L + MISC_OFF) + 8);
    fm::Ctx F; F.lds = L; F.tid = threadIdx.x; F.lane = F.tid & 63; F.wave = __builtin_amdgcn_readfirstlane(F.tid >> 6);
    F.G = gridDim.x; F.wg = blockIdx.x; F.vcu = (F.G % 8 == 0) ? (F.wg % 8) * (F.G / 8) + F.wg / 8 : F.wg;
#define GRID_BAR() do { XcdBarrier b_; b_.bar = (unsigned*)(kws() + fm::WS_CTL); b_.x = (unsigned)__builtin_amdgcn_readfirstlane((int)xb_xcc_id()); b_.st = (volatile LAS unsigned*)(L + MISC_OFF) + 8; xcd_barrier(b_); } while (0)
    fm::ada_phase(F);
    fm::even_convert_weights(F, 0); fm::even_convert_weights(F, 1);
    fm::odd_convert_weights(F, 0); fm::odd_convert_weights(F, 1);
    GRID_BAR();
#pragma unroll 1
    for (int layer = 0; layer < 4; ++layer) {
        const float* xsrc = layer == 0 ? kin(0) : (const float*)kout();
        fm::moe_convert_weights(F, kin(30), kin(31), kin(32), layer);
        __syncthreads();
        fm::norm_phase(F, layer * 2, layer - 1, xsrc); GRID_BAR();
        if (layer % 2 == 0) {
            fm::even_inproj_phase(F, layer / 2); GRID_BAR();
            fm::even_mix_phase(F, layer / 2); GRID_BAR();
            fm::even_outproj_phase(F, layer, xsrc); GRID_BAR();
        } else {
            const int li = layer / 2;
            fm::odd_mix_phase<3>(F, li, 0, 2, 3, 0); GRID_BAR();
            fm::odd_gemm_rkv_phase(F, li); GRID_BAR();
            fm::odd_mix_phase<4>(F, li, 1, 4, 5, 3); GRID_BAR();
            fm::odd_gemm_loradown_phase(F, li); GRID_BAR();
            fm::odd_gemm_loraup_phase(F, li); GRID_BAR();
            fm::odd_wkv1_phase(F, li); GRID_BAR();
            fm::odd_wkv2a_phase(F); GRID_BAR();
            fm::odd_wkv2b_phase(F, li); GRID_BAR();
            fm::odd_gemm_wo_phase(F, layer); GRID_BAR();
        }
        fm::moe_route_phase(F, kin(28), kin(29), layer); GRID_BAR();
        fm::moe_sort_phase(F); GRID_BAR();
        fm::moe_gemm1_phase(F); GRID_BAR();
        fm::moe_gemm2_phase(F); GRID_BAR();
    }
    fm::final_phase(F);
}
extern "C" void kernel_launch(void* const* d_in, const int* in_sizes, int n_in, void* d_out, int out_size, void* d_ws, size_t ws_size, hipStream_t stream) {
    (void)in_sizes; (void)out_size;
    static int grid = 0;
    if (grid == 0) {
        int dev = 0, cus = 0, per_cu = 0;
        hipGetDevice(&dev); hipDeviceGetAttribute(&cus, hipDeviceAttributeMultiprocessorCount, dev);
        hipFuncSetAttribute((const void*)mega_fwd, hipFuncAttributeMaxDynamicSharedMemorySize, LDS_BYTES);
        hipOccupancyMaxActiveBlocksPerMultiprocessor(&per_cu, (const void*)mega_fwd, NTHREADS, LDS_BYTES);
        (void)hipGetLastError();
        grid = 256;
        if (per_cu < 1) fprintf(stderr, "kernel_launch: occupancy query says %d blocks/CU\n", per_cu);
        if (cus < 256 || n_in != 34 || ws_size < fm::WS_END) { fprintf(stderr, "kernel_launch: unexpected cus %d / n_in %d / ws %zu\n", cus, n_in, ws_size); grid = -1; }
    }
    if (grid < 0) return;
    hipMemsetAsync((char*)d_ws + fm::WS_CTL, 0, fm::CTL_ZERO_BYTES, stream);
    Args a{};
    for (int i = 0; i < 34; ++i) a.in[i] = (const float*)d_in[i];
    a.out = (float*)d_out; a.ws = (unsigned char*)d_ws;
    void* kargs[] = {&a};
    hipError_t e = hipLaunchCooperativeKernel((const void*)mega_fwd, dim3(grid), dim3(NTHREADS), kargs, LDS_BYTES, stream);
    if (e != hipSuccess) fprintf(stderr, "cooperative launch failed: %s (grid %d)\n", hipGetErrorString(e), grid);
}
```

```cpp
#include <hip/hip_runtime.h>
#include <stdint.h>
#include <stddef.h>
#include <math.h>
#include <stdio.h>
#define GAS __attribute__((address_space(1)))
#define LAS __attribute__((address_space(3)))
#define XB_TMO      128
#define XB_XCNT(j)  (256  + 64 * (j))
#define XB_XSUB(j)  (1280 + 64 * (j))
#define XB_XGEN(j)  (2304 + 64 * (j))
#define XB_TOP      3328
#define XB_TOPGEN   3392
#define XCD_BAR_WORDS 3456
#define XB_SPIN_CAP (1u << 22)
__device__ __forceinline__ unsigned xb_ld(unsigned* p)              { return __hip_atomic_load(p, __ATOMIC_RELAXED, __HIP_MEMORY_SCOPE_AGENT); }
__device__ __forceinline__ unsigned xb_add(unsigned* p, unsigned v) { return __hip_atomic_fetch_add(p, v, __ATOMIC_RELAXED, __HIP_MEMORY_SCOPE_AGENT); }
__device__ __forceinline__ unsigned xb_xcc_id() { return (unsigned)__builtin_amdgcn_s_getreg((3 << 11) | 20) & 0xFu; }
#define XB_SPIN(cond, bar) do { unsigned _sp = 0; while (cond) { __builtin_amdgcn_s_sleep(1); \
    if ((++_sp & 255u) == 0u) { if (xb_ld(&(bar)[XB_TMO])) break; if (_sp > XB_SPIN_CAP) { atomicAdd(&(bar)[XB_TMO], 1u); break; } } } } while (0)
struct XcdBarrier { unsigned* bar; unsigned x; volatile LAS unsigned* st; bool leader; };
__device__ __forceinline__ XcdBarrier xcd_barrier_post(unsigned* bar, volatile LAS unsigned* st) {
    XcdBarrier b; b.bar = bar; b.x = xb_xcc_id(); b.st = st;
    if (threadIdx.x == 0) (void)xb_add(&bar[XB_XCNT(b.x)], 1u);
    return b;
}
__device__ __forceinline__ void xcd_barrier_complete(unsigned* bar, unsigned x, unsigned& nloc, unsigned& nx) {
    const unsigned G = gridDim.x * gridDim.y * gridDim.z;
    unsigned sum, cnt, mine, sp = 0u;
    for (;;) {
        sum = 0u; cnt = 0u; mine = 0u;
#pragma unroll
        for (unsigned j = 0; j < 16; ++j) { const unsigned c = xb_ld(&bar[XB_XCNT(j)]); sum += c; cnt += (c > 0u) ? 1u : 0u; mine = (j == x) ? c : mine; }
        if (sum == G) break;
        __builtin_amdgcn_s_sleep(1);
        if ((++sp & 255u) == 0u) { if (xb_ld(&bar[XB_TMO])) break; if (sp > XB_SPIN_CAP) { atomicAdd(&bar[XB_TMO], 1u); break; } }
    }
    nloc = mine > 0u ? mine : 1u; nx = cnt > 0u ? cnt : 1u;
}
__device__ __forceinline__ void xcd_barrier(const XcdBarrier& b) {
    asm volatile("s_waitcnt vmcnt(0)" ::: "memory");
    __syncthreads();
    if (b.leader) {
        unsigned* bar = b.bar;
        __builtin_amdgcn_s_waitcnt(0);
        unsigned nloc = b.st[0], nx = b.st[1];
        if (nloc == 0u) { xcd_barrier_complete(bar, b.x, nloc, nx); b.st[0] = nloc; b.st[1] = nx; }
        const unsigned old = xb_add(&bar[XB_XSUB(b.x)], 1u);
        const unsigned gen = old / nloc;
        if (old + 1u == (gen + 1u) * nloc) {
            __builtin_amdgcn_fence(__ATOMIC_RELEASE, "agent");
            asm volatile("s_waitcnt vmcnt(0)" ::: "memory");
            const unsigned og = xb_add(&bar[XB_TOP], 1u);
            const unsigned tg = og / nx;
            if (og + 1u == (tg + 1u) * nx) xb_add(&bar[XB_TOPGEN], 1u);
            else XB_SPIN(xb_ld(&bar[XB_TOPGEN]) == tg, bar);
            __builtin_amdgcn_fence(__ATOMIC_ACQUIRE, "agent");
            xb_add(&bar[XB_XGEN(b.x)], 1u);
            asm volatile("s_waitcnt vmcnt(0)" ::: "memory");
        } else {
            XB_SPIN(xb_ld(&bar[XB_XGEN(b.x)]) == gen, bar);
            __builtin_amdgcn_fence(__ATOMIC_ACQUIRE, "agent");
            asm volatile("s_waitcnt vmcnt(0)" ::: "memory");
        }
    }
    __syncthreads();
}
constexpr int RING_BYTES = 131072;
constexpr int LDSCTL_OFF = RING_BYTES;
constexpr int MISC_OFF = LDSCTL_OFF + 320;
constexpr int LDS_BYTES = 147456;
constexpr int NTHREADS = 512;

__device__ __forceinline__ const void* karg(int i) {
    const void* base = (const void*)__builtin_amdgcn_kernarg_segment_ptr();
    unsigned long long v;
    asm volatile("s_load_dwordx2 %0, %1, %2\n\ts_waitcnt lgkmcnt(0)" : "=s"(v) : "s"(base), "n"(i * 8) : "memory");
    return (const void*)v;
}
__device__ __forceinline__ const float* kin(int i) { return (const float*)karg(i); }
__device__ __forceinline__ float* kout() { return (float*)karg(34); }
__device__ __forceinline__ unsigned char* kws() { return (unsigned char*)karg(35); }
namespace pg8 {
#define PG8_LAS __attribute__((address_space(3)))
typedef unsigned short bf16_t;
typedef short bf16x8 __attribute__((ext_vector_type(8)));
typedef float f32x4 __attribute__((ext_vector_type(4)));
typedef unsigned u32x4 __attribute__((ext_vector_type(4)));
constexpr int BM = 256, BK = 64, HALF = 128, HTB = HALF * BK * 2  , STAGE_BYTES = 8 * HTB, NXCD = 8, WGM = 8;

__host__ __device__ __forceinline__ int lds_byte(int r, int c) { const int st = (r >> 4) * 2 + (c >> 5), rr = r & 15, cc = c & 31, ob = rr * 64 + cc * 2; return st * 1024 + (ob ^ (((ob >> 9) & 1) << 5)); }
__host__ __device__ __forceinline__ void stage_rc(int b, int& R, int& C) { const int st = b / 1024, sb = b % 1024, swz = sb ^ (((sb >> 9) & 1) << 5); R = (st >> 1) * 16 + swz / 64; C = (st & 1) * 32 + (swz % 64) / 2; }
__host__ __device__ __forceinline__ int perm32(int rho) { const int n = rho >> 4, i = rho & 15; return 8 * (i >> 2) + 4 * n + (i & 3); }

struct Unit { int pm, pn; };
struct Gemm { int K; };
__device__ __forceinline__ unsigned cvt_pk_bf16(float lo, float hi) { unsigned r; asm volatile("v_cvt_pk_bf16_f32 %0, %1, %2" : "=v"(r) : "v"(lo), "v"(hi)); return r; }
typedef float f32x2 __attribute__((ext_vector_type(2)));
__device__ __forceinline__ f32x2 gelu_pk(f32x2 v) {
    const f32x2 av = __builtin_elementwise_abs(v), d = av * 0.2316418882f + 1.0f;
    f32x2 t; t.x = __builtin_amdgcn_rcpf(d.x); t.y = __builtin_amdgcn_rcpf(d.y);
    f32x2 q = t * 0.5307027145f + (-0.7265760135f); q = q * t + 0.7107068705f; q = q * t + (-0.142248368f); q = q * t + 0.127414796f; q = q * t;
    const f32x2 s = (v * v) * (-0.72134752044f);
    f32x2 e; e.x = __builtin_amdgcn_exp2f(s.x); e.y = __builtin_amdgcn_exp2f(s.y);
    const f32x2 m = v * (q * e), r = v - m;
    f32x2 o; o.x = v.x < 0.f ? m.x : r.x; o.y = v.y < 0.f ? m.y : r.y; return o;
}
template <class Epi, class Sched, bool ALIGN_EPI = false, bool SP2 = false, bool GA = false  >
__device__ __forceinline__ void gemm_phase(PG8_LAS unsigned char* lds, const Gemm g, const Sched& S, const Epi& E) {
    int tid_ = (int)__builtin_amdgcn_mbcnt_hi(~0u, __builtin_amdgcn_mbcnt_lo(~0u, 0u)) + 64 * S.wave_id; asm volatile("" : "+v"(tid_));
    const int tid = tid_, wid = __builtin_amdgcn_readfirstlane(tid >> 6), lane = tid & 63, wr = wid >> 2, wc = wid & 3, fr = lane & 15, fq = lane >> 4;
    int Kop = g.K; asm volatile("" : "+s"(Kop));
    const int K = Kop, nt = K / BK;
    unsigned voffA[2], voffB[2];
#pragma unroll
    for (int i = 0; i < 2; ++i) { int R, C; stage_rc(tid * 16 + i * 8192, R, C); const int Rb = Epi::PERM ? ((R & ~31) + perm32(R & 31)) : R;
        voffA[i] = (unsigned)(R * K + C) * 2u; voffB[i] = (unsigned)(Rb * K + C) * 2u; }
    int stR[2], stC[2];
#pragma unroll
    for (int i = 0; i < 2; ++i) stage_rc(tid * 16 + i * 8192, stR[i], stC[i]);
    unsigned vAc[2][2], vAn[2][2];
#pragma unroll
    for (int h = 0; h < 2; ++h)
#pragma unroll
        for (int i = 0; i < 2; ++i) { vAc[h][i] = voffA[i] + (unsigned)h * (unsigned)(HALF * K * 2); vAn[h][i] = vAc[h][i]; }
    const size_t kstep = (size_t)(BK * 2);
    const size_t hstep = (size_t)HALF * K * 2;
        const unsigned ldsw = (unsigned)wid * 1024u;
    const int aoff = lds_byte(wr * 64 + fr, fq * 8), boff = lds_byte(wc * 32 + fr, fq * 8);
#define PG8_SA(b, h) (((b) * 2 + (h)) * HTB)
#define PG8_SB(b, h) ((4 + (b) * 2 + (h)) * HTB)
#define PG8_STAGE(bufoff, gbase, voff) do { _Pragma("unroll") for (int _i = 0; _i < 2; ++_i) \
        __builtin_amdgcn_global_load_lds((const unsigned*)((const char*)(gbase) + (voff)[_i]), (PG8_LAS unsigned*)(lds + (bufoff) + ldsw + _i * 8192), 16, 0, 0); } while (0)
#define PG8_LDA(dst, b, h) do { _Pragma("unroll") for (int m = 0; m < 4; ++m) _Pragma("unroll") for (int k = 0; k < 2; ++k) dst[m][k] = *(const PG8_LAS bf16x8*)(lds + PG8_SA(b, h) + aoff + m * 2048 + k * 1024); } while (0)
#define PG8_LDB(dst, b, h) do { _Pragma("unroll") for (int n = 0; n < 2; ++n) _Pragma("unroll") for (int k = 0; k < 2; ++k) dst[n][k] = *(const PG8_LAS bf16x8*)(lds + PG8_SB(b, h) + boff + n * 2048 + k * 1024); } while (0)
#define PG8_MMA(ai, bj, At, Bt) do { __builtin_amdgcn_s_setprio(1); _Pragma("unroll") for (int m = 0; m < 4; ++m) _Pragma("unroll") for (int n = 0; n < 2; ++n) _Pragma("unroll") for (int k = 0; k < 2; ++k) \
        acc[ai][bj][m][n] = __builtin_amdgcn_mfma_f32_16x16x32_bf16(Bt[n][k], At[m][k], acc[ai][bj][m][n], 0, 0, 0); __builtin_amdgcn_s_setprio(0); } while (0)
#define PG8_WAIT_V(n) asm volatile("s_waitcnt vmcnt(" #n ")" ::: "memory")
#define PG8_WAIT_L(n) asm volatile("s_waitcnt lgkmcnt(" #n ")" ::: "memory")
#define PG8_BAR __builtin_amdgcn_s_barrier()
#define PG8_SCHED __builtin_amdgcn_sched_barrier(0)
    Unit cur, nxt; int ui = 0;
    if (!S.next(0, cur)) return;
    f32x4 acc[2][2][4][2];
#pragma unroll
    for (int a = 0; a < 2; ++a)
#pragma unroll
        for (int b = 0; b < 2; ++b)
#pragma unroll
            for (int m = 0; m < 4; ++m)
#pragma unroll
                for (int n = 0; n < 2; ++n) acc[a][b][m][n] = (f32x4){0.f, 0.f, 0.f, 0.f};
    bf16x8 At[4][2], B0[2][2], B1[2][2];
    const char* cA = S.a_base(cur); const char* cB = S.b_base(cur);
    if constexpr (GA) {
#pragma unroll
        for (int h = 0; h < 2; ++h)
#pragma unroll
            for (int i = 0; i < 2; ++i) vAc[h][i] = S.a_rowoff(cur, h * HALF + stR[i]) + (unsigned)stC[i] * 2u;
    }
    S.a_ready(cur);
    if constexpr (SP2) {
        PG8_STAGE(PG8_SB(0, 0), cB, voffB); PG8_STAGE(PG8_SB(0, 1), cB + hstep, voffB); PG8_STAGE(PG8_SA(0, 0), cA, vAc[0]); PG8_STAGE(PG8_SA(0, 1), cA, vAc[1]);
        if (wr == 1) PG8_BAR;
        PG8_WAIT_V(2); PG8_BAR;
        PG8_STAGE(PG8_SB(1, 0), cB + kstep, voffB); PG8_STAGE(PG8_SA(1, 0), cA + kstep, vAc[0]); PG8_STAGE(PG8_SB(1, 1), cB + hstep + kstep, voffB);
        PG8_WAIT_V(6); PG8_BAR;
    } else {
        PG8_STAGE(PG8_SB(0, 0), cB, voffB); PG8_STAGE(PG8_SA(0, 0), cA, vAc[0]); PG8_STAGE(PG8_SB(0, 1), cB + hstep, voffB); PG8_STAGE(PG8_SA(0, 1), cA, vAc[1]);
        if (wr == 1) PG8_BAR;
        PG8_WAIT_V(4); PG8_BAR;
        PG8_STAGE(PG8_SB(1, 0), cB + kstep, voffB); PG8_STAGE(PG8_SA(1, 0), cA + kstep, vAc[0]); PG8_STAGE(PG8_SB(1, 1), cB + hstep + kstep, voffB);
        PG8_WAIT_V(6); PG8_BAR;
    }
    for (;;) {
        const bool has_next = S.next(ui + 1, nxt);
        if constexpr (GA) { if (has_next) {
#pragma unroll
            for (int h = 0; h < 2; ++h)
#pragma unroll
                for (int i = 0; i < 2; ++i) vAn[h][i] = S.a_rowoff(nxt, h * HALF + stR[i]) + (unsigned)stC[i] * 2u;
        } else {
#pragma unroll
            for (int h = 0; h < 2; ++h)
#pragma unroll
                for (int i = 0; i < 2; ++i) vAn[h][i] = vAc[h][i];
        } }
        const char* nA = has_next ? S.a_base(nxt) : cA; const char* nB = has_next ? S.b_base(nxt) : cB;
        for (int t = 0; t < nt; t += 2) {
            const bool last = (t == nt - 2);
            unsigned vS0[2], vS1[2];
            vS0[0] = last ? vAn[0][0] : vAc[0][0]; vS0[1] = last ? vAn[0][1] : vAc[0][1]; vS1[0] = last ? vAn[1][0] : vAc[1][0]; vS1[1] = last ? vAn[1][1] : vAc[1][1];
            const char* a1 = cA + (size_t)(t + 1) * kstep;
            const char* a2 = last ? nA : cA + (size_t)(t + 2) * kstep; const char* b2 = last ? nB : cB + (size_t)(t + 2) * kstep;
            const char* a3 = a2 + kstep; const char* b3 = b2 + kstep;
            if (last && has_next) S.a_ready(nxt);
            if constexpr (SP2) {
            PG8_LDB(B0, 0, 0); PG8_LDB(B1, 0, 1); PG8_SCHED; PG8_LDA(At, 0, 0); PG8_STAGE(PG8_SA(1, 1), a1, vAc[1]);
            PG8_WAIT_V(8); PG8_WAIT_L(0); PG8_BAR; PG8_MMA(0, 0, At, B0); PG8_MMA(0, 1, At, B1); PG8_BAR; PG8_SCHED;
            PG8_LDA(At, 0, 1); PG8_STAGE(PG8_SB(0, 0), b2, voffB); PG8_STAGE(PG8_SB(0, 1), b2 + hstep, voffB); PG8_STAGE(PG8_SA(0, 0), a2, vS0);
            PG8_WAIT_V(8); PG8_WAIT_L(0); PG8_BAR; PG8_MMA(1, 0, At, B0); PG8_MMA(1, 1, At, B1); PG8_BAR; PG8_SCHED;
            PG8_LDB(B0, 1, 0); PG8_LDB(B1, 1, 1); PG8_SCHED; PG8_LDA(At, 1, 0); PG8_STAGE(PG8_SA(0, 1), a2, vS1);
            PG8_WAIT_V(8); PG8_WAIT_L(0); PG8_BAR; PG8_MMA(0, 0, At, B0); PG8_MMA(0, 1, At, B1); PG8_BAR; PG8_SCHED;
            PG8_LDA(At, 1, 1); PG8_STAGE(PG8_SB(1, 0), b3, voffB); PG8_STAGE(PG8_SB(1, 1), b3 + hstep, voffB); PG8_STAGE(PG8_SA(1, 0), a3, vS0);
            PG8_WAIT_V(8); PG8_WAIT_L(0); PG8_BAR; PG8_MMA(1, 0, At, B0); PG8_MMA(1, 1, At, B1); PG8_BAR; PG8_SCHED;
            } else {
            PG8_LDB(B0, 0, 0); PG8_SCHED; PG8_LDA(At, 0, 0); PG8_STAGE(PG8_SA(1, 1), a1, vAc[1]);
            PG8_WAIT_L(8); PG8_BAR; PG8_WAIT_L(0); PG8_MMA(0, 0, At, B0); PG8_BAR; PG8_SCHED;
            PG8_LDB(B1, 0, 1); PG8_STAGE(PG8_SB(0, 0), b2, voffB);
            PG8_BAR; PG8_WAIT_L(0); PG8_MMA(0, 1, At, B1); PG8_BAR;
            PG8_LDA(At, 0, 1); PG8_STAGE(PG8_SA(0, 0), a2, vS0);
            PG8_BAR; PG8_WAIT_L(0); PG8_MMA(1, 0, At, B0); PG8_BAR; PG8_SCHED;
            PG8_STAGE(PG8_SB(0, 1), b2 + hstep, voffB);
            PG8_WAIT_V(6); PG8_BAR; PG8_MMA(1, 1, At, B1); PG8_BAR;
            PG8_LDB(B0, 1, 0); PG8_SCHED; PG8_LDA(At, 1, 0); PG8_STAGE(PG8_SA(0, 1), a2, vS1);
            PG8_WAIT_L(8); PG8_BAR; PG8_WAIT_L(0); PG8_MMA(0, 0, At, B0); PG8_BAR; PG8_SCHED;
            PG8_LDB(B1, 1, 1); PG8_STAGE(PG8_SB(1, 0), b3, voffB);
            PG8_BAR; PG8_WAIT_L(0); PG8_MMA(0, 1, At, B1); PG8_BAR;
            PG8_LDA(At, 1, 1); PG8_STAGE(PG8_SA(1, 0), a3, vS0);
            PG8_BAR; PG8_WAIT_L(0); PG8_MMA(1, 0, At, B0); PG8_BAR; PG8_SCHED;
            PG8_STAGE(PG8_SB(1, 1), b3 + hstep, voffB);
            PG8_WAIT_V(6); PG8_BAR; PG8_MMA(1, 1, At, B1); PG8_BAR;
            }
        }
        if constexpr (ALIGN_EPI) { if (wr == 0) PG8_BAR; }
        if constexpr (!Epi::AFTER_DRAIN) { E(acc, cur, wr, wc, fr, fq); S.done(cur); }
        if (!has_next) break;
#pragma unroll
        for (int a = 0; a < 2; ++a)
#pragma unroll
            for (int b = 0; b < 2; ++b)
#pragma unroll
                for (int m = 0; m < 4; ++m)
#pragma unroll
                    for (int n = 0; n < 2; ++n) acc[a][b][m][n] = (f32x4){0.f, 0.f, 0.f, 0.f};
        cur = nxt; cA = nA; cB = nB; ++ui;
#pragma unroll
        for (int h = 0; h < 2; ++h)
#pragma unroll
            for (int i = 0; i < 2; ++i) vAc[h][i] = vAn[h][i];
        if constexpr (ALIGN_EPI) { if (wr == 1) PG8_BAR; }
    }
    PG8_WAIT_V(0);
    if constexpr (!ALIGN_EPI) { if (wr == 0) PG8_BAR; }
    PG8_BAR;
    if constexpr (Epi::AFTER_DRAIN) { E.fused(acc, cur, wr, wc, fr, fq, lds, wid, lane); S.done(cur); }
#undef PG8_SA
#undef PG8_SB
#undef PG8_STAGE
#undef PG8_LDA
#undef PG8_LDB
#undef PG8_MMA
#undef PG8_WAIT_V
#undef PG8_WAIT_L
#undef PG8_BAR
#undef PG8_SCHED
}
}
namespace fm {
using pg8::bf16_t; using pg8::f32x4; using pg8::u32x4; using pg8::Unit;
typedef unsigned v4u __attribute__((ext_vector_type(4)));
typedef unsigned v2u __attribute__((ext_vector_type(2)));
constexpr int T = 16384, D = 1024, S = 2048, NB = 8, NWAVES = 8;
constexpr size_t MiB = 1u << 20;
constexpr size_t WS_CTL = 0, CTL_ZERO_BYTES = 64 * 1024;
constexpr size_t WS_SMALL = 1 * MiB;
constexpr size_t WS_MOD = 4 * MiB;
constexpr size_t WS_WMIX = 80 * MiB;
constexpr size_t WS_WMOE = 120 * MiB;
constexpr size_t WS_XN = 144 * MiB;
constexpr size_t WS_R1 = 176 * MiB;
constexpr size_t WS_YS = WS_R1;
constexpr size_t WS_AG = WS_R1 + 64 * MiB + 4096;
constexpr size_t WS_HID = WS_R1 + 137 * MiB;
constexpr size_t WS_END = 400 * MiB;
constexpr size_t SM_TOKE = 0;
constexpr size_t SM_TOKW = 128 * 1024;
constexpr size_t SM_CNTG = 256 * 1024;
constexpr size_t SM_ROWINFO = 384 * 1024;
constexpr size_t SM_ROWW = 640 * 1024;
constexpr size_t SM_ROWTOK = 832 * 1024;
constexpr int MOE_ROWS_MAX = 2 * T + 16 * 256;
constexpr int LX_SEG = 1024, LX_TILEE = 1152, LX_BASE = 1792, LX_DPOS = 2048, LX_TE = 2560, LX_TW = 3072, LX_PS = 4096, LX_PB = 6144;

struct Ctx {
    LAS unsigned char* lds; int tid, lane, wave, G, wg, vcu;
};
__device__ __forceinline__ int lane_id() { int l = (int)__builtin_amdgcn_mbcnt_hi(~0u, __builtin_amdgcn_mbcnt_lo(~0u, 0u)); asm volatile("" : "+v"(l)); return l; }
template <int DD> __device__ __forceinline__ float sxor(float v) { static_assert(DD == 1 || DD == 2 || DD == 4 || DD == 8 || DD == 16, "xor mask"); return __builtin_bit_cast(float, __builtin_amdgcn_ds_swizzle(__builtin_bit_cast(int, v), (DD << 10) | 0x1f)); }
#define XOR32_SWAP(v) const auto r_ = __builtin_amdgcn_permlane32_swap(__builtin_bit_cast(unsigned, v), __builtin_bit_cast(unsigned, v), false, false); unsigned x_ = r_[0], y_ = r_[1]; asm volatile("" : "+v"(x_), "+v"(y_));
__device__ __forceinline__ float xor32_sum(float v) { XOR32_SWAP(v) return __builtin_bit_cast(float, x_) + __builtin_bit_cast(float, y_); }
__device__ __forceinline__ float xor32_max(float v) { XOR32_SWAP(v) return fmaxf(__builtin_bit_cast(float, x_), __builtin_bit_cast(float, y_)); }
__device__ __forceinline__ float xor32_get(float v, bool upper_half) { XOR32_SWAP(v) return __builtin_bit_cast(float, upper_half ? x_ : y_); }
__device__ __forceinline__ float wave_sum(float v) { v += sxor<1>(v); v += sxor<2>(v); v += sxor<4>(v); v += sxor<8>(v); v += sxor<16>(v); return xor32_sum(v); }
__device__ __forceinline__ unsigned f2bf(float f) { unsigned u = __builtin_bit_cast(unsigned, f); return (u + 0x7fffu + ((u >> 16) & 1u)) >> 16; }

typedef float f32x2_c __attribute__((ext_vector_type(2))); typedef __bf16 bf16x2_c __attribute__((ext_vector_type(2)));
__device__ __forceinline__ unsigned cvtpk(float lo, float hi) { const f32x2_c v = {lo, hi}; const bf16x2_c b = __builtin_convertvector(v, bf16x2_c); return __builtin_bit_cast(unsigned, b); }
__device__ __forceinline__ unsigned pk2(float lo, float hi) { return cvtpk(lo, hi); }
__device__ __forceinline__ float bf2f(unsigned short b) { return __builtin_bit_cast(float, (unsigned)b << 16); }
__device__ __forceinline__ float bflo(unsigned w) { return __builtin_bit_cast(float, w << 16); }
__device__ __forceinline__ float bfhi(unsigned w) { return __builtin_bit_cast(float, w & 0xffff0000u); }
#define LDS_WAIT() asm volatile("s_waitcnt lgkmcnt(0)" ::: "memory")
__device__ __forceinline__ void transpose_item(const float* W, int N, bf16_t* WT, int ldk, int k0, int n0, int drow0, LAS float* scr, int lane) {
    float wv[32];
#pragma unroll
    for (int i = 0; i < 32; ++i) wv[i] = W[(size_t)(k0 + 2 * i + (lane >> 5)) * N + n0 + (lane & 31)];
#pragma unroll
    for (int i = 0; i < 32; ++i) scr[(2 * i + (lane >> 5)) * 33 + (lane & 31)] = wv[i];
    LDS_WAIT(); asm volatile("" ::: "memory");
    const int c = lane & 7;
#pragma unroll
    for (int j = 0; j < 4; ++j) { const int n = (lane >> 3) + 8 * j; const LAS float* s = scr + (8 * c) * 33 + n;
        v4u o; o.x = pk2(s[0 * 33], s[1 * 33]); o.y = pk2(s[2 * 33], s[3 * 33]); o.z = pk2(s[4 * 33], s[5 * 33]); o.w = pk2(s[6 * 33], s[7 * 33]);
        *(v4u*)(WT + (size_t)(drow0 + n) * ldk + k0 + 8 * c) = o; }
    LDS_WAIT(); asm volatile("" ::: "memory");
}
__device__ __forceinline__ void transpose_item_pad(const float* W, int N, int nvalid, int kvalid, bf16_t* WT, int ldk, int k0, int n0, int drow0, LAS float* scr, int lane) {
    float wv[32];
#pragma unroll
    for (int i = 0; i < 32; ++i) { const int kk = 2 * i + (lane >> 5); const int n = n0 + (lane & 31); wv[i] = (n < nvalid && (k0 + kk) < kvalid) ? W[(size_t)(k0 + kk) * N + n] : 0.f; }
#pragma unroll
    for (int i = 0; i < 32; ++i) scr[(2 * i + (lane >> 5)) * 33 + (lane & 31)] = wv[i];
    LDS_WAIT(); asm volatile("" ::: "memory");
    const int c = lane & 7;
#pragma unroll
    for (int j = 0; j < 4; ++j) { const int n = (lane >> 3) + 8 * j; const LAS float* s = scr + (8 * c) * 33 + n;
        v4u o; o.x = pk2(s[0 * 33], s[1 * 33]); o.y = pk2(s[2 * 33], s[3 * 33]); o.z = pk2(s[4 * 33], s[5 * 33]); o.w = pk2(s[6 * 33], s[7 * 33]);
        *(v4u*)(WT + (size_t)(drow0 + n) * ldk + k0 + 8 * c) = o; }
    LDS_WAIT(); asm volatile("" ::: "memory");
}
__device__ __forceinline__ float fast_sigmoid(float v) { return __builtin_amdgcn_rcpf(1.f + __expf(-v)); }
}
namespace fm {
__device__ __forceinline__ void moe_convert_weights(const Ctx& F_, const float* w1, const float* w3, const float* w2, int layer) {
    Ctx F = F_; F.lane = lane_id(); F.tid = F.wave * 64 + F.lane;
    unsigned char* const ws_ = kws();
    LAS float* scr = (LAS float*)(F.lds + F.wave * 8448);
    bf16_t* W13T = (bf16_t*)(ws_ + WS_WMOE); bf16_t* W2T = W13T + (size_t)16 * 512 * 1024;
    const int gw = F.wg * NWAVES + F.wave, NGW = F.G * NWAVES;
    for (int it = gw; it < 16 * 384; it += NGW) {
        const int e = it / 384, r = it % 384;
        const size_t eoff = (size_t)(layer * 16 + e);
        if (r < 256) {
            const int q = r & 127, kb = q >> 3, nb = q & 7, n0 = nb * 32;
            const float* W = (r < 128 ? w1 : w3) + eoff * 1024 * 256;
            transpose_item(W, 256, W13T + (size_t)e * 512 * 1024, 1024, kb * 64, n0, (n0 >> 7) * 256 + (n0 & 127) + (r < 128 ? 0 : 128), scr, F.lane);
        } else {
            const int q = r - 256, kb = q >> 5, nb = q & 31;
            transpose_item(w2 + eoff * 256 * 1024, 1024, W2T + (size_t)e * 1024 * 256, 256, kb * 64, nb * 32, nb * 32, scr, F.lane);
        }
    }
}
__device__ __forceinline__ void moe_route_phase(const Ctx& F_, const float* router_w, const float* router_b, int layer) {
    Ctx F = F_; F.lane = lane_id(); F.tid = F.wave * 64 + F.lane;
    unsigned char* const ws_ = kws(); const float* const x_ = kout(); const float* const mod_ = (const float*)(ws_ + WS_MOD);
    LAS float* rwT = (LAS float*)F.lds;
    LAS int* cnt = (LAS int*)(F.lds + 65536);
    LAS float* tab = (LAS float*)(F.lds + 65536 + 256 + F.wave * 512);
    for (int i = F.tid; i < 16384; i += NTHREADS) rwT[(i & 15) * 1024 + (i >> 4)] = router_w[i];
    if (F.tid < 16) cnt[F.tid] = 0;
    __syncthreads();
    int* tok_e = (int*)(ws_ + WS_SMALL + SM_TOKE); float* tok_w = (float*)(ws_ + WS_SMALL + SM_TOKW);
    bf16_t* XN = (bf16_t*)(ws_ + WS_XN);
    const int row0 = F.wg * 64 + F.wave * 8, b = row0 / S;
    const float* m = mod_ + ((size_t)(layer * 2 + 1) * NB + b) * 3072;
    const bool b5 = (F.lane & 32) != 0, b4 = (F.lane & 16) != 0, b3 = (F.lane & 8) != 0, b2 = (F.lane & 4) != 0;
    f32x4 vn[4];
#pragma unroll
    for (int j = 0; j < 4; ++j) vn[j] = ((const f32x4*)(x_ + (size_t)row0 * D) + F.lane)[64 * j];
#pragma unroll 1
    for (int r = 0; r < 8; ++r) {
        const int row = row0 + r;
        f32x4 v[4]; float ss = 0.f;
#pragma unroll
        for (int j = 0; j < 4; ++j) { v[j] = vn[j]; ss += (v[j].x * v[j].x + v[j].y * v[j].y) + (v[j].z * v[j].z + v[j].w * v[j].w); }
        { const f32x4* xr = (const f32x4*)(x_ + (size_t)(row0 + (r < 7 ? r + 1 : r)) * D) + F.lane;
#pragma unroll
            for (int j = 0; j < 4; ++j) vn[j] = xr[64 * j]; }
        const float rinv = 1.0f / sqrtf(wave_sum(ss) * (1.f / D) + 1e-6f);
        unsigned long long* o8 = (unsigned long long*)(XN + (size_t)row * D) + F.lane;
#pragma unroll
        for (int j = 0; j < 4; ++j) {
            const f32x4 sh = ((const f32x4*)m)[64 * j + F.lane], sc = ((const f32x4*)(m + 1024))[64 * j + F.lane];
            v[j] = v[j] * rinv * (sc + 1.0f) + sh;
            o8[64 * j] = (unsigned long long)pk2(v[j].x, v[j].y) | ((unsigned long long)pk2(v[j].z, v[j].w) << 32);
        }
        asm volatile("" ::: "memory");
        float acc[16];
#pragma unroll
        for (int e = 0; e < 16; ++e) {
            float a = 0.f;
#pragma unroll
            for (int j = 0; j < 4; ++j) { const f32x4 w = *(const LAS f32x4*)(rwT + e * 1024 + 256 * j + 4 * F.lane); a += (v[j].x * w.x + v[j].y * w.y) + (v[j].z * w.z + v[j].w * w.w); }
            acc[e] = a;
            if ((e & 1) == 1) asm volatile("" ::: "memory");
        }
        float a8[8], a4[4], a2[2], a1;
#pragma unroll
        for (int i = 0; i < 8; ++i) { const float send = b5 ? acc[i] : acc[8 + i]; const float keep = b5 ? acc[8 + i] : acc[i]; a8[i] = keep + xor32_get(send, b5); }
#pragma unroll
        for (int i = 0; i < 4; ++i) { const float send = b4 ? a8[i] : a8[4 + i]; const float keep = b4 ? a8[4 + i] : a8[i]; a4[i] = keep + sxor<16>(send); }
#pragma unroll
        for (int i = 0; i < 2; ++i) { const float send = b3 ? a4[i] : a4[2 + i]; const float keep = b3 ? a4[2 + i] : a4[i]; a2[i] = keep + sxor<8>(send); }
        { const float send = b2 ? a2[0] : a2[1]; const float keep = b2 ? a2[1] : a2[0]; a1 = keep + sxor<4>(send); }
        a1 += sxor<2>(a1); a1 += sxor<1>(a1);
        const float sg = __builtin_amdgcn_rcpf(1.f + __expf(-a1));
        if ((F.lane & 3) == 0) tab[r * 16 + (F.lane >> 2)] = sg;
    }
    asm volatile("s_waitcnt lgkmcnt(0)" ::: "memory");
    if (F.lane < 8) {
        const int row = row0 + F.lane;
        float s[16], sel[16];
#pragma unroll
        for (int q = 0; q < 4; ++q) { const f32x4 t4 = *(const LAS f32x4*)(tab + F.lane * 16 + 4 * q); s[4 * q] = t4.x; s[4 * q + 1] = t4.y; s[4 * q + 2] = t4.z; s[4 * q + 3] = t4.w; }
#pragma unroll
        for (int e = 0; e < 16; ++e) sel[e] = s[e] + router_b[e];
        int bg = 0; float bgs = -INFINITY;
#pragma unroll
        for (int g = 0; g < 4; ++g) {
            const float a0 = sel[4 * g], a1_ = sel[4 * g + 1], a2_ = sel[4 * g + 2], a3 = sel[4 * g + 3];
            const float m1 = fmaxf(fmaxf(a0, a1_), fmaxf(a2_, a3));
            const float lo01 = fminf(a0, a1_), hi01 = fmaxf(a0, a1_), lo23 = fminf(a2_, a3), hi23 = fmaxf(a2_, a3);
            const float m2 = fmaxf(fminf(hi01, hi23), fmaxf(lo01, lo23));
            const float gs = m1 + m2;
            if (gs > bgs) { bgs = gs; bg = g; }
        }
        float g0 = sel[0], g1 = sel[1], g2 = sel[2], g3 = sel[3], t0 = s[0], t1 = s[1], t2 = s[2], t3 = s[3];
#pragma unroll
        for (int g = 1; g < 4; ++g) if (bg == g) { g0 = sel[4 * g]; g1 = sel[4 * g + 1]; g2 = sel[4 * g + 2]; g3 = sel[4 * g + 3]; t0 = s[4 * g]; t1 = s[4 * g + 1]; t2 = s[4 * g + 2]; t3 = s[4 * g + 3]; }
        int i0 = 0; float v0 = g0, w0 = t0;
        if (g1 > v0) { v0 = g1; i0 = 1; w0 = t1; } if (g2 > v0) { v0 = g2; i0 = 2; w0 = t2; } if (g3 > v0) { v0 = g3; i0 = 3; w0 = t3; }
        int i1 = -1; float v1 = -INFINITY, w1 = 0.f;
        if (i0 != 0 && g0 > v1) { v1 = g0; i1 = 0; w1 = t0; } if (i0 != 1 && g1 > v1) { v1 = g1; i1 = 1; w1 = t1; }
        if (i0 != 2 && g2 > v1) { v1 = g2; i1 = 2; w1 = t2; } if (i0 != 3 && g3 > v1) { v1 = g3; i1 = 3; w1 = t3; }
        const int e0 = bg * 4 + i0, e1 = bg * 4 + i1; const float inv = 1.f / (w0 + w1);
        tok_e[row * 2] = e0; tok_e[row * 2 + 1] = e1; tok_w[row * 2] = w0 * inv; tok_w[row * 2 + 1] = w1 * inv;
        __hip_atomic_fetch_add(cnt + e0, 1, __ATOMIC_RELAXED, __HIP_MEMORY_SCOPE_WORKGROUP); __hip_atomic_fetch_add(cnt + e1, 1, __ATOMIC_RELAXED, __HIP_MEMORY_SCOPE_WORKGROUP);
    }
    __syncthreads();
    if (F.tid < 16) ((int*)(ws_ + WS_SMALL + SM_CNTG))[F.wg * 16 + F.tid] = cnt[F.tid];
}
__device__ __forceinline__ void moe_sort_phase(const Ctx& F_) {
    Ctx F = F_; F.lane = lane_id(); F.tid = F.wave * 64 + F.lane;
    unsigned char* const ws_ = kws();
    LAS unsigned char* X = F.lds + LDSCTL_OFF;
    LAS int* seg = (LAS int*)(X + LX_SEG); LAS int* tile_e = (LAS int*)(X + LX_TILEE); LAS int* base = (LAS int*)(X + LX_BASE);
    LAS int* te = (LAS int*)(X + LX_TE); LAS float* tw = (LAS float*)(X + LX_TW); LAS int* ps = (LAS int*)(X + LX_PS); LAS int* pb = (LAS int*)(X + LX_PB); LAS int* tot16 = (LAS int*)(X + LX_DPOS);
    const int* cntG = (const int*)(ws_ + WS_SMALL + SM_CNTG);
    const int* tok_e = (const int*)(ws_ + WS_SMALL + SM_TOKE); const float* tok_w = (const float*)(ws_ + WS_SMALL + SM_TOKW);
    int* rowinfo = (int*)(ws_ + WS_SMALL + SM_ROWINFO); float* roww = (float*)(ws_ + WS_SMALL + SM_ROWW); int* rowtok = (int*)(ws_ + WS_SMALL + SM_ROWTOK);
    { const int e = F.tid & 15, part = F.tid >> 4; int tot = 0, bef = 0;
#pragma unroll
        for (int i = 0; i < 8; ++i) { const int w = part * 8 + i; const int c = cntG[w * 16 + e]; tot += c; bef += (w < F.wg) ? c : 0; }
        ps[part * 16 + e] = tot; pb[part * 16 + e] = bef; }
    if (F.tid < 128) { te[F.tid] = tok_e[F.wg * 128 + F.tid]; tw[F.tid] = tok_w[F.wg * 128 + F.tid]; }
    __syncthreads();
    if (F.tid < 16) { int tot = 0, bef = 0;
#pragma unroll 8
        for (int p = 0; p < 32; ++p) { tot += ps[p * 16 + F.tid]; bef += pb[p * 16 + F.tid]; }
        base[F.tid] = bef; tot16[F.tid] = tot; }
    __syncthreads();
    if (F.tid == 0) { int run = 0;
        for (int e = 0; e < 16; ++e) { const int tot = tot16[e]; seg[e] = run; base[e] += run; run += (tot + 255) & ~255; }
        seg[16] = run; }
    __syncthreads();
    if (F.wave == 0) {
#pragma unroll 1
        for (int pass = 0; pass < 2; ++pass) {
            const int i = pass * 64 + F.lane, e = te[i]; int pos = 0;
#pragma unroll 1
            for (int ee = 0; ee < 16; ++ee) {
                const unsigned long long mk = __ballot(e == ee); const int b0 = base[ee];
                if (e == ee) pos = b0 + __popcll(mk & ((1ull << F.lane) - 1ull));
                if (F.lane == 0) base[ee] = b0 + __popcll(mk);
            }
            rowinfo[pos] = (i & 1) * T + F.wg * 64 + (i >> 1); roww[pos] = tw[i]; rowtok[pos] = F.wg * 64 + (i >> 1);
        }
    }
    const int ntile = seg[16] >> 8;
    for (int t = F.tid; t < ntile; t += NTHREADS) { int e = 0;
#pragma unroll
        for (int k = 1; k < 16; ++k) e += (t * 256 >= seg[k]) ? 1 : 0;
        tile_e[t] = e; }
    if (F.wg < 16) { const int e = F.wg; for (int p = seg[e] + tot16[e] + F.tid; p < seg[e + 1]; p += NTHREADS) { rowinfo[p] = 2 * T; rowtok[p] = 0; } }
}
struct SchedMoe {
    const char* A; const char* Bw; size_t a_tile, b_exp, b_tile; int n_units, G, c, sh; const LAS int* tile_e; const int* rowtok; int wave_id;
    __device__ __forceinline__ unsigned a_rowoff(const Unit& u, int r) const { return (unsigned)rowtok[u.pm * 256 + r] * 2048u; }
    __device__ __forceinline__ bool next(int i, Unit& u) const { const long L = (long)i * G + c; if (L >= n_units) return false; u.pm = (int)(L >> sh); u.pn = (int)(L & ((1 << sh) - 1)); return true; }
    __device__ __forceinline__ const char* a_base(const Unit& u) const { return A + (size_t)u.pm * a_tile; }
    __device__ __forceinline__ const char* b_base(const Unit& u) const { const int e = __builtin_amdgcn_readfirstlane(tile_e[u.pm]); return Bw + (size_t)e * b_exp + (size_t)u.pn * b_tile; }
    __device__ __forceinline__ void a_ready(const Unit&) const {}
    __device__ __forceinline__ void done(const Unit&) const {}
};
struct EpiSwiglu {
    static constexpr bool PERM = true, AFTER_DRAIN = false;
    bf16_t* HID;
    __device__ __forceinline__ void operator()(const f32x4 (&acc)[2][2][4][2], const Unit& u, int wr, int wc, int fr, int fq) const {
        const int row0 = u.pm * 256 + wr * 64 + fr, col0 = u.pn * 128 + wc * 32 + 8 * fq;
#pragma unroll
        for (int ai = 0; ai < 2; ++ai)
#pragma unroll
            for (int m = 0; m < 4; ++m) {
                float h[8];
#pragma unroll
                for (int n = 0; n < 2; ++n)
#pragma unroll
                    for (int q = 0; q < 4; ++q) { const float a = acc[ai][0][m][n][q], g = acc[ai][1][m][n][q]; h[4 * n + q] = a * fast_sigmoid(a) * g; }
                u32x4 w; w.x = pg8::cvt_pk_bf16(h[0], h[1]); w.y = pg8::cvt_pk_bf16(h[2], h[3]); w.z = pg8::cvt_pk_bf16(h[4], h[5]); w.w = pg8::cvt_pk_bf16(h[6], h[7]);
                *(u32x4*)(HID + (size_t)(row0 + ai * 128 + m * 16) * 256 + col0) = w;
                asm volatile("" ::: "memory");
            }
    }
};
struct EpiMoeOut {
    static constexpr bool PERM = true, AFTER_DRAIN = false;
    const int* rowinfo; const float* roww; bf16_t* YS;
    __device__ __forceinline__ void operator()(const f32x4 (&acc)[2][2][4][2], const Unit& u, int wr, int wc, int fr, int fq) const {
        const int row0 = u.pm * 256 + wr * 64 + fr; const unsigned col0 = u.pn * 256 + wc * 32 + 8 * fq;
#pragma unroll
        for (int ai = 0; ai < 2; ++ai)
#pragma unroll
            for (int m = 0; m < 4; ++m) {
                const int r = row0 + ai * 128 + m * 16; const unsigned drow = (unsigned)rowinfo[r]; const float w = roww[r];
                bf16_t* dst = YS + (drow * 1024u + col0);
#pragma unroll
                for (int bj = 0; bj < 2; ++bj) { const f32x4 v0 = acc[ai][bj][m][0] * w, v1 = acc[ai][bj][m][1] * w;
                    u32x4 o; o.x = pg8::cvt_pk_bf16(v0[0], v0[1]); o.y = pg8::cvt_pk_bf16(v0[2], v0[3]); o.z = pg8::cvt_pk_bf16(v1[0], v1[1]); o.w = pg8::cvt_pk_bf16(v1[2], v1[3]);
                    *(u32x4*)(dst + bj * 128) = o; }
                asm volatile("" ::: "memory");
            }
    }
};
__device__ __forceinline__ void moe_gemm1_phase(const Ctx& F_) {
    Ctx F = F_; F.lane = lane_id(); F.tid = F.wave * 64 + F.lane;
    unsigned char* const ws_ = kws();
    LAS unsigned char* X = F.lds + LDSCTL_OFF; const LAS int* seg = (const LAS int*)(X + LX_SEG);
    const int ntile = __builtin_amdgcn_readfirstlane(seg[16]) >> 8;
    SchedMoe Sc{(const char*)(ws_ + WS_XN), (const char*)(ws_ + WS_WMOE), (size_t)0, (size_t)512 * 1024 * 2, (size_t)256 * 1024 * 2, ntile * 2, F.G, F.vcu, 1, (const LAS int*)(X + LX_TILEE), (const int*)(ws_ + WS_SMALL + SM_ROWTOK), F.wave};
    EpiSwiglu E{(bf16_t*)(ws_ + WS_HID)};
    pg8::gemm_phase<EpiSwiglu, SchedMoe, true, true, true>(F.lds, pg8::Gemm{1024}, Sc, E);
}
__device__ __forceinline__ void moe_gemm2_phase(const Ctx& F_) {
    Ctx F = F_; F.lane = lane_id(); F.tid = F.wave * 64 + F.lane;
    unsigned char* const ws_ = kws();
    LAS unsigned char* X = F.lds + LDSCTL_OFF; const LAS int* seg = (const LAS int*)(X + LX_SEG);
    const int ntile = __builtin_amdgcn_readfirstlane(seg[16]) >> 8;
    SchedMoe Sc{(const char*)(ws_ + WS_HID), (const char*)(ws_ + WS_WMOE) + (size_t)16 * 512 * 1024 * 2, (size_t)256 * 256 * 2, (size_t)1024 * 256 * 2, (size_t)256 * 256 * 2, ntile * 4, F.G, F.vcu, 2, (const LAS int*)(X + LX_TILEE), nullptr, F.wave};
    EpiMoeOut E{(const int*)(ws_ + WS_SMALL + SM_ROWINFO), (const float*)(ws_ + WS_SMALL + SM_ROWW), (bf16_t*)(ws_ + WS_YS)};
    pg8::gemm_phase<EpiMoeOut, SchedMoe, true, true>(F.lds, pg8::Gemm{256}, Sc, E);
}
}
namespace fm {
typedef short bf16x8 __attribute__((ext_vector_type(8)));
typedef short s16x4 __attribute__((ext_vector_type(4)));
typedef float f32x16 __attribute__((ext_vector_type(16)));
typedef float f32x2 __attribute__((ext_vector_type(2)));
constexpr int PROJ_LD = 2560;
constexpr float QSCALE = 0.125f * 1.4426950408889634f;
constexpr size_t WM_EVEN_STRIDE = 8 * MiB;
constexpr size_t WM_WIN = 0, WM_WOUT = 5 * MiB, WM_SGUW = 7 * MiB;
constexpr size_t WS_PROJ = WS_R1;
constexpr size_t WS_O = WS_R1 + 80 * MiB;
constexpr size_t SM_ZSS = 1024 * 1024;

struct SchedStd {
    const char* A; const char* Bt; size_t tile_bytes; int nM, nN, nwg, G, c, wave_id;
    __device__ __forceinline__ void init(const void* A_, const void* Bt_, int M, int N, int K, int G_, int c_) { A = (const char*)A_; Bt = (const char*)Bt_; tile_bytes = (size_t)256 * K * 2; nM = M / 256; nN = N / 256; nwg = nM * nN; G = G_; c = c_; wave_id = 0; }
    __device__ __forceinline__ bool next(int i, Unit& u) const {
        const long L = (long)i * G + c; if (L >= nwg) return false;
        int wgid = (int)L; { const int q = nwg / 8, r = nwg % 8, xcd = wgid % 8, off = wgid / 8; wgid = (xcd < r ? xcd * (q + 1) : r * (q + 1) + (xcd - r) * q) + off; }
        const int nig = 8 * nN, gid = wgid / nig, fm_ = gid * 8, gsz = (nM - fm_) < 8 ? (nM - fm_) : 8;
        u.pm = fm_ + ((wgid % nig) % gsz); u.pn = (wgid % nig) / gsz; return true;
    }
    __device__ __forceinline__ const char* a_base(const Unit& u) const { return A + (size_t)u.pm * tile_bytes; }
    __device__ __forceinline__ const char* b_base(const Unit& u) const { return Bt + (size_t)u.pn * tile_bytes; }
    __device__ __forceinline__ void a_ready(const Unit&) const {}
    __device__ __forceinline__ void done(const Unit&) const {}
};
__device__ __forceinline__ void even_convert_weights(const Ctx& F_, int li) {
    Ctx F = F_; F.lane = lane_id(); F.tid = F.wave * 64 + F.lane;
    unsigned char* const ws_ = kws();
    LAS float* scr = (LAS float*)(F.lds + F.wave * 8448);
    bf16_t* base = (bf16_t*)(ws_ + WS_WMIX + (size_t)li * WM_EVEN_STRIDE);
    bf16_t* WinT = base + WM_WIN / 2; bf16_t* WoutT = base + WM_WOUT / 2; bf16_t* SW = base + WM_SGUW / 2;
    const float* w_in = kin(4) + (size_t)li * 1024 * 2560; const float* w_out = kin(5) + (size_t)li * 1024 * 1024; const float* sw = kin(7) + (size_t)li * 8 * 128 * 128;
    const int gw = F.wg * NWAVES + F.wave, NGW = F.G * NWAVES;
    constexpr int I_IN = 16 * 80, I_OUT = 16 * 32;
    for (int it = gw; it < I_IN + I_OUT; it += NGW) {
        if (it < I_IN) { const int kb = it / 80, nb = it % 80; transpose_item(w_in, 2560, WinT, 1024, kb * 64, nb * 32, nb * 32, scr, F.lane); }
        else { const int r = it - I_IN, kb = r / 32, nb = r % 32; transpose_item(w_out, 1024, WoutT, 1024, kb * 64, nb * 32, nb * 32, scr, F.lane); }
    }
    for (int i = gw * 64 + F.lane; i < 8 * 128 * 128 / 4; i += NGW * 64) { const f32x4 v = ((const f32x4*)sw)[i]; v2u o; o.x = pk2(v.x, v.y); o.y = pk2(v.z, v.w); ((v2u*)SW)[i] = o; }
}
struct EpiInProj {
    static constexpr bool PERM = true, AFTER_DRAIN = false;
    bf16_t* P; float* zss;
    __device__ __forceinline__ void operator()(const f32x4 (&acc)[2][2][4][2], const Unit& u, int wr, int wc, int fr, int fq) const {
        const int row0 = u.pm * 256 + wr * 64 + fr, col0 = u.pn * 256 + wc * 32 + 8 * fq;
        const int kind = u.pn < 2 ? 0 : (u.pn < 6 ? 1 : (u.pn < 8 ? 2 : 3));
#pragma unroll
        for (int ai = 0; ai < 2; ++ai)
#pragma unroll
            for (int m = 0; m < 4; ++m) {
                const int row = row0 + ai * 128 + m * 16; bf16_t* rowp = P + (size_t)row * PROJ_LD + col0; float ssq = 0.f;
#pragma unroll
                for (int bj = 0; bj < 2; ++bj) {
                    f32x4 v0 = acc[ai][bj][m][0], v1 = acc[ai][bj][m][1];
                    if (kind == 0) { v0 = v0 * QSCALE; v1 = v1 * QSCALE; }
                    else if (kind >= 2) {
                        const f32x2 a = pg8::gelu_pk((f32x2){v0[0], v0[1]}), b = pg8::gelu_pk((f32x2){v0[2], v0[3]}), c = pg8::gelu_pk((f32x2){v1[0], v1[1]}), d = pg8::gelu_pk((f32x2){v1[2], v1[3]});
                        v0 = (f32x4){a.x, a.y, b.x, b.y}; v1 = (f32x4){c.x, c.y, d.x, d.y};
                        ssq += (v0[0] * v0[0] + v0[1] * v0[1]) + (v0[2] * v0[2] + v0[3] * v0[3]) + (v1[0] * v1[0] + v1[1] * v1[1]) + (v1[2] * v1[2] + v1[3] * v1[3]);
                    }
                    u32x4 w; w.x = pg8::cvt_pk_bf16(v0[0], v0[1]); w.y = pg8::cvt_pk_bf16(v0[2], v0[3]); w.z = pg8::cvt_pk_bf16(v1[0], v1[1]); w.w = pg8::cvt_pk_bf16(v1[2], v1[3]);
                    *(u32x4*)(rowp + bj * 128) = w;
                }
                if (kind == 3) { ssq += sxor<16>(ssq); ssq = xor32_sum(ssq); if (fq == 0) zss[(size_t)row * 8 + (u.pn - 8) * 4 + wc] = ssq; }
                asm volatile("" ::: "memory");
            }
    }
};
struct EpiResid {
    static constexpr bool PERM = false, AFTER_DRAIN = false;
    const float* xin; float* xout; const float* mod;
    __device__ __forceinline__ void operator()(const f32x4 (&acc)[2][2][4][2], const Unit& u, int wr, int wc, int fr, int fq) const {
        const int row0 = u.pm * 256 + wr * 64 + fr, col0 = u.pn * 256 + wc * 32 + 4 * fq, b = (u.pm * 256) / S;
        const float* g = mod + (size_t)b * 3072 + 2048 + col0;
        f32x4 gv[2][2];
#pragma unroll
        for (int bj = 0; bj < 2; ++bj)
#pragma unroll
            for (int n = 0; n < 2; ++n) gv[bj][n] = *(const f32x4*)(g + bj * 128 + n * 16);
#pragma unroll
        for (int ai = 0; ai < 2; ++ai)
#pragma unroll
            for (int m = 0; m < 4; ++m) { const size_t off = (size_t)(row0 + ai * 128 + m * 16) * D + col0;
#pragma unroll
                for (int bj = 0; bj < 2; ++bj)
#pragma unroll
                    for (int n = 0; n < 2; ++n) { const f32x4 xv = *(const f32x4*)(xin + off + bj * 128 + n * 16); *(f32x4*)(xout + off + bj * 128 + n * 16) = xv + gv[bj][n] * acc[ai][bj][m][n]; }
                asm volatile("" ::: "memory"); }
    }
};
__device__ __forceinline__ void even_inproj_phase(const Ctx& F_, int li) {
    Ctx F = F_; F.lane = lane_id(); F.tid = F.wave * 64 + F.lane;
    unsigned char* const ws_ = kws();
    SchedStd Sc; Sc.init(ws_ + WS_XN, ws_ + WS_WMIX + (size_t)li * WM_EVEN_STRIDE + WM_WIN, T, 2560, 1024, F.G, F.wg); Sc.wave_id = F.wave;
    EpiInProj E{(bf16_t*)(ws_ + WS_PROJ), (float*)(ws_ + WS_SMALL + SM_ZSS)};
    pg8::gemm_phase<EpiInProj, SchedStd, true, true>(F.lds, pg8::Gemm{1024}, Sc, E);
}
__device__ __forceinline__ void even_outproj_phase(const Ctx& F_, int layer, const float* xin) {
    Ctx F = F_; F.lane = lane_id(); F.tid = F.wave * 64 + F.lane;
    unsigned char* const ws_ = kws(); float* const x_ = kout();
    SchedStd Sc; Sc.init(ws_ + WS_O, ws_ + WS_WMIX + (size_t)(layer / 2) * WM_EVEN_STRIDE + WM_WOUT, T, 1024, 1024, F.G, F.wg); Sc.wave_id = F.wave;
    EpiResid E{xin, x_, (const float*)(ws_ + WS_MOD) + (size_t)(layer * 2) * NB * 3072};
    pg8::gemm_phase<EpiResid, SchedStd, true, true>(F.lds, pg8::Gemm{1024}, Sc, E);
}
__device__ __forceinline__ s16x4 tr_read(const LAS unsigned char* p) { typedef short v4i16_t __attribute__((ext_vector_type(4))); return __builtin_bit_cast(s16x4, __builtin_amdgcn_ds_read_tr16_b64_v4i16((LAS v4i16_t*)p)); }
constexpr int VPITCH = 144;
constexpr size_t WS_APART = WS_R1 + 112 * MiB;
constexpr size_t APART_WG = 3 * 512 * 64 * 2 + 3 * 512 * 8;
__device__ __forceinline__ void attn_branch_task(const bf16_t* __restrict__ Pb  , unsigned char* part  , LAS unsigned char* vl,
                                                 int br, int dil, int res, int ti  , int qbase  , int lane) {
    const int r32 = lane & 31, h2 = lane >> 5;
    const int qpos = (32 * ti + r32) * dil + res;
    const bf16_t* qrow = Pb + (size_t)qpos * PROJ_LD + 8 * h2;
    bf16x8 qf[4];
#pragma unroll
    for (int ks = 0; ks < 4; ++ks) qf[ks] = *(const bf16x8*)(qrow + 16 * ks);
    float mrun = -INFINITY, lrun = 0.f; f32x16 o0, o1;
#pragma unroll
    for (int r = 0; r < 16; ++r) { o0[r] = 0.f; o1[r] = 0.f; }
    const int vkey = lane >> 3, vch = lane & 7;
    const int g4 = lane >> 4, i16 = lane & 15;
    const LAS unsigned char* trb = vl + (4 * h2 + (i16 >> 2)) * VPITCH + (16 * (g4 & 1) + 4 * (i16 & 3)) * 2;
    const int kt0 = ti > 4 ? ti - 4 : 0;
    const unsigned koff = (unsigned)(r32 * dil) * PROJ_LD + 512 + 8 * h2;
    unsigned voff[4];
#pragma unroll
    for (int it = 0; it < 4; ++it) voff[it] = (unsigned)((vkey + 8 * it) * dil) * PROJ_LD + 1024 + 8 * vch;
    bf16x8 kf[4]; v4u vv[4];
    { const bf16_t* tb = Pb + (size_t)(32 * kt0 * dil + res) * PROJ_LD;
#pragma unroll
        for (int ks = 0; ks < 4; ++ks) kf[ks] = *(const bf16x8*)(tb + koff + 16 * ks);
#pragma unroll
        for (int it = 0; it < 4; ++it) vv[it] = *(const v4u*)(tb + voff[it]); }
#pragma unroll 1
    for (int kt = kt0; kt <= ti; ++kt) {
        const int ktn = kt < ti ? kt + 1 : kt;
        bf16x8 nkf[4]; v4u nvv[4];
        { const bf16_t* tb = Pb + (size_t)(32 * ktn * dil + res) * PROJ_LD;
#pragma unroll
            for (int ks = 0; ks < 4; ++ks) nkf[ks] = *(const bf16x8*)(tb + koff + 16 * ks);
#pragma unroll
            for (int it = 0; it < 4; ++it) nvv[it] = *(const v4u*)(tb + voff[it]); }
        f32x16 s;
#pragma unroll
        for (int r = 0; r < 16; ++r) s[r] = 0.f;
#pragma unroll
        for (int ks = 0; ks < 4; ++ks) s = __builtin_amdgcn_mfma_f32_32x32x16_bf16(kf[ks], qf[ks], s, 0, 0, 0);
#pragma unroll
        for (int it = 0; it < 4; ++it) *(LAS v4u*)(vl + (vkey + 8 * it) * VPITCH + vch * 16) = vv[it];
        const int dq0 = 32 * (ti - kt) + r32 - 4 * h2;
        float tmax = -INFINITY;
#pragma unroll
        for (int r = 0; r < 16; ++r) { const int dq = dq0 - ((r & 3) + 8 * (r >> 2)); s[r] = ((unsigned)dq <= 128u) ? s[r] : -INFINITY; tmax = fmaxf(tmax, s[r]); }
        tmax = xor32_max(tmax);
        const float mnew = fmaxf(mrun, tmax), msafe = (mnew == -INFINITY) ? 0.f : mnew;
        const float alpha = __builtin_amdgcn_exp2f(mrun - msafe);
        float psum = 0.f;
#pragma unroll
        for (int r = 0; r < 16; ++r) { s[r] = __builtin_amdgcn_exp2f(s[r] - msafe); psum += s[r]; }
        lrun = lrun * alpha + psum;
        if (!__all(mnew == mrun)) {
#pragma unroll
            for (int r = 0; r < 16; ++r) { o0[r] *= alpha; o1[r] *= alpha; }
        }
        mrun = mnew;
        bf16x8 pf[2];
#pragma unroll
        for (int st = 0; st < 2; ++st) { v4u w; w.x = cvtpk(s[8 * st], s[8 * st + 1]); w.y = cvtpk(s[8 * st + 2], s[8 * st + 3]); w.z = cvtpk(s[8 * st + 4], s[8 * st + 5]); w.w = cvtpk(s[8 * st + 6], s[8 * st + 7]); pf[st] = __builtin_bit_cast(bf16x8, w); }
#pragma unroll
        for (int st = 0; st < 2; ++st) {
            const s16x4 a0 = tr_read(trb + (16 * st) * VPITCH), a1 = tr_read(trb + (16 * st + 8) * VPITCH);
            const s16x4 b0 = tr_read(trb + (16 * st) * VPITCH + 64), b1 = tr_read(trb + (16 * st + 8) * VPITCH + 64);
            const bf16x8 A0 = (bf16x8){a0[0], a0[1], a0[2], a0[3], a1[0], a1[1], a1[2], a1[3]}, A1 = (bf16x8){b0[0], b0[1], b0[2], b0[3], b1[0], b1[1], b1[2], b1[3]};
            o0 = __builtin_amdgcn_mfma_f32_32x32x16_bf16(A0, pf[st], o0, 0, 0, 0);
            o1 = __builtin_amdgcn_mfma_f32_32x32x16_bf16(A1, pf[st], o1, 0, 0, 0);
        }
#pragma unroll
        for (int ks = 0; ks < 4; ++ks) kf[ks] = nkf[ks];
#pragma unroll
        for (int it = 0; it < 4; ++it) vv[it] = nvv[it];
    }
    const float ltot = xor32_sum(lrun);
    const int ql = qpos - qbase;
    bf16_t* prow = (bf16_t*)(part + (size_t)br * 512 * 64 * 2) + (size_t)ql * 64 + 4 * h2;
#pragma unroll
    for (int gq = 0; gq < 4; ++gq) {
        v2u w0, w1; w0.x = cvtpk(o0[4 * gq], o0[4 * gq + 1]); w0.y = cvtpk(o0[4 * gq + 2], o0[4 * gq + 3]);
        w1.x = cvtpk(o1[4 * gq], o1[4 * gq + 1]); w1.y = cvtpk(o1[4 * gq + 2], o1[4 * gq + 3]);
        *(v2u*)(prow + 8 * gq) = w0; *(v2u*)(prow + 32 + 8 * gq) = w1;
    }
    if (h2 == 0) *(f32x2*)(part + 3 * 512 * 64 * 2 + ((size_t)br * 512 + ql) * 8) = (f32x2){mrun, ltot};
}
__device__ __forceinline__ void attn_merge(const unsigned char* part, bf16_t* __restrict__ Ob  , int tid) {
#pragma unroll 2
    for (int it = 0; it < 8; ++it) {
        const int idx = tid + NTHREADS * it, ql = idx >> 3, pc = idx & 7;
        const f32x2 ml0 = *(const f32x2*)(part + 3 * 512 * 64 * 2 + ((size_t)0 * 512 + ql) * 8), ml1 = *(const f32x2*)(part + 3 * 512 * 64 * 2 + ((size_t)1 * 512 + ql) * 8), ml2 = *(const f32x2*)(part + 3 * 512 * 64 * 2 + ((size_t)2 * 512 + ql) * 8);
        const v4u p0 = *(const v4u*)(part + ((size_t)0 * 512 + ql) * 128 + pc * 16), p1 = *(const v4u*)(part + ((size_t)1 * 512 + ql) * 128 + pc * 16), p2 = *(const v4u*)(part + ((size_t)2 * 512 + ql) * 128 + pc * 16);
        const float M = fmaxf(fmaxf(ml0.x, ml1.x), ml2.x);
        const float w0 = __builtin_amdgcn_exp2f(ml0.x - M), w1 = __builtin_amdgcn_exp2f(ml1.x - M), w2 = __builtin_amdgcn_exp2f(ml2.x - M);
        const float inv = 1.0f / (w0 * ml0.y + w1 * ml1.y + w2 * ml2.y);
        const float a0 = w0 * inv, a1 = w1 * inv, a2 = w2 * inv;
        v4u o;
        o.x = cvtpk(a0 * bflo(p0.x) + a1 * bflo(p1.x) + a2 * bflo(p2.x), a0 * bfhi(p0.x) + a1 * bfhi(p1.x) + a2 * bfhi(p2.x));
        o.y = cvtpk(a0 * bflo(p0.y) + a1 * bflo(p1.y) + a2 * bflo(p2.y), a0 * bfhi(p0.y) + a1 * bfhi(p1.y) + a2 * bfhi(p2.y));
        o.z = cvtpk(a0 * bflo(p0.z) + a1 * bflo(p1.z) + a2 * bflo(p2.z), a0 * bfhi(p0.z) + a1 * bfhi(p1.z) + a2 * bfhi(p2.z));
        o.w = cvtpk(a0 * bflo(p0.w) + a1 * bflo(p1.w) + a2 * bflo(p2.w), a0 * bfhi(p0.w) + a1 * bfhi(p1.w) + a2 * bfhi(p2.w));
        *(v4u*)(Ob + (size_t)ql * D + pc * 8) = o;
    }
}
__device__ __forceinline__ unsigned mask_pair(unsigned x, int e0, int lim) { if (e0 > lim) x &= 0xffff0000u; if (e0 + 1 > lim) x &= 0x0000ffffu; return x; }
constexpr int ZPITCH = 128;
__device__ __forceinline__ void sgu_task(const bf16_t* __restrict__ P, bf16_t* __restrict__ O, const bf16_t* __restrict__ SW, const float* __restrict__ zss, const float* __restrict__ ng, const float* __restrict__ bs,
                                         LAS unsigned char* zl, int b, int ch, int g, int lane, int half) {
    const int r32 = lane & 31, h2 = lane >> 5;
    const size_t t0 = (size_t)b * S + ch * 128;
    { const int chn = lane & 7; f32x4 n0 = *(const f32x4*)(ng + g * 64 + 8 * chn), n1 = *(const f32x4*)(ng + g * 64 + 8 * chn + 4);
#pragma unroll 4
        for (int it = 0; it < 16; ++it) { const int row = (lane >> 3) + 8 * it;
            const float* zp = zss + (t0 + row) * 8; const f32x4 p0 = *(const f32x4*)zp, p1 = *(const f32x4*)(zp + 4);
            const float ri = 1.0f / sqrtf(((p0.x + p0.y) + (p0.z + p0.w) + (p1.x + p1.y) + (p1.z + p1.w)) * (1.f / 512.f) + 1e-6f);
            const v4u z = *(const v4u*)(P + (t0 + row) * PROJ_LD + 2048 + g * 64 + 8 * chn);
            v4u o; o.x = pk2(bflo(z.x) * ri * n0.x, bfhi(z.x) * ri * n0.y); o.y = pk2(bflo(z.y) * ri * n0.z, bfhi(z.y) * ri * n0.w);
            o.z = pk2(bflo(z.z) * ri * n1.x, bfhi(z.z) * ri * n1.y); o.w = pk2(bflo(z.w) * ri * n1.z, bfhi(z.w) * ri * n1.w);
            *(LAS v4u*)(zl + row * ZPITCH + chn * 16) = o; } }
    asm volatile("s_waitcnt lgkmcnt(0)" ::: "memory");
    const int g4 = lane >> 4, i16 = lane & 15;
    const LAS unsigned char* trb = zl + (8 * h2 + (i16 >> 2)) * ZPITCH + (16 * (g4 & 1) + 4 * (i16 & 3)) * 2;
    const bf16_t* Wg = SW + (size_t)g * 128 * 128;
#pragma unroll 1
    for (int mi = 0; mi < 2; ++mi) {
        const int mt = half == 0 ? (mi == 0 ? 0 : 3) : (mi == 0 ? 1 : 2);
        f32x16 a0, a1;
#pragma unroll
        for (int r = 0; r < 16; ++r) { a0[r] = 0.f; a1[r] = 0.f; }
        const int irow = 32 * mt + r32;
#pragma unroll 1
        for (int kt = 0; kt <= mt; ++kt) {
#pragma unroll
            for (int ks = 0; ks < 2; ++ks) {
                const int j0 = 32 * kt + 16 * ks + 8 * h2;
                v4u wv = *(const v4u*)(Wg + (size_t)irow * 128 + j0);
                if (kt == mt) {
                    const int lim = irow - j0;
                    wv.x = mask_pair(wv.x, 0, lim); wv.y = mask_pair(wv.y, 2, lim); wv.z = mask_pair(wv.z, 4, lim); wv.w = mask_pair(wv.w, 6, lim);
                }
                const bf16x8 af = __builtin_bit_cast(bf16x8, wv);
                const LAS unsigned char* tb = trb + (32 * kt + 16 * ks) * ZPITCH;
                const s16x4 x0 = tr_read(tb), x1 = tr_read(tb + 4 * ZPITCH), y0 = tr_read(tb + 64), y1 = tr_read(tb + 4 * ZPITCH + 64);
                const bf16x8 B0 = (bf16x8){x0[0], x0[1], x0[2], x0[3], x1[0], x1[1], x1[2], x1[3]}, B1 = (bf16x8){y0[0], y0[1], y0[2], y0[3], y1[0], y1[1], y1[2], y1[3]};
                a0 = __builtin_amdgcn_mfma_f32_32x32x16_bf16(af, B0, a0, 0, 0, 0);
                a1 = __builtin_amdgcn_mfma_f32_32x32x16_bf16(af, B1, a1, 0, 0, 0);
            }
        }
#pragma unroll
        for (int r = 0; r < 16; ++r) {
            const int i = 32 * mt + (r & 3) + 8 * (r >> 2) + 4 * h2; const float bb = bs[g * 128 + i];
            const bf16_t* up = P + (t0 + i) * PROJ_LD + 1536 + g * 64; bf16_t* op = O + (t0 + i) * D + 512 + g * 64;
            op[r32] = (bf16_t)f2bf(bf2f(up[r32]) * (a0[r] + bb)); op[32 + r32] = (bf16_t)f2bf(bf2f(up[32 + r32]) * (a1[r] + bb));
        }
    }
}
__device__ __forceinline__ void even_mix_phase(const Ctx& F_, int li) {
    Ctx F = F_; F.lane = lane_id(); F.tid = F.wave * 64 + F.lane;
    unsigned char* const ws_ = kws();
    const bf16_t* P = (const bf16_t*)(ws_ + WS_PROJ); bf16_t* O = (bf16_t*)(ws_ + WS_O);
    LAS unsigned char* wl = F.lds + F.wave * 16384;
    { const int b = F.wg >> 5, hh = (F.wg >> 2) & 7, jt = F.wg & 3, qbase = 512 * jt;
        const bf16_t* Pb = P + (size_t)b * S * PROJ_LD + hh * 64; unsigned char* part = ws_ + WS_APART + (size_t)F.wg * APART_WG;
#pragma unroll 1
        for (int u = 0; u < 2; ++u) { const int tk = 2 * F.wave + u;
            attn_branch_task(Pb, part, wl, 0, 1, 0, 16 * jt + tk, qbase, F.lane);
            attn_branch_task(Pb, part, wl, 1, 4, tk >> 2, 4 * jt + (tk & 3), qbase, F.lane);
            attn_branch_task(Pb, part, wl, 2, 16, tk, jt, qbase, F.lane); }
        asm volatile("s_waitcnt vmcnt(0)" ::: "memory");
        __syncthreads();
        attn_merge(part, O + ((size_t)b * S + qbase) * D + hh * 64, F.tid);
    }
    { const int task = F.wg * 4 + (F.wave & 3), b = task >> 7, ch = (task >> 3) & 15, g = task & 7;
        sgu_task(P, O, (const bf16_t*)(ws_ + WS_WMIX + (size_t)li * WM_EVEN_STRIDE + WM_SGUW), (const float*)(ws_ + WS_SMALL + SM_ZSS), kin(6) + li * 512, kin(8) + li * 8 * 128, wl, b, ch, g, F.lane, F.wave >> 2); }
}
}
namespace fm {
constexpr size_t WM_ODD_BASE = 16 * MiB, WM_ODD_STRIDE = 12 * MiB, WM_WRKV = 0, WM_WLD = 6 * MiB, WM_WLU = 8 * MiB, WM_WO = 10 * MiB;
constexpr size_t WS_VFIRST = 16 * MiB;
constexpr size_t WS_LORA = 48 * MiB;
constexpr size_t WS_MIX = WS_R1;
constexpr size_t WS_WDEC = WS_R1, WS_AV = WS_R1 + 64 * MiB, WS_G = WS_R1 + 96 * MiB;
constexpr size_t WS_R = WS_R1 + 128 * MiB, WS_K = WS_R1 + 160 * MiB, WS_V = WS_R1 + 192 * MiB;
constexpr size_t WS_Y = WS_XN;

__device__ __forceinline__ void odd_convert_weights(const Ctx& F_, int li) {
    Ctx F = F_; F.lane = lane_id(); F.tid = F.wave * 64 + F.lane;
    unsigned char* const ws_ = kws();
    LAS float* scr = (LAS float*)(F.lds + F.wave * 8448);
    unsigned char* base = ws_ + WS_WMIX + WM_ODD_BASE + (size_t)li * WM_ODD_STRIDE;
    bf16_t* WRKV = (bf16_t*)(base + WM_WRKV); bf16_t* WLD = (bf16_t*)(base + WM_WLD); bf16_t* WLU = (bf16_t*)(base + WM_WLU); bf16_t* WO = (bf16_t*)(base + WM_WO);
    const float* w_rkv = kin(10) + (size_t)li * 3 * 1024 * 1024; const float* w_o = kin(11) + (size_t)li * 1024 * 1024;
    const float* w1 = kin(13) + (size_t)li * 1024 * 64; const float* a1 = kin(16) + (size_t)li * 1024 * 64; const float* g1 = kin(21) + (size_t)li * 1024 * 160;
    const float* v1 = kin(19);
    const float* w2 = kin(14) + (size_t)li * 64 * 1024; const float* a2 = kin(17) + (size_t)li * 64 * 1024; const float* g2 = kin(22) + (size_t)li * 160 * 1024; const float* v2 = kin(20);
    const int gw = F.wg * NWAVES + F.wave, NGW = F.G * NWAVES;
    constexpr int I_SQ = 16 * 32;
    constexpr int I_LD = 16 * 8;
    constexpr int I_LU = 4 * 32;
    constexpr int NIT = 4 * I_SQ + 4 * I_LD + 4 * I_LU;
    for (int it = gw; it < NIT; it += NGW) {
        int r = it;
        if (r < 4 * I_SQ) { const int mtx = r / I_SQ, q = r % I_SQ, kb = q / 32, nb = q % 32;
            if (mtx < 3) transpose_item(w_rkv + (size_t)mtx * 1024 * 1024, 1024, WRKV + (size_t)mtx * 1024 * 1024, 1024, kb * 64, nb * 32, nb * 32, scr, F.lane);
            else transpose_item(w_o, 1024, WO, 1024, kb * 64, nb * 32, nb * 32, scr, F.lane);
            continue; }
        r -= 4 * I_SQ;
        if (r < 4 * I_LD) { const int tl = r / I_LD, q = r % I_LD, kb = q / 8, nb = q % 8;
            const float* W = tl == 0 ? w1 : (tl == 1 ? a1 : (tl == 2 ? g1 : v1)); const int nv = tl == 0 ? 64 : (tl == 1 ? 64 : (tl == 2 ? 160 : (li > 0 ? 32 : 0)));
            transpose_item_pad(W, tl == 2 ? 160 : (tl == 3 ? 32 : 64), nv, 1024, WLD + (size_t)tl * 256 * 1024, 1024, kb * 64, nb * 32, nb * 32, scr, F.lane);
            continue; }
        r -= 4 * I_LD;
        { const int tl = r / I_LU, q = r % I_LU, kb = q / 32, nb = q % 32;
            const float* W = tl == 0 ? w2 : (tl == 1 ? a2 : (tl == 2 ? g2 : v2)); const int kv = tl == 0 ? 64 : (tl == 1 ? 64 : (tl == 2 ? 160 : (li > 0 ? 32 : 0)));
            transpose_item_pad(W, 1024, 1024, kv, WLU + (size_t)tl * 1024 * 256, 256, kb * 64, nb * 32, nb * 32, scr, F.lane); }
    }
}
template <int NMIX> __device__ __forceinline__ void odd_mix_phase(const Ctx& F_, int li, int m0, int m1, int m2, int m3) {
    Ctx F = F_; F.lane = lane_id(); F.tid = F.wave * 64 + F.lane;
    unsigned char* const ws_ = kws();
    const bf16_t* XN = (const bf16_t*)(ws_ + WS_XN); bf16_t* MIX = (bf16_t*)(ws_ + WS_MIX);
    const float* mu = kin(9) + (size_t)li * 6 * 1024;
    const int ids[4] = {m0, m1, m2, m3};
    const int row0 = F.wg * 64 + F.wave * 8;
    f32x4 hp[4];
    { const bool first = (row0 % S) == 0; const v2u* pr = (const v2u*)(XN + (size_t)(row0 - (first ? 0 : 1)) * D) + F.lane;
#pragma unroll
        for (int j = 0; j < 4; ++j) { const v2u w = pr[64 * j]; hp[j] = first ? (f32x4){0.f, 0.f, 0.f, 0.f} : (f32x4){bflo(w.x), bfhi(w.x), bflo(w.y), bfhi(w.y)}; } }
#pragma unroll 1
    for (int r = 0; r < 8; ++r) {
        const int row = row0 + r; const v2u* pr = (const v2u*)(XN + (size_t)row * D) + F.lane;
        f32x4 h[4];
#pragma unroll
        for (int j = 0; j < 4; ++j) { const v2u w = pr[64 * j]; h[j] = (f32x4){bflo(w.x), bfhi(w.x), bflo(w.y), bfhi(w.y)}; }
#pragma unroll
        for (int s = 0; s < NMIX; ++s) {
            v2u* po = (v2u*)(MIX + ((size_t)s * T + row) * D) + F.lane;
#pragma unroll
            for (int j = 0; j < 4; ++j) { const f32x4 m = ((const f32x4*)(mu + ids[s] * 1024))[64 * j + F.lane]; const f32x4 x = h[j] + (hp[j] - h[j]) * m;
                v2u o; o.x = pk2(x.x, x.y); o.y = pk2(x.z, x.w); po[64 * j] = o; }
        }
#pragma unroll
        for (int j = 0; j < 4; ++j) hp[j] = h[j];
    }
}
struct SchedMulti {
    const char* A; const char* Bt; size_t a_tile, a_sel_stride, b_tile; int nN, nwg, G, c, a_shift, wave_id;
    __device__ __forceinline__ bool next(int i, Unit& u) const { const long L = (long)i * G + c; if (L >= nwg) return false; u.pm = (int)(L / nN); u.pn = (int)(L % nN); return true; }
    __device__ __forceinline__ const char* a_base(const Unit& u) const { return A + (size_t)(u.pn >> a_shift) * a_sel_stride + (size_t)u.pm * a_tile; }
    __device__ __forceinline__ const char* b_base(const Unit& u) const { return Bt + (size_t)u.pn * b_tile; }
    __device__ __forceinline__ void a_ready(const Unit&) const {}
    __device__ __forceinline__ void done(const Unit&) const {}
};
struct EpiRKV {
    static constexpr bool PERM = true, AFTER_DRAIN = false;
    unsigned char* ws; size_t offV;
    __device__ __forceinline__ void operator()(const f32x4 (&acc)[2][2][4][2], const Unit& u, int wr, int wc, int fr, int fq) const {
        const int row0 = u.pm * 256 + wr * 64 + fr, col0 = (u.pn & 3) * 256 + wc * 32 + 8 * fq; const int sel = u.pn >> 2;
        size_t boff = WS_R + (size_t)sel * (WS_K - WS_R); if (sel == 2) boff = offV;
        bf16_t* base = (bf16_t*)(ws + boff);
#pragma unroll
        for (int ai = 0; ai < 2; ++ai)
#pragma unroll
            for (int m = 0; m < 4; ++m) { bf16_t* rowp = base + (size_t)(row0 + ai * 128 + m * 16) * D + col0;
#pragma unroll
                for (int bj = 0; bj < 2; ++bj) { const f32x4 v0 = acc[ai][bj][m][0], v1 = acc[ai][bj][m][1];
                    u32x4 w; w.x = pg8::cvt_pk_bf16(v0[0], v0[1]); w.y = pg8::cvt_pk_bf16(v0[2], v0[3]); w.z = pg8::cvt_pk_bf16(v1[0], v1[1]); w.w = pg8::cvt_pk_bf16(v1[2], v1[3]);
                    *(u32x4*)(rowp + bj * 128) = w; }
                asm volatile("" ::: "memory"); }
    }
};
struct EpiLoraDown {
    static constexpr bool PERM = true, AFTER_DRAIN = false;
    bf16_t* L;
    __device__ __forceinline__ void operator()(const f32x4 (&acc)[2][2][4][2], const Unit& u, int wr, int wc, int fr, int fq) const {
        const int row0 = u.pm * 256 + wr * 64 + fr, col0 = wc * 32 + 8 * fq; const int act = u.pn == 0 ? 1 : (u.pn == 2 ? 2 : 0);
        bf16_t* base = L + (size_t)u.pn * T * 256;
#pragma unroll
        for (int ai = 0; ai < 2; ++ai)
#pragma unroll
            for (int m = 0; m < 4; ++m) { bf16_t* rowp = base + (size_t)(row0 + ai * 128 + m * 16) * 256 + col0;
#pragma unroll
                for (int bj = 0; bj < 2; ++bj) { float h[8];
#pragma unroll
                    for (int n = 0; n < 2; ++n)
#pragma unroll
                        for (int q = 0; q < 4; ++q) { float v = acc[ai][bj][m][n][q];
                            if (act == 1) v = 1.f - 2.f * __builtin_amdgcn_rcpf(1.f + __expf(2.f * v)); else if (act == 2) v = fast_sigmoid(v);
                            h[4 * n + q] = v; }
                    u32x4 w; w.x = pg8::cvt_pk_bf16(h[0], h[1]); w.y = pg8::cvt_pk_bf16(h[2], h[3]); w.z = pg8::cvt_pk_bf16(h[4], h[5]); w.w = pg8::cvt_pk_bf16(h[6], h[7]);
                    *(u32x4*)(rowp + bj * 128) = w; }
                asm volatile("" ::: "memory"); }
    }
};
struct EpiLoraUp {
    static constexpr bool PERM = true, AFTER_DRAIN = false;
    unsigned char* ws; const float* vecs;
    const float *w0, *a0, *v0;
    __device__ __forceinline__ void operator()(const f32x4 (&acc)[2][2][4][2], const Unit& u, int wr, int wc, int fr, int fq) const {
        const int row0 = u.pm * 256 + wr * 64 + fr, col0 = (u.pn & 3) * 256 + wc * 32 + 8 * fq; const int sub = u.pn >> 2;
        f32x4 bv[2][2];
#pragma unroll
        for (int bj = 0; bj < 2; ++bj)
#pragma unroll
            for (int n = 0; n < 2; ++n) { const int cc = col0 + bj * 128 + 4 * n; f32x4 t = (f32x4){0.f, 0.f, 0.f, 0.f};
                if (sub == 0) t = *(const f32x4*)(w0 + cc); else if (sub == 1) t = *(const f32x4*)(a0 + cc); else if (sub == 3) t = *(const f32x4*)(v0 + cc);
                bv[bj][n] = t; }
#pragma unroll
        for (int ai = 0; ai < 2; ++ai)
#pragma unroll
            for (int m = 0; m < 4; ++m) { const size_t off = (size_t)(row0 + ai * 128 + m * 16) * D + col0;
#pragma unroll
                for (int bj = 0; bj < 2; ++bj) {
                    f32x4 v0_ = acc[ai][bj][m][0] + bv[bj][0], v1_ = acc[ai][bj][m][1] + bv[bj][1];
                    if (sub == 0) {
#pragma unroll
                        for (int q = 0; q < 4; ++q) { v0_[q] = -0.8750387749f * fast_sigmoid(v0_[q]); v1_[q] = -0.8750387749f * fast_sigmoid(v1_[q]); }
                        u32x4 w; w.x = pg8::cvt_pk_bf16(v0_[0], v0_[1]); w.y = pg8::cvt_pk_bf16(v0_[2], v0_[3]); w.z = pg8::cvt_pk_bf16(v1_[0], v1_[1]); w.w = pg8::cvt_pk_bf16(v1_[2], v1_[3]);
                        *(u32x4*)((bf16_t*)(ws + WS_WDEC) + off + bj * 128) = w;
                    } else {
                        size_t doff = WS_AV; if (sub == 2) doff = WS_G; if (sub == 3) doff = WS_V;
                        if (sub == 1) {
#pragma unroll
                            for (int q = 0; q < 4; ++q) { v0_[q] = fast_sigmoid(v0_[q]); v1_[q] = fast_sigmoid(v1_[q]); }
                        } else if (sub == 3) {
                            const u32x4 vo = *(const u32x4*)((const bf16_t*)(ws + WS_V) + off + bj * 128), vf = *(const u32x4*)((const bf16_t*)(ws + WS_VFIRST) + off + bj * 128);
                            const f32x4 olo = (f32x4){bflo(vo.x), bfhi(vo.x), bflo(vo.y), bfhi(vo.y)}, ohi = (f32x4){bflo(vo.z), bfhi(vo.z), bflo(vo.w), bfhi(vo.w)};
                            const f32x4 flo = (f32x4){bflo(vf.x), bfhi(vf.x), bflo(vf.y), bfhi(vf.y)}, fhi = (f32x4){bflo(vf.z), bfhi(vf.z), bflo(vf.w), bfhi(vf.w)};
#pragma unroll
                            for (int q = 0; q < 4; ++q) { v0_[q] = olo[q] + (flo[q] - olo[q]) * fast_sigmoid(v0_[q]); v1_[q] = ohi[q] + (fhi[q] - ohi[q]) * fast_sigmoid(v1_[q]); }
                        }
                        u32x4 w; w.x = pg8::cvt_pk_bf16(v0_[0], v0_[1]); w.y = pg8::cvt_pk_bf16(v0_[2], v0_[3]); w.z = pg8::cvt_pk_bf16(v1_[0], v1_[1]); w.w = pg8::cvt_pk_bf16(v1_[2], v1_[3]);
                        *(u32x4*)((bf16_t*)(ws + doff) + off + bj * 128) = w;
                    }
                }
                asm volatile("" ::: "memory"); }
    }
};
__device__ __forceinline__ bf16_t* odd_vbuf(unsigned char* ws_, int li) { return (bf16_t*)(ws_ + (li == 0 ? WS_VFIRST : WS_V)); }
__device__ __forceinline__ void odd_gemm_rkv_phase(const Ctx& F_, int li) {
    Ctx F = F_; F.lane = lane_id(); F.tid = F.wave * 64 + F.lane;
    unsigned char* const ws_ = kws();
    SchedMulti Sc{(const char*)(ws_ + WS_MIX), (const char*)(ws_ + WS_WMIX + WM_ODD_BASE + (size_t)li * WM_ODD_STRIDE + WM_WRKV), (size_t)256 * 1024 * 2, (size_t)T * D * 2, (size_t)256 * 1024 * 2, 12, 64 * 12, F.G, F.vcu, 2, F.wave};
    EpiRKV E{ws_, li == 0 ? WS_VFIRST : WS_V};
    pg8::gemm_phase<EpiRKV, SchedMulti, true, true>(F.lds, pg8::Gemm{1024}, Sc, E);
}
__device__ __forceinline__ void odd_gemm_loradown_phase(const Ctx& F_, int li) {
    Ctx F = F_; F.lane = lane_id(); F.tid = F.wave * 64 + F.lane;
    unsigned char* const ws_ = kws(); const int nN = li == 0 ? 3 : 4;
    SchedMulti Sc{(const char*)(ws_ + WS_MIX), (const char*)(ws_ + WS_WMIX + WM_ODD_BASE + (size_t)li * WM_ODD_STRIDE + WM_WLD), (size_t)256 * 1024 * 2, (size_t)T * D * 2, (size_t)256 * 1024 * 2, nN, 64 * nN, F.G, F.vcu, 0, F.wave};
    EpiLoraDown E{(bf16_t*)(ws_ + WS_LORA)};
    pg8::gemm_phase<EpiLoraDown, SchedMulti, true, true>(F.lds, pg8::Gemm{1024}, Sc, E);
}
__device__ __forceinline__ void odd_gemm_loraup_phase(const Ctx& F_, int li) {
    Ctx F = F_; F.lane = lane_id(); F.tid = F.wave * 64 + F.lane;
    unsigned char* const ws_ = kws(); const int nN = li == 0 ? 12 : 16;
    SchedMulti Sc{(const char*)(ws_ + WS_LORA), (const char*)(ws_ + WS_WMIX + WM_ODD_BASE + (size_t)li * WM_ODD_STRIDE + WM_WLU), (size_t)256 * 256 * 2, (size_t)T * 256 * 2, (size_t)256 * 256 * 2, nN, 64 * nN, F.G, F.vcu, 2, F.wave};
    EpiLoraUp E{ws_, nullptr, kin(12) + li * 1024, kin(15) + li * 1024, kin(18)};
    pg8::gemm_phase<EpiLoraUp, SchedMulti, true, true>(F.lds, pg8::Gemm{256}, Sc, E);
}
__device__ __forceinline__ void odd_gemm_wo_phase(const Ctx& F_, int layer) {
    Ctx F = F_; F.lane = lane_id(); F.tid = F.wave * 64 + F.lane;
    unsigned char* const ws_ = kws(); float* const x_ = kout();
    SchedStd Sc; Sc.init(ws_ + WS_Y, ws_ + WS_WMIX + WM_ODD_BASE + (size_t)(layer / 2) * WM_ODD_STRIDE + WM_WO, T, 1024, 1024, F.G, F.wg); Sc.wave_id = F.wave;
    EpiResid E{x_, x_, (const float*)(ws_ + WS_MOD) + (size_t)(layer * 2) * NB * 3072};
    pg8::gemm_phase<EpiResid, SchedStd, true, true>(F.lds, pg8::Gemm{1024}, Sc, E);
}
}
namespace fm {
constexpr size_t WS_ZS = WS_R1 + 32 * MiB;
constexpr size_t WS_WKVS = WS_LORA;
constexpr size_t SM_RK = SM_ZSS;
constexpr int LX_WC = 8192;
constexpr float LOG2E = 1.4426950408889634f;
__device__ __forceinline__ bf16x8 pk8lo(const f32x16& a) { v4u w; w.x = cvtpk(a[0], a[1]); w.y = cvtpk(a[2], a[3]); w.z = cvtpk(a[4], a[5]); w.w = cvtpk(a[6], a[7]); return __builtin_bit_cast(bf16x8, w); }
__device__ __forceinline__ bf16x8 pk8hi(const f32x16& a) { v4u w; w.x = cvtpk(a[8], a[9]); w.y = cvtpk(a[10], a[11]); w.z = cvtpk(a[12], a[13]); w.w = cvtpk(a[14], a[15]); return __builtin_bit_cast(bf16x8, w); }
struct PH { bf16x8 f0, f1; };
__device__ __forceinline__ PH packh(const f32x16& a) { PH p; p.f0 = pk8lo(a); p.f1 = pk8hi(a); return p; }
__device__ __forceinline__ f32x16 zero16() { f32x16 z;
#pragma unroll
    for (int r = 0; r < 16; ++r) z[r] = 0.f; return z; }
#define MFMA32(a, b, c) __builtin_amdgcn_mfma_f32_32x32x16_bf16((a), (b), (c), 0, 0, 0)
__device__ __forceinline__ f32x16 ident16(int lane) { int l = lane; asm volatile("" : "+v"(l)); f32x16 z;
#pragma unroll
    for (int r = 0; r < 16; ++r) z[r] = (((r & 3) + 8 * (r >> 2) + 4 * (l >> 5)) == (l & 31)) ? 1.f : 0.f; return z; }
__device__ __forceinline__ f32x16 tt(const PH& U, const PH& W, f32x16 C) { C = MFMA32(U.f0, W.f0, C); C = MFMA32(U.f1, W.f1, C); return C; }
__device__ __forceinline__ bf16x8 colfrag(const LAS unsigned char* mat, int nt, int s, int lane) {
    const int g4 = lane >> 4, i16 = lane & 15, h2 = lane >> 5;
    const LAS unsigned char* p = mat + (16 * s + 4 * h2 + (i16 >> 2)) * 128 + (32 * nt + 16 * (g4 & 1) + 4 * (i16 & 3)) * 2;
    const s16x4 lo = tr_read(p), hi = tr_read(p + 8 * 128);
    return (bf16x8){lo[0], lo[1], lo[2], lo[3], hi[0], hi[1], hi[2], hi[3]};
}
__device__ __forceinline__ PH colph(const LAS unsigned char* mat, int nt, int lane) { PH p; p.f0 = colfrag(mat, nt, 0, lane); p.f1 = colfrag(mat, nt, 1, lane); return p; }
__device__ __forceinline__ f32x4 unpk4(v2u w) { return (f32x4){bflo(w.x), bfhi(w.x), bflo(w.y), bfhi(w.y)}; }
__device__ __forceinline__ v2u pk4(f32x4 v) { v2u o; o.x = cvtpk(v.x, v.y); o.y = cvtpk(v.z, v.w); return o; }
__device__ __forceinline__ void store_rowgroups(bf16_t* rowp  , const f32x16& a, int h2) {
#pragma unroll
    for (int g = 0; g < 4; ++g) *(v2u*)(rowp + 8 * g + 4 * h2) = pk4((f32x4){a[4 * g], a[4 * g + 1], a[4 * g + 2], a[4 * g + 3]});
}

__device__ __forceinline__ void wkv1_task(unsigned char* ws_, const float* k_k, const float* k_a, const float* r_k, int li, int b, int hh, int sc, LAS unsigned char* wl, LAS float* wct, int lane_in, bool dry = false) {
    int lane = lane_in; int t32 = lane & 31, h2 = lane >> 5;
    const bf16_t* Rg = (const bf16_t*)(ws_ + WS_R); const bf16_t* Kg = (const bf16_t*)(ws_ + WS_K); const bf16_t* Vg = odd_vbuf(ws_, li);
    bf16_t* AVg = (bf16_t*)(ws_ + WS_AV); bf16_t* LWg = (bf16_t*)(ws_ + WS_WDEC); float* RKg = (float*)(ws_ + WS_SMALL + SM_RK);
    LAS unsigned char* ldsA = wl; LAS unsigned char* ldsB = wl + 4096; LAS unsigned char* ldsK = wl + 8192; LAS unsigned char* ldsV = wl + 12288;
    PH Gh[2][2], Hh[2][2];
    { const PH ip = packh(ident16(lane)), zp = packh(zero16()); Gh[0][0] = ip; Gh[1][1] = ip; Gh[0][1] = zp; Gh[1][0] = zp; Hh[0][0] = zp; Hh[0][1] = zp; Hh[1][0] = zp; Hh[1][1] = zp; }
#pragma unroll 1
    for (int j = 0; j < 4; ++j) {
        lane = lane_in; asm volatile("" : "+v"(lane)); t32 = lane & 31; h2 = lane >> 5;
        const size_t rowoff = ((size_t)b * S + sc * 128 + j * 32 + t32) * D + hh * 64;
        PH fA[2], fB[2], fK[2], fR[2];
        float inv;
        v2u rw_[8], kw_[8], aw_[8], lw_[8];
#pragma unroll
        for (int g = 0; g < 8; ++g) { const int k0 = 8 * g + 4 * h2;
            rw_[g] = *(const v2u*)(Rg + rowoff + k0); kw_[g] = *(const v2u*)(Kg + rowoff + k0); aw_[g] = *(const v2u*)(AVg + rowoff + k0); lw_[g] = *(const v2u*)(LWg + rowoff + k0);
            *(LAS v2u*)(ldsV + t32 * 128 + k0 * 2) = *(const v2u*)(Vg + rowoff + k0); }
        {
            float nrm = 0.f, rk = 0.f;
#pragma unroll
            for (int g = 0; g < 8; ++g) {
                const int k0 = 8 * g + 4 * h2;
                const f32x4 rr = unpk4(rw_[g]), ko = unpk4(kw_[g]), av = unpk4(aw_[g]);
                const f32x4 kkw = *(const f32x4*)(k_k + hh * 64 + k0), kaw = *(const f32x4*)(k_a + hh * 64 + k0), rkw = *(const f32x4*)(r_k + hh * 64 + k0);
                const f32x4 kq = ko * kkw; nrm += (kq.x * kq.x + kq.y * kq.y) + (kq.z * kq.z + kq.w * kq.w);
                const f32x4 t3 = rr * (ko * ((av - 1.0f) * kaw + 1.0f)) * rkw; rk += (t3.x + t3.y) + (t3.z + t3.w);
            }
            nrm = xor32_sum(nrm); rk = xor32_sum(rk);
            if (h2 == 0 && !dry) RKg[((size_t)b * S + sc * 128 + j * 32 + t32) * 16 + hh] = rk;
            inv = 1.0f / fmaxf(sqrtf(nrm), 1e-12f);
        }
#pragma unroll
        for (int ks = 0; ks < 4; ++ks) {
            float cum[8], lw0[8], kk1[8], aa[8], kpp[8], rr1[8];
#pragma unroll
            for (int gg = 0; gg < 2; ++gg) {
                const int g = 2 * ks + gg, k0 = 8 * g + 4 * h2;
                const f32x4 rr = unpk4(rw_[g]), ko = unpk4(kw_[g]), av = unpk4(aw_[g]), lw = unpk4(lw_[g]);
                const f32x4 kkw = *(const f32x4*)(k_k + hh * 64 + k0), kaw = *(const f32x4*)(k_a + hh * 64 + k0);
                const f32x4 kq = ko * kkw * inv, kp = ko * ((av - 1.0f) * kaw + 1.0f);
#pragma unroll
                for (int q = 0; q < 4; ++q) { cum[4 * gg + q] = lw[q]; lw0[4 * gg + q] = lw[q]; kk1[4 * gg + q] = kq[q]; aa[4 * gg + q] = av[q]; kpp[4 * gg + q] = kp[q]; rr1[4 * gg + q] = rr[q]; }
            }
#pragma unroll
            for (int d = 1; d < 32; d <<= 1) {
                const int src = ((lane - d) & 63) << 2;
#pragma unroll
                for (int e = 0; e < 8; ++e) { const float up = __builtin_bit_cast(float, __builtin_amdgcn_ds_bpermute(src, __builtin_bit_cast(int, cum[e]))); cum[e] += (t32 >= d) ? up : 0.f; }
            }
            if (t32 == 31) {
#pragma unroll
                for (int gg = 0; gg < 2; ++gg) *(LAS f32x4*)(wct + 8 * (2 * ks + gg) + 4 * h2) = (f32x4){__builtin_amdgcn_exp2f(cum[4 * gg]), __builtin_amdgcn_exp2f(cum[4 * gg + 1]), __builtin_amdgcn_exp2f(cum[4 * gg + 2]), __builtin_amdgcn_exp2f(cum[4 * gg + 3])};
            }
            float a_[8], b_[8], k_[8], r_[8];
#pragma unroll
            for (int e = 0; e < 8; ++e) {
                const float wt = __builtin_amdgcn_exp2f(cum[e]), wp = __builtin_amdgcn_exp2f(cum[e] - lw0[e]), iw = __builtin_amdgcn_exp2f(-cum[e]);
                a_[e] = -kk1[e] * wp; b_[e] = kk1[e] * aa[e] * iw; k_[e] = kpp[e] * iw; r_[e] = rr1[e] * wt;
            }
            v4u pa, pb, pk, pr;
            pa.x = cvtpk(a_[0], a_[1]); pa.y = cvtpk(a_[2], a_[3]); pa.z = cvtpk(a_[4], a_[5]); pa.w = cvtpk(a_[6], a_[7]);
            pb.x = cvtpk(b_[0], b_[1]); pb.y = cvtpk(b_[2], b_[3]); pb.z = cvtpk(b_[4], b_[5]); pb.w = cvtpk(b_[6], b_[7]);
            pk.x = cvtpk(k_[0], k_[1]); pk.y = cvtpk(k_[2], k_[3]); pk.z = cvtpk(k_[4], k_[5]); pk.w = cvtpk(k_[6], k_[7]);
            pr.x = cvtpk(r_[0], r_[1]); pr.y = cvtpk(r_[2], r_[3]); pr.z = cvtpk(r_[4], r_[5]); pr.w = cvtpk(r_[6], r_[7]);
#pragma unroll
            for (int gg = 0; gg < 2; ++gg) {
                const int k0 = 8 * (2 * ks + gg) + 4 * h2;
                *(LAS v2u*)(ldsA + t32 * 128 + k0 * 2) = gg == 0 ? (v2u){pa.x, pa.y} : (v2u){pa.z, pa.w};
                *(LAS v2u*)(ldsB + t32 * 128 + k0 * 2) = gg == 0 ? (v2u){pb.x, pb.y} : (v2u){pb.z, pb.w};
                *(LAS v2u*)(ldsK + t32 * 128 + k0 * 2) = gg == 0 ? (v2u){pk.x, pk.y} : (v2u){pk.z, pk.w};
            }
            if ((ks & 1) == 0) { fA[ks >> 1].f0 = __builtin_bit_cast(bf16x8, pa); fB[ks >> 1].f0 = __builtin_bit_cast(bf16x8, pb); fK[ks >> 1].f0 = __builtin_bit_cast(bf16x8, pk); fR[ks >> 1].f0 = __builtin_bit_cast(bf16x8, pr); }
            else { fA[ks >> 1].f1 = __builtin_bit_cast(bf16x8, pa); fB[ks >> 1].f1 = __builtin_bit_cast(bf16x8, pb); fK[ks >> 1].f1 = __builtin_bit_cast(bf16x8, pk); fR[ks >> 1].f1 = __builtin_bit_cast(bf16x8, pr); }
        }
        asm volatile("s_waitcnt lgkmcnt(0)" ::: "memory");
        PH pN, pNT, pAakT, pArbT, pArkT; f32x16 PT;
        {
#define KPROD(dst, fa, fb, keep) { f32x16 acc_ = tt(fa[1], fb[1], tt(fa[0], fb[0], zero16())); _Pragma("unroll") for (int r = 0; r < 16; ++r) { const int rowi = (r & 3) + 8 * (r >> 2) + 4 * h2; acc_[r] = (keep) ? acc_[r] : 0.f; } dst; __builtin_amdgcn_sched_barrier(0); }
            KPROD(pN = packh(acc_), fA, fB, t32 < rowi)
            KPROD(PT = ident16(lane) + acc_; pNT = packh(acc_), fB, fA, rowi < t32)
            KPROD(pAakT = packh(acc_), fK, fA, rowi < t32)
            KPROD(pArbT = packh(acc_), fB, fR, rowi <= t32)
            KPROD(pArkT = packh(acc_), fK, fR, rowi <= t32)
#undef KPROD
        }
        {
            PH X = pN, XT = pNT;
#pragma unroll
            for (int step = 0; step < 4; ++step) {
                const f32x16 x2 = tt(XT, X, zero16());
                if (step < 3) { const f32x16 xt2 = tt(X, XT, zero16()); XT = packh(xt2); }
                X = packh(x2);
                PT = tt(X, packh(PT), PT);
            }
        }
        const PH pPT = packh(PT);
        PH pAp[2], pUl[2];
#pragma unroll
        for (int nt = 0; nt < 2; ++nt) {
            pAp[nt] = packh(tt(pPT, colph(ldsA, nt, lane), zero16()));
            const PH x1 = packh(tt(pAakT, colph(ldsV, nt, lane), zero16()));
            pUl[nt] = packh(tt(pPT, x1, zero16()));
        }
        PH pRp[2]; f32x16 YlT[2];
#pragma unroll
        for (int mt = 0; mt < 2; ++mt) {
            f32x16 c0;
#pragma unroll
            for (int q = 0; q < 8; ++q) { c0[q] = bf2f((unsigned short)fR[mt].f0[q]); c0[8 + q] = bf2f((unsigned short)fR[mt].f1[q]); }
            pRp[mt] = packh(tt(pAp[mt], pArbT, c0));
            YlT[mt] = tt(colph(ldsV, mt, lane), pArkT, tt(pUl[mt], pArbT, zero16()));
        }
#pragma unroll
        for (int mt = 0; mt < 2; ++mt) {
            const f32x16 rpp = tt(Gh[1][mt], pRp[1], tt(Gh[0][mt], pRp[0], zero16()));
            if (!dry) store_rowgroups(AVg + rowoff + 32 * mt, rpp, h2); else asm volatile("" :: "v"(rpp));
            const f32x16 yl = tt(Hh[1][mt], pRp[1], tt(Hh[0][mt], pRp[0], YlT[mt]));
            if (!dry) store_rowgroups(LWg + rowoff + 32 * mt, yl, h2); else asm volatile("" :: "v"(yl));
        }
        lane = lane_in; asm volatile("" : "+v"(lane)); t32 = lane & 31; h2 = lane >> 5;
        PH pM[2][2];
#pragma unroll
        for (int mt = 0; mt < 2; ++mt)
#pragma unroll
            for (int nt = 0; nt < 2; ++nt) {
                f32x16 m = tt(pAp[mt], colph(ldsB, nt, lane), mt == nt ? ident16(lane) : zero16());
                const float wc = wct[32 * nt + t32];
#pragma unroll
                for (int r = 0; r < 16; ++r) m[r] *= wc;
                pM[mt][nt] = packh(m);
            }
#pragma unroll
        for (int nt = 0; nt < 2; ++nt) {
            PH gn[2], hn[2];
#pragma unroll
            for (int mt = 0; mt < 2; ++mt) {
                f32x16 hq = tt(colph(ldsK, mt, lane), colph(ldsV, nt, lane), tt(colph(ldsB, mt, lane), pUl[nt], zero16()));
#pragma unroll
                for (int g = 0; g < 4; ++g) { const f32x4 wc4 = *(const LAS f32x4*)(wct + 32 * mt + 8 * g + 4 * h2);
#pragma unroll
                    for (int q = 0; q < 4; ++q) hq[4 * g + q] *= wc4[q]; }
                hn[mt] = packh(tt(pM[1][mt], Hh[1][nt], tt(pM[0][mt], Hh[0][nt], hq)));
                gn[mt] = packh(tt(pM[1][mt], Gh[1][nt], tt(pM[0][mt], Gh[0][nt], zero16())));
            }
            Gh[0][nt] = gn[0]; Gh[1][nt] = gn[1]; Hh[0][nt] = hn[0]; Hh[1][nt] = hn[1];
        }
        asm volatile("s_waitcnt lgkmcnt(0)" ::: "memory");
    }
    lane = lane_in; asm volatile("" : "+v"(lane)); t32 = lane & 31; h2 = lane >> 5;
    unsigned char* outp = ws_ + (dry ? WS_ZS : WS_WKVS) + ((size_t)((b * 16 + hh) * 16 + sc)) * (dry ? 0 : 16384);
#pragma unroll
    for (int kt = 0; kt < 2; ++kt) {
#pragma unroll
        for (int mt = 0; mt < 2; ++mt) {
            const v4u w0 = __builtin_bit_cast(v4u, Gh[mt][kt].f0), w1 = __builtin_bit_cast(v4u, Gh[mt][kt].f1);
            LAS unsigned char* rowp = wl + 4096 * kt + t32 * 128 + (32 * mt + 4 * h2) * 2;
            *(LAS v2u*)(rowp + 0) = (v2u){w0.x, w0.y}; *(LAS v2u*)(rowp + 16) = (v2u){w0.z, w0.w}; *(LAS v2u*)(rowp + 32) = (v2u){w1.x, w1.y}; *(LAS v2u*)(rowp + 48) = (v2u){w1.z, w1.w};
        }
    }
    asm volatile("s_waitcnt lgkmcnt(0)" ::: "memory");
#pragma unroll
    for (int kt = 0; kt < 2; ++kt)
#pragma unroll
        for (int mt = 0; mt < 2; ++mt)
#pragma unroll
            for (int s = 0; s < 2; ++s) *(bf16x8*)(outp + ((size_t)((kt * 2 + mt) * 2 + s) * 64 + lane) * 16) = colfrag(wl + 4096 * kt, mt, s, lane);
#pragma unroll
    for (int mt = 0; mt < 2; ++mt)
#pragma unroll
        for (int nt = 0; nt < 2; ++nt) { *(bf16x8*)(outp + 8192 + ((size_t)((mt * 2 + nt) * 2 + 0) * 64 + lane) * 16) = Hh[mt][nt].f0; *(bf16x8*)(outp + 8192 + ((size_t)((mt * 2 + nt) * 2 + 1) * 64 + lane) * 16) = Hh[mt][nt].f1; }
    asm volatile("s_waitcnt lgkmcnt(0)" ::: "memory");
}
__device__ __forceinline__ void odd_wkv1_phase(const Ctx& F_, int li) {
    Ctx F = F_; F.lane = lane_id(); F.tid = F.wave * 64 + F.lane;
    unsigned char* const ws_ = kws();
    const int task = F.wg * NWAVES + F.wave;
    const int sc = task & 15, hh = (task >> 4) & 15, b = task >> 8;
#ifdef EXP_W1
    wkv1_task(ws_, kin(23) + li * 1024, kin(24) + li * 1024, kin(25) + li * 1024, li, b, hh, sc, F.lds + F.wave * 16384, (LAS float*)(F.lds + LDSCTL_OFF + LX_WC + F.wave * 256), F.lane, true);
#endif
    wkv1_task(ws_, kin(23) + li * 1024, kin(24) + li * 1024, kin(25) + li * 1024, li, b, hh, sc, F.lds + F.wave * 16384, (LAS float*)(F.lds + LDSCTL_OFF + LX_WC + F.wave * 256), F.lane);
}
__device__ __forceinline__ void odd_wkv2a_phase(const Ctx& F_) {
    Ctx F = F_; F.lane = lane_id(); F.tid = F.wave * 64 + F.lane;
    unsigned char* const ws_ = kws();
    if (F.wave != 0 || F.wg >= 128) return;
    const int lane = F.lane, b = F.wg >> 4, hh = F.wg & 15;
    f32x16 Z[2][2];
#pragma unroll
    for (int a = 0; a < 2; ++a)
#pragma unroll
        for (int c = 0; c < 2; ++c) Z[a][c] = zero16();
    const unsigned char* sp0 = ws_ + WS_WKVS + ((size_t)((b * 16 + hh) * 16)) * 16384; unsigned char* zp0 = ws_ + WS_ZS + ((size_t)((b * 16 + hh) * 16)) * 8192;
    bf16x8 mf[8], hf[8];
#pragma unroll
    for (int i = 0; i < 8; ++i) { mf[i] = *(const bf16x8*)(sp0 + ((size_t)i * 64 + lane) * 16); hf[i] = *(const bf16x8*)(sp0 + 8192 + ((size_t)i * 64 + lane) * 16); }
#pragma unroll 1
    for (int sc = 0; sc < 16; ++sc) {
        PH pZ[2][2];
#pragma unroll
        for (int a = 0; a < 2; ++a)
#pragma unroll
            for (int c = 0; c < 2; ++c) { pZ[a][c] = packh(Z[a][c]); *(bf16x8*)(zp0 + (size_t)sc * 8192 + ((size_t)((a * 2 + c) * 2 + 0) * 64 + lane) * 16) = pZ[a][c].f0; *(bf16x8*)(zp0 + (size_t)sc * 8192 + ((size_t)((a * 2 + c) * 2 + 1) * 64 + lane) * 16) = pZ[a][c].f1; }
        bf16x8 mn[8], hn[8]; const unsigned char* spn = sp0 + (size_t)(sc < 15 ? sc + 1 : sc) * 16384;
#pragma unroll
        for (int i = 0; i < 8; ++i) { mn[i] = *(const bf16x8*)(spn + ((size_t)i * 64 + lane) * 16); hn[i] = *(const bf16x8*)(spn + 8192 + ((size_t)i * 64 + lane) * 16); }
#pragma unroll
        for (int mt = 0; mt < 2; ++mt)
#pragma unroll
            for (int nt = 0; nt < 2; ++nt) {
                f32x16 c0;
#pragma unroll
                for (int q = 0; q < 8; ++q) { c0[q] = bf2f((unsigned short)hf[(mt * 2 + nt) * 2][q]); c0[8 + q] = bf2f((unsigned short)hf[(mt * 2 + nt) * 2 + 1][q]); }
#pragma unroll
                for (int kt = 0; kt < 2; ++kt) { PH m_; m_.f0 = mf[(kt * 2 + mt) * 2]; m_.f1 = mf[(kt * 2 + mt) * 2 + 1]; c0 = tt(m_, pZ[kt][nt], c0); }
                Z[mt][nt] = c0;
            }
#pragma unroll
        for (int i = 0; i < 8; ++i) { mf[i] = mn[i]; hf[i] = hn[i]; }
    }
}
__device__ __forceinline__ void odd_wkv2b_phase(const Ctx& F_, int li) {
    Ctx F = F_; F.lane = lane_id(); F.tid = F.wave * 64 + F.lane;
    unsigned char* const ws_ = kws();
    const int task = F.wg * NWAVES + F.wave, sc = task & 15, hh = (task >> 4) & 15, b = task >> 8;
    const int lane = F.lane, t32 = lane & 31, h2 = lane >> 5;
    const bf16_t* RPP = (const bf16_t*)(ws_ + WS_AV); const bf16_t* YL = (const bf16_t*)(ws_ + WS_WDEC); const bf16_t* Vg = odd_vbuf(ws_, li); const bf16_t* Gg = (const bf16_t*)(ws_ + WS_G);
    const float* RKg = (const float*)(ws_ + WS_SMALL + SM_RK); bf16_t* OA = (bf16_t*)(ws_ + WS_Y);
    const float* ln_w = kin(26) + li * 1024 + hh * 64; const float* ln_b = kin(27) + li * 1024 + hh * 64;
    const unsigned char* zp = ws_ + WS_ZS + ((size_t)((b * 16 + hh) * 16 + sc)) * 8192;
    PH pZ[2][2];
#pragma unroll
    for (int a = 0; a < 2; ++a)
#pragma unroll
        for (int c = 0; c < 2; ++c) { pZ[a][c].f0 = *(const bf16x8*)(zp + ((size_t)((a * 2 + c) * 2 + 0) * 64 + lane) * 16); pZ[a][c].f1 = *(const bf16x8*)(zp + ((size_t)((a * 2 + c) * 2 + 1) * 64 + lane) * 16); }
#pragma unroll 1
    for (int j = 0; j < 4; ++j) {
        const size_t trow = (size_t)b * S + sc * 128 + j * 32 + t32, rowoff = trow * D + hh * 64;
        PH rp[2];
#pragma unroll
        for (int kt = 0; kt < 2; ++kt) {
            const v2u a0 = *(const v2u*)(RPP + rowoff + 32 * kt + 4 * h2), a1 = *(const v2u*)(RPP + rowoff + 32 * kt + 8 + 4 * h2), a2 = *(const v2u*)(RPP + rowoff + 32 * kt + 16 + 4 * h2), a3 = *(const v2u*)(RPP + rowoff + 32 * kt + 24 + 4 * h2);
            rp[kt].f0 = __builtin_bit_cast(bf16x8, (v4u){a0.x, a0.y, a1.x, a1.y}); rp[kt].f1 = __builtin_bit_cast(bf16x8, (v4u){a2.x, a2.y, a3.x, a3.y});
        }
        f32x16 y[2];
#pragma unroll
        for (int mt = 0; mt < 2; ++mt) {
            f32x16 c0;
#pragma unroll
            for (int g = 0; g < 4; ++g) { const f32x4 q4 = unpk4(*(const v2u*)(YL + rowoff + 32 * mt + 8 * g + 4 * h2)); c0[4 * g] = q4.x; c0[4 * g + 1] = q4.y; c0[4 * g + 2] = q4.z; c0[4 * g + 3] = q4.w; }
            y[mt] = tt(pZ[1][mt], rp[1], tt(pZ[0][mt], rp[0], c0));
        }
        float s1 = 0.f;
#pragma unroll
        for (int mt = 0; mt < 2; ++mt)
#pragma unroll
            for (int r = 0; r < 16; ++r) s1 += y[mt][r];
        s1 = xor32_sum(s1);
        const float mean = s1 * (1.f / 64.f); float s2 = 0.f;
#pragma unroll
        for (int mt = 0; mt < 2; ++mt)
#pragma unroll
            for (int r = 0; r < 16; ++r) { const float dd = y[mt][r] - mean; s2 += dd * dd; }
        s2 = xor32_sum(s2);
        const float rstd = 1.0f / sqrtf(s2 * (1.f / 64.f) + 64e-5f), rk = RKg[trow * 16 + hh];
#pragma unroll
        for (int mt = 0; mt < 2; ++mt)
#pragma unroll
            for (int g = 0; g < 4; ++g) { const int c0 = 32 * mt + 8 * g + 4 * h2;
                const f32x4 vv = unpk4(*(const v2u*)(Vg + rowoff + c0)), gg = unpk4(*(const v2u*)(Gg + rowoff + c0)), lw = *(const f32x4*)(ln_w + c0), lb = *(const f32x4*)(ln_b + c0);
                const f32x4 yy = (f32x4){y[mt][4 * g], y[mt][4 * g + 1], y[mt][4 * g + 2], y[mt][4 * g + 3]};
                const f32x4 o = ((yy - mean) * rstd * lw + lb + vv * rk) * gg;
                *(v2u*)(OA + rowoff + c0) = pk4(o); }
    }
}
}
namespace fm {
__device__ __forceinline__ void ada_phase(const Ctx& F_) {
    Ctx F = F_; F.lane = lane_id(); F.tid = F.wave * 64 + F.lane;
    unsigned char* const ws_ = kws(); const float* c = kin(1); const float* ada_w = kin(2); const float* ada_b = kin(3);
    float* mod = (float*)(ws_ + WS_MOD);
    LAS float* cs = (LAS float*)F.lds;
    LAS float* part = (LAS float*)(F.lds + 32768);
    for (int i = F.tid; i < 8 * 1024; i += NTHREADS) { const float v = c[i]; cs[i] = v / (1.f + __expf(-v)); }
    __syncthreads();
#pragma unroll 1
    for (int task = F.wg; task < 8 * 48; task += F.G) {
        const int ls = task / 48, n0 = (task % 48) * 64;
        const float* W = ada_w + ((size_t)ls * 1024 + F.wave * 128) * 3072 + n0 + F.lane;
        float acc[8];
#pragma unroll
        for (int b = 0; b < 8; ++b) acc[b] = 0.f;
#pragma unroll 1
        for (int k0 = 0; k0 < 128; k0 += 16) {
            float w[16];
#pragma unroll
            for (int i = 0; i < 16; ++i) w[i] = W[(size_t)(k0 + i) * 3072];
#pragma unroll
            for (int i = 0; i < 16; ++i)
#pragma unroll
                for (int b = 0; b < 8; ++b) acc[b] += cs[b * 1024 + F.wave * 128 + k0 + i] * w[i];
        }
#pragma unroll
        for (int b = 0; b < 8; ++b) part[(F.wave * 8 + b) * 64 + F.lane] = acc[b];
        __syncthreads();
        { const int b = F.tid >> 6, l = F.tid & 63; float s = 0.f;
#pragma unroll
            for (int w8 = 0; w8 < 8; ++w8) s += part[(w8 * 8 + b) * 64 + l];
            mod[((size_t)ls * NB + b) * 3072 + n0 + l] = s + ada_b[ls * 3072 + n0 + l]; }
        __syncthreads();
    }
}
__device__ __forceinline__ void norm_phase(const Ctx& F_, int ls, int comb, const float* xsrc) {
    Ctx F = F_; F.lane = lane_id(); F.tid = F.wave * 64 + F.lane;
    unsigned char* const ws_ = kws(); float* const xo = kout(); const float* const mod_ = (const float*)(ws_ + WS_MOD);
    bf16_t* XN = (bf16_t*)(ws_ + WS_XN); const bf16_t* YS = (const bf16_t*)(ws_ + WS_YS);
    const int row0 = F.wg * 64 + F.wave * 8, b = row0 / S;
    const float* m = mod_ + ((size_t)ls * NB + b) * 3072;
    const float* gm = mod_ + ((size_t)(comb < 0 ? 0 : comb * 2 + 1) * NB + b) * 3072 + 2048;
    f32x4 vn[4]; v2u an[4], cn[4];
#pragma unroll
    for (int j = 0; j < 4; ++j) { vn[j] = ((const f32x4*)(xsrc + (size_t)row0 * D) + F.lane)[64 * j]; an[j] = (v2u){0u, 0u}; cn[j] = (v2u){0u, 0u}; }
    if (comb >= 0) {
#pragma unroll
        for (int j = 0; j < 4; ++j) { an[j] = ((const v2u*)(YS + (size_t)row0 * D) + F.lane)[64 * j]; cn[j] = ((const v2u*)(YS + ((size_t)T + row0) * D) + F.lane)[64 * j]; }
    }
#pragma unroll 1
    for (int r = 0; r < 8; ++r) {
        const int row = row0 + r, rown = row0 + (r < 7 ? r + 1 : r);
        f32x4 v[4]; v2u ya[4], yc[4]; float ss = 0.f;
#pragma unroll
        for (int j = 0; j < 4; ++j) { v[j] = vn[j]; ya[j] = an[j]; yc[j] = cn[j]; }
#pragma unroll
        for (int j = 0; j < 4; ++j) vn[j] = ((const f32x4*)(xsrc + (size_t)rown * D) + F.lane)[64 * j];
        if (comb >= 0) {
#pragma unroll
            for (int j = 0; j < 4; ++j) { an[j] = ((const v2u*)(YS + (size_t)rown * D) + F.lane)[64 * j]; cn[j] = ((const v2u*)(YS + ((size_t)T + rown) * D) + F.lane)[64 * j]; }
            f32x4* xw = (f32x4*)(xo + (size_t)row * D) + F.lane;
#pragma unroll
            for (int j = 0; j < 4; ++j) { const v2u a = ya[j], c = yc[j]; const f32x4 g = ((const f32x4*)gm)[64 * j + F.lane];
                v[j].x += g.x * (bflo(a.x) + bflo(c.x)); v[j].y += g.y * (bfhi(a.x) + bfhi(c.x)); v[j].z += g.z * (bflo(a.y) + bflo(c.y)); v[j].w += g.w * (bfhi(a.y) + bfhi(c.y));
                xw[64 * j] = v[j]; }
        }
#pragma unroll
        for (int j = 0; j < 4; ++j) ss += (v[j].x * v[j].x + v[j].y * v[j].y) + (v[j].z * v[j].z + v[j].w * v[j].w);
        const float rinv = 1.0f / sqrtf(wave_sum(ss) * (1.f / D) + 1e-6f);
        unsigned long long* o8 = (unsigned long long*)(XN + (size_t)row * D) + F.lane;
#pragma unroll
        for (int j = 0; j < 4; ++j) {
            const f32x4 sh = ((const f32x4*)m)[64 * j + F.lane], sc = ((const f32x4*)(m + 1024))[64 * j + F.lane];
            const f32x4 h = v[j] * rinv * (sc + 1.0f) + sh;
            o8[64 * j] = (unsigned long long)pk2(h.x, h.y) | ((unsigned long long)pk2(h.z, h.w) << 32);
        }
    }
}
__device__ __forceinline__ void final_phase(const Ctx& F_) {
    Ctx F = F_; F.lane = lane_id(); F.tid = F.wave * 64 + F.lane;
    unsigned char* const ws_ = kws(); float* const xo = kout(); const float* const mod_ = (const float*)(ws_ + WS_MOD); const float* fg = kin(33);
    const bf16_t* YS = (const bf16_t*)(ws_ + WS_YS);
    const int row0 = F.wg * 64 + F.wave * 8, b = row0 / S;
    const float* gm = mod_ + ((size_t)(3 * 2 + 1) * NB + b) * 3072 + 2048;
#pragma unroll 1
    for (int r = 0; r < 8; ++r) {
        const int row = row0 + r;
        f32x4* xr = (f32x4*)(xo + (size_t)row * D) + F.lane;
        const v2u* y0 = (const v2u*)(YS + (size_t)row * D) + F.lane; const v2u* y1 = (const v2u*)(YS + ((size_t)T + row) * D) + F.lane;
        f32x4 v[4]; float ss = 0.f;
#pragma unroll
        for (int j = 0; j < 4; ++j) { v[j] = xr[64 * j]; const v2u a = y0[64 * j], c = y1[64 * j]; const f32x4 g = ((const f32x4*)gm)[64 * j + F.lane];
            v[j].x += g.x * (bflo(a.x) + bflo(c.x)); v[j].y += g.y * (bfhi(a.x) + bfhi(c.x)); v[j].z += g.z * (bflo(a.y) + bflo(c.y)); v[j].w += g.w * (bfhi(a.y) + bfhi(c.y));
            ss += (v[j].x * v[j].x + v[j].y * v[j].y) + (v[j].z * v[j].z + v[j].w * v[j].w); }
        const float rinv = 1.0f / sqrtf(wave_sum(ss) * (1.f / D) + 1e-6f);
#pragma unroll
        for (int j = 0; j < 4; ++j) xr[64 * j] = v[j] * rinv * ((const f32x4*)fg)[64 * j + F.lane];
    }
}
}
struct Args { const float* in[34]; float* out; unsigned char* ws; };
__global__ void __launch_bounds__(NTHREADS, 2) mega_fwd(Args args) {
    (void)args;
    extern __shared__ __attribute__((aligned(16))) unsigned char lds[];
    LAS unsigned char* L = (LAS unsigned char*)lds;
    for (int u = threadIdx.x; u < (LDS_BYTES - LDSCTL_OFF) / 4; u += NTHREADS) ((LAS unsigned*)(L + LDSCTL_OFF))[u] = 0u;
    __syncthreads();
    (void)xcd_barrier_post((unsigned*)(kws() + fm::WS_CTL), (volatile LAS unsigned*)(L + MISC_OFF) + 8);
    fm::Ctx F; F.lds = L; F.tid = 0; F.lane = 0; F.wave = __builtin_amdgcn_readfirstlane((int)threadIdx.x >> 6);
    F.G = gridDim.x; F.wg = blockIdx.x; F.vcu = (F.G % 8 == 0) ? (F.wg % 8) * (F.G / 8) + F.wg / 8 : F.wg;
#define GRID_BAR() do { XcdBarrier b_; b_.bar = (unsigned*)(kws() + fm::WS_CTL); b_.x = (unsigned)__builtin_amdgcn_readfirstlane((int)xb_xcc_id()); b_.st = (volatile LAS unsigned*)(L + MISC_OFF) + 8; b_.leader = (F.wave == 0) && (fm::lane_id() == 0); xcd_barrier(b_); } while (0)
    fm::ada_phase(F);
    fm::even_convert_weights(F, 0); fm::even_convert_weights(F, 1);
    fm::odd_convert_weights(F, 0); fm::odd_convert_weights(F, 1);
    GRID_BAR();
#pragma unroll 1
    for (int layer = 0; layer < 4; ++layer) {
        const float* xsrc = layer == 0 ? kin(0) : (const float*)kout();
        fm::moe_convert_weights(F, kin(30), kin(31), kin(32), layer);
        __syncthreads();
        fm::norm_phase(F, layer * 2, layer - 1, xsrc); GRID_BAR();
        if (layer % 2 == 0) {
            fm::even_inproj_phase(F, layer / 2); GRID_BAR();
            fm::even_mix_phase(F, layer / 2); GRID_BAR();
            fm::even_outproj_phase(F, layer, xsrc); GRID_BAR();
        } else {
            const int li = layer / 2;
            fm::odd_mix_phase<3>(F, li, 0, 2, 3, 0); GRID_BAR();
            fm::odd_gemm_rkv_phase(F, li); GRID_BAR();
            fm::odd_mix_phase<4>(F, li, 1, 4, 5, 3); GRID_BAR();
            fm::odd_gemm_loradown_phase(F, li); GRID_BAR();
            fm::odd_gemm_loraup_phase(F, li); GRID_BAR();
            fm::odd_wkv1_phase(F, li); GRID_BAR();
            fm::odd_wkv2a_phase(F); GRID_BAR();
            fm::odd_wkv2b_phase(F, li); GRID_BAR();
            fm::odd_gemm_wo_phase(F, layer); GRID_BAR();
        }
        fm::moe_route_phase(F, kin(28), kin(29), layer); GRID_BAR();
        fm::moe_sort_phase(F); GRID_BAR();
        fm::moe_gemm1_phase(F); GRID_BAR();
        fm::moe_gemm2_phase(F); GRID_BAR();
    }
    fm::final_phase(F);
}
extern "C" void kernel_launch(void* const* d_in, const int* in_sizes, int n_in, void* d_out, int out_size, void* d_ws, size_t ws_size, hipStream_t stream) {
    (void)in_sizes; (void)out_size;
    static int grid = 0;
    if (grid == 0) {
        int dev = 0, cus = 0, per_cu = 0;
        hipGetDevice(&dev); hipDeviceGetAttribute(&cus, hipDeviceAttributeMultiprocessorCount, dev);
        hipFuncSetAttribute((const void*)mega_fwd, hipFuncAttributeMaxDynamicSharedMemorySize, LDS_BYTES);
        hipOccupancyMaxActiveBlocksPerMultiprocessor(&per_cu, (const void*)mega_fwd, NTHREADS, LDS_BYTES);
        (void)hipGetLastError();
        grid = 256;
        if (per_cu < 1) fprintf(stderr, "kernel_launch: occupancy query says %d blocks/CU\n", per_cu);
        if (cus < 256 || n_in != 34 || ws_size < fm::WS_END) { fprintf(stderr, "kernel_launch: unexpected cus %d / n_in %d / ws %zu\n", cus, n_in, ws_size); grid = -1; }
    }
    if (grid < 0) return;
    hipMemsetAsync((char*)d_ws + fm::WS_CTL, 0, fm::CTL_ZERO_BYTES, stream);
    Args a{};
    for (int i = 0; i < 34; ++i) a.in[i] = (const float*)d_in[i];
    a.out = (float*)d_out; a.ws = (unsigned char*)d_ws;
    void* kargs[] = {&a};
    hipError_t e = hipLaunchCooperativeKernel((const void*)mega_fwd, dim3(grid), dim3(NTHREADS), kargs, LDS_BYTES, stream);
    if (e != hipSuccess) fprintf(stderr, "cooperative launch failed: %s (grid %d)\n", hipGetErrorString(e), grid);
}
```
